# Optimizing an MI355X kernel written in HIP

```python
import jax
import jax.numpy as jnp
from jax import lax
import numpy as np

D_MODEL = 1024
BATCH = 8
SEQ = 4096
DEPTH = 2

CTX_LEN = 256
GRID_W = 64

BRANCH_WIDTH = 512
N_BRANCH = 3

POOL_WINDOWS = (2, 4, 8, 16)
POOL_WIDTH = BRANCH_WIDTH
POOL_GROUP = POOL_WIDTH // len(POOL_WINDOWS)

N_Q_HEADS = 8
N_KV_HEADS = 2
HEAD_DIM = 64
GQA_GROUP = N_Q_HEADS // N_KV_HEADS
Q_WIDTH = N_Q_HEADS * HEAD_DIM
KV_WIDTH = N_KV_HEADS * HEAD_DIM
Q_BLOCK = 128
ROPE_THETA = 10000.0
ATTN_SCALE = HEAD_DIM ** -0.5

LRU_WIDTH = BRANCH_WIDTH
LRU_BLOCKS = 8
LRU_BLOCK_DIM = LRU_WIDTH // LRU_BLOCKS
CONV_WIDTH = 4
RG_C = 8.0

OFF_Q = POOL_WIDTH
OFF_K = OFF_Q + Q_WIDTH
OFF_V = OFF_K + KV_WIDTH
OFF_LX = OFF_V + KV_WIDTH
OFF_LG = OFF_LX + LRU_WIDTH
OFF_GATE = OFF_LG + LRU_WIDTH
W_IN = OFF_GATE + N_BRANCH * D_MODEL
SPLITS = (OFF_Q, OFF_K, OFF_V, OFF_LX, OFF_LG, OFF_GATE)

D_FF = 2816
N_EXPERTS = 8
TOP_K = 2
D_EXPERT = 3584
EXPERT_BLOCK = 256
N_DENSE = (DEPTH + 1) // 2
N_MOE = DEPTH // 2

ALPHA = (2 * DEPTH) ** 0.25
BETA = (8 * DEPTH) ** -0.25
LN_EPS = 1e-5
RMS_EPS = 1e-6
F32 = jnp.float32

kernel_name = 'hybrid_pool_gqa_rglru_moe_dit'


def layer_norm(x, g, b):
    xf = x.astype(F32)
    mu = jnp.mean(xf, axis=-1, keepdims=True)
    var = jnp.mean(jnp.square(xf - mu), axis=-1, keepdims=True)
    return ((xf - mu) * lax.rsqrt(var + LN_EPS) * g.astype(F32) + b.astype(F32)).astype(x.dtype)


def rms_norm(x, g):
    xf = x.astype(F32)
    return (xf * lax.rsqrt(jnp.mean(xf * xf, axis=-1, keepdims=True) + RMS_EPS) * g.astype(F32)).astype(x.dtype)


def axial_rope(x, row_pos, col_pos):
    half = HEAD_DIM // 2
    nf = half // 2
    inv = ROPE_THETA ** (-jnp.arange(nf, dtype=F32) / nf)
    xf = x.astype(F32)

    def rotate(xa, pos):
        ang = pos[:, None] * inv
        cos = jnp.cos(ang)[None, :, None, :]
        sin = jnp.sin(ang)[None, :, None, :]
        x1, x2 = xa[..., :nf], xa[..., nf:]
        return jnp.concatenate([x1 * cos - x2 * sin, x2 * cos + x1 * sin], axis=-1)

    out = jnp.concatenate([rotate(xf[..., :half], row_pos), rotate(xf[..., half:], col_pos)], axis=-1)
    return out.astype(x.dtype)


def attend(q, k, v):
    B, Lq = q.shape[:2]
    qg = q.reshape(B, Lq, N_KV_HEADS, GQA_GROUP, HEAD_DIM)
    s = jnp.einsum('bqhgd,bkhd->bhgqk', qg, k, preferred_element_type=F32) * ATTN_SCALE
    p = jax.nn.softmax(s, axis=-1).astype(v.dtype)
    o = jnp.einsum('bhgqk,bkhd->bqhgd', p, v)
    return o.reshape(B, Lq, Q_WIDTH)


def blocked_attention(q, k, v):
    B, S = q.shape[:2]
    nb = S // Q_BLOCK
    qb = jnp.moveaxis(q.reshape(B, nb, Q_BLOCK, N_Q_HEADS, HEAD_DIM), 1, 0)
    ob = lax.map(lambda qq: attend(qq, k, v), qb)
    return jnp.moveaxis(ob, 0, 1).reshape(B, S, Q_WIDTH)


def multiscale_pool(x, pool_w, pool_scale):
    B, L, _ = x.shape
    xf = x.astype(F32)
    cs = jnp.concatenate([jnp.zeros((B, 1, POOL_WIDTH), F32), jnp.cumsum(xf, axis=1)], axis=1)
    t = jnp.arange(L)
    outs = []
    for g, w in enumerate(POOL_WINDOWS):
        lo = w // 2
        start = jnp.clip(t - lo, 0, L)
        end = jnp.clip(t - lo + w, 0, L)
        sl = slice(g * POOL_GROUP, (g + 1) * POOL_GROUP)
        csg = cs[..., sl]
        mean = (jnp.take(csg, end, axis=1) - jnp.take(csg, start, axis=1)) / (end - start).astype(F32)[None, :, None]
        outs.append(jnp.einsum('blc,cd->bld', (mean - xf[..., sl]).astype(x.dtype), pool_w[g]))
    return jnp.concatenate(outs, axis=-1) * pool_scale


def centred_dwconv(x, w, b):
    L = x.shape[1]
    lo = CONV_WIDTH // 2
    hi = CONV_WIDTH - 1 - lo
    xp = jnp.pad(x, ((0, 0), (lo, hi), (0, 0)))
    return sum(xp[:, k:k + L] * w[k] for k in range(CONV_WIDTH)) + b


def _lin_combine(left, right):
    a1, b1 = left
    a2, b2 = right
    return a1 * a2, a2 * b1 + b2


def rglru(x, wa, ba, wx, bx, lam, h0, reverse):
    B, L, _ = x.shape
    xb = x.reshape(B, L, LRU_BLOCKS, LRU_BLOCK_DIM)
    r = jax.nn.sigmoid(jnp.einsum('blhi,hij->blhj', xb, wa).reshape(B, L, LRU_WIDTH).astype(F32) + ba.astype(F32))
    i = jax.nn.sigmoid(jnp.einsum('blhi,hij->blhj', xb, wx).reshape(B, L, LRU_WIDTH).astype(F32) + bx.astype(F32))
    log_a = -RG_C * r * jax.nn.softplus(-lam.astype(F32))
    a = jnp.exp(log_a)
    u = jnp.sqrt(-jnp.expm1(2.0 * log_a)) * i * x.astype(F32)
    if h0 is not None:
        edge = -1 if reverse else 0
        u = u.at[:, edge].add(a[:, edge] * h0)
    _, h = lax.associative_scan(_lin_combine, (a, u), reverse=reverse, axis=1)
    return h


def merge_branches(pool_y, attn_y, lru_y, gates, w_branch, w_out):
    ys = jnp.stack([pool_y, attn_y, lru_y], axis=2)
    branch = jnp.einsum('blnc,ncd->blnd', ys, w_branch)
    return jnp.sum(gates.astype(branch.dtype) * branch, axis=2) @ w_out


def token_mixer(h_ctx, h_lat, row_pos, col_pos, w_in, b_merge, pool_w, pool_scale, q_norm, k_norm,
                conv_w, conv_b, lru_wa, lru_ba, lru_wx, lru_bx, lru_lambda, w_branch, w_out, need_ctx):
    dtype = h_lat.dtype

    def project(h):
        B, L, _ = h.shape
        z = h @ w_in
        p_in, q, k, v, lx, lg, gz = jnp.split(z, SPLITS, axis=-1)
        q = rms_norm(q.reshape(B, L, N_Q_HEADS, HEAD_DIM), q_norm)
        k = rms_norm(k.reshape(B, L, N_KV_HEADS, HEAD_DIM), k_norm)
        v = v.reshape(B, L, N_KV_HEADS, HEAD_DIM)
        lx = centred_dwconv(lx, conv_w, conv_b)
        gates = jax.nn.sigmoid(gz.reshape(B, L, N_BRANCH, D_MODEL).astype(F32) + b_merge.astype(F32))
        return p_in, q, k, v, lx, lg, gates

    p_c, q_c, k_c, v_c, lx_c, lg_c, g_c = project(h_ctx)
    p_l, q_l, k_l, v_l, lx_l, lg_l, g_l = project(h_lat)

    q_l = axial_rope(q_l, row_pos, col_pos)
    k_l = axial_rope(k_l, row_pos, col_pos)
    k_all = jnp.concatenate([k_c, k_l], axis=1)
    v_all = jnp.concatenate([v_c, v_l], axis=1)
    attn_l = blocked_attention(q_l, k_all, v_all)

    h_cf = rglru(lx_c, lru_wa[0], lru_ba[0], lru_wx[0], lru_bx[0], lru_lambda[0], None, False)
    h_cb = rglru(lx_c, lru_wa[1], lru_ba[1], lru_wx[1], lru_bx[1], lru_lambda[1], None, True)
    h_lf = rglru(lx_l, lru_wa[0], lru_ba[0], lru_wx[0], lru_bx[0], lru_lambda[0], h_cf[:, -1], False)
    h_lb = rglru(lx_l, lru_wa[1], lru_ba[1], lru_wx[1], lru_bx[1], lru_lambda[1], h_cb[:, 0], True)
    lru_l = ((h_lf + h_lb) * jax.nn.gelu(lg_l.astype(F32))).astype(dtype)

    y_lat = merge_branches(multiscale_pool(p_l, pool_w, pool_scale), attn_l, lru_l, g_l, w_branch, w_out)
    if need_ctx:
        attn_c = attend(q_c, k_c, v_c)
        lru_c = ((h_cf + h_cb) * jax.nn.gelu(lg_c.astype(F32))).astype(dtype)
        y_ctx = merge_branches(multiscale_pool(p_c, pool_w, pool_scale), attn_c, lru_c, g_c, w_branch, w_out)
    else:
        y_ctx = None
    return y_ctx, y_lat


def swiglu(x, w_gate, w_up, w_down):
    return (jax.nn.silu(x @ w_gate) * (x @ w_up)) @ w_down


def moe_swiglu(t, router, router_b, w_gate, w_up, w_down):
    N, D = t.shape
    logits = (t @ router + router_b).astype(F32)
    top_v, top_i = lax.top_k(logits, TOP_K)
    probs = jax.nn.softmax(top_v, axis=-1)
    M = N * TOP_K
    flat_e = top_i.reshape(M)
    order = jnp.argsort(flat_e)
    sorted_e = flat_e[order]
    sorted_tok = order // TOP_K
    sorted_p = probs.reshape(M)[order]
    counts = jnp.bincount(flat_e, length=N_EXPERTS)
    padded = (counts + EXPERT_BLOCK - 1) // EXPERT_BLOCK * EXPERT_BLOCK
    start = jnp.cumsum(counts) - counts
    ends_p = jnp.cumsum(padded)
    start_p = ends_p - padded
    dest = start_p[sorted_e] + jnp.arange(M) - start[sorted_e]
    n_blocks = -(-(M + N_EXPERTS * (EXPERT_BLOCK - 1)) // EXPERT_BLOCK)
    P = n_blocks * EXPERT_BLOCK
    buf_tok = jnp.full((P,), N, jnp.int32).at[dest].set(sorted_tok.astype(jnp.int32))
    buf_p = jnp.zeros((P,), F32).at[dest].set(sorted_p)
    block_e = jnp.minimum(jnp.searchsorted(ends_p, jnp.arange(n_blocks) * EXPERT_BLOCK, side='right'), N_EXPERTS - 1)
    t_pad = jnp.concatenate([t, jnp.zeros((1, D), t.dtype)], axis=0)
    xb = t_pad[buf_tok].reshape(n_blocks, EXPERT_BLOCK, D)

    def expert_block(args):
        xe, e = args
        return swiglu(xe, w_gate[e], w_up[e], w_down[e])

    yb = lax.map(expert_block, (xb, block_e))
    y = yb.reshape(P, D) * buf_p[:, None].astype(t.dtype)
    return jnp.zeros((N + 1, D), t.dtype).at[buf_tok].add(y)[:N]


def setup_inputs(seed: int = 0) -> dict:
    key = jax.random.key(seed)
    ks = jax.random.split(key, 40)

    def nrm(i, shape, scale):
        return jax.random.normal(ks[i], shape, F32) * scale

    u = jax.random.uniform(ks[30], (DEPTH, 2, LRU_WIDTH), F32, 0.9, 0.999)
    a0 = u ** (1.0 / RG_C)
    lru_lambda = jnp.log(a0) - jnp.log1p(-a0)
    return {
        'x': nrm(0, (BATCH, SEQ, D_MODEL), 1.0),
        'c': nrm(1, (BATCH, D_MODEL), 1.0),
        'ctx': nrm(2, (BATCH, CTX_LEN, D_MODEL), 1.0),
        'c_ctx': nrm(3, (D_MODEL,), 1.0),
        'w_mod': nrm(4, (DEPTH, D_MODEL, 6 * D_MODEL), 0.5 * D_MODEL ** -0.5),
        'b_mod': nrm(5, (DEPTH, 6 * D_MODEL), 0.02),
        'w_in': nrm(6, (DEPTH, D_MODEL, W_IN), D_MODEL ** -0.5),
        'b_merge': nrm(7, (DEPTH, N_BRANCH, D_MODEL), 0.1),
        'pool_w': nrm(8, (DEPTH, len(POOL_WINDOWS), POOL_GROUP, POOL_GROUP), POOL_GROUP ** -0.5),
        'pool_scale': 1.0 + nrm(9, (DEPTH, POOL_WIDTH), 0.1),
        'q_norm': 1.0 + nrm(10, (DEPTH, HEAD_DIM), 0.1),
        'k_norm': 1.0 + nrm(11, (DEPTH, HEAD_DIM), 0.1),
        'conv_w': nrm(12, (DEPTH, CONV_WIDTH, LRU_WIDTH), CONV_WIDTH ** -0.5),
        'conv_b': nrm(13, (DEPTH, LRU_WIDTH), 0.02),
        'lru_wa': nrm(14, (DEPTH, 2, LRU_BLOCKS, LRU_BLOCK_DIM, LRU_BLOCK_DIM), LRU_BLOCK_DIM ** -0.5),
        'lru_ba': nrm(15, (DEPTH, 2, LRU_WIDTH), 0.1),
        'lru_wx': nrm(16, (DEPTH, 2, LRU_BLOCKS, LRU_BLOCK_DIM, LRU_BLOCK_DIM), LRU_BLOCK_DIM ** -0.5),
        'lru_bx': nrm(17, (DEPTH, 2, LRU_WIDTH), 0.1),
        'lru_lambda': lru_lambda,
        'w_branch': nrm(18, (DEPTH, N_BRANCH, BRANCH_WIDTH, D_MODEL), BRANCH_WIDTH ** -0.5),
        'w_out': nrm(19, (DEPTH, D_MODEL, D_MODEL), BETA * D_MODEL ** -0.5),
        'ln1_g': 1.0 + nrm(20, (DEPTH, D_MODEL), 0.1),
        'ln1_b': nrm(21, (DEPTH, D_MODEL), 0.02),
        'ffn_w_gate': nrm(22, (N_DENSE, D_MODEL, D_FF), D_MODEL ** -0.5),
        'ffn_w_up': nrm(23, (N_DENSE, D_MODEL, D_FF), D_MODEL ** -0.5),
        'ffn_w_down': nrm(24, (N_DENSE, D_FF, D_MODEL), BETA * D_FF ** -0.5),
        'moe_router': nrm(25, (N_MOE, D_MODEL, N_EXPERTS), D_MODEL ** -0.5),
        'moe_router_b': nrm(26, (N_MOE, N_EXPERTS), 0.01),
        'moe_w_gate': nrm(27, (N_MOE, N_EXPERTS, D_MODEL, D_EXPERT), D_MODEL ** -0.5),
        'moe_w_up': nrm(28, (N_MOE, N_EXPERTS, D_MODEL, D_EXPERT), D_MODEL ** -0.5),
        'moe_w_down': nrm(29, (N_MOE, N_EXPERTS, D_EXPERT, D_MODEL), BETA * D_EXPERT ** -0.5),
        'ln2_g': 1.0 + nrm(31, (DEPTH, D_MODEL), 0.1),
        'ln2_b': nrm(32, (DEPTH, D_MODEL), 0.02),
    }


def reference(x, c, ctx, c_ctx, w_mod, b_mod, w_in, b_merge, pool_w, pool_scale, q_norm, k_norm,
              conv_w, conv_b, lru_wa, lru_ba, lru_wx, lru_bx, lru_lambda, w_branch, w_out, ln1_g, ln1_b,
              ffn_w_gate, ffn_w_up, ffn_w_down, moe_router, moe_router_b, moe_w_gate, moe_w_up, moe_w_down,
              ln2_g, ln2_b):
    B, S, D = x.shape
    rows = S // GRID_W
    row_pos = jnp.repeat(jnp.arange(rows, dtype=F32), GRID_W)
    col_pos = jnp.tile(jnp.arange(GRID_W, dtype=F32), rows)
    x_lat, x_ctx = x, ctx
    for l in range(DEPTH):
        last = l == DEPTH - 1
        m_lat = jnp.split((jax.nn.silu(c) @ w_mod[l] + b_mod[l])[:, None, :], 6, axis=-1)
        m_ctx = jnp.split(jax.nn.silu(c_ctx) @ w_mod[l] + b_mod[l], 6, axis=-1)

        h_lat = x_lat * (1 + m_lat[1]) + m_lat[0]
        h_ctx = x_ctx * (1 + m_ctx[1]) + m_ctx[0]
        y_ctx, y_lat = token_mixer(h_ctx, h_lat, row_pos, col_pos, w_in[l], b_merge[l], pool_w[l], pool_scale[l],
                                   q_norm[l], k_norm[l], conv_w[l], conv_b[l], lru_wa[l], lru_ba[l], lru_wx[l],
                                   lru_bx[l], lru_lambda[l], w_branch[l], w_out[l], not last)
        x_lat = layer_norm(ALPHA * x_lat + m_lat[2] * y_lat, ln1_g[l], ln1_b[l])
        if not last:
            x_ctx = layer_norm(ALPHA * x_ctx + m_ctx[2] * y_ctx, ln1_g[l], ln1_b[l])

        h2_lat = x_lat * (1 + m_lat[4]) + m_lat[3]
        if last:
            tokens = h2_lat.reshape(B * S, D)
        else:
            h2_ctx = x_ctx * (1 + m_ctx[4]) + m_ctx[3]
            tokens = jnp.concatenate([h2_ctx.reshape(-1, D), h2_lat.reshape(B * S, D)], axis=0)
        if l % 2 == 0:
            j = l // 2
            f = swiglu(tokens, ffn_w_gate[j], ffn_w_up[j], ffn_w_down[j])
        else:
            j = l // 2
            f = moe_swiglu(tokens, moe_router[j], moe_router_b[j], moe_w_gate[j], moe_w_up[j], moe_w_down[j])
        n_ctx_tok = tokens.shape[0] - B * S
        x_lat = layer_norm(ALPHA * x_lat + m_lat[5] * f[n_ctx_tok:].reshape(B, S, D), ln2_g[l], ln2_b[l])
        if not last:
            f_ctx = f[:n_ctx_tok].reshape(x_ctx.shape)
            x_ctx = layer_norm(ALPHA * x_ctx + m_ctx[5] * f_ctx, ln2_g[l], ln2_b[l])
    return x_lat
```

```cpp
#include <hip/hip_runtime.h>
#include <stdint.h>
#include <stddef.h>

typedef _Float16 h16;
typedef _Float16 h16x2 __attribute__((ext_vector_type(2)));
typedef _Float16 h16x4 __attribute__((ext_vector_type(4)));
typedef _Float16 h16x8 __attribute__((ext_vector_type(8)));

constexpr int D = 1024, NB = 8, SEQ = 4096, CTX = 256, SB = CTX + SEQ;
constexpr int MC = NB * CTX, ML = NB * SEQ, MT = MC + ML;
constexpr int WIN = 5376, ZW = 2304, AW = 2560;
constexpr int DFF = 2816, NE = 8, DEX = 3584;
constexpr int PMAX = 264 * 256;
constexpr float ALPHA = 1.41421356237309515f;
constexpr float QSCALE = 0.125f * 1.4426950408889634f;
constexpr int ZP = 0, ZQ = 512, ZK = 1024, ZV = 1152, ZLX = 1280, ZLG = 1792;
constexpr int AH = 0, AY0 = 1024, AY1 = 1536, AY2 = 2048;

constexpr size_t al256(size_t x) { return (x + 255) & ~(size_t)255; }
constexpr size_t OFF_BAR = 0;
constexpr size_t OFF_MOD = 16384;
constexpr size_t OFF_CNT = OFF_MOD + al256((size_t)2 * 9 * 6144 * 4);
constexpr size_t OFF_PLAN = OFF_CNT + 256;
constexpr size_t OFF_TOKE = OFF_PLAN + 2048;
constexpr size_t OFF_TOKP = OFF_TOKE + (size_t)ML * 2 * 4;
constexpr size_t OFF_TOKR = OFF_TOKP + (size_t)ML * 2 * 4;
constexpr size_t OFF_ROWT = OFF_TOKR + (size_t)ML * 2 * 4;
constexpr size_t OFF_ROWP = OFF_ROWT + (size_t)PMAX * 4;
constexpr size_t OFF_TBL_END = OFF_ROWP + (size_t)PMAX * 4;
constexpr size_t OFF_X = (size_t)8 << 20;
constexpr size_t OFF_A = OFF_X + (size_t)MT * D * 4;
constexpr size_t OFF_BIG = OFF_A + (size_t)MT * AW * 2;
static_assert(OFF_TBL_END <= OFF_X, "tables");
constexpr size_t OFF_Z = OFF_BIG;
constexpr size_t OFF_QH = OFF_Z + (size_t)MT * ZW * 2;
constexpr size_t OFF_KH = OFF_QH + (size_t)MT * 512 * 2;
constexpr size_t OFF_VH = OFF_KH + (size_t)NB * SB * 128 * 2;
constexpr size_t OFF_W16 = OFF_VH + (size_t)NB * SB * 128 * 2;
constexpr size_t SZ_WINT = (size_t)ZW * 1024 * 2, SZ_BTALL = (size_t)3072 * 1536 * 2, SZ_WOUTT = (size_t)1024 * 1024 * 2;
constexpr size_t SZ_LAYERW = SZ_WINT + SZ_BTALL + SZ_WOUTT;
constexpr size_t OFF_WGUT = OFF_W16 + 2 * SZ_LAYERW;
constexpr size_t OFF_WDT = OFF_WGUT + (size_t)2 * DFF * 1024 * 2;
constexpr size_t OFF_W16_END = OFF_WDT + (size_t)1024 * DFF * 2;
constexpr size_t OFF_ACT = OFF_BIG;
static_assert(OFF_ACT + (size_t)MT * DFF * 2 <= OFF_W16, "ACT overlay");
constexpr size_t OFF_WMOE_GU = OFF_BIG;
constexpr size_t OFF_WMOE_D = OFF_WMOE_GU + (size_t)NE * 2 * DEX * 1024 * 2;
constexpr size_t OFF_XG = OFF_WMOE_D + (size_t)NE * 1024 * DEX * 2;
constexpr size_t WS_NEED = OFF_XG + (size_t)PMAX * 1024 * 2;
static_assert(WS_NEED <= 646673440ull, "workspace budget");
static_assert(OFF_W16_END <= WS_NEED, "w16");
constexpr size_t OFF_OUT2 = OFF_A;
static_assert((size_t)2 * ML * 1024 * 2 <= (size_t)MT * AW * 2, "OUT2 overlay");
static_assert((size_t)64 * 256 * DEX * 2 <= (size_t)ML * D * 4, "ACTe chunk in d_out");

struct Params {
    const float *x, *c, *ctx, *c_ctx, *w_mod, *b_mod, *w_in, *b_merge, *pool_w, *pool_scale, *q_norm, *k_norm, *conv_w, *conv_b,
        *lru_wa, *lru_ba, *lru_wx, *lru_bx, *lru_lambda, *w_branch, *w_out, *ln1_g, *ln1_b, *ffn_w_gate, *ffn_w_up, *ffn_w_down,
        *moe_router, *moe_router_b, *moe_w_gate, *moe_w_up, *moe_w_down, *ln2_g, *ln2_b;
    float* out;
    char* ws;
};
#define WSP(T, off) ((T*)(p.ws + (off)))

__device__ __forceinline__ int row_group(int r) { return r < MC ? 0 : 1 + ((r - MC) >> 12); }
__device__ __forceinline__ void row_seq(int r, int& s0, int& len, int& pos) {
    if (r < MC) { s0 = r & ~255; len = 256; pos = r & 255; } else { const int q = r - MC; s0 = MC + (q & ~4095); len = 4096; pos = q & 4095; }
}
__device__ __forceinline__ const float* xin_row(const Params& p, int r) { return r < MC ? p.ctx + (size_t)r * D : p.x + (size_t)(r - MC) * D; }
__device__ __forceinline__ float sigmoidf_(float x) { return 1.0f / (1.0f + __expf(-x)); }
__device__ __forceinline__ float siluf_(float x) { return x / (1.0f + __expf(-x)); }
__device__ __forceinline__ float gelu_tanh(float x) { const float u = 0.7978845608028654f * (x + 0.044715f * x * x * x); return 0.5f * x * (1.0f + tanhf(u)); }

struct CvtJob { const float* src; int ld_src, K, N; h16* dst; int ldd, col_off, rmode; };
constexpr int NJOBS_L = 6, NJOBS_SMALL = 2 * NJOBS_L + 3, NJOBS_ALL = NJOBS_SMALL + 24;
__device__ __forceinline__ CvtJob get_job(const Params& p, int j) {
    CvtJob q; q.col_off = 0; q.rmode = 0;
    if (j < 2 * NJOBS_L) {
        const int l = j / NJOBS_L, s = j % NJOBS_L;
        h16* wint = WSP(h16, OFF_W16 + l * SZ_LAYERW); h16* btall = WSP(h16, OFF_W16 + l * SZ_LAYERW + SZ_WINT); h16* woutt = WSP(h16, OFF_W16 + l * SZ_LAYERW + SZ_WINT + SZ_BTALL);
        if (s == 0) { q.src = p.w_in + (size_t)l * 1024 * WIN + 512; q.ld_src = WIN; q.K = 1024; q.N = ZW - 512; q.dst = wint + (size_t)512 * 1024; q.ldd = 1024; }
        else if (s == 1) { q.src = p.w_in + (size_t)l * 1024 * WIN + ZW; q.ld_src = WIN; q.K = 1024; q.N = 3072; q.dst = btall; q.ldd = 1536; }
        else if (s < 5) { const int n = s - 2; q.src = p.w_branch + (size_t)(l * 3 + n) * 512 * 1024; q.ld_src = 1024; q.K = 512; q.N = 1024; q.dst = btall + (size_t)n * 1024 * 1536; q.ldd = 1536; q.col_off = 1024; }
        else { q.src = p.w_out + (size_t)l * 1024 * 1024; q.ld_src = 1024; q.K = 1024; q.N = 1024; q.dst = woutt; q.ldd = 1024; }
    } else if (j < NJOBS_SMALL) {
        const int s = j - 2 * NJOBS_L;
        if (s == 0) { q.src = p.ffn_w_gate; q.ld_src = DFF; q.K = 1024; q.N = DFF; q.dst = WSP(h16, OFF_WGUT); q.ldd = 1024; q.rmode = 1; }
        else if (s == 1) { q.src = p.ffn_w_up; q.ld_src = DFF; q.K = 1024; q.N = DFF; q.dst = WSP(h16, OFF_WGUT); q.ldd = 1024; q.rmode = 2; }
        else { q.src = p.ffn_w_down; q.ld_src = 1024; q.K = DFF; q.N = 1024; q.dst = WSP(h16, OFF_WDT); q.ldd = DFF; }
    } else {
        const int s = j - NJOBS_SMALL, e = s / 3, t = s % 3;
        if (t == 0) { q.src = p.moe_w_gate + (size_t)e * 1024 * DEX; q.ld_src = DEX; q.K = 1024; q.N = DEX; q.dst = WSP(h16, OFF_WMOE_GU) + (size_t)e * 2 * DEX * 1024; q.ldd = 1024; q.rmode = 1; }
        else if (t == 1) { q.src = p.moe_w_up + (size_t)e * 1024 * DEX; q.ld_src = DEX; q.K = 1024; q.N = DEX; q.dst = WSP(h16, OFF_WMOE_GU) + (size_t)e * 2 * DEX * 1024; q.ldd = 1024; q.rmode = 2; }
        else { q.src = p.moe_w_down + (size_t)e * DEX * 1024; q.ld_src = 1024; q.K = DEX; q.N = 1024; q.dst = WSP(h16, OFF_WMOE_D) + (size_t)e * 1024 * DEX; q.ldd = DEX; }
    }
    return q;
}
__device__ __forceinline__ int job_tiles(const CvtJob& q) { return (q.K / 64) * (q.N / 64); }
__device__ __forceinline__ int cvt_rowmap(int n, int rmode) { return rmode == 0 ? n : ((n >> 7) * 256 + (n & 127) + (rmode == 2 ? 128 : 0)); }
template <int NT> __device__ __forceinline__ void cvt_tile(const CvtJob& q, int t, float (*tile)[65]) {
    const int nk = q.K / 64, tk = t % nk, tn = t / nk, k0 = tk * 64, n0 = tn * 64, tid = threadIdx.x;
    __syncthreads();
    for (int i = tid >> 6; i < 64; i += NT / 64) tile[i][tid & 63] = q.src[(size_t)(k0 + i) * q.ld_src + n0 + (tid & 63)];
    __syncthreads();
    for (int j = tid >> 6; j < 64; j += NT / 64) q.dst[(size_t)cvt_rowmap(n0 + j, q.rmode) * q.ldd + q.col_off + k0 + (tid & 63)] = (h16)tile[tid & 63][j];
}
__global__ void __launch_bounds__(256) k_cvt(Params p, int j0, int j1) {
    __shared__ float tile[64][65];
    int base = 0;
    for (int j = j0; j < j1; ++j) {
        const CvtJob q = get_job(p, j); const int nt = job_tiles(q);
        int first = ((int)blockIdx.x - base % (int)gridDim.x + (int)gridDim.x) % (int)gridDim.x;
        for (int t = first; t < nt; t += gridDim.x) cvt_tile<256>(q, t, tile);
        base += nt;
    }
}
__global__ void __launch_bounds__(256) k_poolfold(Params p) {
    __shared__ float Ws[64][129];
    const int nunits = 2 * 4 * 16;
    for (int u = blockIdx.x; u < nunits; u += gridDim.x) {
        const int l = u / 64, g = (u / 16) % 4, k0 = (u % 16) * 64, tid = threadIdx.x;
        __syncthreads();
        for (int i = tid; i < 64 * 128; i += 256) Ws[i >> 7][i & 127] = p.w_in[(size_t)l * 1024 * WIN + (size_t)(k0 + (i >> 7)) * WIN + g * 128 + (i & 127)];
        __syncthreads();
        const float* pw = p.pool_w + (size_t)(l * 4 + g) * 128 * 128;
        h16* wint = WSP(h16, OFF_W16 + l * SZ_LAYERW);
        const int jj = tid & 127;
        const float sc = p.pool_scale[l * 512 + g * 128 + jj];
        for (int kk = tid >> 7; kk < 64; kk += 2) {
            float acc = 0.f;
            for (int c2 = 0; c2 < 128; ++c2) acc += Ws[kk][c2] * pw[c2 * 128 + jj];
            wint[(size_t)(g * 128 + jj) * 1024 + k0 + kk] = (h16)(acc * sc);
        }
    }
}
template <int NT> __device__ __forceinline__ void mod_unit(const Params& p, int u, float* sc  , float* red  ) {
    const int l = u / 96, n0 = (u % 96) * 64, tid = threadIdx.x, n = tid & 63, ks = tid >> 6;
    constexpr int NKS = NT / 64, KPER = 1024 / NKS;
    __syncthreads();
    for (int i = tid; i < 9 * 1024; i += NT) { const int g = i >> 10, k = i & 1023; const float v = g == 0 ? p.c_ctx[k] : p.c[(g - 1) * 1024 + k]; sc[i] = siluf_(v); }
    __syncthreads();
    float acc[9];
#pragma unroll
    for (int g = 0; g < 9; ++g) acc[g] = 0.f;
    const float* w = p.w_mod + (size_t)l * 1024 * 6144 + n0 + n;
#pragma unroll 8
    for (int k = ks * KPER; k < (ks + 1) * KPER; ++k) { const float wv = w[(size_t)k * 6144];
#pragma unroll
        for (int g = 0; g < 9; ++g) acc[g] += sc[g * 1024 + k] * wv; }
#pragma unroll
    for (int g = 0; g < 9; ++g) red[(ks * 9 + g) * 64 + n] = acc[g];
    __syncthreads();
    for (int i = tid; i < 9 * 64; i += NT) { const int g = i >> 6, nn = i & 63; float s = p.b_mod[l * 6144 + n0 + nn];
        for (int k2 = 0; k2 < NKS; ++k2) s += red[(k2 * 9 + g) * 64 + nn];
        WSP(float, OFF_MOD)[(size_t)(l * 9 + g) * 6144 + n0 + nn] = s; }
}
__global__ void __launch_bounds__(256) k_mod(Params p) {
    __shared__ float sc[9 * 1024]; __shared__ float red[4 * 9 * 64];
    if (blockIdx.x == 0 && threadIdx.x < 8) WSP(int, OFF_CNT)[threadIdx.x] = 0;
    for (int u = blockIdx.x; u < 192; u += gridDim.x) mod_unit<256>(p, u, sc, red);
}
__global__ void __launch_bounds__(256) k_h0(Params p) {
    const float* mod = WSP(float, OFF_MOD); h16* A = WSP(h16, OFF_A);
    for (int r = blockIdx.x; r < MT; r += gridDim.x) {
        const int g = row_group(r), d = threadIdx.x * 4; const float* xr = xin_row(p, r);
        const float4 xv = *(const float4*)(xr + d); const float4 m0 = *(const float4*)(mod + (size_t)g * 6144 + d); const float4 m1 = *(const float4*)(mod + (size_t)g * 6144 + 1024 + d);
        h16x4 o; o[0] = (h16)(xv.x * (1.f + m1.x) + m0.x); o[1] = (h16)(xv.y * (1.f + m1.y) + m0.y); o[2] = (h16)(xv.z * (1.f + m1.z) + m0.z); o[3] = (h16)(xv.w * (1.f + m1.w) + m0.w);
        *(h16x4*)(A + (size_t)r * AW + AH + d) = o;
    }
}

__device__ __forceinline__ void nv_tile_mm(const h16* __restrict__ A, int lda, const h16* __restrict__ Bt, int ldb, int K, float (&acc)[4][4], float (*As)[68], float (*Bs)[68]) {
    const int tid = threadIdx.x, lr = tid >> 2, lk = (tid & 3) * 4, ty = tid >> 4, tx = tid & 15;
    for (int k0 = 0; k0 < K; k0 += 16) {
        const h16x4 av = *(const h16x4*)(A + (size_t)lr * lda + k0 + lk);
        const h16x4 bv = *(const h16x4*)(Bt + (size_t)lr * ldb + k0 + lk);
        __syncthreads();
#pragma unroll
        for (int i = 0; i < 4; ++i) { As[lk + i][lr] = (float)av[i]; Bs[lk + i][lr] = (float)bv[i]; }
        __syncthreads();
#pragma unroll
        for (int kk = 0; kk < 16; ++kk) {
            const float4 a = *(const float4*)&As[kk][ty * 4]; const float4 b = *(const float4*)&Bs[kk][tx * 4];
            const float aa[4] = {a.x, a.y, a.z, a.w}, bb[4] = {b.x, b.y, b.z, b.w};
#pragma unroll
            for (int i = 0; i < 4; ++i)
#pragma unroll
                for (int j = 0; j < 4; ++j) acc[i][j] += aa[i] * bb[j];
        }
    }
}
#define NV_ZERO(acc) do { _Pragma("unroll") for (int i_ = 0; i_ < 4; ++i_) _Pragma("unroll") for (int j_ = 0; j_ < 4; ++j_) acc[i_][j_] = 0.f; } while (0)

__global__ void __launch_bounds__(256) k_gemm_in(Params p, int l) {
    __shared__ float As[16][68], Bs[16][68];
    const h16* A = WSP(h16, OFF_A); const h16* Bt = WSP(h16, OFF_W16 + l * SZ_LAYERW); h16* Z = WSP(h16, OFF_Z);
    const int ntn = ZW / 64, ntiles = (MT / 64) * ntn, ty = threadIdx.x >> 4, tx = threadIdx.x & 15;
    for (int t = blockIdx.x; t < ntiles; t += gridDim.x) {
        const int r0 = (t / ntn) * 64, c0 = (t % ntn) * 64; float acc[4][4]; NV_ZERO(acc);
        nv_tile_mm(A + (size_t)r0 * AW + AH, AW, Bt + (size_t)c0 * 1024, 1024, 1024, acc, As, Bs);
#pragma unroll
        for (int i = 0; i < 4; ++i) { h16x4 o; o[0] = (h16)acc[i][0]; o[1] = (h16)acc[i][1]; o[2] = (h16)acc[i][2]; o[3] = (h16)acc[i][3];
            *(h16x4*)(Z + (size_t)(r0 + ty * 4 + i) * ZW + c0 + tx * 4) = o; }
    }
}
__global__ void __launch_bounds__(256) k_qkv(Params p, int l) {
    const h16* Z = WSP(h16, OFF_Z); h16* Qh = WSP(h16, OFF_QH); h16* Kh = WSP(h16, OFF_KH); h16* Vh = WSP(h16, OFF_VH);
    const int lane = threadIdx.x & 63, wv = threadIdx.x >> 6;
    const int nitems = MT * 12;
    for (int it = blockIdx.x * 4 + wv; it < nitems; it += gridDim.x * 4) {
        const int r = it / 12, s = it % 12; int s0, len, pos; row_seq(r, s0, len, pos);
        const bool lat = r >= MC; const int b = lat ? (r - MC) >> 12 : r >> 8; const size_t krow = (size_t)b * SB + (lat ? CTX + pos : pos);
        if (s >= 10) { Vh[krow * 128 + (s - 10) * 64 + lane] = Z[(size_t)r * ZW + ZV + (s - 10) * 64 + lane]; continue; }
        const int zc = s < 8 ? ZQ + s * 64 : ZK + (s - 8) * 64;
        const float z = (float)Z[(size_t)r * ZW + zc + lane];
        float ss = z * z;
#pragma unroll
        for (int o = 32; o >= 1; o >>= 1) ss += __shfl_xor(ss, o);
        const float g = s < 8 ? p.q_norm[l * 64 + lane] : p.k_norm[l * 64 + lane];
        float y = z * rsqrtf(ss * (1.0f / 64.0f) + 1e-6f) * g;
        const float yp = __shfl_xor(y, 16);
        if (lat) {
            const float posf = (lane < 32) ? (float)(pos >> 6) : (float)(pos & 63);
            const float inv = exp2f(-(float)(lane & 15) * (13.287712379549449f / 16.0f));
            float sn, cs; sincosf(posf * inv, &sn, &cs);
            y = (lane & 16) ? (y * cs + yp * sn) : (y * cs - yp * sn);
        }
        if (s < 8) Qh[(size_t)r * 512 + s * 64 + lane] = (h16)(y * QSCALE);
        else Kh[krow * 128 + (s - 8) * 64 + lane] = (h16)y;
    }
}
__global__ void __launch_bounds__(256) k_pool(Params p, int r_begin) {
    const h16* Z = WSP(h16, OFF_Z); h16* A = WSP(h16, OFF_A);
    for (int r = r_begin + blockIdx.x; r < MT; r += gridDim.x) {
        int s0, len, pos; row_seq(r, s0, len, pos);
        for (int j = threadIdx.x; j < 512; j += 256) {
            const int w = 2 << (j >> 7), lo = pos - (w >> 1); const int a = lo < 0 ? 0 : lo, e = (lo + w) > len ? len : (lo + w);
            float s = 0.f; for (int t = a; t < e; ++t) s += (float)Z[(size_t)(s0 + t) * ZW + ZP + j];
            A[(size_t)r * AW + AY0 + j] = (h16)(s / (float)(e - a) - (float)Z[(size_t)r * ZW + ZP + j]);
        }
    }
}
__global__ void __launch_bounds__(64) k_lru_scan(Params p, int l, int dir) {
    __shared__ float xs[64];
    const int b = blockIdx.x >> 3, blk = blockIdx.x & 7, j = threadIdx.x, c = blk * 64 + j;
    const h16* Z = WSP(h16, OFF_Z); h16* A = WSP(h16, OFF_A); float* HF = p.out;
    float wa[64], wx[64];
    const float* pwa = p.lru_wa + ((size_t)(l * 2 + dir) * 8 + blk) * 4096; const float* pwx = p.lru_wx + ((size_t)(l * 2 + dir) * 8 + blk) * 4096;
#pragma unroll
    for (int i = 0; i < 64; ++i) { wa[i] = pwa[i * 64 + j]; wx[i] = pwx[i * 64 + j]; }
    const float ba = p.lru_ba[(l * 2 + dir) * 512 + c], bx = p.lru_bx[(l * 2 + dir) * 512 + c], lam = p.lru_lambda[(l * 2 + dir) * 512 + c];
    const float sp = log1pf(expf(-lam));
    float cw[4]; for (int k = 0; k < 4; ++k) cw[k] = p.conv_w[(l * 4 + k) * 512 + c];
    const float cb = p.conv_b[l * 512 + c];
    float h = 0.f;
    for (int idx = 0; idx < SB; ++idx) {
        int s0, len, pos;
        if (idx < CTX) { s0 = b * CTX; len = CTX; pos = dir ? CTX - 1 - idx : idx; } else { s0 = MC + b * SEQ; len = SEQ; pos = dir ? SEQ - 1 - (idx - CTX) : idx - CTX; }
        float xc = cb;
#pragma unroll
        for (int k = 0; k < 4; ++k) { const int t = pos + k - 2; if (t >= 0 && t < len) xc += cw[k] * (float)Z[(size_t)(s0 + t) * ZW + ZLX + c]; }
        __syncthreads(); xs[j] = xc; __syncthreads();
        float ra = ba, ri = bx;
#pragma unroll
        for (int i = 0; i < 64; ++i) { const float xv = xs[i]; ra += xv * wa[i]; ri += xv * wx[i]; }
        const float rg = sigmoidf_(ra), ig = sigmoidf_(ri), la = -8.0f * rg * sp, a = expf(la), u = sqrtf(-expm1f(2.0f * la)) * ig * xc;
        h = a * h + u;
        const int r = s0 + pos;
        if (dir == 0) HF[(size_t)r * 512 + c] = h;
        else { const float tot = HF[(size_t)r * 512 + c] + h; A[(size_t)r * AW + AY2 + c] = (h16)(tot * gelu_tanh((float)Z[(size_t)r * ZW + ZLG + c])); }
    }
}
__global__ void __launch_bounds__(256) k_attn(Params p, int isctx) {
    __shared__ float Ks[64][64], Vs[64][64];
    const h16* Qh = WSP(h16, OFF_QH); const h16* Kh = WSP(h16, OFF_KH); const h16* Vh = WSP(h16, OFF_VH); h16* A = WSP(h16, OFF_A);
    const int nqb = isctx ? 1 : 16, nunits = NB * 8 * nqb, tid = threadIdx.x;
    for (int u = blockIdx.x; u < nunits; u += gridDim.x) {
        const int b = u / (8 * nqb), hq = (u / nqb) % 8, qb = u % nqb, kvh = hq >> 2;
        const int r = isctx ? b * CTX + tid : MC + b * SEQ + qb * 256 + tid; const int nkeys = isctx ? CTX : SB;
        float q[64], o[64];
#pragma unroll
        for (int d = 0; d < 64; ++d) { q[d] = (float)Qh[(size_t)r * 512 + hq * 64 + d]; o[d] = 0.f; }
        float m = -INFINITY, lsum = 0.f;
        for (int k0 = 0; k0 < nkeys; k0 += 64) {
            __syncthreads();
            { const int key = tid >> 2, d0 = (tid & 3) * 16; const size_t base = ((size_t)b * SB + k0 + key) * 128 + kvh * 64 + d0;
#pragma unroll
              for (int i = 0; i < 16; ++i) { Ks[key][d0 + i] = (float)Kh[base + i]; Vs[key][d0 + i] = (float)Vh[base + i]; } }
            __syncthreads();
            for (int key = 0; key < 64; ++key) {
                float s = 0.f;
#pragma unroll
                for (int d = 0; d < 64; ++d) s += q[d] * Ks[key][d];
                const float mn = fmaxf(m, s), corr = exp2f(m - mn), pe = exp2f(s - mn);
                lsum = lsum * corr + pe;
#pragma unroll
                for (int d = 0; d < 64; ++d) o[d] = o[d] * corr + pe * Vs[key][d];
                m = mn;
            }
        }
        const float il = 1.0f / lsum;
#pragma unroll
        for (int d = 0; d < 64; ++d) A[(size_t)r * AW + AY1 + hq * 64 + d] = (h16)(o[d] * il);
    }
}
__global__ void __launch_bounds__(256) k_merge(Params p, int l, int r_begin) {
    __shared__ float As[16][68], Bs[16][68];
    const h16* A = WSP(h16, OFF_A); const h16* Bt = WSP(h16, OFF_W16 + l * SZ_LAYERW + SZ_WINT); h16* S16 = (h16*)p.out;
    const int nrt = (MT - r_begin) / 64, ntiles = nrt * 16, ty = threadIdx.x >> 4, tx = threadIdx.x & 15;
    for (int t = blockIdx.x; t < ntiles; t += gridDim.x) {
        const int r0 = r_begin + (t / 16) * 64, c0 = (t % 16) * 64; float sum[4][4]; NV_ZERO(sum);
        for (int n = 0; n < 3; ++n) {
            float ag[4][4], ab[4][4]; NV_ZERO(ag); NV_ZERO(ab);
            nv_tile_mm(A + (size_t)r0 * AW + AH, AW, Bt + (size_t)(n * 1024 + c0) * 1536, 1536, 1024, ag, As, Bs);
            nv_tile_mm(A + (size_t)r0 * AW + AY0 + n * 512, AW, Bt + (size_t)(n * 1024 + c0) * 1536 + 1024, 1536, 512, ab, As, Bs);
#pragma unroll
            for (int i = 0; i < 4; ++i)
#pragma unroll
                for (int j = 0; j < 4; ++j) sum[i][j] += sigmoidf_(ag[i][j] + p.b_merge[(l * 3 + n) * 1024 + c0 + tx * 4 + j]) * ab[i][j];
        }
#pragma unroll
        for (int i = 0; i < 4; ++i) { h16x4 o; o[0] = (h16)sum[i][0]; o[1] = (h16)sum[i][1]; o[2] = (h16)sum[i][2]; o[3] = (h16)sum[i][3];
            *(h16x4*)(S16 + (size_t)(r0 + ty * 4 + i) * 1024 + c0 + tx * 4) = o; }
    }
}
__global__ void __launch_bounds__(256) k_wout(Params p, int l, int r_begin) {
    __shared__ float As[16][68], Bs[16][68];
    const h16* S16 = (const h16*)p.out; const h16* Bt = WSP(h16, OFF_W16 + l * SZ_LAYERW + SZ_WINT + SZ_BTALL); float* X = WSP(float, OFF_X); const float* mod = WSP(float, OFF_MOD) + (size_t)l * 9 * 6144;
    const int nrt = (MT - r_begin) / 64, ntiles = nrt * 16, ty = threadIdx.x >> 4, tx = threadIdx.x & 15;
    for (int t = blockIdx.x; t < ntiles; t += gridDim.x) {
        const int r0 = r_begin + (t / 16) * 64, c0 = (t % 16) * 64; float acc[4][4]; NV_ZERO(acc);
        nv_tile_mm(S16 + (size_t)r0 * 1024, 1024, Bt + (size_t)c0 * 1024, 1024, 1024, acc, As, Bs);
#pragma unroll
        for (int i = 0; i < 4; ++i) { const int r = r0 + ty * 4 + i, g = row_group(r); const float* res = (l == 0) ? xin_row(p, r) : X + (size_t)r * D;
#pragma unroll
            for (int j = 0; j < 4; ++j) { const int d = c0 + tx * 4 + j; X[(size_t)r * D + d] = ALPHA * res[d] + mod[(size_t)g * 6144 + 2 * 1024 + d] * acc[i][j]; } }
    }
}
__global__ void __launch_bounds__(256) k_ln(Params p, int mode, int r_begin, const float* __restrict__ gam, const float* __restrict__ bet, int lm, int sh, int sc) {
    float* X = WSP(float, OFF_X); h16* A = WSP(h16, OFF_A); const float* mod = WSP(float, OFF_MOD) + (size_t)lm * 9 * 6144;
    const int lane = threadIdx.x & 63, wv = threadIdx.x >> 6;
    for (int r = r_begin + blockIdx.x * 4 + wv; r < MT; r += gridDim.x * 4) {
        const int g = row_group(r); float v[16];
#pragma unroll
        for (int i = 0; i < 4; ++i) { const float4 t = *(const float4*)(X + (size_t)r * D + i * 256 + lane * 4); v[i * 4] = t.x; v[i * 4 + 1] = t.y; v[i * 4 + 2] = t.z; v[i * 4 + 3] = t.w; }
        if (mode == 2) {
            const h16* o0 = WSP(h16, OFF_OUT2) + (size_t)(r - MC) * 1024; const h16* o1 = o0 + (size_t)ML * 1024; const float* m5 = WSP(float, OFF_MOD) + (size_t)(1 * 9 + g) * 6144 + 5 * 1024;
#pragma unroll
            for (int i = 0; i < 4; ++i) { const h16x4 a = *(const h16x4*)(o0 + i * 256 + lane * 4), b2 = *(const h16x4*)(o1 + i * 256 + lane * 4); const float4 mm = *(const float4*)(m5 + i * 256 + lane * 4);
                const float mv[4] = {mm.x, mm.y, mm.z, mm.w};
#pragma unroll
                for (int j = 0; j < 4; ++j) v[i * 4 + j] = ALPHA * v[i * 4 + j] + mv[j] * ((float)a[j] + (float)b2[j]); }
        }
        float s = 0.f;
#pragma unroll
        for (int i = 0; i < 16; ++i) s += v[i];
#pragma unroll
        for (int o = 32; o >= 1; o >>= 1) s += __shfl_xor(s, o);
        const float mean = s * (1.0f / 1024.0f); float q = 0.f;
#pragma unroll
        for (int i = 0; i < 16; ++i) { const float dlt = v[i] - mean; q += dlt * dlt; }
#pragma unroll
        for (int o = 32; o >= 1; o >>= 1) q += __shfl_xor(q, o);
        const float rstd = rsqrtf(q * (1.0f / 1024.0f) + 1e-5f);
        float lg8[8];
#pragma unroll
        for (int e = 0; e < 8; ++e) lg8[e] = 0.f;
#pragma unroll
        for (int i = 0; i < 4; ++i) {
            const int d = i * 256 + lane * 4; const float4 gg = *(const float4*)(gam + d), bb = *(const float4*)(bet + d);
            const float gv[4] = {gg.x, gg.y, gg.z, gg.w}, bv[4] = {bb.x, bb.y, bb.z, bb.w}; float y[4];
#pragma unroll
            for (int j = 0; j < 4; ++j) y[j] = (v[i * 4 + j] - mean) * rstd * gv[j] + bv[j];
            if (mode == 2) { *(float4*)(p.out + (size_t)(r - MC) * D + d) = make_float4(y[0], y[1], y[2], y[3]); continue; }
            *(float4*)(X + (size_t)r * D + d) = make_float4(y[0], y[1], y[2], y[3]);
            const float4 ms = *(const float4*)(mod + (size_t)g * 6144 + sh * 1024 + d), mc = *(const float4*)(mod + (size_t)g * 6144 + sc * 1024 + d);
            const float msv[4] = {ms.x, ms.y, ms.z, ms.w}, mcv[4] = {mc.x, mc.y, mc.z, mc.w}; float hh[4]; h16x4 ho;
#pragma unroll
            for (int j = 0; j < 4; ++j) { hh[j] = y[j] * (1.f + mcv[j]) + msv[j]; ho[j] = (h16)hh[j]; }
            *(h16x4*)(A + (size_t)r * AW + AH + d) = ho;
            if (mode == 1) {
#pragma unroll
                for (int j = 0; j < 4; ++j) { const float4 r0 = *(const float4*)(p.moe_router + (size_t)(d + j) * 8), r1 = *(const float4*)(p.moe_router + (size_t)(d + j) * 8 + 4);
                    lg8[0] += hh[j] * r0.x; lg8[1] += hh[j] * r0.y; lg8[2] += hh[j] * r0.z; lg8[3] += hh[j] * r0.w; lg8[4] += hh[j] * r1.x; lg8[5] += hh[j] * r1.y; lg8[6] += hh[j] * r1.z; lg8[7] += hh[j] * r1.w; }
            }
        }
        if (mode == 1) {
#pragma unroll
            for (int e = 0; e < 8; ++e) {
#pragma unroll
                for (int o = 32; o >= 1; o >>= 1) lg8[e] += __shfl_xor(lg8[e], o);
                lg8[e] += p.moe_router_b[e]; }
            if (lane == 0) {
                int i0 = 0; float v0 = lg8[0];
#pragma unroll
                for (int e = 1; e < 8; ++e) if (lg8[e] > v0) { v0 = lg8[e]; i0 = e; }
                int i1 = -1; float v1 = -INFINITY;
#pragma unroll
                for (int e = 0; e < 8; ++e) if (e != i0 && lg8[e] > v1) { v1 = lg8[e]; i1 = e; }
                const float p1 = 1.0f / (1.0f + expf(v0 - v1)), p0 = 1.0f - p1;
                const int t = r - MC; int* cnt = WSP(int, OFF_CNT);
                const int k0 = atomicAdd(&cnt[i0], 1), k1 = atomicAdd(&cnt[i1], 1);
                WSP(int, OFF_TOKE)[t * 2] = i0; WSP(int, OFF_TOKE)[t * 2 + 1] = i1; WSP(float, OFF_TOKP)[t * 2] = p0; WSP(float, OFF_TOKP)[t * 2 + 1] = p1; WSP(int, OFF_TOKR)[t * 2] = k0; WSP(int, OFF_TOKR)[t * 2 + 1] = k1;
            }
        }
    }
}
__global__ void __launch_bounds__(256) k_ffn_gu(Params p, int moe, int panel0, int npan) {
    __shared__ float As[16][68], Bs[16][68];
    const int* plan = WSP(int, OFF_PLAN); const int npanels = moe ? plan[8] : MT / 256;
    const int dff = moe ? DEX : DFF, ntn = dff / 64, ty = threadIdx.x >> 4, tx = threadIdx.x & 15;
    const h16* A = moe ? WSP(h16, OFF_XG) : WSP(h16, OFF_A) + AH; const int lda = moe ? 1024 : AW;
    h16* ACT = moe ? (h16*)p.out : WSP(h16, OFF_ACT);
    const int ntiles = npan * 4 * ntn;
    for (int t = blockIdx.x; t < ntiles; t += gridDim.x) {
        const int rt = t / ntn, panel = panel0 + rt / 4; if (panel >= npanels) break;
        const int r0 = panel * 256 + (rt % 4) * 64, j0 = (t % ntn) * 64;
        const h16* Bt = moe ? WSP(h16, OFF_WMOE_GU) + (size_t)plan[16 + panel] * 2 * DEX * 1024 : WSP(h16, OFF_WGUT);
        const int brow = (j0 >> 7) * 256 + (j0 & 127);
        float ag[4][4], au[4][4]; NV_ZERO(ag); NV_ZERO(au);
        nv_tile_mm(A + (size_t)r0 * lda, lda, Bt + (size_t)brow * 1024, 1024, 1024, ag, As, Bs);
        nv_tile_mm(A + (size_t)r0 * lda, lda, Bt + (size_t)(brow + 128) * 1024, 1024, 1024, au, As, Bs);
        const size_t orow0 = moe ? (size_t)(r0 - panel0 * 256) : (size_t)r0;
#pragma unroll
        for (int i = 0; i < 4; ++i) { h16x4 o;
#pragma unroll
            for (int j = 0; j < 4; ++j) o[j] = (h16)(siluf_(ag[i][j]) * au[i][j]);
            *(h16x4*)(ACT + (orow0 + ty * 4 + i) * dff + j0 + tx * 4) = o; }
    }
}
__global__ void __launch_bounds__(256) k_ffn_down(Params p, int moe, int panel0, int npan) {
    __shared__ float As[16][68], Bs[16][68];
    const int* plan = WSP(int, OFF_PLAN); const int npanels = moe ? plan[8] : MT / 256;
    const int dff = moe ? DEX : DFF, ty = threadIdx.x >> 4, tx = threadIdx.x & 15;
    const h16* ACT = moe ? (const h16*)p.out : WSP(h16, OFF_ACT);
    float* X = WSP(float, OFF_X); const float* mod = WSP(float, OFF_MOD);
    const int ntiles = npan * 4 * 16;
    for (int t = blockIdx.x; t < ntiles; t += gridDim.x) {
        const int rt = t / 16, panel = panel0 + rt / 4; if (panel >= npanels) break;
        const int r0 = panel * 256 + (rt % 4) * 64, c0 = (t % 16) * 64;
        const h16* Bt = moe ? WSP(h16, OFF_WMOE_D) + (size_t)plan[16 + panel] * 1024 * DEX : WSP(h16, OFF_WDT);
        const size_t arow0 = moe ? (size_t)(r0 - panel0 * 256) : (size_t)r0;
        float acc[4][4]; NV_ZERO(acc);
        nv_tile_mm(ACT + arow0 * dff, dff, Bt + (size_t)c0 * dff, dff, dff, acc, As, Bs);
#pragma unroll
        for (int i = 0; i < 4; ++i) { const int r = r0 + ty * 4 + i;
            if (!moe) { const int g = row_group(r);
#pragma unroll
                for (int j = 0; j < 4; ++j) { const int d = c0 + tx * 4 + j; X[(size_t)r * D + d] = ALPHA * X[(size_t)r * D + d] + mod[(size_t)g * 6144 + 5 * 1024 + d] * acc[i][j]; } }
            else { const int tk = WSP(int, OFF_ROWT)[r]; if (tk < 0) continue; const float pp = WSP(float, OFF_ROWP)[r];
                h16x4 o;
#pragma unroll
                for (int j = 0; j < 4; ++j) o[j] = (h16)(pp * acc[i][j]);
                *(h16x4*)(WSP(h16, OFF_OUT2) + ((size_t)(tk & 1) * ML + (tk >> 1)) * 1024 + c0 + tx * 4) = o; }
        }
    }
}
__global__ void __launch_bounds__(256) k_moe_plan(Params p) {
    int* plan = WSP(int, OFF_PLAN); const int* cnt = WSP(int, OFF_CNT); int* rowT = WSP(int, OFF_ROWT);
    __shared__ int sp[9];
    if (threadIdx.x == 0) { int acc = 0; for (int e = 0; e < 8; ++e) { sp[e] = acc; plan[e] = acc; const int np = (cnt[e] + 255) / 256; for (int q = 0; q < np; ++q) plan[16 + acc / 256 + q] = e; acc += np * 256; } sp[8] = acc; plan[8] = acc / 256; }
    __syncthreads();
    for (int e = 0; e < 8; ++e) { const int a = sp[e] + cnt[e], b = sp[e + 1]; for (int i = a + threadIdx.x; i < b; i += 256) rowT[i] = -1; }
}
__global__ void __launch_bounds__(256) k_moe_gather(Params p) {
    const int* plan = WSP(int, OFF_PLAN); const h16* A = WSP(h16, OFF_A); h16* Xg = WSP(h16, OFF_XG);
    const int lane = threadIdx.x & 63, wv = threadIdx.x >> 6;
    for (int it = blockIdx.x * 4 + wv; it < ML * 2; it += gridDim.x * 4) {
        const int t = it >> 1, e = WSP(int, OFF_TOKE)[it], pos = plan[e] + WSP(int, OFF_TOKR)[it];
        const h16* src = A + (size_t)(MC + t) * AW + AH; h16* dst = Xg + (size_t)pos * 1024;
        *(h16x8*)(dst + lane * 8) = *(const h16x8*)(src + lane * 8); *(h16x8*)(dst + 512 + lane * 8) = *(const h16x8*)(src + 512 + lane * 8);
        if (lane == 0) { WSP(int, OFF_ROWT)[pos] = it; WSP(float, OFF_ROWP)[pos] = WSP(float, OFF_TOKP)[it]; }
    }
}

extern "C" void kernel_launch(void* const* d_in, const int* in_sizes, int n_in, void* d_out, int out_size, void* d_ws, size_t ws_size, hipStream_t stream) {
    (void)in_sizes; (void)n_in; (void)out_size;
    if (ws_size < WS_NEED) return;
    Params p;
    const float** pp = (const float**)&p;
    for (int i = 0; i < 33; ++i) pp[i] = (const float*)d_in[i];
    p.out = (float*)d_out; p.ws = (char*)d_ws;
    const int G = 1024;
    k_mod<<<192, 256, 0, stream>>>(p);
    k_cvt<<<G, 256, 0, stream>>>(p, 0, NJOBS_SMALL);
    k_poolfold<<<128, 256, 0, stream>>>(p);
    k_h0<<<G * 2, 256, 0, stream>>>(p);
    for (int l = 0; l < 2; ++l) {
        const int rb = l == 0 ? 0 : MC;
        const float* ln1g = p.ln1_g + l * D; const float* ln1b = p.ln1_b + l * D; const float* ln2g = p.ln2_g + l * D; const float* ln2b = p.ln2_b + l * D;
        k_gemm_in<<<G * 4, 256, 0, stream>>>(p, l);
        k_qkv<<<G * 2, 256, 0, stream>>>(p, l);
        k_pool<<<G * 2, 256, 0, stream>>>(p, rb);
        k_lru_scan<<<64, 64, 0, stream>>>(p, l, 0);
        k_lru_scan<<<64, 64, 0, stream>>>(p, l, 1);
        k_attn<<<1024, 256, 0, stream>>>(p, 0);
        if (l == 0) k_attn<<<64, 256, 0, stream>>>(p, 1);
        k_merge<<<G * 4, 256, 0, stream>>>(p, l, rb);
        k_wout<<<G * 4, 256, 0, stream>>>(p, l, rb);
        if (l == 0) {
            k_ln<<<G, 256, 0, stream>>>(p, 0, rb, ln1g, ln1b, 0, 3, 4);
            k_ffn_gu<<<G * 4, 256, 0, stream>>>(p, 0, 0, MT / 256);
            k_ffn_down<<<G * 4, 256, 0, stream>>>(p, 0, 0, MT / 256);
            k_ln<<<G, 256, 0, stream>>>(p, 0, 0, ln2g, ln2b, 1, 0, 1);
        } else {
            k_ln<<<G, 256, 0, stream>>>(p, 1, rb, ln1g, ln1b, 1, 3, 4);
            k_cvt<<<G, 256, 0, stream>>>(p, NJOBS_SMALL, NJOBS_ALL);
            k_moe_plan<<<1, 256, 0, stream>>>(p);
            k_moe_gather<<<G, 256, 0, stream>>>(p);
            for (int ch = 0; ch < 5; ++ch) {
                k_ffn_gu<<<G * 4, 256, 0, stream>>>(p, 1, ch * 64, 64);
                k_ffn_down<<<G * 4, 256, 0, stream>>>(p, 1, ch * 64, 64);
            }
            k_ln<<<G, 256, 0, stream>>>(p, 2, MC, ln2g, ln2b, 1, 0, 1);
        }
    }
}
```

```cpp
#include <hip/hip_runtime.h>
#include <stdint.h>
#include <stddef.h>

typedef _Float16 h16;
typedef _Float16 h16x2 __attribute__((ext_vector_type(2)));
typedef _Float16 h16x4 __attribute__((ext_vector_type(4)));
typedef _Float16 h16x8 __attribute__((ext_vector_type(8)));

constexpr int D = 1024, NB = 8, SEQ = 4096, CTX = 256, SB = CTX + SEQ;
constexpr int MC = NB * CTX, ML = NB * SEQ, MT = MC + ML;
constexpr int WIN = 5376, ZW = 2304, AW = 2560;
constexpr int DFF = 2816, NE = 8, DEX = 3584;
constexpr int PMAX = 264 * 256;
constexpr float ALPHA = 1.41421356237309515f;
constexpr float QSCALE = 0.125f * 1.4426950408889634f;
constexpr int ZP = 0, ZQ = 512, ZK = 1024, ZV = 1152, ZLX = 1280, ZLG = 1792;
constexpr int AH = 0, AY0 = 1024, AY1 = 1536, AY2 = 2048;

constexpr size_t al256(size_t x) { return (x + 255) & ~(size_t)255; }
constexpr size_t OFF_BAR = 0;
constexpr size_t OFF_MOD = 16384;
constexpr size_t OFF_CNT = OFF_MOD + al256((size_t)2 * 9 * 6144 * 4);
constexpr size_t OFF_PLAN = OFF_CNT + 256;
constexpr size_t OFF_TOKE = OFF_PLAN + 2048;
constexpr size_t OFF_TOKP = OFF_TOKE + (size_t)ML * 2 * 4;
constexpr size_t OFF_TOKR = OFF_TOKP + (size_t)ML * 2 * 4;
constexpr size_t OFF_ROWT = OFF_TOKR + (size_t)ML * 2 * 4;
constexpr size_t OFF_ROWP = OFF_ROWT + (size_t)PMAX * 4;
constexpr size_t OFF_TBL_END = OFF_ROWP + (size_t)PMAX * 4;
constexpr size_t OFF_X = (size_t)8 << 20;
constexpr size_t OFF_A = OFF_X + (size_t)MT * D * 4;
constexpr size_t OFF_BIG = OFF_A + (size_t)MT * AW * 2;
static_assert(OFF_TBL_END <= OFF_X, "tables");
constexpr size_t OFF_Z = OFF_BIG;
constexpr size_t OFF_QH = OFF_Z + (size_t)MT * ZW * 2;
constexpr size_t OFF_KH = OFF_QH + (size_t)MT * 512 * 2;
constexpr size_t OFF_VH = OFF_KH + (size_t)NB * SB * 128 * 2;
constexpr size_t OFF_W16 = OFF_VH + (size_t)NB * SB * 128 * 2;
constexpr size_t SZ_WINT = (size_t)ZW * 1024 * 2, SZ_BTALL = (size_t)3072 * 1536 * 2, SZ_WOUTT = (size_t)1024 * 1024 * 2;
constexpr size_t SZ_LAYERW = SZ_WINT + SZ_BTALL + SZ_WOUTT;
constexpr size_t OFF_WGUT = OFF_W16 + 2 * SZ_LAYERW;
constexpr size_t OFF_WDT = OFF_WGUT + (size_t)2 * DFF * 1024 * 2;
constexpr size_t OFF_W16_END = OFF_WDT + (size_t)1024 * DFF * 2;
constexpr size_t OFF_ACT = OFF_BIG;
static_assert(OFF_ACT + (size_t)MT * DFF * 2 <= OFF_W16, "ACT overlay");
constexpr size_t OFF_WMOE_GU = OFF_BIG;
constexpr size_t OFF_WMOE_D = OFF_WMOE_GU + (size_t)NE * 2 * DEX * 1024 * 2;
constexpr size_t OFF_XG = OFF_WMOE_D + (size_t)NE * 1024 * DEX * 2;
constexpr size_t WS_NEED = OFF_XG + (size_t)PMAX * 1024 * 2;
static_assert(WS_NEED <= 646673440ull, "workspace budget");
static_assert(OFF_W16_END <= WS_NEED, "w16");
constexpr size_t OFF_OUT2 = OFF_A;
static_assert((size_t)2 * ML * 1024 * 2 <= (size_t)MT * AW * 2, "OUT2 overlay");
static_assert((size_t)64 * 256 * DEX * 2 <= (size_t)ML * D * 4, "ACTe chunk in d_out");

struct Params {
    const float *x, *c, *ctx, *c_ctx, *w_mod, *b_mod, *w_in, *b_merge, *pool_w, *pool_scale, *q_norm, *k_norm, *conv_w, *conv_b,
        *lru_wa, *lru_ba, *lru_wx, *lru_bx, *lru_lambda, *w_branch, *w_out, *ln1_g, *ln1_b, *ffn_w_gate, *ffn_w_up, *ffn_w_down,
        *moe_router, *moe_router_b, *moe_w_gate, *moe_w_up, *moe_w_down, *ln2_g, *ln2_b;
    float* out;
    char* ws;
};
#define WSP(T, off) ((T*)(p.ws + (off)))

__device__ __forceinline__ int row_group(int r) { return r < MC ? 0 : 1 + ((r - MC) >> 12); }
__device__ __forceinline__ void row_seq(int r, int& s0, int& len, int& pos) {
    if (r < MC) { s0 = r & ~255; len = 256; pos = r & 255; } else { const int q = r - MC; s0 = MC + (q & ~4095); len = 4096; pos = q & 4095; }
}
__device__ __forceinline__ const float* xin_row(const Params& p, int r) { return r < MC ? p.ctx + (size_t)r * D : p.x + (size_t)(r - MC) * D; }
__device__ __forceinline__ float sigmoidf_(float x) { return 1.0f / (1.0f + __expf(-x)); }
__device__ __forceinline__ float siluf_(float x) { return x / (1.0f + __expf(-x)); }
__device__ __forceinline__ float gelu_tanh(float x) { const float u = 0.7978845608028654f * (x + 0.044715f * x * x * x); return 0.5f * x * (1.0f + tanhf(u)); }

struct CvtJob { const float* src; int ld_src, K, N; h16* dst; int ldd, col_off, rmode; };
constexpr int NJOBS_L = 6, NJOBS_SMALL = 2 * NJOBS_L + 3, NJOBS_ALL = NJOBS_SMALL + 24;
__device__ __forceinline__ CvtJob get_job(const Params& p, int j) {
    CvtJob q; q.col_off = 0; q.rmode = 0;
    if (j < 2 * NJOBS_L) {
        const int l = j / NJOBS_L, s = j % NJOBS_L;
        h16* wint = WSP(h16, OFF_W16 + l * SZ_LAYERW); h16* btall = WSP(h16, OFF_W16 + l * SZ_LAYERW + SZ_WINT); h16* woutt = WSP(h16, OFF_W16 + l * SZ_LAYERW + SZ_WINT + SZ_BTALL);
        if (s == 0) { q.src = p.w_in + (size_t)l * 1024 * WIN + 512; q.ld_src = WIN; q.K = 1024; q.N = ZW - 512; q.dst = wint + (size_t)512 * 1024; q.ldd = 1024; }
        else if (s == 1) { q.src = p.w_in + (size_t)l * 1024 * WIN + ZW; q.ld_src = WIN; q.K = 1024; q.N = 3072; q.dst = btall; q.ldd = 1536; }
        else if (s < 5) { const int n = s - 2; q.src = p.w_branch + (size_t)(l * 3 + n) * 512 * 1024; q.ld_src = 1024; q.K = 512; q.N = 1024; q.dst = btall + (size_t)n * 1024 * 1536; q.ldd = 1536; q.col_off = 1024; }
        else { q.src = p.w_out + (size_t)l * 1024 * 1024; q.ld_src = 1024; q.K = 1024; q.N = 1024; q.dst = woutt; q.ldd = 1024; }
    } else if (j < NJOBS_SMALL) {
        const int s = j - 2 * NJOBS_L;
        if (s == 0) { q.src = p.ffn_w_gate; q.ld_src = DFF; q.K = 1024; q.N = DFF; q.dst = WSP(h16, OFF_WGUT); q.ldd = 1024; q.rmode = 1; }
        else if (s == 1) { q.src = p.ffn_w_up; q.ld_src = DFF; q.K = 1024; q.N = DFF; q.dst = WSP(h16, OFF_WGUT); q.ldd = 1024; q.rmode = 2; }
        else { q.src = p.ffn_w_down; q.ld_src = 1024; q.K = DFF; q.N = 1024; q.dst = WSP(h16, OFF_WDT); q.ldd = DFF; }
    } else {
        const int s = j - NJOBS_SMALL, e = s / 3, t = s % 3;
        if (t == 0) { q.src = p.moe_w_gate + (size_t)e * 1024 * DEX; q.ld_src = DEX; q.K = 1024; q.N = DEX; q.dst = WSP(h16, OFF_WMOE_GU) + (size_t)e * 2 * DEX * 1024; q.ldd = 1024; q.rmode = 1; }
        else if (t == 1) { q.src = p.moe_w_up + (size_t)e * 1024 * DEX; q.ld_src = DEX; q.K = 1024; q.N = DEX; q.dst = WSP(h16, OFF_WMOE_GU) + (size_t)e * 2 * DEX * 1024; q.ldd = 1024; q.rmode = 2; }
        else { q.src = p.moe_w_down + (size_t)e * DEX * 1024; q.ld_src = 1024; q.K = DEX; q.N = 1024; q.dst = WSP(h16, OFF_WMOE_D) + (size_t)e * 1024 * DEX; q.ldd = DEX; }
    }
    return q;
}
__device__ __forceinline__ int job_tiles(const CvtJob& q) { return (q.K / 64) * (q.N / 64); }
__device__ __forceinline__ int cvt_rowmap(int n, int rmode) { return rmode == 0 ? n : ((n >> 7) * 256 + (n & 127) + (rmode == 2 ? 128 : 0)); }
template <int NT> __device__ __forceinline__ void cvt_tile(const CvtJob& q, int t, float (*tile)[65]) {
    const int nk = q.K / 64, tk = t % nk, tn = t / nk, k0 = tk * 64, n0 = tn * 64, tid = threadIdx.x;
    __syncthreads();
    for (int i = tid >> 6; i < 64; i += NT / 64) tile[i][tid & 63] = q.src[(size_t)(k0 + i) * q.ld_src + n0 + (tid & 63)];
    __syncthreads();
    for (int j = tid >> 6; j < 64; j += NT / 64) q.dst[(size_t)cvt_rowmap(n0 + j, q.rmode) * q.ldd + q.col_off + k0 + (tid & 63)] = (h16)tile[tid & 63][j];
}
__global__ void __launch_bounds__(256) k_cvt(Params p, int j0, int j1) {
    __shared__ float tile[64][65];
    int base = 0;
    for (int j = j0; j < j1; ++j) {
        const CvtJob q = get_job(p, j); const int nt = job_tiles(q);
        int first = ((int)blockIdx.x - base % (int)gridDim.x + (int)gridDim.x) % (int)gridDim.x;
        for (int t = first; t < nt; t += gridDim.x) cvt_tile<256>(q, t, tile);
        base += nt;
    }
}
__global__ void __launch_bounds__(256) k_poolfold(Params p) {
    __shared__ float Ws[64][129];
    const int nunits = 2 * 4 * 16;
    for (int u = blockIdx.x; u < nunits; u += gridDim.x) {
        const int l = u / 64, g = (u / 16) % 4, k0 = (u % 16) * 64, tid = threadIdx.x;
        __syncthreads();
        for (int i = tid; i < 64 * 128; i += 256) Ws[i >> 7][i & 127] = p.w_in[(size_t)l * 1024 * WIN + (size_t)(k0 + (i >> 7)) * WIN + g * 128 + (i & 127)];
        __syncthreads();
        const float* pw = p.pool_w + (size_t)(l * 4 + g) * 128 * 128;
        h16* wint = WSP(h16, OFF_W16 + l * SZ_LAYERW);
        const int jj = tid & 127;
        const float sc = p.pool_scale[l * 512 + g * 128 + jj];
        for (int kk = tid >> 7; kk < 64; kk += 2) {
            float acc = 0.f;
            for (int c2 = 0; c2 < 128; ++c2) acc += Ws[kk][c2] * pw[c2 * 128 + jj];
            wint[(size_t)(g * 128 + jj) * 1024 + k0 + kk] = (h16)(acc * sc);
        }
    }
}
template <int NT> __device__ __forceinline__ void mod_unit(const Params& p, int u, float* sc  , float* red  ) {
    const int l = u / 96, n0 = (u % 96) * 64, tid = threadIdx.x, n = tid & 63, ks = tid >> 6;
    constexpr int NKS = NT / 64, KPER = 1024 / NKS;
    __syncthreads();
    for (int i = tid; i < 9 * 1024; i += NT) { const int g = i >> 10, k = i & 1023; const float v = g == 0 ? p.c_ctx[k] : p.c[(g - 1) * 1024 + k]; sc[i] = siluf_(v); }
    __syncthreads();
    float acc[9];
#pragma unroll
    for (int g = 0; g < 9; ++g) acc[g] = 0.f;
    const float* w = p.w_mod + (size_t)l * 1024 * 6144 + n0 + n;
#pragma unroll 8
    for (int k = ks * KPER; k < (ks + 1) * KPER; ++k) { const float wv = w[(size_t)k * 6144];
#pragma unroll
        for (int g = 0; g < 9; ++g) acc[g] += sc[g * 1024 + k] * wv; }
#pragma unroll
    for (int g = 0; g < 9; ++g) red[(ks * 9 + g) * 64 + n] = acc[g];
    __syncthreads();
    for (int i = tid; i < 9 * 64; i += NT) { const int g = i >> 6, nn = i & 63; float s = p.b_mod[l * 6144 + n0 + nn];
        for (int k2 = 0; k2 < NKS; ++k2) s += red[(k2 * 9 + g) * 64 + nn];
        WSP(float, OFF_MOD)[(size_t)(l * 9 + g) * 6144 + n0 + nn] = s; }
}
__global__ void __launch_bounds__(256) k_mod(Params p) {
    __shared__ float sc[9 * 1024]; __shared__ float red[4 * 9 * 64];
    if (blockIdx.x == 0 && threadIdx.x < 8) WSP(int, OFF_CNT)[threadIdx.x] = 0;
    for (int u = blockIdx.x; u < 192; u += gridDim.x) mod_unit<256>(p, u, sc, red);
}
__global__ void __launch_bounds__(256) k_h0(Params p) {
    const float* mod = WSP(float, OFF_MOD); h16* A = WSP(h16, OFF_A);
    for (int r = blockIdx.x; r < MT; r += gridDim.x) {
        const int g = row_group(r), d = threadIdx.x * 4; const float* xr = xin_row(p, r);
        const float4 xv = *(const float4*)(xr + d); const float4 m0 = *(const float4*)(mod + (size_t)g * 6144 + d); const float4 m1 = *(const float4*)(mod + (size_t)g * 6144 + 1024 + d);
        h16x4 o; o[0] = (h16)(xv.x * (1.f + m1.x) + m0.x); o[1] = (h16)(xv.y * (1.f + m1.y) + m0.y); o[2] = (h16)(xv.z * (1.f + m1.z) + m0.z); o[3] = (h16)(xv.w * (1.f + m1.w) + m0.w);
        *(h16x4*)(A + (size_t)r * AW + AH + d) = o;
    }
}

__device__ __forceinline__ void nv_tile_mm(const h16* __restrict__ A, int lda, const h16* __restrict__ Bt, int ldb, int K, float (&acc)[4][4], float (*As)[68], float (*Bs)[68]) {
    const int tid = threadIdx.x, lr = tid >> 2, lk = (tid & 3) * 4, ty = tid >> 4, tx = tid & 15;
    for (int k0 = 0; k0 < K; k0 += 16) {
        const h16x4 av = *(const h16x4*)(A + (size_t)lr * lda + k0 + lk);
        const h16x4 bv = *(const h16x4*)(Bt + (size_t)lr * ldb + k0 + lk);
        __syncthreads();
#pragma unroll
        for (int i = 0; i < 4; ++i) { As[lk + i][lr] = (float)av[i]; Bs[lk + i][lr] = (float)bv[i]; }
        __syncthreads();
#pragma unroll
        for (int kk = 0; kk < 16; ++kk) {
            const float4 a = *(const float4*)&As[kk][ty * 4]; const float4 b = *(const float4*)&Bs[kk][tx * 4];
            const float aa[4] = {a.x, a.y, a.z, a.w}, bb[4] = {b.x, b.y, b.z, b.w};
#pragma unroll
            for (int i = 0; i < 4; ++i)
#pragma unroll
                for (int j = 0; j < 4; ++j) acc[i][j] += aa[i] * bb[j];
        }
    }
}
#define NV_ZERO(acc) do { _Pragma("unroll") for (int i_ = 0; i_ < 4; ++i_) _Pragma("unroll") for (int j_ = 0; j_ < 4; ++j_) acc[i_][j_] = 0.f; } while (0)

__global__ void __launch_bounds__(256) k_gemm_in(Params p, int l) {
    __shared__ float As[16][68], Bs[16][68];
    const h16* A = WSP(h16, OFF_A); const h16* Bt = WSP(h16, OFF_W16 + l * SZ_LAYERW); h16* Z = WSP(h16, OFF_Z);
    const int ntn = ZW / 64, ntiles = (MT / 64) * ntn, ty = threadIdx.x >> 4, tx = threadIdx.x & 15;
    for (int t = blockIdx.x; t < ntiles; t += gridDim.x) {
        const int r0 = (t / ntn) * 64, c0 = (t % ntn) * 64; float acc[4][4]; NV_ZERO(acc);
        nv_tile_mm(A + (size_t)r0 * AW + AH, AW, Bt + (size_t)c0 * 1024, 1024, 1024, acc, As, Bs);
#pragma unroll
        for (int i = 0; i < 4; ++i) { h16x4 o; o[0] = (h16)acc[i][0]; o[1] = (h16)acc[i][1]; o[2] = (h16)acc[i][2]; o[3] = (h16)acc[i][3];
            *(h16x4*)(Z + (size_t)(r0 + ty * 4 + i) * ZW + c0 + tx * 4) = o; }
    }
}
__global__ void __launch_bounds__(256) k_qkv(Params p, int l) {
    const h16* Z = WSP(h16, OFF_Z); h16* Qh = WSP(h16, OFF_QH); h16* Kh = WSP(h16, OFF_KH); h16* Vh = WSP(h16, OFF_VH);
    const int lane = threadIdx.x & 63, wv = threadIdx.x >> 6;
    const int nitems = MT * 12;
    for (int it = blockIdx.x * 4 + wv; it < nitems; it += gridDim.x * 4) {
        const int r = it / 12, s = it % 12; int s0, len, pos; row_seq(r, s0, len, pos);
        const bool lat = r >= MC; const int b = lat ? (r - MC) >> 12 : r >> 8; const size_t krow = (size_t)b * SB + (lat ? CTX + pos : pos);
        if (s >= 10) { Vh[krow * 128 + (s - 10) * 64 + lane] = Z[(size_t)r * ZW + ZV + (s - 10) * 64 + lane]; continue; }
        const int zc = s < 8 ? ZQ + s * 64 : ZK + (s - 8) * 64;
        const float z = (float)Z[(size_t)r * ZW + zc + lane];
        float ss = z * z;
#pragma unroll
        for (int o = 32; o >= 1; o >>= 1) ss += __shfl_xor(ss, o);
        const float g = s < 8 ? p.q_norm[l * 64 + lane] : p.k_norm[l * 64 + lane];
        float y = z * rsqrtf(ss * (1.0f / 64.0f) + 1e-6f) * g;
        const float yp = __shfl_xor(y, 16);
        if (lat) {
            const float posf = (lane < 32) ? (float)(pos >> 6) : (float)(pos & 63);
            const float inv = exp2f(-(float)(lane & 15) * (13.287712379549449f / 16.0f));
            float sn, cs; sincosf(posf * inv, &sn, &cs);
            y = (lane & 16) ? (y * cs + yp * sn) : (y * cs - yp * sn);
        }
        if (s < 8) Qh[(size_t)r * 512 + s * 64 + lane] = (h16)(y * QSCALE);
        else Kh[krow * 128 + (s - 8) * 64 + lane] = (h16)y;
    }
}
__global__ void __launch_bounds__(256) k_pool(Params p, int r_begin) {
    const h16* Z = WSP(h16, OFF_Z); h16* A = WSP(h16, OFF_A);
    for (int r = r_begin + blockIdx.x; r < MT; r += gridDim.x) {
        int s0, len, pos; row_seq(r, s0, len, pos);
        for (int j = threadIdx.x; j < 512; j += 256) {
            const int w = 2 << (j >> 7), lo = pos - (w >> 1); const int a = lo < 0 ? 0 : lo, e = (lo + w) > len ? len : (lo + w);
            float s = 0.f; for (int t = a; t < e; ++t) s += (float)Z[(size_t)(s0 + t) * ZW + ZP + j];
            A[(size_t)r * AW + AY0 + j] = (h16)(s / (float)(e - a) - (float)Z[(size_t)r * ZW + ZP + j]);
        }
    }
}
__global__ void __launch_bounds__(64) k_lru_scan(Params p, int l, int dir) {
    __shared__ float xs[64];
    const int b = blockIdx.x >> 3, blk = blockIdx.x & 7, j = threadIdx.x, c = blk * 64 + j;
    const h16* Z = WSP(h16, OFF_Z); h16* A = WSP(h16, OFF_A); float* HF = p.out;
    float wa[64], wx[64];
    const float* pwa = p.lru_wa + ((size_t)(l * 2 + dir) * 8 + blk) * 4096; const float* pwx = p.lru_wx + ((size_t)(l * 2 + dir) * 8 + blk) * 4096;
#pragma unroll
    for (int i = 0; i < 64; ++i) { wa[i] = pwa[i * 64 + j]; wx[i] = pwx[i * 64 + j]; }
    const float ba = p.lru_ba[(l * 2 + dir) * 512 + c], bx = p.lru_bx[(l * 2 + dir) * 512 + c], lam = p.lru_lambda[(l * 2 + dir) * 512 + c];
    const float sp = log1pf(expf(-lam));
    float cw[4]; for (int k = 0; k < 4; ++k) cw[k] = p.conv_w[(l * 4 + k) * 512 + c];
    const float cb = p.conv_b[l * 512 + c];
    float h = 0.f;
    for (int idx = 0; idx < SB; ++idx) {
        int s0, len, pos;
        if (idx < CTX) { s0 = b * CTX; len = CTX; pos = dir ? CTX - 1 - idx : idx; } else { s0 = MC + b * SEQ; len = SEQ; pos = dir ? SEQ - 1 - (idx - CTX) : idx - CTX; }
        float xc = cb;
#pragma unroll
        for (int k = 0; k < 4; ++k) { const int t = pos + k - 2; if (t >= 0 && t < len) xc += cw[k] * (float)Z[(size_t)(s0 + t) * ZW + ZLX + c]; }
        __syncthreads(); xs[j] = xc; __syncthreads();
        float ra = ba, ri = bx;
#pragma unroll
        for (int i = 0; i < 64; ++i) { const float xv = xs[i]; ra += xv * wa[i]; ri += xv * wx[i]; }
        const float rg = sigmoidf_(ra), ig = sigmoidf_(ri), la = -8.0f * rg * sp, a = expf(la), u = sqrtf(-expm1f(2.0f * la)) * ig * xc;
        h = a * h + u;
        const int r = s0 + pos;
        if (dir == 0) HF[(size_t)r * 512 + c] = h;
        else { const float tot = HF[(size_t)r * 512 + c] + h; A[(size_t)r * AW + AY2 + c] = (h16)(tot * gelu_tanh((float)Z[(size_t)r * ZW + ZLG + c])); }
    }
}
__global__ void __launch_bounds__(256) k_attn(Params p, int isctx) {
    __shared__ float Ks[64][64], Vs[64][64];
    const h16* Qh = WSP(h16, OFF_QH); const h16* Kh = WSP(h16, OFF_KH); const h16* Vh = WSP(h16, OFF_VH); h16* A = WSP(h16, OFF_A);
    const int nqb = isctx ? 1 : 16, nunits = NB * 8 * nqb, tid = threadIdx.x;
    for (int u = blockIdx.x; u < nunits; u += gridDim.x) {
        const int b = u / (8 * nqb), hq = (u / nqb) % 8, qb = u % nqb, kvh = hq >> 2;
        const int r = isctx ? b * CTX + tid : MC + b * SEQ + qb * 256 + tid; const int nkeys = isctx ? CTX : SB;
        float q[64], o[64];
#pragma unroll
        for (int d = 0; d < 64; ++d) { q[d] = (float)Qh[(size_t)r * 512 + hq * 64 + d]; o[d] = 0.f; }
        float m = -INFINITY, lsum = 0.f;
        for (int k0 = 0; k0 < nkeys; k0 += 64) {
            __syncthreads();
            { const int key = tid >> 2, d0 = (tid & 3) * 16; const size_t base = ((size_t)b * SB + k0 + key) * 128 + kvh * 64 + d0;
#pragma unroll
              for (int i = 0; i < 16; ++i) { Ks[key][d0 + i] = (float)Kh[base + i]; Vs[key][d0 + i] = (float)Vh[base + i]; } }
            __syncthreads();
            for (int key = 0; key < 64; ++key) {
                float s = 0.f;
#pragma unroll
                for (int d = 0; d < 64; ++d) s += q[d] * Ks[key][d];
                const float mn = fmaxf(m, s), corr = exp2f(m - mn), pe = exp2f(s - mn);
                lsum = lsum * corr + pe;
#pragma unroll
                for (int d = 0; d < 64; ++d) o[d] = o[d] * corr + pe * Vs[key][d];
                m = mn;
            }
        }
        const float il = 1.0f / lsum;
#pragma unroll
        for (int d = 0; d < 64; ++d) A[(size_t)r * AW + AY1 + hq * 64 + d] = (h16)(o[d] * il);
    }
}
__global__ void __launch_bounds__(256) k_merge(Params p, int l, int r_begin) {
    __shared__ float As[16][68], Bs[16][68];
    const h16* A = WSP(h16, OFF_A); const h16* Bt = WSP(h16, OFF_W16 + l * SZ_LAYERW + SZ_WINT); h16* S16 = (h16*)p.out;
    const int nrt = (MT - r_begin) / 64, ntiles = nrt * 16, ty = threadIdx.x >> 4, tx = threadIdx.x & 15;
    for (int t = blockIdx.x; t < ntiles; t += gridDim.x) {
        const int r0 = r_begin + (t / 16) * 64, c0 = (t % 16) * 64; float sum[4][4]; NV_ZERO(sum);
        for (int n = 0; n < 3; ++n) {
            float ag[4][4], ab[4][4]; NV_ZERO(ag); NV_ZERO(ab);
            nv_tile_mm(A + (size_t)r0 * AW + AH, AW, Bt + (size_t)(n * 1024 + c0) * 1536, 1536, 1024, ag, As, Bs);
            nv_tile_mm(A + (size_t)r0 * AW + AY0 + n * 512, AW, Bt + (size_t)(n * 1024 + c0) * 1536 + 1024, 1536, 512, ab, As, Bs);
#pragma unroll
            for (int i = 0; i < 4; ++i)
#pragma unroll
                for (int j = 0; j < 4; ++j) sum[i][j] += sigmoidf_(ag[i][j] + p.b_merge[(l * 3 + n) * 1024 + c0 + tx * 4 + j]) * ab[i][j];
        }
#pragma unroll
        for (int i = 0; i < 4; ++i) { h16x4 o; o[0] = (h16)sum[i][0]; o[1] = (h16)sum[i][1]; o[2] = (h16)sum[i][2]; o[3] = (h16)sum[i][3];
            *(h16x4*)(S16 + (size_t)(r0 + ty * 4 + i) * 1024 + c0 + tx * 4) = o; }
    }
}
__global__ void __launch_bounds__(256) k_wout(Params p, int l, int r_begin) {
    __shared__ float As[16][68], Bs[16][68];
    const h16* S16 = (const h16*)p.out; const h16* Bt = WSP(h16, OFF_W16 + l * SZ_LAYERW + SZ_WINT + SZ_BTALL); float* X = WSP(float, OFF_X); const float* mod = WSP(float, OFF_MOD) + (size_t)l * 9 * 6144;
    const int nrt = (MT - r_begin) / 64, ntiles = nrt * 16, ty = threadIdx.x >> 4, tx = threadIdx.x & 15;
    for (int t = blockIdx.x; t < ntiles; t += gridDim.x) {
        const int r0 = r_begin + (t / 16) * 64, c0 = (t % 16) * 64; float acc[4][4]; NV_ZERO(acc);
        nv_tile_mm(S16 + (size_t)r0 * 1024, 1024, Bt + (size_t)c0 * 1024, 1024, 1024, acc, As, Bs);
#pragma unroll
        for (int i = 0; i < 4; ++i) { const int r = r0 + ty * 4 + i, g = row_group(r); const float* res = (l == 0) ? xin_row(p, r) : X + (size_t)r * D;
#pragma unroll
            for (int j = 0; j < 4; ++j) { const int d = c0 + tx * 4 + j; X[(size_t)r * D + d] = ALPHA * res[d] + mod[(size_t)g * 6144 + 2 * 1024 + d] * acc[i][j]; } }
    }
}
__global__ void __launch_bounds__(256) k_ln(Params p, int mode, int r_begin, const float* __restrict__ gam, const float* __restrict__ bet, int lm, int sh, int sc) {
    float* X = WSP(float, OFF_X); h16* A = WSP(h16, OFF_A); const float* mod = WSP(float, OFF_MOD) + (size_t)lm * 9 * 6144;
    const int lane = threadIdx.x & 63, wv = threadIdx.x >> 6;
    for (int r = r_begin + blockIdx.x * 4 + wv; r < MT; r += gridDim.x * 4) {
        const int g = row_group(r); float v[16];
#pragma unroll
        for (int i = 0; i < 4; ++i) { const float4 t = *(const float4*)(X + (size_t)r * D + i * 256 + lane * 4); v[i * 4] = t.x; v[i * 4 + 1] = t.y; v[i * 4 + 2] = t.z; v[i * 4 + 3] = t.w; }
        if (mode == 2) {
            const h16* o0 = WSP(h16, OFF_OUT2) + (size_t)(r - MC) * 1024; const h16* o1 = o0 + (size_t)ML * 1024; const float* m5 = WSP(float, OFF_MOD) + (size_t)(1 * 9 + g) * 6144 + 5 * 1024;
#pragma unroll
            for (int i = 0; i < 4; ++i) { const h16x4 a = *(const h16x4*)(o0 + i * 256 + lane * 4), b2 = *(const h16x4*)(o1 + i * 256 + lane * 4); const float4 mm = *(const float4*)(m5 + i * 256 + lane * 4);
                const float mv[4] = {mm.x, mm.y, mm.z, mm.w};
#pragma unroll
                for (int j = 0; j < 4; ++j) v[i * 4 + j] = ALPHA * v[i * 4 + j] + mv[j] * ((float)a[j] + (float)b2[j]); }
        }
        float s = 0.f;
#pragma unroll
        for (int i = 0; i < 16; ++i) s += v[i];
#pragma unroll
        for (int o = 32; o >= 1; o >>= 1) s += __shfl_xor(s, o);
        const float mean = s * (1.0f / 1024.0f); float q = 0.f;
#pragma unroll
        for (int i = 0; i < 16; ++i) { const float dlt = v[i] - mean; q += dlt * dlt; }
#pragma unroll
        for (int o = 32; o >= 1; o >>= 1) q += __shfl_xor(q, o);
        const float rstd = rsqrtf(q * (1.0f / 1024.0f) + 1e-5f);
        float lg8[8];
#pragma unroll
        for (int e = 0; e < 8; ++e) lg8[e] = 0.f;
#pragma unroll
        for (int i = 0; i < 4; ++i) {
            const int d = i * 256 + lane * 4; const float4 gg = *(const float4*)(gam + d), bb = *(const float4*)(bet + d);
            const float gv[4] = {gg.x, gg.y, gg.z, gg.w}, bv[4] = {bb.x, bb.y, bb.z, bb.w}; float y[4];
#pragma unroll
            for (int j = 0; j < 4; ++j) y[j] = (v[i * 4 + j] - mean) * rstd * gv[j] + bv[j];
            if (mode == 2) { *(float4*)(p.out + (size_t)(r - MC) * D + d) = make_float4(y[0], y[1], y[2], y[3]); continue; }
            *(float4*)(X + (size_t)r * D + d) = make_float4(y[0], y[1], y[2], y[3]);
            const float4 ms = *(const float4*)(mod + (size_t)g * 6144 + sh * 1024 + d), mc = *(const float4*)(mod + (size_t)g * 6144 + sc * 1024 + d);
            const float msv[4] = {ms.x, ms.y, ms.z, ms.w}, mcv[4] = {mc.x, mc.y, mc.z, mc.w}; float hh[4]; h16x4 ho;
#pragma unroll
            for (int j = 0; j < 4; ++j) { hh[j] = y[j] * (1.f + mcv[j]) + msv[j]; ho[j] = (h16)hh[j]; }
            *(h16x4*)(A + (size_t)r * AW + AH + d) = ho;
            if (mode == 1) {
#pragma unroll
                for (int j = 0; j < 4; ++j) { const float4 r0 = *(const float4*)(p.moe_router + (size_t)(d + j) * 8), r1 = *(const float4*)(p.moe_router + (size_t)(d + j) * 8 + 4);
                    lg8[0] += hh[j] * r0.x; lg8[1] += hh[j] * r0.y; lg8[2] += hh[j] * r0.z; lg8[3] += hh[j] * r0.w; lg8[4] += hh[j] * r1.x; lg8[5] += hh[j] * r1.y; lg8[6] += hh[j] * r1.z; lg8[7] += hh[j] * r1.w; }
            }
        }
        if (mode == 1) {
#pragma unroll
            for (int e = 0; e < 8; ++e) {
#pragma unroll
                for (int o = 32; o >= 1; o >>= 1) lg8[e] += __shfl_xor(lg8[e], o);
                lg8[e] += p.moe_router_b[e]; }
            if (lane == 0) {
                int i0 = 0; float v0 = lg8[0];
#pragma unroll
                for (int e = 1; e < 8; ++e) if (lg8[e] > v0) { v0 = lg8[e]; i0 = e; }
                int i1 = -1; float v1 = -INFINITY;
#pragma unroll
                for (int e = 0; e < 8; ++e) if (e != i0 && lg8[e] > v1) { v1 = lg8[e]; i1 = e; }
                const float p1 = 1.0f / (1.0f + expf(v0 - v1)), p0 = 1.0f - p1;
                const int t = r - MC; int* cnt = WSP(int, OFF_CNT);
                const int k0 = atomicAdd(&cnt[i0], 1), k1 = atomicAdd(&cnt[i1], 1);
                WSP(int, OFF_TOKE)[t * 2] = i0; WSP(int, OFF_TOKE)[t * 2 + 1] = i1; WSP(float, OFF_TOKP)[t * 2] = p0; WSP(float, OFF_TOKP)[t * 2 + 1] = p1; WSP(int, OFF_TOKR)[t * 2] = k0; WSP(int, OFF_TOKR)[t * 2 + 1] = k1;
            }
        }
    }
}
__global__ void __launch_bounds__(256) k_ffn_gu(Params p, int moe, int panel0, int npan) {
    __shared__ float As[16][68], Bs[16][68];
    const int* plan = WSP(int, OFF_PLAN); const int npanels = moe ? plan[8] : MT / 256;
    const int dff = moe ? DEX : DFF, ntn = dff / 64, ty = threadIdx.x >> 4, tx = threadIdx.x & 15;
    const h16* A = moe ? WSP(h16, OFF_XG) : WSP(h16, OFF_A) + AH; const int lda = moe ? 1024 : AW;
    h16* ACT = moe ? (h16*)p.out : WSP(h16, OFF_ACT);
    const int ntiles = npan * 4 * ntn;
    for (int t = blockIdx.x; t < ntiles; t += gridDim.x) {
        const int rt = t / ntn, panel = panel0 + rt / 4; if (panel >= npanels) break;
        const int r0 = panel * 256 + (rt % 4) * 64, j0 = (t % ntn) * 64;
        const h16* Bt = moe ? WSP(h16, OFF_WMOE_GU) + (size_t)plan[16 + panel] * 2 * DEX * 1024 : WSP(h16, OFF_WGUT);
        const int brow = (j0 >> 7) * 256 + (j0 & 127);
        float ag[4][4], au[4][4]; NV_ZERO(ag); NV_ZERO(au);
        nv_tile_mm(A + (size_t)r0 * lda, lda, Bt + (size_t)brow * 1024, 1024, 1024, ag, As, Bs);
        nv_tile_mm(A + (size_t)r0 * lda, lda, Bt + (size_t)(brow + 128) * 1024, 1024, 1024, au, As, Bs);
        const size_t orow0 = moe ? (size_t)(r0 - panel0 * 256) : (size_t)r0;
#pragma unroll
        for (int i = 0; i < 4; ++i) { h16x4 o;
#pragma unroll
            for (int j = 0; j < 4; ++j) o[j] = (h16)(siluf_(ag[i][j]) * au[i][j]);
            *(h16x4*)(ACT + (orow0 + ty * 4 + i) * dff + j0 + tx * 4) = o; }
    }
}
__global__ void __launch_bounds__(256) k_ffn_down(Params p, int moe, int panel0, int npan) {
    __shared__ float As[16][68], Bs[16][68];
    const int* plan = WSP(int, OFF_PLAN); const int npanels = moe ? plan[8] : MT / 256;
    const int dff = moe ? DEX : DFF, ty = threadIdx.x >> 4, tx = threadIdx.x & 15;
    const h16* ACT = moe ? (const h16*)p.out : WSP(h16, OFF_ACT);
    float* X = WSP(float, OFF_X); const float* mod = WSP(float, OFF_MOD);
    const int ntiles = npan * 4 * 16;
    for (int t = blockIdx.x; t < ntiles; t += gridDim.x) {
        const int rt = t / 16, panel = panel0 + rt / 4; if (panel >= npanels) break;
        const int r0 = panel * 256 + (rt % 4) * 64, c0 = (t % 16) * 64;
        const h16* Bt = moe ? WSP(h16, OFF_WMOE_D) + (size_t)plan[16 + panel] * 1024 * DEX : WSP(h16, OFF_WDT);
        const size_t arow0 = moe ? (size_t)(r0 - panel0 * 256) : (size_t)r0;
        float acc[4][4]; NV_ZERO(acc);
        nv_tile_mm(ACT + arow0 * dff, dff, Bt + (size_t)c0 * dff, dff, dff, acc, As, Bs);
#pragma unroll
        for (int i = 0; i < 4; ++i) { const int r = r0 + ty * 4 + i;
            if (!moe) { const int g = row_group(r);
#pragma unroll
                for (int j = 0; j < 4; ++j) { const int d = c0 + tx * 4 + j; X[(size_t)r * D + d] = ALPHA * X[(size_t)r * D + d] + mod[(size_t)g * 6144 + 5 * 1024 + d] * acc[i][j]; } }
            else { const int tk = WSP(int, OFF_ROWT)[r]; if (tk < 0) continue; const float pp = WSP(float, OFF_ROWP)[r];
                h16x4 o;
#pragma unroll
                for (int j = 0; j < 4; ++j) o[j] = (h16)(pp * acc[i][j]);
                *(h16x4*)(WSP(h16, OFF_OUT2) + ((size_t)(tk & 1) * ML + (tk >> 1)) * 1024 + c0 + tx * 4) = o; }
        }
    }
}
__global__ void __launch_bounds__(256) k_moe_plan(Params p) {
    int* plan = WSP(int, OFF_PLAN); const int* cnt = WSP(int, OFF_CNT); int* rowT = WSP(int, OFF_ROWT);
    __shared__ int sp[9];
    if (threadIdx.x == 0) { int acc = 0; for (int e = 0; e < 8; ++e) { sp[e] = acc; plan[e] = acc; const int np = (cnt[e] + 255) / 256; for (int q = 0; q < np; ++q) plan[16 + acc / 256 + q] = e; acc += np * 256; } sp[8] = acc; plan[8] = acc / 256; }
    __syncthreads();
    for (int e = 0; e < 8; ++e) { const int a = sp[e] + cnt[e], b = sp[e + 1]; for (int i = a + threadIdx.x; i < b; i += 256) rowT[i] = -1; }
}
__global__ void __launch_bounds__(256) k_moe_gather(Params p) {
    const int* plan = WSP(int, OFF_PLAN); const h16* A = WSP(h16, OFF_A); h16* Xg = WSP(h16, OFF_XG);
    const int lane = threadIdx.x & 63, wv = threadIdx.x >> 6;
    for (int it = blockIdx.x * 4 + wv; it < ML * 2; it += gridDim.x * 4) {
        const int t = it >> 1, e = WSP(int, OFF_TOKE)[it], pos = plan[e] + WSP(int, OFF_TOKR)[it];
        const h16* src = A + (size_t)(MC + t) * AW + AH; h16* dst = Xg + (size_t)pos * 1024;
        *(h16x8*)(dst + lane * 8) = *(const h16x8*)(src + lane * 8); *(h16x8*)(dst + 512 + lane * 8) = *(const h16x8*)(src + 512 + lane * 8);
        if (lane == 0) { WSP(int, OFF_ROWT)[pos] = it; WSP(float, OFF_ROWP)[pos] = WSP(float, OFF_TOKP)[it]; }
    }
}


#define LAS __attribute__((address_space(3)))
typedef float f32x4 __attribute__((ext_vector_type(4)));
typedef unsigned u32x4 __attribute__((ext_vector_type(4)));
typedef unsigned u32x2 __attribute__((ext_vector_type(2)));
namespace pg8 {
constexpr int BM = 256, BK = 64, HALF = 128, HTB = HALF * BK * 2, STAGE_BYTES = 8 * HTB;
__host__ __device__ __forceinline__ int lds_byte(int r, int c) { const int st = (r >> 4) * 2 + (c >> 5), rr = r & 15, cc = c & 31, ob = rr * 64 + cc * 2; return st * 1024 + (ob ^ (((ob >> 9) & 1) << 5)); }
__host__ __device__ __forceinline__ void stage_rc(int b, int& R, int& C) { const int st = b / 1024, sb = b % 1024, swz = sb ^ (((sb >> 9) & 1) << 5); R = (st >> 1) * 16 + swz / 64; C = (st & 1) * 32 + (swz % 64) / 2; }
__host__ __device__ __forceinline__ int perm32(int rho) { const int n = rho >> 4, i = rho & 15; return 8 * (i >> 2) + 4 * n + (i & 3); }
struct GUnit { const char* A; const char* B; int nt; int kind; int pm; int pn; int aux; };
__device__ __forceinline__ void tile_map(int L, int nM, int nN, int& pm, int& pn) {
    const int nwg = nM * nN; int wgid = L;
    { const int q = nwg / 8, r = nwg % 8, xcd = wgid % 8, off = wgid / 8; wgid = (xcd < r ? xcd * (q + 1) : r * (q + 1) + (xcd - r) * q) + off; }
    const int nig = 8 * nN, gid = wgid / nig, fm = gid * 8, gsz = (nM - fm) < 8 ? (nM - fm) : 8;
    pm = fm + ((wgid % nig) % gsz); pn = (wgid % nig) / gsz;
}
__device__ __forceinline__ unsigned cvt_pk_f16(float lo, float hi) { typedef float f2 __attribute__((ext_vector_type(2))); const f2 v = {lo, hi}; const h16x2 h = __builtin_convertvector(v, h16x2); return __builtin_bit_cast(unsigned, h); }

template <class Epi, class Sched>
__device__ __forceinline__ void gemm_phase(LAS unsigned char* lds, const int lda, const int ldb, const Sched& S, const Epi& E) {
    const int tid = threadIdx.x, wid = __builtin_amdgcn_readfirstlane(tid >> 6), lane = tid & 63, wr = wid >> 2, wc = wid & 3, fr = lane & 15, fq = lane >> 4;
    unsigned voffA[2], voffB[2];
#pragma unroll
    for (int i = 0; i < 2; ++i) { int R, C; stage_rc(tid * 16 + i * 8192, R, C); const int Rb = Epi::PERM ? ((R & ~31) + perm32(R & 31)) : R;
        voffA[i] = (unsigned)(R * lda + C) * 2u; voffB[i] = (unsigned)(Rb * ldb + C) * 2u; }
    const size_t kstep = (size_t)(BK * 2);
    const size_t hstepA = (size_t)HALF * lda * 2, hstepB = (size_t)HALF * ldb * 2;
    const unsigned ldsw = (unsigned)wid * 1024u;
    const int aoff = lds_byte(wr * 64 + fr, fq * 8), boff = lds_byte(wc * 32 + fr, fq * 8);
#define PG8_SA(b, h) (((b) * 2 + (h)) * HTB)
#define PG8_SB(b, h) ((4 + (b) * 2 + (h)) * HTB)
#define PG8_STAGE(bufoff, gbase, voff) do { _Pragma("unroll") for (int _i = 0; _i < 2; ++_i) \
        __builtin_amdgcn_global_load_lds((const unsigned*)((const char*)(gbase) + (voff)[_i]), (LAS unsigned*)(lds + (bufoff) + ldsw + _i * 8192), 16, 0, 0); } while (0)
#define PG8_LDA(dst, b, h) do { _Pragma("unroll") for (int m = 0; m < 4; ++m) _Pragma("unroll") for (int k = 0; k < 2; ++k) dst[m][k] = *(const LAS h16x8*)(lds + PG8_SA(b, h) + aoff + m * 2048 + k * 1024); } while (0)
#define PG8_LDB(dst, b, h) do { _Pragma("unroll") for (int n = 0; n < 2; ++n) _Pragma("unroll") for (int k = 0; k < 2; ++k) dst[n][k] = *(const LAS h16x8*)(lds + PG8_SB(b, h) + boff + n * 2048 + k * 1024); } while (0)
#define PG8_MMA(ai, bj, At, Bt) do { __builtin_amdgcn_s_setprio(1); _Pragma("unroll") for (int m = 0; m < 4; ++m) _Pragma("unroll") for (int n = 0; n < 2; ++n) _Pragma("unroll") for (int k = 0; k < 2; ++k) \
        acc[ai][bj][m][n] = __builtin_amdgcn_mfma_f32_16x16x32_f16(Bt[n][k], At[m][k], acc[ai][bj][m][n], 0, 0, 0); __builtin_amdgcn_s_setprio(0); } while (0)
#define PG8_WAIT_V(n) asm volatile("s_waitcnt vmcnt(" #n ")" ::: "memory")
#define PG8_WAIT_L(n) asm volatile("s_waitcnt lgkmcnt(" #n ")" ::: "memory")
#define PG8_BAR __builtin_amdgcn_s_barrier()
#define PG8_SCHED __builtin_amdgcn_sched_barrier(0)
    GUnit cur, nxt; int ui = 0;
    if (!S.next(0, cur)) return;
    f32x4 acc[2][2][4][2];
#pragma unroll
    for (int a = 0; a < 2; ++a)
#pragma unroll
        for (int b = 0; b < 2; ++b)
#pragma unroll
            for (int m = 0; m < 4; ++m)
#pragma unroll
                for (int n = 0; n < 2; ++n) acc[a][b][m][n] = (f32x4){0.f, 0.f, 0.f, 0.f};
    h16x8 At[4][2], B0[2][2], B1[2][2];
    const char* cA = cur.A; const char* cB = cur.B;
    PG8_STAGE(PG8_SB(0, 0), cB, voffB); PG8_STAGE(PG8_SA(0, 0), cA, voffA); PG8_STAGE(PG8_SB(0, 1), cB + hstepB, voffB); PG8_STAGE(PG8_SA(0, 1), cA + hstepA, voffA);
    if (wr == 1) PG8_BAR;
    PG8_WAIT_V(4); PG8_BAR;
    PG8_STAGE(PG8_SB(1, 0), cB + kstep, voffB); PG8_STAGE(PG8_SA(1, 0), cA + kstep, voffA); PG8_STAGE(PG8_SB(1, 1), cB + hstepB + kstep, voffB);
    PG8_WAIT_V(6); PG8_BAR;
    for (;;) {
        const bool has_next = S.next(ui + 1, nxt);
        const char* nA = has_next ? nxt.A : cA; const char* nB = has_next ? nxt.B : cB;
        const int nt = cur.nt;
        for (int t = 0; t < nt; t += 2) {
            const bool last = (t == nt - 2);
            const char* a1 = cA + (size_t)(t + 1) * kstep;
            const char* a2 = last ? nA : cA + (size_t)(t + 2) * kstep; const char* b2 = last ? nB : cB + (size_t)(t + 2) * kstep;
            const char* a3 = a2 + kstep; const char* b3 = b2 + kstep;
            PG8_LDB(B0, 0, 0); PG8_SCHED; PG8_LDA(At, 0, 0); PG8_STAGE(PG8_SA(1, 1), a1 + hstepA, voffA);
            PG8_WAIT_L(8); PG8_BAR; PG8_WAIT_L(0); PG8_MMA(0, 0, At, B0); PG8_BAR; PG8_SCHED;
            PG8_LDB(B1, 0, 1); PG8_STAGE(PG8_SB(0, 0), b2, voffB);
            PG8_BAR; PG8_WAIT_L(0); PG8_MMA(0, 1, At, B1); PG8_BAR;
            PG8_LDA(At, 0, 1); PG8_STAGE(PG8_SA(0, 0), a2, voffA);
            PG8_BAR; PG8_WAIT_L(0); PG8_MMA(1, 0, At, B0); PG8_BAR; PG8_SCHED;
            PG8_STAGE(PG8_SB(0, 1), b2 + hstepB, voffB);
            PG8_WAIT_V(6); PG8_BAR; PG8_MMA(1, 1, At, B1); PG8_BAR;
            PG8_LDB(B0, 1, 0); PG8_SCHED; PG8_LDA(At, 1, 0); PG8_STAGE(PG8_SA(0, 1), a2 + hstepA, voffA);
            PG8_WAIT_L(8); PG8_BAR; PG8_WAIT_L(0); PG8_MMA(0, 0, At, B0); PG8_BAR; PG8_SCHED;
            PG8_LDB(B1, 1, 1); PG8_STAGE(PG8_SB(1, 0), b3, voffB);
            PG8_BAR; PG8_WAIT_L(0); PG8_MMA(0, 1, At, B1); PG8_BAR;
            PG8_LDA(At, 1, 1); PG8_STAGE(PG8_SA(1, 0), a3, voffA);
            PG8_BAR; PG8_WAIT_L(0); PG8_MMA(1, 0, At, B0); PG8_BAR; PG8_SCHED;
            PG8_STAGE(PG8_SB(1, 1), b3 + hstepB, voffB);
            PG8_WAIT_V(6); PG8_BAR; PG8_MMA(1, 1, At, B1); PG8_BAR;
        }
        E(acc, cur, wr, wc, fr, fq);
        if (!has_next) break;
#pragma unroll
        for (int a = 0; a < 2; ++a)
#pragma unroll
            for (int b = 0; b < 2; ++b)
#pragma unroll
                for (int m = 0; m < 4; ++m)
#pragma unroll
                    for (int n = 0; n < 2; ++n) acc[a][b][m][n] = (f32x4){0.f, 0.f, 0.f, 0.f};
        cur = nxt; cA = nA; cB = nB; ++ui;
    }
    PG8_WAIT_V(0);
    if (wr == 0) PG8_BAR;
    PG8_BAR;
#undef PG8_SA
#undef PG8_SB
#undef PG8_STAGE
#undef PG8_LDA
#undef PG8_LDB
#undef PG8_MMA
#undef PG8_WAIT_V
#undef PG8_WAIT_L
#undef PG8_BAR
#undef PG8_SCHED
}
}
using pg8::GUnit;

struct SchedPlain {
    const char* A; const char* B; int lda, ldb, nt, pm0, nM, nN, G, c;
    __device__ __forceinline__ bool next(int i, GUnit& u) const {
        const int L = i * G + c; if (L >= nM * nN) return false;
        int pm, pn; pg8::tile_map(L, nM, nN, pm, pn);
        u.pm = pm0 + pm; u.pn = pn; u.kind = 0; u.aux = 0; u.nt = nt;
        u.A = A + (size_t)u.pm * 256 * lda * 2; u.B = B + (size_t)pn * 256 * ldb * 2; return true;
    }
};
struct SchedMerge {
    const char* A; const char* B; int pm0, nM, G, c;
    __device__ __forceinline__ bool next(int i, GUnit& u) const {
        const int ti = i / 6, sub = i - ti * 6, L = ti * G + c; if (L >= nM * 4) return false;
        int pm, pn; pg8::tile_map(L, nM, 4, pm, pn);
        const int n = sub >> 1, br = sub & 1;
        u.pm = pm0 + pm; u.pn = pn; u.kind = sub; u.aux = n; u.nt = br ? 8 : 16;
        u.A = A + ((size_t)u.pm * 256 * AW + (br ? AY0 + n * 512 : AH)) * 2;
        u.B = B + ((size_t)(n * 1024 + pn * 256) * 1536 + (br ? 1024 : 0)) * 2; return true;
    }
};
struct SchedMoe {
    const char* A; const char* B; const int* panelE; int lda, ldb, nt, pm0, arow_pm0, nM, nN, G, c; size_t estride;
    __device__ __forceinline__ bool next(int i, GUnit& u) const {
        const int L = i * G + c; if (L >= nM * nN) return false;
        int pm, pn; pg8::tile_map(L, nM, nN, pm, pn);
        u.pm = pm0 + pm; u.pn = pn; u.kind = 0; u.aux = 0; u.nt = nt;
        const int e = panelE[u.pm];
        u.A = A + (size_t)(u.pm - arow_pm0) * 256 * lda * 2; u.B = B + (size_t)e * estride + (size_t)pn * 256 * ldb * 2; return true;
    }
};

#define EPI_ARGS const f32x4 (&acc)[2][2][4][2], const GUnit& u, int wr, int wc, int fr, int fq
struct EpiF16 {
    static constexpr bool PERM = true;
    h16* O; int ldc;
    __device__ __forceinline__ void operator()(EPI_ARGS) const {
        const int row0 = u.pm * 256 + wr * 64 + fr, col0 = u.pn * 256 + wc * 32 + 8 * fq;
#pragma unroll
        for (int ai = 0; ai < 2; ++ai)
#pragma unroll
            for (int m = 0; m < 4; ++m) { h16* rowp = O + (size_t)(row0 + ai * 128 + m * 16) * ldc + col0;
#pragma unroll
                for (int bj = 0; bj < 2; ++bj) { const f32x4 v0 = acc[ai][bj][m][0], v1 = acc[ai][bj][m][1];
                    u32x4 w; w.x = pg8::cvt_pk_f16(v0[0], v0[1]); w.y = pg8::cvt_pk_f16(v0[2], v0[3]); w.z = pg8::cvt_pk_f16(v1[0], v1[1]); w.w = pg8::cvt_pk_f16(v1[2], v1[3]);
                    *(u32x4*)(rowp + bj * 128) = w; } }
    }
};
struct EpiMerge {
    static constexpr bool PERM = true;
    const float* bmerge;
    char* priv;
    h16* S16;
    __device__ __forceinline__ void operator()(EPI_ARGS) const {
        unsigned off0 = (unsigned)threadIdx.x * 16u; asm volatile("" : "+v"(off0));
        u32x4* pg = (u32x4*)(priv + off0); f32x4* ps = (f32x4*)(priv + 131072 + off0);
        if ((u.kind & 1) == 0) {
            const float* bb = bmerge + u.aux * 1024 + u.pn * 256 + wc * 32 + 8 * fq;
#pragma unroll
            for (int bj = 0; bj < 2; ++bj) { const f32x4 b0 = *(const f32x4*)(bb + bj * 128), b1 = *(const f32x4*)(bb + bj * 128 + 4);
#pragma unroll
                for (int ai = 0; ai < 2; ++ai)
#pragma unroll
                    for (int m = 0; m < 4; ++m) { f32x4 v0 = acc[ai][bj][m][0] + b0, v1 = acc[ai][bj][m][1] + b1;
#pragma unroll
                        for (int j = 0; j < 4; ++j) { v0[j] = sigmoidf_(v0[j]); v1[j] = sigmoidf_(v1[j]); }
                        u32x4 w; w.x = pg8::cvt_pk_f16(v0[0], v0[1]); w.y = pg8::cvt_pk_f16(v0[2], v0[3]); w.z = pg8::cvt_pk_f16(v1[0], v1[1]); w.w = pg8::cvt_pk_f16(v1[2], v1[3]);
                        pg[((ai * 2 + bj) * 4 + m) * 512] = w; } }
        } else {
            const int row0 = u.pm * 256 + wr * 64 + fr, col0 = u.pn * 256 + wc * 32 + 8 * fq;
#pragma unroll
            for (int ai = 0; ai < 2; ++ai)
#pragma unroll
                for (int m = 0; m < 4; ++m)
#pragma unroll
                    for (int bj = 0; bj < 2; ++bj) { const int slot = (ai * 2 + bj) * 4 + m;
                        const u32x4 w = pg[slot * 512]; const h16x8 g = __builtin_bit_cast(h16x8, w);
                        f32x4 s0 = acc[ai][bj][m][0], s1 = acc[ai][bj][m][1];
#pragma unroll
                        for (int j = 0; j < 4; ++j) { s0[j] *= (float)g[j]; s1[j] *= (float)g[4 + j]; }
                        if (u.kind != 1) { s0 += ps[(slot * 2) * 512]; s1 += ps[(slot * 2 + 1) * 512]; }
                        if (u.kind != 5) { ps[(slot * 2) * 512] = s0; ps[(slot * 2 + 1) * 512] = s1; }
                        else { u32x4 o; o.x = pg8::cvt_pk_f16(s0[0], s0[1]); o.y = pg8::cvt_pk_f16(s0[2], s0[3]); o.z = pg8::cvt_pk_f16(s1[0], s1[1]); o.w = pg8::cvt_pk_f16(s1[2], s1[3]);
                            *(u32x4*)(S16 + (size_t)(row0 + ai * 128 + m * 16) * 1024 + col0 + bj * 128) = o; }
                        if (bj) asm volatile("" ::: "memory"); }
        }
    }
};
struct EpiResid {
    static constexpr bool PERM = false;
    float* X; const float* res_ctx; const float* res_lat;
    const float* modv;
    __device__ __forceinline__ void operator()(EPI_ARGS) const {
        const int row0 = u.pm * 256 + wr * 64 + fr, col0 = u.pn * 256 + wc * 32 + 4 * fq;
        const int g = u.pm < 8 ? 0 : 1 + ((u.pm - 8) >> 4);
        const float* res = u.pm < 8 ? res_ctx : res_lat - (size_t)MC * D;
        f32x4 mv[2][2];
#pragma unroll
        for (int bj = 0; bj < 2; ++bj)
#pragma unroll
            for (int n = 0; n < 2; ++n) mv[bj][n] = *(const f32x4*)(modv + (size_t)g * 6144 + col0 + bj * 128 + n * 16);
#pragma unroll
        for (int ai = 0; ai < 2; ++ai)
#pragma unroll
            for (int m = 0; m < 4; ++m) { const size_t off = (size_t)(row0 + ai * 128 + m * 16) * D + col0;
#pragma unroll
                for (int bj = 0; bj < 2; ++bj)
#pragma unroll
                    for (int n = 0; n < 2; ++n) { const f32x4 r = *(const f32x4*)(res + off + bj * 128 + n * 16);
                        *(f32x4*)(X + off + bj * 128 + n * 16) = ALPHA * r + mv[bj][n] * acc[ai][bj][m][n]; } }
    }
};
struct EpiSwiglu {
    static constexpr bool PERM = true;
    h16* O; int ldc; int orow0;
    __device__ __forceinline__ void operator()(EPI_ARGS) const {
        const int row0 = u.pm * 256 - orow0 + wr * 64 + fr, col0 = u.pn * 128 + wc * 32 + 8 * fq;
#pragma unroll
        for (int ai = 0; ai < 2; ++ai)
#pragma unroll
            for (int m = 0; m < 4; ++m) { float o[8];
#pragma unroll
                for (int n = 0; n < 2; ++n)
#pragma unroll
                    for (int j = 0; j < 4; ++j) o[n * 4 + j] = siluf_(acc[ai][0][m][n][j]) * acc[ai][1][m][n][j];
                u32x4 w; w.x = pg8::cvt_pk_f16(o[0], o[1]); w.y = pg8::cvt_pk_f16(o[2], o[3]); w.z = pg8::cvt_pk_f16(o[4], o[5]); w.w = pg8::cvt_pk_f16(o[6], o[7]);
                *(u32x4*)(O + (size_t)(row0 + ai * 128 + m * 16) * ldc + col0) = w; }
    }
};
struct EpiMoeDown {
    static constexpr bool PERM = true;
    h16* OUT2; const int* rowT; const float* rowP;
    __device__ __forceinline__ void operator()(EPI_ARGS) const {
        const int row0 = u.pm * 256 + wr * 64 + fr, col0 = u.pn * 256 + wc * 32 + 8 * fq;
#pragma unroll
        for (int ai = 0; ai < 2; ++ai)
#pragma unroll
            for (int m = 0; m < 4; ++m) { const int r = row0 + ai * 128 + m * 16; const int tk = rowT[r]; const float pp = rowP[r];
                if (tk < 0) continue;
                h16* rowp = OUT2 + ((size_t)(tk & 1) * ML + (tk >> 1)) * 1024 + col0;
#pragma unroll
                for (int bj = 0; bj < 2; ++bj) { const f32x4 v0 = acc[ai][bj][m][0] * pp, v1 = acc[ai][bj][m][1] * pp;
                    u32x4 w; w.x = pg8::cvt_pk_f16(v0[0], v0[1]); w.y = pg8::cvt_pk_f16(v0[2], v0[3]); w.z = pg8::cvt_pk_f16(v1[0], v1[1]); w.w = pg8::cvt_pk_f16(v1[2], v1[3]);
                    *(u32x4*)(rowp + bj * 128) = w; } }
    }
};

constexpr int LDS_BYTES = 147456;
constexpr size_t OFF_PRIV = OFF_BIG;
__device__ __forceinline__ void ph_gemm_in(const Params& p, LAS unsigned char* lds, int l, int G, int c) {
    SchedPlain S; S.A = (const char*)(WSP(h16, OFF_A) + AH); S.B = (const char*)WSP(h16, OFF_W16 + l * SZ_LAYERW); S.lda = AW; S.ldb = 1024; S.nt = 16; S.pm0 = 0; S.nM = MT / 256; S.nN = ZW / 256; S.G = G; S.c = c;
    EpiF16 E; E.O = WSP(h16, OFF_Z); E.ldc = ZW;
    pg8::gemm_phase(lds, AW, 1024, S, E);
}
__device__ __forceinline__ void ph_merge(const Params& p, LAS unsigned char* lds, int l, int G, int c) {
    SchedMerge S; S.A = (const char*)WSP(h16, OFF_A); S.B = (const char*)WSP(h16, OFF_W16 + l * SZ_LAYERW + SZ_WINT); S.pm0 = l == 0 ? 0 : 8; S.nM = MT / 256 - S.pm0; S.G = G; S.c = c;
    EpiMerge E; E.bmerge = p.b_merge + (size_t)l * 3 * 1024; E.priv = p.ws + OFF_PRIV + (size_t)c * 393216; E.S16 = (h16*)p.out;
    pg8::gemm_phase(lds, AW, 1536, S, E);
}
__device__ __forceinline__ void ph_wout(const Params& p, LAS unsigned char* lds, int l, int G, int c) {
    SchedPlain S; S.A = (const char*)p.out; S.B = (const char*)WSP(h16, OFF_W16 + l * SZ_LAYERW + SZ_WINT + SZ_BTALL); S.lda = 1024; S.ldb = 1024; S.nt = 16; S.pm0 = l == 0 ? 0 : 8; S.nM = MT / 256 - S.pm0; S.nN = 4; S.G = G; S.c = c;
    EpiResid E; E.X = WSP(float, OFF_X); E.res_ctx = l == 0 ? p.ctx : WSP(float, OFF_X); E.res_lat = l == 0 ? p.x : WSP(float, OFF_X) + (size_t)MC * D; E.modv = WSP(float, OFF_MOD) + (size_t)l * 9 * 6144 + 2 * 1024;
    pg8::gemm_phase(lds, 1024, 1024, S, E);
}
__device__ __forceinline__ void ph_ffn_gu(const Params& p, LAS unsigned char* lds, int G, int c) {
    SchedPlain S; S.A = (const char*)(WSP(h16, OFF_A) + AH); S.B = (const char*)WSP(h16, OFF_WGUT); S.lda = AW; S.ldb = 1024; S.nt = 16; S.pm0 = 0; S.nM = MT / 256; S.nN = 2 * DFF / 256; S.G = G; S.c = c;
    EpiSwiglu E; E.O = WSP(h16, OFF_ACT); E.ldc = DFF; E.orow0 = 0;
    pg8::gemm_phase(lds, AW, 1024, S, E);
}
__device__ __forceinline__ void ph_ffn_down(const Params& p, LAS unsigned char* lds, int G, int c) {
    SchedPlain S; S.A = (const char*)WSP(h16, OFF_ACT); S.B = (const char*)WSP(h16, OFF_WDT); S.lda = DFF; S.ldb = DFF; S.nt = DFF / 64; S.pm0 = 0; S.nM = MT / 256; S.nN = 4; S.G = G; S.c = c;
    EpiResid E; E.X = WSP(float, OFF_X); E.res_ctx = WSP(float, OFF_X); E.res_lat = WSP(float, OFF_X) + (size_t)MC * D; E.modv = WSP(float, OFF_MOD) + 5 * 1024;
    pg8::gemm_phase(lds, DFF, DFF, S, E);
}
__device__ __forceinline__ void ph_moe_gu(const Params& p, LAS unsigned char* lds, int panel0, int G, int c) {
    const int* plan = WSP(int, OFF_PLAN); const int np = plan[8]; int nM = np - panel0; nM = nM > 64 ? 64 : nM; if (nM <= 0) return;
    SchedMoe S; S.A = (const char*)WSP(h16, OFF_XG); S.B = (const char*)WSP(h16, OFF_WMOE_GU); S.panelE = plan + 16; S.lda = 1024; S.ldb = 1024; S.nt = 16; S.pm0 = panel0; S.arow_pm0 = 0; S.nM = nM; S.nN = 2 * DEX / 256; S.G = G; S.c = c; S.estride = (size_t)2 * DEX * 1024 * 2;
    EpiSwiglu E; E.O = (h16*)p.out; E.ldc = DEX; E.orow0 = panel0 * 256;
    pg8::gemm_phase(lds, 1024, 1024, S, E);
}
__device__ __forceinline__ void ph_moe_down(const Params& p, LAS unsigned char* lds, int panel0, int G, int c) {
    const int* plan = WSP(int, OFF_PLAN); const int np = plan[8]; int nM = np - panel0; nM = nM > 64 ? 64 : nM; if (nM <= 0) return;
    SchedMoe S; S.A = (const char*)p.out; S.B = (const char*)WSP(h16, OFF_WMOE_D); S.panelE = plan + 16; S.lda = DEX; S.ldb = DEX; S.nt = DEX / 64; S.pm0 = panel0; S.arow_pm0 = panel0; S.nM = nM; S.nN = 4; S.G = G; S.c = c; S.estride = (size_t)1024 * DEX * 2;
    EpiMoeDown E; E.OUT2 = WSP(h16, OFF_OUT2); E.rowT = WSP(int, OFF_ROWT); E.rowP = WSP(float, OFF_ROWP);
    pg8::gemm_phase(lds, DEX, DEX, S, E);
}

namespace attn_body {
using s16x4 = __attribute__((ext_vector_type(4))) short;
using s16x8 = __attribute__((ext_vector_type(8))) short;
using f32x16 = __attribute__((ext_vector_type(16))) float;
constexpr int D64 = 64, NW = 8, QBLK = 32, QB = QBLK * NW, KVBLK = 64;
constexpr int QP = 512, KP = 128, OP = AW;
__device__ __forceinline__ int crow(int r, int hi) { return (r & 3) + 8 * (r >> 2) + 4 * hi; }
#define SBAR() __builtin_amdgcn_sched_barrier(0)
constexpr int NSLOT = 3, SLOTB = 8192;
constexpr int LDS_K = 0, LDS_V = NSLOT * SLOTB, LDS_WS = 2 * NSLOT * SLOTB, LDS_OST = LDS_WS + NW * 64 * 4, ATTN_LDS_BYTES = LDS_OST + NW * 4096;
__device__ __forceinline__ void glds16(const void* gsrc, unsigned lds_dst) { unsigned keep;
    asm volatile("s_mov_b32 %0, m0\n\ts_mov_b32 m0, %2\n\ts_nop 0\n\tglobal_load_lds_dwordx4 %1, off\n\ts_mov_b32 m0, %0" : "=&s"(keep) : "v"(gsrc), "s"(lds_dst) : "memory"); }
__device__ __forceinline__ float max3f(float a, float b, float c) { float r; asm("v_max3_f32 %0, %1, %2, %3" : "=v"(r) : "v"(a), "v"(b), "v"(c)); return r; }
__device__ __forceinline__ float max2f(float a, float b) { float r; asm("v_max_f32_e32 %0, %1, %2" : "=v"(r) : "v"(a), "v"(b)); return r; }
__device__ __forceinline__ float fadd_s(float a, float b) { float r; asm("v_add_f32_e32 %0, %1, %2" : "=v"(r) : "v"(a), "v"(b)); return r; }
__device__ __forceinline__ float fsub_s(float a, float b) { float r; asm("v_sub_f32_e32 %0, %1, %2" : "=v"(r) : "v"(a), "v"(b)); return r; }
__device__ __forceinline__ unsigned cvtpk_s(float lo, float hi) { return pg8::cvt_pk_f16(lo, hi); }
#define WAIT_BAR(N) asm volatile("s_waitcnt vmcnt(" #N ") lgkmcnt(0)\n\ts_barrier" ::: "memory")
#define AMFMA(a, b, c) __builtin_amdgcn_mfma_f32_32x32x16_f16(__builtin_bit_cast(h16x8, a), __builtin_bit_cast(h16x8, b), c, 0, 0, 0)
__device__ __forceinline__ void qkt(f32x16& p0, f32x16& p1, const char* Kslot, const s16x8* qr, const f32x16& negm, int r32, int hi) {
    const char* kb = Kslot + hi * 1024 + r32 * 16;
#pragma unroll
    for (int d0 = 0; d0 < 4; ++d0) {
        const s16x8 b0 = *reinterpret_cast<const s16x8*>(kb + d0 * 2048);
        const s16x8 b1 = *reinterpret_cast<const s16x8*>(kb + d0 * 2048 + 512);
        if (d0 == 0) { p0 = AMFMA(b0, qr[0], negm); p1 = AMFMA(b1, qr[0], negm); }
        else { p0 = AMFMA(b0, qr[d0], p0); p1 = AMFMA(b1, qr[d0], p1); } }
}
typedef __attribute__((address_space(3))) const char* lds_cptr;
typedef short v4i16_t __attribute__((ext_vector_type(4)));
__device__ __forceinline__ void kload8(s16x8* kf, lds_cptr kp) {
    kf[0] = *(const __attribute__((address_space(3))) s16x8*)(kp);        kf[1] = *(const __attribute__((address_space(3))) s16x8*)(kp + 512);
    kf[2] = *(const __attribute__((address_space(3))) s16x8*)(kp + 2048); kf[3] = *(const __attribute__((address_space(3))) s16x8*)(kp + 2560);
    kf[4] = *(const __attribute__((address_space(3))) s16x8*)(kp + 4096); kf[5] = *(const __attribute__((address_space(3))) s16x8*)(kp + 4608);
    kf[6] = *(const __attribute__((address_space(3))) s16x8*)(kp + 6144); kf[7] = *(const __attribute__((address_space(3))) s16x8*)(kp + 6656);
}
__device__ __forceinline__ void kload2(s16x8* kf, lds_cptr kp, int j) { kf[2 * j] = *(const __attribute__((address_space(3))) s16x8*)(kp + j * 2048); kf[2 * j + 1] = *(const __attribute__((address_space(3))) s16x8*)(kp + j * 2048 + 512); }
__device__ __forceinline__ s16x4 vtr(lds_cptr p) { return __builtin_bit_cast(s16x4, __builtin_amdgcn_ds_read_tr16_b64_v4i16((__attribute__((address_space(3))) v4i16_t*)p)); }
__device__ __forceinline__ float rowmax(const f32x16& p0, const f32x16& p1) {
    float a = max3f(p0[0], p0[1], p1[0]), b = max3f(p0[2], p0[3], p1[1]); a = max3f(a, p1[2], p1[3]);
#pragma unroll
    for (int r = 4; r < 16; r += 4) { a = max3f(a, p0[r], p0[r + 1]); b = max3f(b, p0[r + 2], p0[r + 3]); a = max3f(a, p1[r], p1[r + 1]); b = max3f(b, p1[r + 2], p1[r + 3]); }
    const float m = max2f(a, b);
    auto rr = __builtin_amdgcn_permlane32_swap(__float_as_uint(m), __float_as_uint(m), false, false);
    return max2f(__uint_as_float(rr[0]), __uint_as_float(rr[1]));
}
__device__ __forceinline__ void pv(f32x16* o, int vb, s16x8 pa0, s16x8 pa1, s16x8 pa2, s16x8 pa3) {
#pragma unroll
    for (int d0 = 0; d0 < 2; ++d0) { s16x4 lo[4], hi[4];
#pragma unroll
        for (int ks = 0; ks < 4; ++ks) {
            asm volatile("ds_read_b64_tr_b16 %0,%1 offset:%c2" : "=&v"(lo[ks]) : "v"(vb), "i"(d0 * 4096 + ks * 1024) : "memory");
            asm volatile("ds_read_b64_tr_b16 %0,%1 offset:%c2" : "=&v"(hi[ks]) : "v"(vb), "i"(d0 * 4096 + ks * 1024 + 512) : "memory"); }
        asm volatile("s_waitcnt lgkmcnt(0)" ::: "memory"); SBAR();
#define PK(k) (s16x8){lo[k][0], lo[k][1], lo[k][2], lo[k][3], hi[k][0], hi[k][1], hi[k][2], hi[k][3]}
        o[d0] = AMFMA(pa0, PK(0), o[d0]);
        o[d0] = AMFMA(pa1, PK(1), o[d0]);
        o[d0] = AMFMA(pa2, PK(2), o[d0]);
        o[d0] = AMFMA(pa3, PK(3), o[d0]);
#undef PK
    }
}
template <int THRL> __device__ __forceinline__ void attn_unit(const h16* Qu, const h16* __restrict__ Ku, const h16* __restrict__ Vu, h16* Ou, const int NT, char* shm) {
    const int tid = threadIdx.x, lane = tid & 63, r32 = lane & 31, hi = lane >> 5; const int wid = __builtin_amdgcn_readfirstlane(tid >> 6);
    const h16* Qw = Qu + (size_t)(wid * QBLK) * QP;
    const unsigned lds0 = (unsigned)(uintptr_t)shm;
    float* wsf = (float*)(shm + LDS_WS) + wid * 64;
    const h16* ksrc = Ku + (long)lane * KP + wid * 8;
    const h16* vsrc = Vu + (long)(16 * (wid & 3) + (lane >> 2)) * KP + (wid >> 2) * 32 + (lane & 3) * 8;
    const unsigned kdst = lds0 + LDS_K + wid * 1024, vdst = lds0 + LDS_V + wid * 1024;
#define DMA_K(t, slot) glds16(ksrc + (long)(t) * KVBLK * KP, (unsigned)__builtin_amdgcn_readfirstlane(kdst + (slot)))
#define DMA_V(t, slot) glds16(vsrc + (long)(t) * KVBLK * KP, (unsigned)__builtin_amdgcn_readfirstlane(vdst + (slot)))
    const int vb0 = (int)(lds0 + LDS_V) + ((lane >> 4) & 1) * 32 + (lane & 3) * 8 + (4 * hi + ((lane & 15) >> 2)) * 64;
    const char* Kbase = shm + LDS_K; s16x8 kf[8];
    const lds_cptr shm3 = (lds_cptr)shm; const lds_cptr kp0 = shm3 + LDS_K + hi * 1024 + r32 * 16; const lds_cptr vp0 = shm3 + LDS_V + ((lane >> 4) & 1) * 32 + (lane & 3) * 8 + (4 * hi + ((lane & 15) >> 2)) * 64;
    DMA_K(0, 0); DMA_V(0, 0); DMA_K(1, SLOTB);
    s16x8 qr[4];
#pragma unroll
    for (int d0 = 0; d0 < 4; ++d0) qr[d0] = *reinterpret_cast<const s16x8*>(&Qw[(long)r32 * QP + d0 * 16 + hi * 8]);
    float mhat = 0.f, l_reg = 0.f; f32x16 o[2]; o[0] = f32x16{}; o[1] = f32x16{}; f32x16 negm = f32x16{}; asm volatile("" : "+v"(negm));
    bool resc = false;
#define START(P0, P1) do { const float rm = rowmax(P0, P1); resc = false; \
    { const float dl = rm; mhat = fadd_s(mhat, dl); \
      _Pragma("unroll") for (int r = 0; r < 16; ++r) { P0[r] = fsub_s(P0[r], dl); P1[r] = fsub_s(P1[r], dl); } \
      _Pragma("unroll") for (int r = 0; r < 16; ++r) negm[r] = -mhat; asm volatile("" : "+v"(negm)); } \
    _Pragma("unroll") for (int r = 0; r < 16; ++r) P0[r] = __builtin_amdgcn_exp2f(P0[r]); } while (0)
#define RESC() do { if (resc) { asm volatile("s_waitcnt lgkmcnt(0)" ::: "memory"); \
      _Pragma("unroll") for (int d_ = 0; d_ < 2; ++d_) _Pragma("unroll") for (int r = 0; r < 16; ++r) o[d_][r] *= wsf[crow(r, hi)]; } } while (0)
    f32x16 pA0, pA1, pB0, pB1;
    int sl_prev = 0, sl_cur = 0, sl_next = SLOTB;
#define ROT() do { sl_prev = sl_cur; sl_cur = sl_next; sl_next = (sl_next == (NSLOT - 1) * SLOTB) ? 0 : sl_next + SLOTB; } while (0)
    DMA_K(2, 2 * SLOTB);
    WAIT_BAR(3);
    qkt(pA0, pA1, Kbase, qr, negm, r32, hi); asm volatile("s_nop 15\n\ts_nop 7" : "+v"(pA0), "+v"(pA1));
    START(pA0, pA1);
    _Pragma("unroll") for (int r = 0; r < 16; ++r) pA1[r] = __builtin_amdgcn_exp2f(pA1[r]);
    WAIT_BAR(0);
    DMA_K(3, 0); DMA_V(1, SLOTB);
    ROT();
    kload8(kf, kp0 + sl_cur);
    WAIT_BAR(2);
    s16x4 vlo[8], vhi[8]; u32x4 pw0, pw1, pw2, pw3;
#define PKW(P, B) cvtpk_s(P[B], P[B + 1])
#define PAF(k) __builtin_bit_cast(s16x8, pw##k)
#define VFR(i) (s16x8){vlo[i][0], vlo[i][1], vlo[i][2], vlo[i][3], vhi[i][0], vhi[i][1], vhi[i][2], vhi[i][3]}
#define PIN(x) asm volatile("" : "+v"(x))
#define MX3(a, b, c) __builtin_fmaxf(__builtin_fmaxf((a), (b)), (c))
#define GAPA(MF, A0, A1, A2, A3, W0, W1, PW) do { MF; sacc += A0; sacc += A1; sacc += A2; sacc += A3; PIN(sacc); W0; W1; PIN(PW); SBAR(); } while (0)
#define EX(v) __builtin_amdgcn_exp2f(v)
#define GAPB(MF, X, B) do { MF; X[B] = EX(X[B]); X[B + 1] = EX(X[B + 1]); X[B + 2] = EX(X[B + 2]); X[B + 3] = EX(X[B + 3]); PIN(X); SBAR(); } while (0)
#define VRD(i) do { vlo[i] = vtr(vp_ + (((i) >> 2) * 4096 + ((i) & 3) * 1024)); vhi[i] = vtr(vp_ + (((i) >> 2) * 4096 + ((i) & 3) * 1024 + 512)); } while (0)
#define KRD(G, j) do { if (G) { kload2(kf, kp0 + sl_next, j); SBAR(); } } while (0)
#define STEP(C0, C1, P0, P1, t, GK, GV, GL) do { SBAR(); \
    const lds_cptr vp_ = vp0 + sl_prev; \
    VRD(0); SBAR(); float sacc = (P0[0] + P0[1]); \
    GAPA(C0 = AMFMA(kf[0], qr[0], negm), P0[2], P0[3], P0[4], P0[5],     pw0[0] = PKW(P0, 0), pw0[1] = PKW(P0, 2), pw0); \
    VRD(4); SBAR(); GAPA(C1 = AMFMA(kf[1], qr[0], negm), P0[6], P0[7], P0[8], P0[9],     pw0[2] = PKW(P0, 4), pw0[3] = PKW(P0, 6), pw0); \
    VRD(1); SBAR(); GAPA(C0 = AMFMA(kf[2], qr[1], C0),   P0[10], P0[11], P0[12], P0[13], pw1[0] = PKW(P0, 8), pw1[1] = PKW(P0, 10), pw1); \
    VRD(5); SBAR(); GAPA(C1 = AMFMA(kf[3], qr[1], C1),   P0[14], P0[15], P1[0], P1[1],   pw1[2] = PKW(P0, 12), pw1[3] = PKW(P0, 14), pw1); \
    VRD(2); SBAR(); GAPA(C0 = AMFMA(kf[4], qr[2], C0),   P1[2], P1[3], P1[4], P1[5],     pw2[0] = PKW(P1, 0), pw2[1] = PKW(P1, 2), pw2); \
    VRD(6); SBAR(); GAPA(C1 = AMFMA(kf[5], qr[2], C1),   P1[6], P1[7], P1[8], P1[9],     pw2[2] = PKW(P1, 4), pw2[3] = PKW(P1, 6), pw2); \
    VRD(3); SBAR(); GAPA(C0 = AMFMA(kf[6], qr[3], C0),   P1[10], P1[11], P1[12], P1[13], pw3[0] = PKW(P1, 8), pw3[1] = PKW(P1, 10), pw3); \
    VRD(7); SBAR(); GAPA(C1 = AMFMA(kf[7], qr[3], C1),   P1[14], P1[15], 0.f, 0.f,       pw3[2] = PKW(P1, 12), pw3[3] = PKW(P1, 14), pw3); \
    l_reg += sacc; \
    if (GK) { DMA_K((t) + 3, sl_cur); } if (GV) { DMA_V((t) + 1, sl_next); } \
    { float a = MX3(C0[0], C0[1], C1[0]), b = MX3(C0[2], C0[3], C1[1]); a = MX3(a, C1[2], C1[3]); \
      _Pragma("unroll") for (int r = 4; r < 16; r += 4) { a = MX3(a, C0[r], C0[r + 1]); b = MX3(b, C0[r + 2], C0[r + 3]); a = MX3(a, C1[r], C1[r + 1]); b = MX3(b, C1[r + 2], C1[r + 3]); } \
      float rm = __builtin_fmaxf(a, b); { auto rr = __builtin_amdgcn_permlane32_swap(__float_as_uint(rm), __float_as_uint(rm), false, false); rm = __builtin_fmaxf(__uint_as_float(rr[0]), __uint_as_float(rr[1])); } \
      resc = false; \
      if (__builtin_expect(__any(rm > (float)THRL), 0)) { const float dl = __builtin_fmaxf(rm, 0.f); mhat += dl; \
        _Pragma("unroll") for (int r = 0; r < 16; ++r) { C0[r] -= dl; C1[r] -= dl; } \
        _Pragma("unroll") for (int r = 0; r < 16; ++r) negm[r] = -mhat; asm volatile("" : "+v"(negm)); \
        const float f = __builtin_amdgcn_exp2f(-dl); l_reg *= f; if (hi == 0) wsf[r32] = f; resc = true; } } \
    SBAR(); \
    GAPB(o[0] = AMFMA(PAF(0), VFR(0), o[0]), C0, 0); \
    GAPB(o[1] = AMFMA(PAF(0), VFR(4), o[1]), C0, 4); \
    KRD(GL, 0); GAPB(o[0] = AMFMA(PAF(1), VFR(1), o[0]), C0, 8); \
    KRD(GL, 1); GAPB(o[1] = AMFMA(PAF(1), VFR(5), o[1]), C0, 12); \
    KRD(GL, 2); GAPB(o[0] = AMFMA(PAF(2), VFR(2), o[0]), C1, 0); \
    KRD(GL, 3); GAPB(o[1] = AMFMA(PAF(2), VFR(6), o[1]), C1, 4); \
    GAPB(o[0] = AMFMA(PAF(3), VFR(3), o[0]), C1, 8); \
    GAPB(o[1] = AMFMA(PAF(3), VFR(7), o[1]), C1, 12); \
    } while (0)
    int t = 1;
    for (; t + 5 < NT; t += 2) {
        STEP(pB0, pB1, pA0, pA1, t, true, true, true);     WAIT_BAR(2); RESC(); ROT();
        STEP(pA0, pA1, pB0, pB1, t + 1, true, true, true); WAIT_BAR(2); RESC(); ROT();
    }
#define ENDW(tt) do { if ((tt) + 3 < NT) { WAIT_BAR(2); } else if ((tt) + 2 < NT) { WAIT_BAR(1); } else { WAIT_BAR(0); } } while (0)
    for (; t + 1 < NT; t += 2) {
        STEP(pB0, pB1, pA0, pA1, t, (t + 3 < NT), (t + 1 < NT), (t + 1 < NT));         ENDW(t);     RESC(); ROT();
        STEP(pA0, pA1, pB0, pB1, t + 1, (t + 4 < NT), (t + 2 < NT), (t + 2 < NT));     ENDW(t + 1); RESC(); ROT();
    }
    STEP(pB0, pB1, pA0, pA1, NT - 1, false, false, false); RESC();
    { float sacc = pB0[0] + pB0[1]; _Pragma("unroll") for (int r = 2; r < 16; ++r) sacc += pB0[r]; _Pragma("unroll") for (int r = 0; r < 16; ++r) sacc += pB1[r]; l_reg += sacc;
      pw0 = (u32x4){PKW(pB0, 0), PKW(pB0, 2), PKW(pB0, 4), PKW(pB0, 6)}; pw1 = (u32x4){PKW(pB0, 8), PKW(pB0, 10), PKW(pB0, 12), PKW(pB0, 14)}; pw2 = (u32x4){PKW(pB1, 0), PKW(pB1, 2), PKW(pB1, 4), PKW(pB1, 6)}; pw3 = (u32x4){PKW(pB1, 8), PKW(pB1, 10), PKW(pB1, 12), PKW(pB1, 14)};
      SBAR(); pv(o, vb0 + sl_cur, PAF(0), PAF(1), PAF(2), PAF(3)); }
#undef PKW
#undef PAF
#undef VFR
#undef PIN
#undef MX3
#undef GAPA
#undef GAPB
#undef EX
#undef VRD
#undef KRD
#undef STEP
#undef ENDW
    { auto rr = __builtin_amdgcn_permlane32_swap(__float_as_uint(l_reg), __float_as_uint(l_reg), false, false); l_reg = __uint_as_float(rr[0]) + __uint_as_float(rr[1]); }
    if (hi == 0) wsf[32 + r32] = l_reg; asm volatile("s_waitcnt lgkmcnt(0)" ::: "memory");
    float rli[16];
#pragma unroll
    for (int r = 0; r < 16; ++r) rli[r] = __builtin_amdgcn_rcpf(wsf[32 + crow(r, hi)]);
    h16* Ow = Ou + (size_t)(wid * QBLK) * OP;
    { h16* stg = (h16*)(shm + LDS_OST) + wid * 2048;
#pragma unroll
      for (int r = 0; r < 16; ++r) { const int orow = crow(r, hi);
#pragma unroll
        for (int d0 = 0; d0 < 2; ++d0) stg[orow * 64 + d0 * 32 + r32] = (h16)(o[d0][r] * rli[r]); }
      asm volatile("s_waitcnt lgkmcnt(0)" ::: "memory");
#pragma unroll
      for (int i = 0; i < 4; ++i) { const int row = i * 8 + (lane >> 3), ch = lane & 7; const u32x4 v = *(const u32x4*)(stg + row * 64 + ch * 8); *(u32x4*)(Ow + (long)row * OP + ch * 8) = v; } }
    asm volatile("s_waitcnt lgkmcnt(0)\n\ts_barrier" ::: "memory");
#undef DMA_K
#undef DMA_V
#undef START
#undef RESC
#undef ROT
}
#undef SBAR
#undef WAIT_BAR
#undef AMFMA
}

__device__ __forceinline__ void ph_attn(const Params& p, char* shm, int l, int G, int c) {
    const h16* Qh = WSP(h16, OFF_QH); const h16* Kh = WSP(h16, OFF_KH); const h16* Vh = WSP(h16, OFF_VH); h16* A = WSP(h16, OFF_A);
    const int x = c & 7, j0 = c >> 3, nx = (G + 7 - x) >> 3;
    for (int j = j0; j < 128; j += nx) {
        const int set = 2 * x + (j >> 6), un = j & 63, b = set >> 1, kvh = set & 1, hq = kvh * 4 + (un >> 4), qb = un & 15;
        const size_t qrow = (size_t)MC + (size_t)b * SEQ + (size_t)qb * 256;
        attn_body::attn_unit<8>(Qh + qrow * 512 + hq * 64, Kh + (size_t)b * SB * 128 + kvh * 64, Vh + (size_t)b * SB * 128 + kvh * 64, A + qrow * AW + AY1 + hq * 64, SB / 64, shm);
    }
    if (l == 0) for (int u = c; u < 64; u += G) {
        const int b = u >> 3, hq = u & 7, kvh = hq >> 2; const size_t qrow = (size_t)b * CTX;
        attn_body::attn_unit<8>(Qh + qrow * 512 + hq * 64, Kh + (size_t)b * SB * 128 + kvh * 64, Vh + (size_t)b * SB * 128 + kvh * 64, A + qrow * AW + AY1 + hq * 64, CTX / 64, shm);
    }
}
template <int PH> __global__ void __launch_bounds__(512, 2) k_fast(Params p, int l, int a0) {
    extern __shared__ __attribute__((aligned(16))) unsigned char shm[];
    LAS unsigned char* lds = (LAS unsigned char*)shm;
    const int G = gridDim.x, c = blockIdx.x;
    if constexpr (PH == 0) ph_gemm_in(p, lds, l, G, c);
    if constexpr (PH == 1) ph_merge(p, lds, l, G, c);
    if constexpr (PH == 2) ph_wout(p, lds, l, G, c);
    if constexpr (PH == 3) ph_ffn_gu(p, lds, G, c);
    if constexpr (PH == 4) ph_ffn_down(p, lds, G, c);
    if constexpr (PH == 5) ph_moe_gu(p, lds, a0, G, c);
    if constexpr (PH == 6) ph_moe_down(p, lds, a0, G, c);
    if constexpr (PH == 7) ph_attn(p, (char*)shm, l, G, c);
}

#define XB_TMO      128
#define XB_XCNT(j)  (256  + 64 * (j))
#define XB_XSUB(j)  (1280 + 64 * (j))
#define XB_XGEN(j)  (2304 + 64 * (j))
#define XB_TOP      3328
#define XB_TOPGEN   3392
#define XCD_BAR_WORDS 3456
#define XB_SPIN_CAP (1u << 18)
__device__ __forceinline__ unsigned xb_ld(unsigned* p)              { return __hip_atomic_load(p, __ATOMIC_RELAXED, __HIP_MEMORY_SCOPE_AGENT); }
__device__ __forceinline__ unsigned xb_add(unsigned* p, unsigned v) { return __hip_atomic_fetch_add(p, v, __ATOMIC_RELAXED, __HIP_MEMORY_SCOPE_AGENT); }
__device__ __forceinline__ unsigned xb_xcc_id() { return (unsigned)__builtin_amdgcn_s_getreg((3 << 11) | 20) & 0xFu; }
#define XB_SPIN(cond, bar) do { unsigned _sp = 0; while (cond) { __builtin_amdgcn_s_sleep(1); \
    if ((++_sp & 255u) == 0u) { if (xb_ld(&(bar)[XB_TMO])) break; if (_sp > XB_SPIN_CAP) { atomicAdd(&(bar)[XB_TMO], 1u); break; } } } } while (0)
struct XcdBarrier { unsigned* bar; unsigned x; volatile LAS unsigned* st; };
__device__ __forceinline__ XcdBarrier xcd_barrier_post(unsigned* bar, volatile LAS unsigned* st) {
    XcdBarrier b; b.bar = bar; b.x = xb_xcc_id(); b.st = st;
    if (threadIdx.x == 0) (void)xb_add(&bar[XB_XCNT(b.x)], 1u);
    return b;
}
__device__ __forceinline__ void xcd_barrier_complete(unsigned* bar, unsigned x, unsigned& nloc, unsigned& nx) {
    const unsigned G = gridDim.x * gridDim.y * gridDim.z;
    unsigned sum, cnt, mine, sp = 0u;
    for (;;) {
        sum = 0u; cnt = 0u; mine = 0u;
#pragma unroll
        for (unsigned j = 0; j < 16; ++j) { const unsigned c = xb_ld(&bar[XB_XCNT(j)]); sum += c; cnt += (c > 0u) ? 1u : 0u; mine = (j == x) ? c : mine; }
        if (sum == G) break;
        __builtin_amdgcn_s_sleep(1);
        if ((++sp & 255u) == 0u) { if (xb_ld(&bar[XB_TMO])) break; if (sp > XB_SPIN_CAP) { atomicAdd(&bar[XB_TMO], 1u); break; } }
    }
    nloc = mine > 0u ? mine : 1u; nx = cnt > 0u ? cnt : 1u;
}
__device__ __forceinline__ void xcd_barrier(const XcdBarrier& b) {
    asm volatile("s_waitcnt vmcnt(0)" ::: "memory");
    __syncthreads();
    if (threadIdx.x == 0) {
        unsigned* bar = b.bar;
        __builtin_amdgcn_s_waitcnt(0);
        unsigned nloc = b.st[0], nx = b.st[1];
        if (nloc == 0u) { xcd_barrier_complete(bar, b.x, nloc, nx); b.st[0] = nloc; b.st[1] = nx; }
        const unsigned old = xb_add(&bar[XB_XSUB(b.x)], 1u);
        const unsigned gen = old / nloc;
        if (old + 1u == (gen + 1u) * nloc) {
            __builtin_amdgcn_fence(__ATOMIC_RELEASE, "agent");
            asm volatile("s_waitcnt vmcnt(0)" ::: "memory");
            const unsigned og = xb_add(&bar[XB_TOP], 1u);
            const unsigned tg = og / nx;
            if (og + 1u == (tg + 1u) * nx) xb_add(&bar[XB_TOPGEN], 1u);
            else XB_SPIN(xb_ld(&bar[XB_TOPGEN]) == tg, bar);
            __builtin_amdgcn_fence(__ATOMIC_ACQUIRE, "agent");
            xb_add(&bar[XB_XGEN(b.x)], 1u);
            asm volatile("s_waitcnt vmcnt(0)" ::: "memory");
        } else {
            XB_SPIN(xb_ld(&bar[XB_XGEN(b.x)]) == gen, bar);
            __builtin_amdgcn_fence(__ATOMIC_ACQUIRE, "agent");
            asm volatile("s_waitcnt vmcnt(0)" ::: "memory");
        }
    }
    __syncthreads();
}

constexpr int NTH = 512;
template <int NT> __device__ __forceinline__ void poolfold_unit(const Params& p, int u, float (*Ws)[129]) {
    const int l = u / 64, g = (u / 16) % 4, k0 = (u % 16) * 64, tid = threadIdx.x;
    __syncthreads();
    for (int i = tid; i < 64 * 128; i += NT) Ws[i >> 7][i & 127] = p.w_in[(size_t)l * 1024 * WIN + (size_t)(k0 + (i >> 7)) * WIN + g * 128 + (i & 127)];
    __syncthreads();
    const float* pw = p.pool_w + (size_t)(l * 4 + g) * 128 * 128;
    h16* wint = WSP(h16, OFF_W16 + l * SZ_LAYERW);
    const int jj = tid & 127;
    const float sc = p.pool_scale[l * 512 + g * 128 + jj];
    for (int kk = tid >> 7; kk < 64; kk += NT / 128) {
        float acc = 0.f;
        for (int c2 = 0; c2 < 128; ++c2) acc += Ws[kk][c2] * pw[c2 * 128 + jj];
        wint[(size_t)(g * 128 + jj) * 1024 + k0 + kk] = (h16)(acc * sc);
    }
}
__device__ __forceinline__ void cvt_jobs(const Params& p, int j0, int j1, int ubase, int G, int c, float (*tile)[65]) {
    int base = ubase;
    for (int j = j0; j < j1; ++j) {
        const CvtJob q = get_job(p, j); const int nt = job_tiles(q);
        const int first = ((c - base % G) + G) % G;
        for (int t = first; t < nt; t += G) cvt_tile<NTH>(q, t, tile);
        base += nt;
    }
}
__device__ __forceinline__ void ph_prologue(const Params& p, char* shm, int G, int c) {
    if (c == 0 && threadIdx.x < 8) WSP(int, OFF_CNT)[threadIdx.x] = 0;
    for (int u = c; u < 192; u += G) mod_unit<NTH>(p, u, (float*)shm, (float*)shm + 9 * 1024);
    for (int u = c; u < 128; u += G) poolfold_unit<NTH>(p, (u + 64) % 128, (float (*)[129])shm);
    cvt_jobs(p, 0, NJOBS_SMALL, 320, G, c, (float (*)[65])shm);
}
__device__ __forceinline__ void ph_h0(const Params& p, int G, int c) {
    const float* mod = WSP(float, OFF_MOD); h16* A = WSP(h16, OFF_A); const int tid = threadIdx.x;
    for (int r = c * 2 + (tid >> 8); r < MT; r += G * 2) {
        const int g = row_group(r), d = (tid & 255) * 4; const float* xr = xin_row(p, r);
        const float4 xv = *(const float4*)(xr + d); const float4 m0 = *(const float4*)(mod + (size_t)g * 6144 + d); const float4 m1 = *(const float4*)(mod + (size_t)g * 6144 + 1024 + d);
        h16x4 o; o[0] = (h16)(xv.x * (1.f + m1.x) + m0.x); o[1] = (h16)(xv.y * (1.f + m1.y) + m0.y); o[2] = (h16)(xv.z * (1.f + m1.z) + m0.z); o[3] = (h16)(xv.w * (1.f + m1.w) + m0.w);
        *(h16x4*)(A + (size_t)r * AW + AH + d) = o;
    }
}
__device__ __forceinline__ void ph_qkv(const Params& p, int l, int G, int c) {
    const h16* Z = WSP(h16, OFF_Z); h16* Qh = WSP(h16, OFF_QH); h16* Kh = WSP(h16, OFF_KH); h16* Vh = WSP(h16, OFF_VH);
    const int lane = threadIdx.x & 63, wv = threadIdx.x >> 6;
    const int nitems = MT * 12;
    for (int it = c * 8 + wv; it < nitems; it += G * 8) {
        const int r = it / 12, s = it % 12; int s0, len, pos; row_seq(r, s0, len, pos);
        const bool lat = r >= MC; const int b = lat ? (r - MC) >> 12 : r >> 8; const size_t krow = (size_t)b * SB + (lat ? CTX + pos : pos);
        if (s >= 10) { Vh[krow * 128 + (s - 10) * 64 + lane] = Z[(size_t)r * ZW + ZV + (s - 10) * 64 + lane]; continue; }
        const int zc = s < 8 ? ZQ + s * 64 : ZK + (s - 8) * 64;
        const float z = (float)Z[(size_t)r * ZW + zc + lane];
        float ss = z * z;
#pragma unroll
        for (int o = 32; o >= 1; o >>= 1) ss += __shfl_xor(ss, o);
        const float g = s < 8 ? p.q_norm[l * 64 + lane] : p.k_norm[l * 64 + lane];
        float y = z * rsqrtf(ss * (1.0f / 64.0f) + 1e-6f) * g;
        const float yp = __shfl_xor(y, 16);
        if (lat) {
            const float posf = (lane < 32) ? (float)(pos >> 6) : (float)(pos & 63);
            const float inv = exp2f(-(float)(lane & 15) * (13.287712379549449f / 16.0f));
            float sn, cs; sincosf(posf * inv, &sn, &cs);
            y = (lane & 16) ? (y * cs + yp * sn) : (y * cs - yp * sn);
        }
        if (s < 8) Qh[(size_t)r * 512 + s * 64 + lane] = (h16)(y * QSCALE);
        else Kh[krow * 128 + (s - 8) * 64 + lane] = (h16)y;
    }
}
__device__ __forceinline__ void ph_pool(const Params& p, int r_begin, int G, int c) {
    const h16* Z = WSP(h16, OFF_Z); h16* A = WSP(h16, OFF_A); const int j = threadIdx.x;
    for (int r = r_begin + c; r < MT; r += G) {
        int s0, len, pos; row_seq(r, s0, len, pos);
        const int w = 2 << (j >> 7), lo = pos - (w >> 1); const int a = lo < 0 ? 0 : lo, e = (lo + w) > len ? len : (lo + w);
        float s = 0.f; for (int t = a; t < e; ++t) s += (float)Z[(size_t)(s0 + t) * ZW + ZP + j];
        A[(size_t)r * AW + AY0 + j] = (h16)(s / (float)(e - a) - (float)Z[(size_t)r * ZW + ZP + j]);
    }
}
__device__ __forceinline__ void ph_lru_naive(const Params& p, char* shm, int l, int c) {
    if (c >= 64 || threadIdx.x >= 64) return;
    volatile float* xs = (volatile float*)shm;
    const int b = c >> 3, blk = c & 7, j = threadIdx.x, ch = blk * 64 + j;
    const h16* Z = WSP(h16, OFF_Z); h16* A = WSP(h16, OFF_A); float* HF = p.out;
    for (int dir = 0; dir < 2; ++dir) {
        float wa[64], wx[64];
        const float* pwa = p.lru_wa + ((size_t)(l * 2 + dir) * 8 + blk) * 4096; const float* pwx = p.lru_wx + ((size_t)(l * 2 + dir) * 8 + blk) * 4096;
#pragma unroll
        for (int i = 0; i < 64; ++i) { wa[i] = pwa[i * 64 + j]; wx[i] = pwx[i * 64 + j]; }
        const float ba = p.lru_ba[(l * 2 + dir) * 512 + ch], bx = p.lru_bx[(l * 2 + dir) * 512 + ch], lam = p.lru_lambda[(l * 2 + dir) * 512 + ch];
        const float sp = log1pf(expf(-lam));
        float cw[4]; for (int k = 0; k < 4; ++k) cw[k] = p.conv_w[(l * 4 + k) * 512 + ch];
        const float cb = p.conv_b[l * 512 + ch];
        float h = 0.f;
        for (int idx = 0; idx < SB; ++idx) {
            int s0, len, pos;
            if (idx < CTX) { s0 = b * CTX; len = CTX; pos = dir ? CTX - 1 - idx : idx; } else { s0 = MC + b * SEQ; len = SEQ; pos = dir ? SEQ - 1 - (idx - CTX) : idx - CTX; }
            float xc = cb;
#pragma unroll
            for (int k = 0; k < 4; ++k) { const int t = pos + k - 2; if (t >= 0 && t < len) xc += cw[k] * (float)Z[(size_t)(s0 + t) * ZW + ZLX + ch]; }
            __builtin_amdgcn_wave_barrier(); xs[j] = xc; asm volatile("s_waitcnt lgkmcnt(0)" ::: "memory"); __builtin_amdgcn_wave_barrier();
            float ra = ba, ri = bx;
#pragma unroll
            for (int i = 0; i < 64; ++i) { const float xv = xs[i]; ra += xv * wa[i]; ri += xv * wx[i]; }
            const float rg = sigmoidf_(ra), ig = sigmoidf_(ri), la = -8.0f * rg * sp, a = expf(la), u = sqrtf(-expm1f(2.0f * la)) * ig * xc;
            h = a * h + u;
            const int r = s0 + pos;
            if (dir == 0) HF[(size_t)r * 512 + ch] = h;
            else { const float tot = HF[(size_t)r * 512 + ch] + h; A[(size_t)r * AW + AY2 + ch] = (h16)(tot * gelu_tanh((float)Z[(size_t)r * ZW + ZLG + ch])); }
        }
    }
}
__device__ __forceinline__ void ph_ln(const Params& p, int mode, int r_begin, const float* __restrict__ gam, const float* __restrict__ bet, int lm, int sh, int sc, int G, int c) {
    float* X = WSP(float, OFF_X); h16* A = WSP(h16, OFF_A); const float* mod = WSP(float, OFF_MOD) + (size_t)lm * 9 * 6144;
    const int lane = threadIdx.x & 63, wv = threadIdx.x >> 6;
    for (int r = r_begin + c * 8 + wv; r < MT; r += G * 8) {
        const int g = row_group(r); float v[16];
#pragma unroll
        for (int i = 0; i < 4; ++i) { const float4 t = *(const float4*)(X + (size_t)r * D + i * 256 + lane * 4); v[i * 4] = t.x; v[i * 4 + 1] = t.y; v[i * 4 + 2] = t.z; v[i * 4 + 3] = t.w; }
        if (mode == 2) {
            const h16* o0 = WSP(h16, OFF_OUT2) + (size_t)(r - MC) * 1024; const h16* o1 = o0 + (size_t)ML * 1024; const float* m5 = WSP(float, OFF_MOD) + (size_t)(1 * 9 + g) * 6144 + 5 * 1024;
#pragma unroll
            for (int i = 0; i < 4; ++i) { const h16x4 a = *(const h16x4*)(o0 + i * 256 + lane * 4), b2 = *(const h16x4*)(o1 + i * 256 + lane * 4); const float4 mm = *(const float4*)(m5 + i * 256 + lane * 4);
                const float mv[4] = {mm.x, mm.y, mm.z, mm.w};
#pragma unroll
                for (int j = 0; j < 4; ++j) v[i * 4 + j] = ALPHA * v[i * 4 + j] + mv[j] * ((float)a[j] + (float)b2[j]); }
        }
        float s = 0.f;
#pragma unroll
        for (int i = 0; i < 16; ++i) s += v[i];
#pragma unroll
        for (int o = 32; o >= 1; o >>= 1) s += __shfl_xor(s, o);
        const float mean = s * (1.0f / 1024.0f); float q = 0.f;
#pragma unroll
        for (int i = 0; i < 16; ++i) { const float dlt = v[i] - mean; q += dlt * dlt; }
#pragma unroll
        for (int o = 32; o >= 1; o >>= 1) q += __shfl_xor(q, o);
        const float rstd = rsqrtf(q * (1.0f / 1024.0f) + 1e-5f);
        float lg8[8];
#pragma unroll
        for (int e = 0; e < 8; ++e) lg8[e] = 0.f;
#pragma unroll
        for (int i = 0; i < 4; ++i) {
            const int d = i * 256 + lane * 4; const float4 gg = *(const float4*)(gam + d), bb = *(const float4*)(bet + d);
            const float gv[4] = {gg.x, gg.y, gg.z, gg.w}, bv[4] = {bb.x, bb.y, bb.z, bb.w}; float y[4];
#pragma unroll
            for (int j = 0; j < 4; ++j) y[j] = (v[i * 4 + j] - mean) * rstd * gv[j] + bv[j];
            if (mode == 2) { *(float4*)(p.out + (size_t)(r - MC) * D + d) = make_float4(y[0], y[1], y[2], y[3]); continue; }
            *(float4*)(X + (size_t)r * D + d) = make_float4(y[0], y[1], y[2], y[3]);
            const float4 ms = *(const float4*)(mod + (size_t)g * 6144 + sh * 1024 + d), mc = *(const float4*)(mod + (size_t)g * 6144 + sc * 1024 + d);
            const float msv[4] = {ms.x, ms.y, ms.z, ms.w}, mcv[4] = {mc.x, mc.y, mc.z, mc.w}; float hh[4]; h16x4 ho;
#pragma unroll
            for (int j = 0; j < 4; ++j) { hh[j] = y[j] * (1.f + mcv[j]) + msv[j]; ho[j] = (h16)hh[j]; }
            *(h16x4*)(A + (size_t)r * AW + AH + d) = ho;
            if (mode == 1) {
#pragma unroll
                for (int j = 0; j < 4; ++j) { const float4 r0 = *(const float4*)(p.moe_router + (size_t)(d + j) * 8), r1 = *(const float4*)(p.moe_router + (size_t)(d + j) * 8 + 4);
                    lg8[0] += hh[j] * r0.x; lg8[1] += hh[j] * r0.y; lg8[2] += hh[j] * r0.z; lg8[3] += hh[j] * r0.w; lg8[4] += hh[j] * r1.x; lg8[5] += hh[j] * r1.y; lg8[6] += hh[j] * r1.z; lg8[7] += hh[j] * r1.w; }
            }
        }
        if (mode == 1) {
#pragma unroll
            for (int e = 0; e < 8; ++e) {
#pragma unroll
                for (int o = 32; o >= 1; o >>= 1) lg8[e] += __shfl_xor(lg8[e], o);
                lg8[e] += p.moe_router_b[e]; }
            if (lane == 0) {
                int i0 = 0; float v0 = lg8[0];
#pragma unroll
                for (int e = 1; e < 8; ++e) if (lg8[e] > v0) { v0 = lg8[e]; i0 = e; }
                int i1 = -1; float v1 = -INFINITY;
#pragma unroll
                for (int e = 0; e < 8; ++e) if (e != i0 && lg8[e] > v1) { v1 = lg8[e]; i1 = e; }
                const float p1 = 1.0f / (1.0f + expf(v0 - v1)), p0 = 1.0f - p1;
                const int t = r - MC; int* cnt = WSP(int, OFF_CNT);
                const int k0 = atomicAdd(&cnt[i0], 1), k1 = atomicAdd(&cnt[i1], 1);
                WSP(int, OFF_TOKE)[t * 2] = i0; WSP(int, OFF_TOKE)[t * 2 + 1] = i1; WSP(float, OFF_TOKP)[t * 2] = p0; WSP(float, OFF_TOKP)[t * 2 + 1] = p1; WSP(int, OFF_TOKR)[t * 2] = k0; WSP(int, OFF_TOKR)[t * 2 + 1] = k1;
            }
        }
    }
}
__device__ __forceinline__ void ph_moe_gather(const Params& p, char* shm, int G, int c) {
    int* sp = (int*)shm; int* plan = WSP(int, OFF_PLAN); const int* cnt = WSP(int, OFF_CNT); int* rowT = WSP(int, OFF_ROWT);
    const int tid = threadIdx.x;
    __syncthreads();
    if (tid == 0) { int acc = 0; for (int e = 0; e < 8; ++e) { sp[e] = acc; const int np = (cnt[e] + 255) / 256; if (c == 0) { plan[e] = acc; for (int q = 0; q < np; ++q) plan[16 + acc / 256 + q] = e; } acc += np * 256; } sp[8] = acc; if (c == 0) plan[8] = acc / 256; }
    __syncthreads();
    if (c == 0) for (int e = 0; e < 8; ++e) { const int a = sp[e] + cnt[e], b = sp[e + 1]; for (int i = a + tid; i < b; i += NTH) rowT[i] = -1; }
    const h16* A = WSP(h16, OFF_A); h16* Xg = WSP(h16, OFF_XG);
    const int lane = tid & 63, wv = tid >> 6;
    for (int it = c * 8 + wv; it < ML * 2; it += G * 8) {
        const int t = it >> 1, e = WSP(int, OFF_TOKE)[it], pos = sp[e] + WSP(int, OFF_TOKR)[it];
        const h16* src = A + (size_t)(MC + t) * AW + AH; h16* dst = Xg + (size_t)pos * 1024;
        *(h16x8*)(dst + lane * 8) = *(const h16x8*)(src + lane * 8); *(h16x8*)(dst + 512 + lane * 8) = *(const h16x8*)(src + 512 + lane * 8);
        if (lane == 0) { WSP(int, OFF_ROWT)[pos] = it; WSP(float, OFF_ROWP)[pos] = WSP(float, OFF_TOKP)[it]; }
    }
}

constexpr int XB_LDS_OFF = LDS_BYTES - 16;
__global__ void __launch_bounds__(512, 2) k_mega(Params p, int lo, int hi) {
    extern __shared__ __attribute__((aligned(16))) unsigned char shm[];
    LAS unsigned char* lds = (LAS unsigned char*)shm;
    const int G = gridDim.x, c = blockIdx.x;
    if (threadIdx.x == 0) *(uint4*)(shm + XB_LDS_OFF) = make_uint4(0u, 0u, 0u, 0u);
    __syncthreads();
    XcdBarrier bar = xcd_barrier_post(WSP(unsigned, OFF_BAR), (volatile LAS unsigned*)(lds + XB_LDS_OFF));
    int ph = 0;
#define PHASE(body) do { if (ph >= lo && ph < hi) { body; if (ph + 1 < hi) xcd_barrier(bar); } ++ph; } while (0)
    PHASE(ph_prologue(p, (char*)shm, G, c));
    PHASE(ph_h0(p, G, c));
#define LAYER(l) do { \
        const int rb = (l) == 0 ? 0 : MC; \
        const float* ln1g = p.ln1_g + (l) * D; const float* ln1b = p.ln1_b + (l) * D; const float* ln2g = p.ln2_g + (l) * D; const float* ln2b = p.ln2_b + (l) * D; \
        PHASE(ph_gemm_in(p, lds, (l), G, c)); \
        PHASE(ph_qkv(p, (l), G, c); ph_pool(p, rb, G, c)); \
        PHASE(ph_attn(p, (char*)shm, (l), G, c)); \
        PHASE(ph_lru_naive(p, (char*)shm, (l), c)); \
        PHASE(ph_merge(p, lds, (l), G, c)); \
        PHASE(ph_wout(p, lds, (l), G, c)); \
        if ((l) == 0) { \
            PHASE(ph_ln(p, 0, rb, ln1g, ln1b, 0, 3, 4, G, c)); \
            PHASE(ph_ffn_gu(p, lds, G, c)); \
            PHASE(ph_ffn_down(p, lds, G, c)); \
            PHASE(ph_ln(p, 0, 0, ln2g, ln2b, 1, 0, 1, G, c)); \
        } else { \
            PHASE(ph_ln(p, 1, rb, ln1g, ln1b, 1, 3, 4, G, c); cvt_jobs(p, NJOBS_SMALL, NJOBS_ALL, 0, G, c, (float (*)[65])shm)); \
            PHASE(ph_moe_gather(p, (char*)shm, G, c)); \
            for (int chn = 0; chn < 5; ++chn) { \
                PHASE(ph_moe_gu(p, lds, chn * 64, G, c)); \
                PHASE(ph_moe_down(p, lds, chn * 64, G, c)); \
            } \
            PHASE(ph_ln(p, 2, MC, ln2g, ln2b, 1, 0, 1, G, c)); \
        } } while (0)
    LAYER(0);
    LAYER(1);
#undef LAYER
#undef PHASE
}
constexpr int NPHASES = 2 + 10 + (6 + 2 + 10 + 1);

#ifndef MEGA_LAUNCHES
#define MEGA_LAUNCHES 1
#endif
extern "C" void kernel_launch(void* const* d_in, const int* in_sizes, int n_in, void* d_out, int out_size, void* d_ws, size_t ws_size, hipStream_t stream) {
    (void)in_sizes; (void)n_in; (void)out_size;
    if (ws_size < WS_NEED) return;
    Params p;
    const float** pp = (const float**)&p;
    for (int i = 0; i < 33; ++i) pp[i] = (const float*)d_in[i];
    p.out = (float*)d_out; p.ws = (char*)d_ws;
    static int grid = 0;
    if (!grid) {
        int dev = 0, cus = 0, per_cu = 0;
        hipGetDevice(&dev);
        hipDeviceGetAttribute(&cus, hipDeviceAttributeMultiprocessorCount, dev);
        hipFuncSetAttribute((const void*)k_mega, hipFuncAttributeMaxDynamicSharedMemorySize, LDS_BYTES);
        hipOccupancyMaxActiveBlocksPerMultiprocessor(&per_cu, (const void*)k_mega, 512, LDS_BYTES);
        grid = (per_cu >= 1 && cus > 0) ? cus : -1;
    }
    if (grid <= 0) return;
    hipMemsetAsync(p.ws + OFF_BAR, 0, XCD_BAR_WORDS * sizeof(unsigned), stream);
#if MEGA_LAUNCHES == 1
    k_mega<<<grid, 512, LDS_BYTES, stream>>>(p, 0, NPHASES);
#else
    for (int ph = 0; ph < NPHASES; ++ph) k_mega<<<grid, 512, LDS_BYTES, stream>>>(p, ph, ph + 1);
#endif
}
```

```cpp
#include <hip/hip_runtime.h>
#include <stdint.h>
#include <stddef.h>

typedef _Float16 h16;
typedef _Float16 h16x2 __attribute__((ext_vector_type(2)));
typedef _Float16 h16x4 __attribute__((ext_vector_type(4)));
typedef _Float16 h16x8 __attribute__((ext_vector_type(8)));

constexpr int D = 1024, NB = 8, SEQ = 4096, CTX = 256, SB = CTX + SEQ;
constexpr int MC = NB * CTX, ML = NB * SEQ, MT = MC + ML;
constexpr int WIN = 5376, ZW = 2304, AW = 2560;
constexpr int DFF = 2816, NE = 8, DEX = 3584;
constexpr int PMAX = 264 * 256;
constexpr float ALPHA = 1.41421356237309515f;
constexpr float QSCALE = 0.125f * 1.4426950408889634f;
constexpr int ZP = 0, ZQ = 512, ZK = 1024, ZV = 1152, ZLX = 1280, ZLG = 1792;
constexpr int AH = 0, AY0 = 1024, AY1 = 1536, AY2 = 2048;

constexpr size_t al256(size_t x) { return (x + 255) & ~(size_t)255; }
constexpr size_t OFF_BAR = 0;
constexpr size_t OFF_MOD = 16384;
constexpr size_t OFF_CNT = OFF_MOD + al256((size_t)2 * 9 * 6144 * 4);
constexpr size_t OFF_PLAN = OFF_CNT + 256;
constexpr size_t OFF_TOKE = OFF_PLAN + 2048;
constexpr size_t OFF_TOKP = OFF_TOKE + (size_t)ML * 2 * 4;
constexpr size_t OFF_TOKR = OFF_TOKP + (size_t)ML * 2 * 4;
constexpr size_t OFF_ROWT = OFF_TOKR + (size_t)ML * 2 * 4;
constexpr size_t OFF_ROWP = OFF_ROWT + (size_t)PMAX * 4;
constexpr size_t OFF_LRUP = OFF_ROWP + (size_t)PMAX * 4;
constexpr size_t OFF_LRUH = OFF_LRUP + (size_t)NB * 2 * 68 * 512 * 4;
constexpr size_t OFF_LRUWT = OFF_LRUH + (size_t)NB * 2 * 68 * 512 * 4;
constexpr size_t OFF_TBL_END = OFF_LRUWT + (size_t)2 * 2 * 2 * 8 * 4096 * 2;
constexpr size_t OFF_X = (size_t)8 << 20;
constexpr size_t OFF_A = OFF_X + (size_t)MT * D * 4;
constexpr size_t OFF_BIG = OFF_A + (size_t)MT * AW * 2;
static_assert(OFF_TBL_END <= OFF_X, "tables");
constexpr size_t OFF_Z = OFF_BIG;
constexpr size_t OFF_QH = OFF_Z + (size_t)MT * ZW * 2;
constexpr size_t OFF_KH = OFF_QH + (size_t)MT * 512 * 2;
constexpr size_t OFF_VH = OFF_KH + (size_t)NB * SB * 128 * 2;
constexpr size_t OFF_W16 = OFF_VH + (size_t)NB * SB * 128 * 2;
constexpr size_t SZ_WINT = (size_t)ZW * 1024 * 2, SZ_BTALL = (size_t)3072 * 1536 * 2, SZ_WOUTT = (size_t)1024 * 1024 * 2;
constexpr size_t SZ_LAYERW = SZ_WINT + SZ_BTALL + SZ_WOUTT;
constexpr size_t OFF_WGUT = OFF_W16 + 2 * SZ_LAYERW;
constexpr size_t OFF_WDT = OFF_WGUT + (size_t)2 * DFF * 1024 * 2;
constexpr size_t OFF_W16_END = OFF_WDT + (size_t)1024 * DFF * 2;
constexpr size_t OFF_ACT = OFF_BIG;
static_assert(OFF_ACT + (size_t)MT * DFF * 2 <= OFF_W16, "ACT overlay");
constexpr size_t OFF_WMOE_GU = OFF_BIG;
constexpr size_t OFF_WMOE_D = OFF_WMOE_GU + (size_t)NE * 2 * DEX * 1024 * 2;
constexpr size_t OFF_XG = OFF_WMOE_D + (size_t)NE * 1024 * DEX * 2;
constexpr size_t WS_NEED = OFF_XG + (size_t)PMAX * 1024 * 2;
static_assert(WS_NEED <= 646673440ull, "workspace budget");
static_assert(OFF_W16_END <= WS_NEED, "w16");
constexpr size_t OFF_OUT2 = OFF_A;
static_assert((size_t)2 * ML * 1024 * 2 <= (size_t)MT * AW * 2, "OUT2 overlay");
static_assert((size_t)64 * 256 * DEX * 2 <= (size_t)ML * D * 4, "ACTe chunk in d_out");

struct Params {
    const float *x, *c, *ctx, *c_ctx, *w_mod, *b_mod, *w_in, *b_merge, *pool_w, *pool_scale, *q_norm, *k_norm, *conv_w, *conv_b,
        *lru_wa, *lru_ba, *lru_wx, *lru_bx, *lru_lambda, *w_branch, *w_out, *ln1_g, *ln1_b, *ffn_w_gate, *ffn_w_up, *ffn_w_down,
        *moe_router, *moe_router_b, *moe_w_gate, *moe_w_up, *moe_w_down, *ln2_g, *ln2_b;
    float* out;
    char* ws;
};
#define WSP(T, off) ((T*)(p.ws + (off)))

__device__ __forceinline__ int row_group(int r) { return r < MC ? 0 : 1 + ((r - MC) >> 12); }
__device__ __forceinline__ void row_seq(int r, int& s0, int& len, int& pos) {
    if (r < MC) { s0 = r & ~255; len = 256; pos = r & 255; } else { const int q = r - MC; s0 = MC + (q & ~4095); len = 4096; pos = q & 4095; }
}
__device__ __forceinline__ const float* xin_row(const Params& p, int r) { return r < MC ? p.ctx + (size_t)r * D : p.x + (size_t)(r - MC) * D; }
__device__ __forceinline__ float sigmoidf_(float x) { return 1.0f / (1.0f + __expf(-x)); }
__device__ __forceinline__ float siluf_(float x) { return x / (1.0f + __expf(-x)); }
__device__ __forceinline__ float gelu_tanh(float x) { const float u = 0.7978845608028654f * (x + 0.044715f * x * x * x); return 0.5f * x * (1.0f + tanhf(u)); }

struct CvtJob { const float* src; int ld_src, K, N; h16* dst; int ldd, col_off, rmode; };
constexpr int NJOBS_L = 6, NJOBS_SMALL = 2 * NJOBS_L + 3, NJOBS_ALL = NJOBS_SMALL + 24;
__device__ __forceinline__ CvtJob get_job(const Params& p, int j) {
    CvtJob q; q.col_off = 0; q.rmode = 0;
    if (j < 2 * NJOBS_L) {
        const int l = j / NJOBS_L, s = j % NJOBS_L;
        h16* wint = WSP(h16, OFF_W16 + l * SZ_LAYERW); h16* btall = WSP(h16, OFF_W16 + l * SZ_LAYERW + SZ_WINT); h16* woutt = WSP(h16, OFF_W16 + l * SZ_LAYERW + SZ_WINT + SZ_BTALL);
        if (s == 0) { q.src = p.w_in + (size_t)l * 1024 * WIN + 512; q.ld_src = WIN; q.K = 1024; q.N = ZW - 512; q.dst = wint + (size_t)512 * 1024; q.ldd = 1024; }
        else if (s == 1) { q.src = p.w_in + (size_t)l * 1024 * WIN + ZW; q.ld_src = WIN; q.K = 1024; q.N = 3072; q.dst = btall; q.ldd = 1536; }
        else if (s < 5) { const int n = s - 2; q.src = p.w_branch + (size_t)(l * 3 + n) * 512 * 1024; q.ld_src = 1024; q.K = 512; q.N = 1024; q.dst = btall + (size_t)n * 1024 * 1536; q.ldd = 1536; q.col_off = 1024; }
        else { q.src = p.w_out + (size_t)l * 1024 * 1024; q.ld_src = 1024; q.K = 1024; q.N = 1024; q.dst = woutt; q.ldd = 1024; }
    } else if (j < NJOBS_SMALL) {
        const int s = j - 2 * NJOBS_L;
        if (s == 0) { q.src = p.ffn_w_gate; q.ld_src = DFF; q.K = 1024; q.N = DFF; q.dst = WSP(h16, OFF_WGUT); q.ldd = 1024; q.rmode = 1; }
        else if (s == 1) { q.src = p.ffn_w_up; q.ld_src = DFF; q.K = 1024; q.N = DFF; q.dst = WSP(h16, OFF_WGUT); q.ldd = 1024; q.rmode = 2; }
        else { q.src = p.ffn_w_down; q.ld_src = 1024; q.K = DFF; q.N = 1024; q.dst = WSP(h16, OFF_WDT); q.ldd = DFF; }
    } else {
        const int s = j - NJOBS_SMALL, e = s / 3, t = s % 3;
        if (t == 0) { q.src = p.moe_w_gate + (size_t)e * 1024 * DEX; q.ld_src = DEX; q.K = 1024; q.N = DEX; q.dst = WSP(h16, OFF_WMOE_GU) + (size_t)e * 2 * DEX * 1024; q.ldd = 1024; q.rmode = 1; }
        else if (t == 1) { q.src = p.moe_w_up + (size_t)e * 1024 * DEX; q.ld_src = DEX; q.K = 1024; q.N = DEX; q.dst = WSP(h16, OFF_WMOE_GU) + (size_t)e * 2 * DEX * 1024; q.ldd = 1024; q.rmode = 2; }
        else { q.src = p.moe_w_down + (size_t)e * DEX * 1024; q.ld_src = 1024; q.K = DEX; q.N = 1024; q.dst = WSP(h16, OFF_WMOE_D) + (size_t)e * 1024 * DEX; q.ldd = DEX; }
    }
    return q;
}
__device__ __forceinline__ int job_tiles(const CvtJob& q) { return (q.K / 64) * (q.N / 64); }
__device__ __forceinline__ int cvt_rowmap(int n, int rmode) { return rmode == 0 ? n : ((n >> 7) * 256 + (n & 127) + (rmode == 2 ? 128 : 0)); }
template <int NT> __device__ __forceinline__ void cvt_tile(const CvtJob& q, int t, float (*tile)[65]) {
    const int nk = q.K / 64, tk = t % nk, tn = t / nk, k0 = tk * 64, n0 = tn * 64, tid = threadIdx.x;
    __syncthreads();
    for (int i = tid >> 6; i < 64; i += NT / 64) tile[i][tid & 63] = q.src[(size_t)(k0 + i) * q.ld_src + n0 + (tid & 63)];
    __syncthreads();
    for (int j = tid >> 6; j < 64; j += NT / 64) q.dst[(size_t)cvt_rowmap(n0 + j, q.rmode) * q.ldd + q.col_off + k0 + (tid & 63)] = (h16)tile[tid & 63][j];
}
__global__ void __launch_bounds__(256) k_cvt(Params p, int j0, int j1) {
    __shared__ float tile[64][65];
    int base = 0;
    for (int j = j0; j < j1; ++j) {
        const CvtJob q = get_job(p, j); const int nt = job_tiles(q);
        int first = ((int)blockIdx.x - base % (int)gridDim.x + (int)gridDim.x) % (int)gridDim.x;
        for (int t = first; t < nt; t += gridDim.x) cvt_tile<256>(q, t, tile);
        base += nt;
    }
}
__global__ void __launch_bounds__(256) k_poolfold(Params p) {
    __shared__ float Ws[64][129];
    const int nunits = 2 * 4 * 16;
    for (int u = blockIdx.x; u < nunits; u += gridDim.x) {
        const int l = u / 64, g = (u / 16) % 4, k0 = (u % 16) * 64, tid = threadIdx.x;
        __syncthreads();
        for (int i = tid; i < 64 * 128; i += 256) Ws[i >> 7][i & 127] = p.w_in[(size_t)l * 1024 * WIN + (size_t)(k0 + (i >> 7)) * WIN + g * 128 + (i & 127)];
        __syncthreads();
        const float* pw = p.pool_w + (size_t)(l * 4 + g) * 128 * 128;
        h16* wint = WSP(h16, OFF_W16 + l * SZ_LAYERW);
        const int jj = tid & 127;
        const float sc = p.pool_scale[l * 512 + g * 128 + jj];
        for (int kk = tid >> 7; kk < 64; kk += 2) {
            float acc = 0.f;
            for (int c2 = 0; c2 < 128; ++c2) acc += Ws[kk][c2] * pw[c2 * 128 + jj];
            wint[(size_t)(g * 128 + jj) * 1024 + k0 + kk] = (h16)(acc * sc);
        }
    }
}
template <int NT> __device__ __forceinline__ void mod_unit(const Params& p, int u, float* sc  , float* red  ) {
    const int l = u / 96, n0 = (u % 96) * 64, tid = threadIdx.x, n = tid & 63, ks = tid >> 6;
    constexpr int NKS = NT / 64, KPER = 1024 / NKS;
    __syncthreads();
    for (int i = tid; i < 9 * 1024; i += NT) { const int g = i >> 10, k = i & 1023; const float v = g == 0 ? p.c_ctx[k] : p.c[(g - 1) * 1024 + k]; sc[i] = siluf_(v); }
    __syncthreads();
    float acc[9];
#pragma unroll
    for (int g = 0; g < 9; ++g) acc[g] = 0.f;
    const float* w = p.w_mod + (size_t)l * 1024 * 6144 + n0 + n;
#pragma unroll 8
    for (int k = ks * KPER; k < (ks + 1) * KPER; ++k) { const float wv = w[(size_t)k * 6144];
#pragma unroll
        for (int g = 0; g < 9; ++g) acc[g] += sc[g * 1024 + k] * wv; }
#pragma unroll
    for (int g = 0; g < 9; ++g) red[(ks * 9 + g) * 64 + n] = acc[g];
    __syncthreads();
    for (int i = tid; i < 9 * 64; i += NT) { const int g = i >> 6, nn = i & 63; float s = p.b_mod[l * 6144 + n0 + nn];
        for (int k2 = 0; k2 < NKS; ++k2) s += red[(k2 * 9 + g) * 64 + nn];
        WSP(float, OFF_MOD)[(size_t)(l * 9 + g) * 6144 + n0 + nn] = s; }
}
__global__ void __launch_bounds__(256) k_mod(Params p) {
    __shared__ float sc[9 * 1024]; __shared__ float red[4 * 9 * 64];
    if (blockIdx.x == 0 && threadIdx.x < 8) WSP(int, OFF_CNT)[threadIdx.x] = 0;
    for (int u = blockIdx.x; u < 192; u += gridDim.x) mod_unit<256>(p, u, sc, red);
}
__global__ void __launch_bounds__(256) k_h0(Params p) {
    const float* mod = WSP(float, OFF_MOD); h16* A = WSP(h16, OFF_A);
    for (int r = blockIdx.x; r < MT; r += gridDim.x) {
        const int g = row_group(r), d = threadIdx.x * 4; const float* xr = xin_row(p, r);
        const float4 xv = *(const float4*)(xr + d); const float4 m0 = *(const float4*)(mod + (size_t)g * 6144 + d); const float4 m1 = *(const float4*)(mod + (size_t)g * 6144 + 1024 + d);
        h16x4 o; o[0] = (h16)(xv.x * (1.f + m1.x) + m0.x); o[1] = (h16)(xv.y * (1.f + m1.y) + m0.y); o[2] = (h16)(xv.z * (1.f + m1.z) + m0.z); o[3] = (h16)(xv.w * (1.f + m1.w) + m0.w);
        *(h16x4*)(A + (size_t)r * AW + AH + d) = o;
    }
}

__device__ __forceinline__ void nv_tile_mm(const h16* __restrict__ A, int lda, const h16* __restrict__ Bt, int ldb, int K, float (&acc)[4][4], float (*As)[68], float (*Bs)[68]) {
    const int tid = threadIdx.x, lr = tid >> 2, lk = (tid & 3) * 4, ty = tid >> 4, tx = tid & 15;
    for (int k0 = 0; k0 < K; k0 += 16) {
        const h16x4 av = *(const h16x4*)(A + (size_t)lr * lda + k0 + lk);
        const h16x4 bv = *(const h16x4*)(Bt + (size_t)lr * ldb + k0 + lk);
        __syncthreads();
#pragma unroll
        for (int i = 0; i < 4; ++i) { As[lk + i][lr] = (float)av[i]; Bs[lk + i][lr] = (float)bv[i]; }
        __syncthreads();
#pragma unroll
        for (int kk = 0; kk < 16; ++kk) {
            const float4 a = *(const float4*)&As[kk][ty * 4]; const float4 b = *(const float4*)&Bs[kk][tx * 4];
            const float aa[4] = {a.x, a.y, a.z, a.w}, bb[4] = {b.x, b.y, b.z, b.w};
#pragma unroll
            for (int i = 0; i < 4; ++i)
#pragma unroll
                for (int j = 0; j < 4; ++j) acc[i][j] += aa[i] * bb[j];
        }
    }
}
#define NV_ZERO(acc) do { _Pragma("unroll") for (int i_ = 0; i_ < 4; ++i_) _Pragma("unroll") for (int j_ = 0; j_ < 4; ++j_) acc[i_][j_] = 0.f; } while (0)

__global__ void __launch_bounds__(256) k_gemm_in(Params p, int l) {
    __shared__ float As[16][68], Bs[16][68];
    const h16* A = WSP(h16, OFF_A); const h16* Bt = WSP(h16, OFF_W16 + l * SZ_LAYERW); h16* Z = WSP(h16, OFF_Z);
    const int ntn = ZW / 64, ntiles = (MT / 64) * ntn, ty = threadIdx.x >> 4, tx = threadIdx.x & 15;
    for (int t = blockIdx.x; t < ntiles; t += gridDim.x) {
        const int r0 = (t / ntn) * 64, c0 = (t % ntn) * 64; float acc[4][4]; NV_ZERO(acc);
        nv_tile_mm(A + (size_t)r0 * AW + AH, AW, Bt + (size_t)c0 * 1024, 1024, 1024, acc, As, Bs);
#pragma unroll
        for (int i = 0; i < 4; ++i) { h16x4 o; o[0] = (h16)acc[i][0]; o[1] = (h16)acc[i][1]; o[2] = (h16)acc[i][2]; o[3] = (h16)acc[i][3];
            *(h16x4*)(Z + (size_t)(r0 + ty * 4 + i) * ZW + c0 + tx * 4) = o; }
    }
}
__global__ void __launch_bounds__(256) k_qkv(Params p, int l) {
    const h16* Z = WSP(h16, OFF_Z); h16* Qh = WSP(h16, OFF_QH); h16* Kh = WSP(h16, OFF_KH); h16* Vh = WSP(h16, OFF_VH);
    const int lane = threadIdx.x & 63, wv = threadIdx.x >> 6;
    const int nitems = MT * 12;
    for (int it = blockIdx.x * 4 + wv; it < nitems; it += gridDim.x * 4) {
        const int r = it / 12, s = it % 12; int s0, len, pos; row_seq(r, s0, len, pos);
        const bool lat = r >= MC; const int b = lat ? (r - MC) >> 12 : r >> 8; const size_t krow = (size_t)b * SB + (lat ? CTX + pos : pos);
        if (s >= 10) { Vh[krow * 128 + (s - 10) * 64 + lane] = Z[(size_t)r * ZW + ZV + (s - 10) * 64 + lane]; continue; }
        const int zc = s < 8 ? ZQ + s * 64 : ZK + (s - 8) * 64;
        const float z = (float)Z[(size_t)r * ZW + zc + lane];
        float ss = z * z;
#pragma unroll
        for (int o = 32; o >= 1; o >>= 1) ss += __shfl_xor(ss, o);
        const float g = s < 8 ? p.q_norm[l * 64 + lane] : p.k_norm[l * 64 + lane];
        float y = z * rsqrtf(ss * (1.0f / 64.0f) + 1e-6f) * g;
        const float yp = __shfl_xor(y, 16);
        if (lat) {
            const float posf = (lane < 32) ? (float)(pos >> 6) : (float)(pos & 63);
            const float inv = exp2f(-(float)(lane & 15) * (13.287712379549449f / 16.0f));
            float sn, cs; sincosf(posf * inv, &sn, &cs);
            y = (lane & 16) ? (y * cs + yp * sn) : (y * cs - yp * sn);
        }
        if (s < 8) Qh[(size_t)r * 512 + s * 64 + lane] = (h16)(y * QSCALE);
        else Kh[krow * 128 + (s - 8) * 64 + lane] = (h16)y;
    }
}
__global__ void __launch_bounds__(256) k_pool(Params p, int r_begin) {
    const h16* Z = WSP(h16, OFF_Z); h16* A = WSP(h16, OFF_A);
    for (int r = r_begin + blockIdx.x; r < MT; r += gridDim.x) {
        int s0, len, pos; row_seq(r, s0, len, pos);
        for (int j = threadIdx.x; j < 512; j += 256) {
            const int w = 2 << (j >> 7), lo = pos - (w >> 1); const int a = lo < 0 ? 0 : lo, e = (lo + w) > len ? len : (lo + w);
            float s = 0.f; for (int t = a; t < e; ++t) s += (float)Z[(size_t)(s0 + t) * ZW + ZP + j];
            A[(size_t)r * AW + AY0 + j] = (h16)(s / (float)(e - a) - (float)Z[(size_t)r * ZW + ZP + j]);
        }
    }
}
__global__ void __launch_bounds__(64) k_lru_scan(Params p, int l, int dir) {
    __shared__ float xs[64];
    const int b = blockIdx.x >> 3, blk = blockIdx.x & 7, j = threadIdx.x, c = blk * 64 + j;
    const h16* Z = WSP(h16, OFF_Z); h16* A = WSP(h16, OFF_A); float* HF = p.out;
    float wa[64], wx[64];
    const float* pwa = p.lru_wa + ((size_t)(l * 2 + dir) * 8 + blk) * 4096; const float* pwx = p.lru_wx + ((size_t)(l * 2 + dir) * 8 + blk) * 4096;
#pragma unroll
    for (int i = 0; i < 64; ++i) { wa[i] = pwa[i * 64 + j]; wx[i] = pwx[i * 64 + j]; }
    const float ba = p.lru_ba[(l * 2 + dir) * 512 + c], bx = p.lru_bx[(l * 2 + dir) * 512 + c], lam = p.lru_lambda[(l * 2 + dir) * 512 + c];
    const float sp = log1pf(expf(-lam));
    float cw[4]; for (int k = 0; k < 4; ++k) cw[k] = p.conv_w[(l * 4 + k) * 512 + c];
    const float cb = p.conv_b[l * 512 + c];
    float h = 0.f;
    for (int idx = 0; idx < SB; ++idx) {
        int s0, len, pos;
        if (idx < CTX) { s0 = b * CTX; len = CTX; pos = dir ? CTX - 1 - idx : idx; } else { s0 = MC + b * SEQ; len = SEQ; pos = dir ? SEQ - 1 - (idx - CTX) : idx - CTX; }
        float xc = cb;
#pragma unroll
        for (int k = 0; k < 4; ++k) { const int t = pos + k - 2; if (t >= 0 && t < len) xc += cw[k] * (float)Z[(size_t)(s0 + t) * ZW + ZLX + c]; }
        __syncthreads(); xs[j] = xc; __syncthreads();
        float ra = ba, ri = bx;
#pragma unroll
        for (int i = 0; i < 64; ++i) { const float xv = xs[i]; ra += xv * wa[i]; ri += xv * wx[i]; }
        const float rg = sigmoidf_(ra), ig = sigmoidf_(ri), la = -8.0f * rg * sp, a = expf(la), u = sqrtf(-expm1f(2.0f * la)) * ig * xc;
        h = a * h + u;
        const int r = s0 + pos;
        if (dir == 0) HF[(size_t)r * 512 + c] = h;
        else { const float tot = HF[(size_t)r * 512 + c] + h; A[(size_t)r * AW + AY2 + c] = (h16)(tot * gelu_tanh((float)Z[(size_t)r * ZW + ZLG + c])); }
    }
}
__global__ void __launch_bounds__(256) k_attn(Params p, int isctx) {
    __shared__ float Ks[64][64], Vs[64][64];
    const h16* Qh = WSP(h16, OFF_QH); const h16* Kh = WSP(h16, OFF_KH); const h16* Vh = WSP(h16, OFF_VH); h16* A = WSP(h16, OFF_A);
    const int nqb = isctx ? 1 : 16, nunits = NB * 8 * nqb, tid = threadIdx.x;
    for (int u = blockIdx.x; u < nunits; u += gridDim.x) {
        const int b = u / (8 * nqb), hq = (u / nqb) % 8, qb = u % nqb, kvh = hq >> 2;
        const int r = isctx ? b * CTX + tid : MC + b * SEQ + qb * 256 + tid; const int nkeys = isctx ? CTX : SB;
        float q[64], o[64];
#pragma unroll
        for (int d = 0; d < 64; ++d) { q[d] = (float)Qh[(size_t)r * 512 + hq * 64 + d]; o[d] = 0.f; }
        float m = -INFINITY, lsum = 0.f;
        for (int k0 = 0; k0 < nkeys; k0 += 64) {
            __syncthreads();
            { const int key = tid >> 2, d0 = (tid & 3) * 16; const size_t base = ((size_t)b * SB + k0 + key) * 128 + kvh * 64 + d0;
#pragma unroll
              for (int i = 0; i < 16; ++i) { Ks[key][d0 + i] = (float)Kh[base + i]; Vs[key][d0 + i] = (float)Vh[base + i]; } }
            __syncthreads();
            for (int key = 0; key < 64; ++key) {
                float s = 0.f;
#pragma unroll
                for (int d = 0; d < 64; ++d) s += q[d] * Ks[key][d];
                const float mn = fmaxf(m, s), corr = exp2f(m - mn), pe = exp2f(s - mn);
                lsum = lsum * corr + pe;
#pragma unroll
                for (int d = 0; d < 64; ++d) o[d] = o[d] * corr + pe * Vs[key][d];
                m = mn;
            }
        }
        const float il = 1.0f / lsum;
#pragma unroll
        for (int d = 0; d < 64; ++d) A[(size_t)r * AW + AY1 + hq * 64 + d] = (h16)(o[d] * il);
    }
}
__global__ void __launch_bounds__(256) k_merge(Params p, int l, int r_begin) {
    __shared__ float As[16][68], Bs[16][68];
    const h16* A = WSP(h16, OFF_A); const h16* Bt = WSP(h16, OFF_W16 + l * SZ_LAYERW + SZ_WINT); h16* S16 = (h16*)p.out;
    const int nrt = (MT - r_begin) / 64, ntiles = nrt * 16, ty = threadIdx.x >> 4, tx = threadIdx.x & 15;
    for (int t = blockIdx.x; t < ntiles; t += gridDim.x) {
        const int r0 = r_begin + (t / 16) * 64, c0 = (t % 16) * 64; float sum[4][4]; NV_ZERO(sum);
        for (int n = 0; n < 3; ++n) {
            float ag[4][4], ab[4][4]; NV_ZERO(ag); NV_ZERO(ab);
            nv_tile_mm(A + (size_t)r0 * AW + AH, AW, Bt + (size_t)(n * 1024 + c0) * 1536, 1536, 1024, ag, As, Bs);
            nv_tile_mm(A + (size_t)r0 * AW + AY0 + n * 512, AW, Bt + (size_t)(n * 1024 + c0) * 1536 + 1024, 1536, 512, ab, As, Bs);
#pragma unroll
            for (int i = 0; i < 4; ++i)
#pragma unroll
                for (int j = 0; j < 4; ++j) sum[i][j] += sigmoidf_(ag[i][j] + p.b_merge[(l * 3 + n) * 1024 + c0 + tx * 4 + j]) * ab[i][j];
        }
#pragma unroll
        for (int i = 0; i < 4; ++i) { h16x4 o; o[0] = (h16)sum[i][0]; o[1] = (h16)sum[i][1]; o[2] = (h16)sum[i][2]; o[3] = (h16)sum[i][3];
            *(h16x4*)(S16 + (size_t)(r0 + ty * 4 + i) * 1024 + c0 + tx * 4) = o; }
    }
}
__global__ void __launch_bounds__(256) k_wout(Params p, int l, int r_begin) {
    __shared__ float As[16][68], Bs[16][68];
    const h16* S16 = (const h16*)p.out; const h16* Bt = WSP(h16, OFF_W16 + l * SZ_LAYERW + SZ_WINT + SZ_BTALL); float* X = WSP(float, OFF_X); const float* mod = WSP(float, OFF_MOD) + (size_t)l * 9 * 6144;
    const int nrt = (MT - r_begin) / 64, ntiles = nrt * 16, ty = threadIdx.x >> 4, tx = threadIdx.x & 15;
    for (int t = blockIdx.x; t < ntiles; t += gridDim.x) {
        const int r0 = r_begin + (t / 16) * 64, c0 = (t % 16) * 64; float acc[4][4]; NV_ZERO(acc);
        nv_tile_mm(S16 + (size_t)r0 * 1024, 1024, Bt + (size_t)c0 * 1024, 1024, 1024, acc, As, Bs);
#pragma unroll
        for (int i = 0; i < 4; ++i) { const int r = r0 + ty * 4 + i, g = row_group(r); const float* res = (l == 0) ? xin_row(p, r) : X + (size_t)r * D;
#pragma unroll
            for (int j = 0; j < 4; ++j) { const int d = c0 + tx * 4 + j; X[(size_t)r * D + d] = ALPHA * res[d] + mod[(size_t)g * 6144 + 2 * 1024 + d] * acc[i][j]; } }
    }
}
__global__ void __launch_bounds__(256) k_ln(Params p, int mode, int r_begin, const float* __restrict__ gam, const float* __restrict__ bet, int lm, int sh, int sc) {
    float* X = WSP(float, OFF_X); h16* A = WSP(h16, OFF_A); const float* mod = WSP(float, OFF_MOD) + (size_t)lm * 9 * 6144;
    const int lane = threadIdx.x & 63, wv = threadIdx.x >> 6;
    for (int r = r_begin + blockIdx.x * 4 + wv; r < MT; r += gridDim.x * 4) {
        const int g = row_group(r); float v[16];
#pragma unroll
        for (int i = 0; i < 4; ++i) { const float4 t = *(const float4*)(X + (size_t)r * D + i * 256 + lane * 4); v[i * 4] = t.x; v[i * 4 + 1] = t.y; v[i * 4 + 2] = t.z; v[i * 4 + 3] = t.w; }
        if (mode == 2) {
            const h16* o0 = WSP(h16, OFF_OUT2) + (size_t)(r - MC) * 1024; const h16* o1 = o0 + (size_t)ML * 1024; const float* m5 = WSP(float, OFF_MOD) + (size_t)(1 * 9 + g) * 6144 + 5 * 1024;
#pragma unroll
            for (int i = 0; i < 4; ++i) { const h16x4 a = *(const h16x4*)(o0 + i * 256 + lane * 4), b2 = *(const h16x4*)(o1 + i * 256 + lane * 4); const float4 mm = *(const float4*)(m5 + i * 256 + lane * 4);
                const float mv[4] = {mm.x, mm.y, mm.z, mm.w};
#pragma unroll
                for (int j = 0; j < 4; ++j) v[i * 4 + j] = ALPHA * v[i * 4 + j] + mv[j] * ((float)a[j] + (float)b2[j]); }
        }
        float s = 0.f;
#pragma unroll
        for (int i = 0; i < 16; ++i) s += v[i];
#pragma unroll
        for (int o = 32; o >= 1; o >>= 1) s += __shfl_xor(s, o);
        const float mean = s * (1.0f / 1024.0f); float q = 0.f;
#pragma unroll
        for (int i = 0; i < 16; ++i) { const float dlt = v[i] - mean; q += dlt * dlt; }
#pragma unroll
        for (int o = 32; o >= 1; o >>= 1) q += __shfl_xor(q, o);
        const float rstd = rsqrtf(q * (1.0f / 1024.0f) + 1e-5f);
        float lg8[8];
#pragma unroll
        for (int e = 0; e < 8; ++e) lg8[e] = 0.f;
#pragma unroll
        for (int i = 0; i < 4; ++i) {
            const int d = i * 256 + lane * 4; const float4 gg = *(const float4*)(gam + d), bb = *(const float4*)(bet + d);
            const float gv[4] = {gg.x, gg.y, gg.z, gg.w}, bv[4] = {bb.x, bb.y, bb.z, bb.w}; float y[4];
#pragma unroll
            for (int j = 0; j < 4; ++j) y[j] = (v[i * 4 + j] - mean) * rstd * gv[j] + bv[j];
            if (mode == 2) { *(float4*)(p.out + (size_t)(r - MC) * D + d) = make_float4(y[0], y[1], y[2], y[3]); continue; }
            *(float4*)(X + (size_t)r * D + d) = make_float4(y[0], y[1], y[2], y[3]);
            const float4 ms = *(const float4*)(mod + (size_t)g * 6144 + sh * 1024 + d), mc = *(const float4*)(mod + (size_t)g * 6144 + sc * 1024 + d);
            const float msv[4] = {ms.x, ms.y, ms.z, ms.w}, mcv[4] = {mc.x, mc.y, mc.z, mc.w}; float hh[4]; h16x4 ho;
#pragma unroll
            for (int j = 0; j < 4; ++j) { hh[j] = y[j] * (1.f + mcv[j]) + msv[j]; ho[j] = (h16)hh[j]; }
            *(h16x4*)(A + (size_t)r * AW + AH + d) = ho;
            if (mode == 1) {
#pragma unroll
                for (int j = 0; j < 4; ++j) { const float4 r0 = *(const float4*)(p.moe_router + (size_t)(d + j) * 8), r1 = *(const float4*)(p.moe_router + (size_t)(d + j) * 8 + 4);
                    lg8[0] += hh[j] * r0.x; lg8[1] += hh[j] * r0.y; lg8[2] += hh[j] * r0.z; lg8[3] += hh[j] * r0.w; lg8[4] += hh[j] * r1.x; lg8[5] += hh[j] * r1.y; lg8[6] += hh[j] * r1.z; lg8[7] += hh[j] * r1.w; }
            }
        }
        if (mode == 1) {
#pragma unroll
            for (int e = 0; e < 8; ++e) {
#pragma unroll
                for (int o = 32; o >= 1; o >>= 1) lg8[e] += __shfl_xor(lg8[e], o);
                lg8[e] += p.moe_router_b[e]; }
            if (lane == 0) {
                int i0 = 0; float v0 = lg8[0];
#pragma unroll
                for (int e = 1; e < 8; ++e) if (lg8[e] > v0) { v0 = lg8[e]; i0 = e; }
                int i1 = -1; float v1 = -INFINITY;
#pragma unroll
                for (int e = 0; e < 8; ++e) if (e != i0 && lg8[e] > v1) { v1 = lg8[e]; i1 = e; }
                const float p1 = 1.0f / (1.0f + expf(v0 - v1)), p0 = 1.0f - p1;
                const int t = r - MC; int* cnt = WSP(int, OFF_CNT);
                const int k0 = atomicAdd(&cnt[i0], 1), k1 = atomicAdd(&cnt[i1], 1);
                WSP(int, OFF_TOKE)[t * 2] = i0; WSP(int, OFF_TOKE)[t * 2 + 1] = i1; WSP(float, OFF_TOKP)[t * 2] = p0; WSP(float, OFF_TOKP)[t * 2 + 1] = p1; WSP(int, OFF_TOKR)[t * 2] = k0; WSP(int, OFF_TOKR)[t * 2 + 1] = k1;
            }
        }
    }
}
__global__ void __launch_bounds__(256) k_ffn_gu(Params p, int moe, int panel0, int npan) {
    __shared__ float As[16][68], Bs[16][68];
    const int* plan = WSP(int, OFF_PLAN); const int npanels = moe ? plan[8] : MT / 256;
    const int dff = moe ? DEX : DFF, ntn = dff / 64, ty = threadIdx.x >> 4, tx = threadIdx.x & 15;
    const h16* A = moe ? WSP(h16, OFF_XG) : WSP(h16, OFF_A) + AH; const int lda = moe ? 1024 : AW;
    h16* ACT = moe ? (h16*)p.out : WSP(h16, OFF_ACT);
    const int ntiles = npan * 4 * ntn;
    for (int t = blockIdx.x; t < ntiles; t += gridDim.x) {
        const int rt = t / ntn, panel = panel0 + rt / 4; if (panel >= npanels) break;
        const int r0 = panel * 256 + (rt % 4) * 64, j0 = (t % ntn) * 64;
        const h16* Bt = moe ? WSP(h16, OFF_WMOE_GU) + (size_t)plan[16 + panel] * 2 * DEX * 1024 : WSP(h16, OFF_WGUT);
        const int brow = (j0 >> 7) * 256 + (j0 & 127);
        float ag[4][4], au[4][4]; NV_ZERO(ag); NV_ZERO(au);
        nv_tile_mm(A + (size_t)r0 * lda, lda, Bt + (size_t)brow * 1024, 1024, 1024, ag, As, Bs);
        nv_tile_mm(A + (size_t)r0 * lda, lda, Bt + (size_t)(brow + 128) * 1024, 1024, 1024, au, As, Bs);
        const size_t orow0 = moe ? (size_t)(r0 - panel0 * 256) : (size_t)r0;
#pragma unroll
        for (int i = 0; i < 4; ++i) { h16x4 o;
#pragma unroll
            for (int j = 0; j < 4; ++j) o[j] = (h16)(siluf_(ag[i][j]) * au[i][j]);
            *(h16x4*)(ACT + (orow0 + ty * 4 + i) * dff + j0 + tx * 4) = o; }
    }
}
__global__ void __launch_bounds__(256) k_ffn_down(Params p, int moe, int panel0, int npan) {
    __shared__ float As[16][68], Bs[16][68];
    const int* plan = WSP(int, OFF_PLAN); const int npanels = moe ? plan[8] : MT / 256;
    const int dff = moe ? DEX : DFF, ty = threadIdx.x >> 4, tx = threadIdx.x & 15;
    const h16* ACT = moe ? (const h16*)p.out : WSP(h16, OFF_ACT);
    float* X = WSP(float, OFF_X); const float* mod = WSP(float, OFF_MOD);
    const int ntiles = npan * 4 * 16;
    for (int t = blockIdx.x; t < ntiles; t += gridDim.x) {
        const int rt = t / 16, panel = panel0 + rt / 4; if (panel >= npanels) break;
        const int r0 = panel * 256 + (rt % 4) * 64, c0 = (t % 16) * 64;
        const h16* Bt = moe ? WSP(h16, OFF_WMOE_D) + (size_t)plan[16 + panel] * 1024 * DEX : WSP(h16, OFF_WDT);
        const size_t arow0 = moe ? (size_t)(r0 - panel0 * 256) : (size_t)r0;
        float acc[4][4]; NV_ZERO(acc);
        nv_tile_mm(ACT + arow0 * dff, dff, Bt + (size_t)c0 * dff, dff, dff, acc, As, Bs);
#pragma unroll
        for (int i = 0; i < 4; ++i) { const int r = r0 + ty * 4 + i;
            if (!moe) { const int g = row_group(r);
#pragma unroll
                for (int j = 0; j < 4; ++j) { const int d = c0 + tx * 4 + j; X[(size_t)r * D + d] = ALPHA * X[(size_t)r * D + d] + mod[(size_t)g * 6144 + 5 * 1024 + d] * acc[i][j]; } }
            else { const int tk = WSP(int, OFF_ROWT)[r]; if (tk < 0) continue; const float pp = WSP(float, OFF_ROWP)[r];
                h16x4 o;
#pragma unroll
                for (int j = 0; j < 4; ++j) o[j] = (h16)(pp * acc[i][j]);
                *(h16x4*)(WSP(h16, OFF_OUT2) + ((size_t)(tk & 1) * ML + (tk >> 1)) * 1024 + c0 + tx * 4) = o; }
        }
    }
}
__global__ void __launch_bounds__(256) k_moe_plan(Params p) {
    int* plan = WSP(int, OFF_PLAN); const int* cnt = WSP(int, OFF_CNT); int* rowT = WSP(int, OFF_ROWT);
    __shared__ int sp[9];
    if (threadIdx.x == 0) { int acc = 0; for (int e = 0; e < 8; ++e) { sp[e] = acc; plan[e] = acc; const int np = (cnt[e] + 255) / 256; for (int q = 0; q < np; ++q) plan[16 + acc / 256 + q] = e; acc += np * 256; } sp[8] = acc; plan[8] = acc / 256; }
    __syncthreads();
    for (int e = 0; e < 8; ++e) { const int a = sp[e] + cnt[e], b = sp[e + 1]; for (int i = a + threadIdx.x; i < b; i += 256) rowT[i] = -1; }
}
__global__ void __launch_bounds__(256) k_moe_gather(Params p) {
    const int* plan = WSP(int, OFF_PLAN); const h16* A = WSP(h16, OFF_A); h16* Xg = WSP(h16, OFF_XG);
    const int lane = threadIdx.x & 63, wv = threadIdx.x >> 6;
    for (int it = blockIdx.x * 4 + wv; it < ML * 2; it += gridDim.x * 4) {
        const int t = it >> 1, e = WSP(int, OFF_TOKE)[it], pos = plan[e] + WSP(int, OFF_TOKR)[it];
        const h16* src = A + (size_t)(MC + t) * AW + AH; h16* dst = Xg + (size_t)pos * 1024;
        *(h16x8*)(dst + lane * 8) = *(const h16x8*)(src + lane * 8); *(h16x8*)(dst + 512 + lane * 8) = *(const h16x8*)(src + 512 + lane * 8);
        if (lane == 0) { WSP(int, OFF_ROWT)[pos] = it; WSP(float, OFF_ROWP)[pos] = WSP(float, OFF_TOKP)[it]; }
    }
}


#define LAS __attribute__((address_space(3)))
typedef float f32x4 __attribute__((ext_vector_type(4)));
typedef unsigned u32x4 __attribute__((ext_vector_type(4)));
typedef unsigned u32x2 __attribute__((ext_vector_type(2)));
namespace pg8 {
constexpr int BM = 256, BK = 64, HALF = 128, HTB = HALF * BK * 2, STAGE_BYTES = 8 * HTB;
__host__ __device__ __forceinline__ int lds_byte(int r, int c) { const int st = (r >> 4) * 2 + (c >> 5), rr = r & 15, cc = c & 31, ob = rr * 64 + cc * 2; return st * 1024 + (ob ^ (((ob >> 9) & 1) << 5)); }
__host__ __device__ __forceinline__ void stage_rc(int b, int& R, int& C) { const int st = b / 1024, sb = b % 1024, swz = sb ^ (((sb >> 9) & 1) << 5); R = (st >> 1) * 16 + swz / 64; C = (st & 1) * 32 + (swz % 64) / 2; }
__host__ __device__ __forceinline__ int perm32(int rho) { const int n = rho >> 4, i = rho & 15; return 8 * (i >> 2) + 4 * n + (i & 3); }
struct GUnit { const char* A; const char* B; int nt; int kind; int pm; int pn; int aux; };
__device__ __forceinline__ void tile_map(int L, int nM, int nN, int& pm, int& pn) {
    const int nwg = nM * nN; int wgid = L;
    { const int q = nwg / 8, r = nwg % 8, xcd = wgid % 8, off = wgid / 8; wgid = (xcd < r ? xcd * (q + 1) : r * (q + 1) + (xcd - r) * q) + off; }
    const int nig = 8 * nN, gid = wgid / nig, fm = gid * 8, gsz = (nM - fm) < 8 ? (nM - fm) : 8;
    pm = fm + ((wgid % nig) % gsz); pn = (wgid % nig) / gsz;
}
__device__ __forceinline__ unsigned cvt_pk_f16(float lo, float hi) { typedef float f2 __attribute__((ext_vector_type(2))); const f2 v = {lo, hi}; const h16x2 h = __builtin_convertvector(v, h16x2); return __builtin_bit_cast(unsigned, h); }

template <class Epi, class Sched>
__device__ __forceinline__ void gemm_phase(LAS unsigned char* lds, const int lda, const int ldb, const Sched& S, const Epi& E) {
    const int tid = threadIdx.x, wid = __builtin_amdgcn_readfirstlane(tid >> 6), lane = tid & 63, wr = wid >> 2, wc = wid & 3, fr = lane & 15, fq = lane >> 4;
    unsigned voffA[2], voffB[2];
#pragma unroll
    for (int i = 0; i < 2; ++i) { int R, C; stage_rc(tid * 16 + i * 8192, R, C); const int Rb = Epi::PERM ? ((R & ~31) + perm32(R & 31)) : R;
        voffA[i] = (unsigned)(R * lda + C) * 2u; voffB[i] = (unsigned)(Rb * ldb + C) * 2u; }
    const size_t kstep = (size_t)(BK * 2);
    const size_t hstepA = (size_t)HALF * lda * 2, hstepB = (size_t)HALF * ldb * 2;
    const unsigned ldsw = (unsigned)wid * 1024u;
    const int aoff = lds_byte(wr * 64 + fr, fq * 8), boff = lds_byte(wc * 32 + fr, fq * 8);
#define PG8_SA(b, h) (((b) * 2 + (h)) * HTB)
#define PG8_SB(b, h) ((4 + (b) * 2 + (h)) * HTB)
#define PG8_STAGE(bufoff, gbase, voff) do { _Pragma("unroll") for (int _i = 0; _i < 2; ++_i) \
        __builtin_amdgcn_global_load_lds((const unsigned*)((const char*)(gbase) + (voff)[_i]), (LAS unsigned*)(lds + (bufoff) + ldsw + _i * 8192), 16, 0, 0); } while (0)
#define PG8_LDA(dst, b, h) do { _Pragma("unroll") for (int m = 0; m < 4; ++m) _Pragma("unroll") for (int k = 0; k < 2; ++k) dst[m][k] = *(const LAS h16x8*)(lds + PG8_SA(b, h) + aoff + m * 2048 + k * 1024); } while (0)
#define PG8_LDB(dst, b, h) do { _Pragma("unroll") for (int n = 0; n < 2; ++n) _Pragma("unroll") for (int k = 0; k < 2; ++k) dst[n][k] = *(const LAS h16x8*)(lds + PG8_SB(b, h) + boff + n * 2048 + k * 1024); } while (0)
#define PG8_MMA(ai, bj, At, Bt) do { __builtin_amdgcn_s_setprio(1); _Pragma("unroll") for (int m = 0; m < 4; ++m) _Pragma("unroll") for (int n = 0; n < 2; ++n) _Pragma("unroll") for (int k = 0; k < 2; ++k) \
        acc[ai][bj][m][n] = __builtin_amdgcn_mfma_f32_16x16x32_f16(Bt[n][k], At[m][k], acc[ai][bj][m][n], 0, 0, 0); __builtin_amdgcn_s_setprio(0); } while (0)
#define PG8_WAIT_V(n) asm volatile("s_waitcnt vmcnt(" #n ")" ::: "memory")
#define PG8_WAIT_L(n) asm volatile("s_waitcnt lgkmcnt(" #n ")" ::: "memory")
#define PG8_BAR __builtin_amdgcn_s_barrier()
#define PG8_SCHED __builtin_amdgcn_sched_barrier(0)
    GUnit cur, nxt; int ui = 0;
    if (!S.next(0, cur)) return;
    f32x4 acc[2][2][4][2];
#pragma unroll
    for (int a = 0; a < 2; ++a)
#pragma unroll
        for (int b = 0; b < 2; ++b)
#pragma unroll
            for (int m = 0; m < 4; ++m)
#pragma unroll
                for (int n = 0; n < 2; ++n) acc[a][b][m][n] = (f32x4){0.f, 0.f, 0.f, 0.f};
    h16x8 At[4][2], B0[2][2], B1[2][2];
    const char* cA = cur.A; const char* cB = cur.B;
    PG8_STAGE(PG8_SB(0, 0), cB, voffB); PG8_STAGE(PG8_SA(0, 0), cA, voffA); PG8_STAGE(PG8_SB(0, 1), cB + hstepB, voffB); PG8_STAGE(PG8_SA(0, 1), cA + hstepA, voffA);
    if (wr == 1) PG8_BAR;
    PG8_WAIT_V(4); PG8_BAR;
    PG8_STAGE(PG8_SB(1, 0), cB + kstep, voffB); PG8_STAGE(PG8_SA(1, 0), cA + kstep, voffA); PG8_STAGE(PG8_SB(1, 1), cB + hstepB + kstep, voffB);
    PG8_WAIT_V(6); PG8_BAR;
    for (;;) {
        const bool has_next = S.next(ui + 1, nxt);
        const char* nA = has_next ? nxt.A : cA; const char* nB = has_next ? nxt.B : cB;
        const int nt = cur.nt;
        for (int t = 0; t < nt; t += 2) {
            const bool last = (t == nt - 2);
            const char* a1 = cA + (size_t)(t + 1) * kstep;
            const char* a2 = last ? nA : cA + (size_t)(t + 2) * kstep; const char* b2 = last ? nB : cB + (size_t)(t + 2) * kstep;
            const char* a3 = a2 + kstep; const char* b3 = b2 + kstep;
            PG8_LDB(B0, 0, 0); PG8_SCHED; PG8_LDA(At, 0, 0); PG8_STAGE(PG8_SA(1, 1), a1 + hstepA, voffA);
            PG8_WAIT_L(8); PG8_BAR; PG8_WAIT_L(0); PG8_MMA(0, 0, At, B0); PG8_BAR; PG8_SCHED;
            PG8_LDB(B1, 0, 1); PG8_STAGE(PG8_SB(0, 0), b2, voffB);
            PG8_BAR; PG8_WAIT_L(0); PG8_MMA(0, 1, At, B1); PG8_BAR;
            PG8_LDA(At, 0, 1); PG8_STAGE(PG8_SA(0, 0), a2, voffA);
            PG8_BAR; PG8_WAIT_L(0); PG8_MMA(1, 0, At, B0); PG8_BAR; PG8_SCHED;
            PG8_STAGE(PG8_SB(0, 1), b2 + hstepB, voffB);
            PG8_WAIT_V(6); PG8_BAR; PG8_MMA(1, 1, At, B1); PG8_BAR;
            PG8_LDB(B0, 1, 0); PG8_SCHED; PG8_LDA(At, 1, 0); PG8_STAGE(PG8_SA(0, 1), a2 + hstepA, voffA);
            PG8_WAIT_L(8); PG8_BAR; PG8_WAIT_L(0); PG8_MMA(0, 0, At, B0); PG8_BAR; PG8_SCHED;
            PG8_LDB(B1, 1, 1); PG8_STAGE(PG8_SB(1, 0), b3, voffB);
            PG8_BAR; PG8_WAIT_L(0); PG8_MMA(0, 1, At, B1); PG8_BAR;
            PG8_LDA(At, 1, 1); PG8_STAGE(PG8_SA(1, 0), a3, voffA);
            PG8_BAR; PG8_WAIT_L(0); PG8_MMA(1, 0, At, B0); PG8_BAR; PG8_SCHED;
            PG8_STAGE(PG8_SB(1, 1), b3 + hstepB, voffB);
            PG8_WAIT_V(6); PG8_BAR; PG8_MMA(1, 1, At, B1); PG8_BAR;
        }
        E(acc, cur, wr, wc, fr, fq);
        if (!has_next) break;
#pragma unroll
        for (int a = 0; a < 2; ++a)
#pragma unroll
            for (int b = 0; b < 2; ++b)
#pragma unroll
                for (int m = 0; m < 4; ++m)
#pragma unroll
                    for (int n = 0; n < 2; ++n) acc[a][b][m][n] = (f32x4){0.f, 0.f, 0.f, 0.f};
        cur = nxt; cA = nA; cB = nB; ++ui;
    }
    PG8_WAIT_V(0);
    if (wr == 0) PG8_BAR;
    PG8_BAR;
#undef PG8_SA
#undef PG8_SB
#undef PG8_STAGE
#undef PG8_LDA
#undef PG8_LDB
#undef PG8_MMA
#undef PG8_WAIT_V
#undef PG8_WAIT_L
#undef PG8_BAR
#undef PG8_SCHED
}
}
using pg8::GUnit;

struct SchedPlain {
    const char* A; const char* B; int lda, ldb, nt, pm0, nM, nN, G, c;
    __device__ __forceinline__ bool next(int i, GUnit& u) const {
        const int L = i * G + c; if (L >= nM * nN) return false;
        int pm, pn; pg8::tile_map(L, nM, nN, pm, pn);
        u.pm = pm0 + pm; u.pn = pn; u.kind = 0; u.aux = 0; u.nt = nt;
        u.A = A + (size_t)u.pm * 256 * lda * 2; u.B = B + (size_t)pn * 256 * ldb * 2; return true;
    }
};
struct SchedMerge {
    const char* A; const char* B; int pm0, nM, G, c;
    __device__ __forceinline__ bool next(int i, GUnit& u) const {
        const int ti = i / 6, sub = i - ti * 6, L = ti * G + c; if (L >= nM * 4) return false;
        int pm, pn; pg8::tile_map(L, nM, 4, pm, pn);
        const int n = sub >> 1, br = sub & 1;
        u.pm = pm0 + pm; u.pn = pn; u.kind = sub; u.aux = n; u.nt = br ? 8 : 16;
        u.A = A + ((size_t)u.pm * 256 * AW + (br ? AY0 + n * 512 : AH)) * 2;
        u.B = B + ((size_t)(n * 1024 + pn * 256) * 1536 + (br ? 1024 : 0)) * 2; return true;
    }
};
struct SchedMoe {
    const char* A; const char* B; const int* panelE; int lda, ldb, nt, pm0, arow_pm0, nM, nN, G, c; size_t estride;
    __device__ __forceinline__ bool next(int i, GUnit& u) const {
        const int L = i * G + c; if (L >= nM * nN) return false;
        int pm, pn; pg8::tile_map(L, nM, nN, pm, pn);
        u.pm = pm0 + pm; u.pn = pn; u.kind = 0; u.aux = 0; u.nt = nt;
        const int e = panelE[u.pm];
        u.A = A + (size_t)(u.pm - arow_pm0) * 256 * lda * 2; u.B = B + (size_t)e * estride + (size_t)pn * 256 * ldb * 2; return true;
    }
};

#define EPI_ARGS const f32x4 (&acc)[2][2][4][2], const GUnit& u, int wr, int wc, int fr, int fq
struct EpiF16 {
    static constexpr bool PERM = true;
    h16* O; int ldc;
    __device__ __forceinline__ void operator()(EPI_ARGS) const {
        const int row0 = u.pm * 256 + wr * 64 + fr, col0 = u.pn * 256 + wc * 32 + 8 * fq;
#pragma unroll
        for (int ai = 0; ai < 2; ++ai)
#pragma unroll
            for (int m = 0; m < 4; ++m) { h16* rowp = O + (size_t)(row0 + ai * 128 + m * 16) * ldc + col0;
#pragma unroll
                for (int bj = 0; bj < 2; ++bj) { const f32x4 v0 = acc[ai][bj][m][0], v1 = acc[ai][bj][m][1];
                    u32x4 w; w.x = pg8::cvt_pk_f16(v0[0], v0[1]); w.y = pg8::cvt_pk_f16(v0[2], v0[3]); w.z = pg8::cvt_pk_f16(v1[0], v1[1]); w.w = pg8::cvt_pk_f16(v1[2], v1[3]);
                    *(u32x4*)(rowp + bj * 128) = w; } }
    }
};
struct EpiMerge {
    static constexpr bool PERM = true;
    const float* bmerge;
    char* priv;
    h16* S16;
    __device__ __forceinline__ void operator()(EPI_ARGS) const {
        unsigned off0 = (unsigned)threadIdx.x * 16u; asm volatile("" : "+v"(off0));
        u32x4* pg = (u32x4*)(priv + off0); f32x4* ps = (f32x4*)(priv + 131072 + off0);
        if ((u.kind & 1) == 0) {
            const float* bb = bmerge + u.aux * 1024 + u.pn * 256 + wc * 32 + 8 * fq;
#pragma unroll
            for (int bj = 0; bj < 2; ++bj) { const f32x4 b0 = *(const f32x4*)(bb + bj * 128), b1 = *(const f32x4*)(bb + bj * 128 + 4);
#pragma unroll
                for (int ai = 0; ai < 2; ++ai)
#pragma unroll
                    for (int m = 0; m < 4; ++m) { f32x4 v0 = acc[ai][bj][m][0] + b0, v1 = acc[ai][bj][m][1] + b1;
#pragma unroll
                        for (int j = 0; j < 4; ++j) { v0[j] = sigmoidf_(v0[j]); v1[j] = sigmoidf_(v1[j]); }
                        u32x4 w; w.x = pg8::cvt_pk_f16(v0[0], v0[1]); w.y = pg8::cvt_pk_f16(v0[2], v0[3]); w.z = pg8::cvt_pk_f16(v1[0], v1[1]); w.w = pg8::cvt_pk_f16(v1[2], v1[3]);
                        pg[((ai * 2 + bj) * 4 + m) * 512] = w; } }
        } else {
            const int row0 = u.pm * 256 + wr * 64 + fr, col0 = u.pn * 256 + wc * 32 + 8 * fq;
#pragma unroll
            for (int ai = 0; ai < 2; ++ai)
#pragma unroll
                for (int m = 0; m < 4; ++m)
#pragma unroll
                    for (int bj = 0; bj < 2; ++bj) { const int slot = (ai * 2 + bj) * 4 + m;
                        const u32x4 w = pg[slot * 512]; const h16x8 g = __builtin_bit_cast(h16x8, w);
                        f32x4 s0 = acc[ai][bj][m][0], s1 = acc[ai][bj][m][1];
#pragma unroll
                        for (int j = 0; j < 4; ++j) { s0[j] *= (float)g[j]; s1[j] *= (float)g[4 + j]; }
                        if (u.kind != 1) { s0 += ps[(slot * 2) * 512]; s1 += ps[(slot * 2 + 1) * 512]; }
                        if (u.kind != 5) { ps[(slot * 2) * 512] = s0; ps[(slot * 2 + 1) * 512] = s1; }
                        else { u32x4 o; o.x = pg8::cvt_pk_f16(s0[0], s0[1]); o.y = pg8::cvt_pk_f16(s0[2], s0[3]); o.z = pg8::cvt_pk_f16(s1[0], s1[1]); o.w = pg8::cvt_pk_f16(s1[2], s1[3]);
                            *(u32x4*)(S16 + (size_t)(row0 + ai * 128 + m * 16) * 1024 + col0 + bj * 128) = o; }
                        if (bj) asm volatile("" ::: "memory"); }
        }
    }
};
struct EpiResid {
    static constexpr bool PERM = false;
    float* X; const float* res_ctx; const float* res_lat;
    const float* modv;
    __device__ __forceinline__ void operator()(EPI_ARGS) const {
        const int row0 = u.pm * 256 + wr * 64 + fr, col0 = u.pn * 256 + wc * 32 + 4 * fq;
        const int g = u.pm < 8 ? 0 : 1 + ((u.pm - 8) >> 4);
        const float* res = u.pm < 8 ? res_ctx : res_lat - (size_t)MC * D;
        f32x4 mv[2][2];
#pragma unroll
        for (int bj = 0; bj < 2; ++bj)
#pragma unroll
            for (int n = 0; n < 2; ++n) mv[bj][n] = *(const f32x4*)(modv + (size_t)g * 6144 + col0 + bj * 128 + n * 16);
#pragma unroll
        for (int ai = 0; ai < 2; ++ai)
#pragma unroll
            for (int m = 0; m < 4; ++m) { const size_t off = (size_t)(row0 + ai * 128 + m * 16) * D + col0;
#pragma unroll
                for (int bj = 0; bj < 2; ++bj)
#pragma unroll
                    for (int n = 0; n < 2; ++n) { const f32x4 r = *(const f32x4*)(res + off + bj * 128 + n * 16);
                        *(f32x4*)(X + off + bj * 128 + n * 16) = ALPHA * r + mv[bj][n] * acc[ai][bj][m][n]; } }
    }
};
struct EpiSwiglu {
    static constexpr bool PERM = true;
    h16* O; int ldc; int orow0;
    __device__ __forceinline__ void operator()(EPI_ARGS) const {
        const int row0 = u.pm * 256 - orow0 + wr * 64 + fr, col0 = u.pn * 128 + wc * 32 + 8 * fq;
#pragma unroll
        for (int ai = 0; ai < 2; ++ai)
#pragma unroll
            for (int m = 0; m < 4; ++m) { float o[8];
#pragma unroll
                for (int n = 0; n < 2; ++n)
#pragma unroll
                    for (int j = 0; j < 4; ++j) o[n * 4 + j] = siluf_(acc[ai][0][m][n][j]) * acc[ai][1][m][n][j];
                u32x4 w; w.x = pg8::cvt_pk_f16(o[0], o[1]); w.y = pg8::cvt_pk_f16(o[2], o[3]); w.z = pg8::cvt_pk_f16(o[4], o[5]); w.w = pg8::cvt_pk_f16(o[6], o[7]);
                *(u32x4*)(O + (size_t)(row0 + ai * 128 + m * 16) * ldc + col0) = w; }
    }
};
struct EpiMoeDown {
    static constexpr bool PERM = true;
    h16* OUT2; const int* rowT; const float* rowP;
    __device__ __forceinline__ void operator()(EPI_ARGS) const {
        const int row0 = u.pm * 256 + wr * 64 + fr, col0 = u.pn * 256 + wc * 32 + 8 * fq;
#pragma unroll
        for (int ai = 0; ai < 2; ++ai)
#pragma unroll
            for (int m = 0; m < 4; ++m) { const int r = row0 + ai * 128 + m * 16; const int tk = rowT[r]; const float pp = rowP[r];
                if (tk < 0) continue;
                h16* rowp = OUT2 + ((size_t)(tk & 1) * ML + (tk >> 1)) * 1024 + col0;
#pragma unroll
                for (int bj = 0; bj < 2; ++bj) { const f32x4 v0 = acc[ai][bj][m][0] * pp, v1 = acc[ai][bj][m][1] * pp;
                    u32x4 w; w.x = pg8::cvt_pk_f16(v0[0], v0[1]); w.y = pg8::cvt_pk_f16(v0[2], v0[3]); w.z = pg8::cvt_pk_f16(v1[0], v1[1]); w.w = pg8::cvt_pk_f16(v1[2], v1[3]);
                    *(u32x4*)(rowp + bj * 128) = w; } }
    }
};

constexpr int LDS_BYTES = 147456;
constexpr size_t OFF_PRIV = OFF_BIG;
__device__ __forceinline__ void ph_gemm_in(const Params& p, LAS unsigned char* lds, int l, int G, int c) {
    SchedPlain S; S.A = (const char*)(WSP(h16, OFF_A) + AH); S.B = (const char*)WSP(h16, OFF_W16 + l * SZ_LAYERW); S.lda = AW; S.ldb = 1024; S.nt = 16; S.pm0 = 0; S.nM = MT / 256; S.nN = ZW / 256; S.G = G; S.c = c;
    EpiF16 E; E.O = WSP(h16, OFF_Z); E.ldc = ZW;
    pg8::gemm_phase(lds, AW, 1024, S, E);
}
__device__ __forceinline__ void ph_merge(const Params& p, LAS unsigned char* lds, int l, int G, int c) {
    SchedMerge S; S.A = (const char*)WSP(h16, OFF_A); S.B = (const char*)WSP(h16, OFF_W16 + l * SZ_LAYERW + SZ_WINT); S.pm0 = l == 0 ? 0 : 8; S.nM = MT / 256 - S.pm0; S.G = G; S.c = c;
    EpiMerge E; E.bmerge = p.b_merge + (size_t)l * 3 * 1024; E.priv = p.ws + OFF_PRIV + (size_t)c * 393216; E.S16 = (h16*)p.out;
    pg8::gemm_phase(lds, AW, 1536, S, E);
}
__device__ __forceinline__ void ph_wout(const Params& p, LAS unsigned char* lds, int l, int G, int c) {
    SchedPlain S; S.A = (const char*)p.out; S.B = (const char*)WSP(h16, OFF_W16 + l * SZ_LAYERW + SZ_WINT + SZ_BTALL); S.lda = 1024; S.ldb = 1024; S.nt = 16; S.pm0 = l == 0 ? 0 : 8; S.nM = MT / 256 - S.pm0; S.nN = 4; S.G = G; S.c = c;
    EpiResid E; E.X = WSP(float, OFF_X); E.res_ctx = l == 0 ? p.ctx : WSP(float, OFF_X); E.res_lat = l == 0 ? p.x : WSP(float, OFF_X) + (size_t)MC * D; E.modv = WSP(float, OFF_MOD) + (size_t)l * 9 * 6144 + 2 * 1024;
    pg8::gemm_phase(lds, 1024, 1024, S, E);
}
__device__ __forceinline__ void ph_ffn_gu(const Params& p, LAS unsigned char* lds, int G, int c) {
    SchedPlain S; S.A = (const char*)(WSP(h16, OFF_A) + AH); S.B = (const char*)WSP(h16, OFF_WGUT); S.lda = AW; S.ldb = 1024; S.nt = 16; S.pm0 = 0; S.nM = MT / 256; S.nN = 2 * DFF / 256; S.G = G; S.c = c;
    EpiSwiglu E; E.O = WSP(h16, OFF_ACT); E.ldc = DFF; E.orow0 = 0;
    pg8::gemm_phase(lds, AW, 1024, S, E);
}
__device__ __forceinline__ void ph_ffn_down(const Params& p, LAS unsigned char* lds, int G, int c) {
    SchedPlain S; S.A = (const char*)WSP(h16, OFF_ACT); S.B = (const char*)WSP(h16, OFF_WDT); S.lda = DFF; S.ldb = DFF; S.nt = DFF / 64; S.pm0 = 0; S.nM = MT / 256; S.nN = 4; S.G = G; S.c = c;
    EpiResid E; E.X = WSP(float, OFF_X); E.res_ctx = WSP(float, OFF_X); E.res_lat = WSP(float, OFF_X) + (size_t)MC * D; E.modv = WSP(float, OFF_MOD) + 5 * 1024;
    pg8::gemm_phase(lds, DFF, DFF, S, E);
}
__device__ __forceinline__ void ph_moe_gu(const Params& p, LAS unsigned char* lds, int panel0, int G, int c) {
    const int* plan = WSP(int, OFF_PLAN); const int np = plan[8]; int nM = np - panel0; nM = nM > 64 ? 64 : nM; if (nM <= 0) return;
    SchedMoe S; S.A = (const char*)WSP(h16, OFF_XG); S.B = (const char*)WSP(h16, OFF_WMOE_GU); S.panelE = plan + 16; S.lda = 1024; S.ldb = 1024; S.nt = 16; S.pm0 = panel0; S.arow_pm0 = 0; S.nM = nM; S.nN = 2 * DEX / 256; S.G = G; S.c = c; S.estride = (size_t)2 * DEX * 1024 * 2;
    EpiSwiglu E; E.O = (h16*)p.out; E.ldc = DEX; E.orow0 = panel0 * 256;
    pg8::gemm_phase(lds, 1024, 1024, S, E);
}
__device__ __forceinline__ void ph_moe_down(const Params& p, LAS unsigned char* lds, int panel0, int G, int c) {
    const int* plan = WSP(int, OFF_PLAN); const int np = plan[8]; int nM = np - panel0; nM = nM > 64 ? 64 : nM; if (nM <= 0) return;
    SchedMoe S; S.A = (const char*)p.out; S.B = (const char*)WSP(h16, OFF_WMOE_D); S.panelE = plan + 16; S.lda = DEX; S.ldb = DEX; S.nt = DEX / 64; S.pm0 = panel0; S.arow_pm0 = panel0; S.nM = nM; S.nN = 4; S.G = G; S.c = c; S.estride = (size_t)1024 * DEX * 2;
    EpiMoeDown E; E.OUT2 = WSP(h16, OFF_OUT2); E.rowT = WSP(int, OFF_ROWT); E.rowP = WSP(float, OFF_ROWP);
    pg8::gemm_phase(lds, DEX, DEX, S, E);
}

namespace attn_body {
using s16x4 = __attribute__((ext_vector_type(4))) short;
using s16x8 = __attribute__((ext_vector_type(8))) short;
using f32x16 = __attribute__((ext_vector_type(16))) float;
constexpr int D64 = 64, NW = 8, QBLK = 32, QB = QBLK * NW, KVBLK = 64;
constexpr int QP = 512, KP = 128, OP = AW;
__device__ __forceinline__ int crow(int r, int hi) { return (r & 3) + 8 * (r >> 2) + 4 * hi; }
#define SBAR() __builtin_amdgcn_sched_barrier(0)
constexpr int NSLOT = 3, SLOTB = 8192;
constexpr int LDS_K = 0, LDS_V = NSLOT * SLOTB, LDS_WS = 2 * NSLOT * SLOTB, LDS_OST = LDS_WS + NW * 64 * 4, ATTN_LDS_BYTES = LDS_OST + NW * 4096;
__device__ __forceinline__ void glds16(const void* gsrc, unsigned lds_dst) { unsigned keep;
    asm volatile("s_mov_b32 %0, m0\n\ts_mov_b32 m0, %2\n\ts_nop 0\n\tglobal_load_lds_dwordx4 %1, off\n\ts_mov_b32 m0, %0" : "=&s"(keep) : "v"(gsrc), "s"(lds_dst) : "memory"); }
__device__ __forceinline__ float max3f(float a, float b, float c) { float r; asm("v_max3_f32 %0, %1, %2, %3" : "=v"(r) : "v"(a), "v"(b), "v"(c)); return r; }
__device__ __forceinline__ float max2f(float a, float b) { float r; asm("v_max_f32_e32 %0, %1, %2" : "=v"(r) : "v"(a), "v"(b)); return r; }
__device__ __forceinline__ float fadd_s(float a, float b) { float r; asm("v_add_f32_e32 %0, %1, %2" : "=v"(r) : "v"(a), "v"(b)); return r; }
__device__ __forceinline__ float fsub_s(float a, float b) { float r; asm("v_sub_f32_e32 %0, %1, %2" : "=v"(r) : "v"(a), "v"(b)); return r; }
__device__ __forceinline__ unsigned cvtpk_s(float lo, float hi) { return pg8::cvt_pk_f16(lo, hi); }
#define WAIT_BAR(N) asm volatile("s_waitcnt vmcnt(" #N ") lgkmcnt(0)\n\ts_barrier" ::: "memory")
#define AMFMA(a, b, c) __builtin_amdgcn_mfma_f32_32x32x16_f16(__builtin_bit_cast(h16x8, a), __builtin_bit_cast(h16x8, b), c, 0, 0, 0)
__device__ __forceinline__ void qkt(f32x16& p0, f32x16& p1, const char* Kslot, const s16x8* qr, const f32x16& negm, int r32, int hi) {
    const char* kb = Kslot + hi * 1024 + r32 * 16;
#pragma unroll
    for (int d0 = 0; d0 < 4; ++d0) {
        const s16x8 b0 = *reinterpret_cast<const s16x8*>(kb + d0 * 2048);
        const s16x8 b1 = *reinterpret_cast<const s16x8*>(kb + d0 * 2048 + 512);
        if (d0 == 0) { p0 = AMFMA(b0, qr[0], negm); p1 = AMFMA(b1, qr[0], negm); }
        else { p0 = AMFMA(b0, qr[d0], p0); p1 = AMFMA(b1, qr[d0], p1); } }
}
typedef __attribute__((address_space(3))) const char* lds_cptr;
typedef short v4i16_t __attribute__((ext_vector_type(4)));
__device__ __forceinline__ void kload8(s16x8* kf, lds_cptr kp) {
    kf[0] = *(const __attribute__((address_space(3))) s16x8*)(kp);        kf[1] = *(const __attribute__((address_space(3))) s16x8*)(kp + 512);
    kf[2] = *(const __attribute__((address_space(3))) s16x8*)(kp + 2048); kf[3] = *(const __attribute__((address_space(3))) s16x8*)(kp + 2560);
    kf[4] = *(const __attribute__((address_space(3))) s16x8*)(kp + 4096); kf[5] = *(const __attribute__((address_space(3))) s16x8*)(kp + 4608);
    kf[6] = *(const __attribute__((address_space(3))) s16x8*)(kp + 6144); kf[7] = *(const __attribute__((address_space(3))) s16x8*)(kp + 6656);
}
__device__ __forceinline__ void kload2(s16x8* kf, lds_cptr kp, int j) { kf[2 * j] = *(const __attribute__((address_space(3))) s16x8*)(kp + j * 2048); kf[2 * j + 1] = *(const __attribute__((address_space(3))) s16x8*)(kp + j * 2048 + 512); }
__device__ __forceinline__ s16x4 vtr(lds_cptr p) { return __builtin_bit_cast(s16x4, __builtin_amdgcn_ds_read_tr16_b64_v4i16((__attribute__((address_space(3))) v4i16_t*)p)); }
__device__ __forceinline__ float rowmax(const f32x16& p0, const f32x16& p1) {
    float a = max3f(p0[0], p0[1], p1[0]), b = max3f(p0[2], p0[3], p1[1]); a = max3f(a, p1[2], p1[3]);
#pragma unroll
    for (int r = 4; r < 16; r += 4) { a = max3f(a, p0[r], p0[r + 1]); b = max3f(b, p0[r + 2], p0[r + 3]); a = max3f(a, p1[r], p1[r + 1]); b = max3f(b, p1[r + 2], p1[r + 3]); }
    const float m = max2f(a, b);
    auto rr = __builtin_amdgcn_permlane32_swap(__float_as_uint(m), __float_as_uint(m), false, false);
    return max2f(__uint_as_float(rr[0]), __uint_as_float(rr[1]));
}
__device__ __forceinline__ void pv(f32x16* o, int vb, s16x8 pa0, s16x8 pa1, s16x8 pa2, s16x8 pa3) {
#pragma unroll
    for (int d0 = 0; d0 < 2; ++d0) { s16x4 lo[4], hi[4];
#pragma unroll
        for (int ks = 0; ks < 4; ++ks) {
            asm volatile("ds_read_b64_tr_b16 %0,%1 offset:%c2" : "=&v"(lo[ks]) : "v"(vb), "i"(d0 * 4096 + ks * 1024) : "memory");
            asm volatile("ds_read_b64_tr_b16 %0,%1 offset:%c2" : "=&v"(hi[ks]) : "v"(vb), "i"(d0 * 4096 + ks * 1024 + 512) : "memory"); }
        asm volatile("s_waitcnt lgkmcnt(0)" ::: "memory"); SBAR();
#define PK(k) (s16x8){lo[k][0], lo[k][1], lo[k][2], lo[k][3], hi[k][0], hi[k][1], hi[k][2], hi[k][3]}
        o[d0] = AMFMA(pa0, PK(0), o[d0]);
        o[d0] = AMFMA(pa1, PK(1), o[d0]);
        o[d0] = AMFMA(pa2, PK(2), o[d0]);
        o[d0] = AMFMA(pa3, PK(3), o[d0]);
#undef PK
    }
}
template <int THRL> __device__ __forceinline__ void attn_unit(const h16* Qu, const h16* __restrict__ Ku, const h16* __restrict__ Vu, h16* Ou, const int NT, char* shm) {
    const int tid = threadIdx.x, lane = tid & 63, r32 = lane & 31, hi = lane >> 5; const int wid = __builtin_amdgcn_readfirstlane(tid >> 6);
    const h16* Qw = Qu + (size_t)(wid * QBLK) * QP;
    const unsigned lds0 = (unsigned)(uintptr_t)shm;
    float* wsf = (float*)(shm + LDS_WS) + wid * 64;
    const h16* ksrc = Ku + (long)lane * KP + wid * 8;
    const h16* vsrc = Vu + (long)(16 * (wid & 3) + (lane >> 2)) * KP + (wid >> 2) * 32 + (lane & 3) * 8;
    const unsigned kdst = lds0 + LDS_K + wid * 1024, vdst = lds0 + LDS_V + wid * 1024;
#define DMA_K(t, slot) glds16(ksrc + (long)(t) * KVBLK * KP, (unsigned)__builtin_amdgcn_readfirstlane(kdst + (slot)))
#define DMA_V(t, slot) glds16(vsrc + (long)(t) * KVBLK * KP, (unsigned)__builtin_amdgcn_readfirstlane(vdst + (slot)))
    const int vb0 = (int)(lds0 + LDS_V) + ((lane >> 4) & 1) * 32 + (lane & 3) * 8 + (4 * hi + ((lane & 15) >> 2)) * 64;
    const char* Kbase = shm + LDS_K; s16x8 kf[8];
    const lds_cptr shm3 = (lds_cptr)shm; const lds_cptr kp0 = shm3 + LDS_K + hi * 1024 + r32 * 16; const lds_cptr vp0 = shm3 + LDS_V + ((lane >> 4) & 1) * 32 + (lane & 3) * 8 + (4 * hi + ((lane & 15) >> 2)) * 64;
    DMA_K(0, 0); DMA_V(0, 0); DMA_K(1, SLOTB);
    s16x8 qr[4];
#pragma unroll
    for (int d0 = 0; d0 < 4; ++d0) qr[d0] = *reinterpret_cast<const s16x8*>(&Qw[(long)r32 * QP + d0 * 16 + hi * 8]);
    float mhat = 0.f, l_reg = 0.f; f32x16 o[2]; o[0] = f32x16{}; o[1] = f32x16{}; f32x16 negm = f32x16{}; asm volatile("" : "+v"(negm));
    bool resc = false;
#define START(P0, P1) do { const float rm = rowmax(P0, P1); resc = false; \
    { const float dl = rm; mhat = fadd_s(mhat, dl); \
      _Pragma("unroll") for (int r = 0; r < 16; ++r) { P0[r] = fsub_s(P0[r], dl); P1[r] = fsub_s(P1[r], dl); } \
      _Pragma("unroll") for (int r = 0; r < 16; ++r) negm[r] = -mhat; asm volatile("" : "+v"(negm)); } \
    _Pragma("unroll") for (int r = 0; r < 16; ++r) P0[r] = __builtin_amdgcn_exp2f(P0[r]); } while (0)
#define RESC() do { if (resc) { asm volatile("s_waitcnt lgkmcnt(0)" ::: "memory"); \
      _Pragma("unroll") for (int d_ = 0; d_ < 2; ++d_) _Pragma("unroll") for (int r = 0; r < 16; ++r) o[d_][r] *= wsf[crow(r, hi)]; } } while (0)
    f32x16 pA0, pA1, pB0, pB1;
    int sl_prev = 0, sl_cur = 0, sl_next = SLOTB;
#define ROT() do { sl_prev = sl_cur; sl_cur = sl_next; sl_next = (sl_next == (NSLOT - 1) * SLOTB) ? 0 : sl_next + SLOTB; } while (0)
    DMA_K(2, 2 * SLOTB);
    WAIT_BAR(3);
    qkt(pA0, pA1, Kbase, qr, negm, r32, hi); asm volatile("s_nop 15\n\ts_nop 7" : "+v"(pA0), "+v"(pA1));
    START(pA0, pA1);
    _Pragma("unroll") for (int r = 0; r < 16; ++r) pA1[r] = __builtin_amdgcn_exp2f(pA1[r]);
    WAIT_BAR(0);
    DMA_K(3, 0); DMA_V(1, SLOTB);
    ROT();
    kload8(kf, kp0 + sl_cur);
    WAIT_BAR(2);
    s16x4 vlo[8], vhi[8]; u32x4 pw0, pw1, pw2, pw3;
#define PKW(P, B) cvtpk_s(P[B], P[B + 1])
#define PAF(k) __builtin_bit_cast(s16x8, pw##k)
#define VFR(i) (s16x8){vlo[i][0], vlo[i][1], vlo[i][2], vlo[i][3], vhi[i][0], vhi[i][1], vhi[i][2], vhi[i][3]}
#define PIN(x) asm volatile("" : "+v"(x))
#define MX3(a, b, c) __builtin_fmaxf(__builtin_fmaxf((a), (b)), (c))
#define GAPA(MF, A0, A1, A2, A3, W0, W1, PW) do { MF; sacc += A0; sacc += A1; sacc += A2; sacc += A3; PIN(sacc); W0; W1; PIN(PW); SBAR(); } while (0)
#define EX(v) __builtin_amdgcn_exp2f(v)
#define GAPB(MF, X, B) do { MF; X[B] = EX(X[B]); X[B + 1] = EX(X[B + 1]); X[B + 2] = EX(X[B + 2]); X[B + 3] = EX(X[B + 3]); PIN(X); SBAR(); } while (0)
#define VRD(i) do { vlo[i] = vtr(vp_ + (((i) >> 2) * 4096 + ((i) & 3) * 1024)); vhi[i] = vtr(vp_ + (((i) >> 2) * 4096 + ((i) & 3) * 1024 + 512)); } while (0)
#define KRD(G, j) do { if (G) { kload2(kf, kp0 + sl_next, j); SBAR(); } } while (0)
#define STEP(C0, C1, P0, P1, t, GK, GV, GL) do { SBAR(); \
    const lds_cptr vp_ = vp0 + sl_prev; \
    VRD(0); SBAR(); float sacc = (P0[0] + P0[1]); \
    GAPA(C0 = AMFMA(kf[0], qr[0], negm), P0[2], P0[3], P0[4], P0[5],     pw0[0] = PKW(P0, 0), pw0[1] = PKW(P0, 2), pw0); \
    VRD(4); SBAR(); GAPA(C1 = AMFMA(kf[1], qr[0], negm), P0[6], P0[7], P0[8], P0[9],     pw0[2] = PKW(P0, 4), pw0[3] = PKW(P0, 6), pw0); \
    VRD(1); SBAR(); GAPA(C0 = AMFMA(kf[2], qr[1], C0),   P0[10], P0[11], P0[12], P0[13], pw1[0] = PKW(P0, 8), pw1[1] = PKW(P0, 10), pw1); \
    VRD(5); SBAR(); GAPA(C1 = AMFMA(kf[3], qr[1], C1),   P0[14], P0[15], P1[0], P1[1],   pw1[2] = PKW(P0, 12), pw1[3] = PKW(P0, 14), pw1); \
    VRD(2); SBAR(); GAPA(C0 = AMFMA(kf[4], qr[2], C0),   P1[2], P1[3], P1[4], P1[5],     pw2[0] = PKW(P1, 0), pw2[1] = PKW(P1, 2), pw2); \
    VRD(6); SBAR(); GAPA(C1 = AMFMA(kf[5], qr[2], C1),   P1[6], P1[7], P1[8], P1[9],     pw2[2] = PKW(P1, 4), pw2[3] = PKW(P1, 6), pw2); \
    VRD(3); SBAR(); GAPA(C0 = AMFMA(kf[6], qr[3], C0),   P1[10], P1[11], P1[12], P1[13], pw3[0] = PKW(P1, 8), pw3[1] = PKW(P1, 10), pw3); \
    VRD(7); SBAR(); GAPA(C1 = AMFMA(kf[7], qr[3], C1),   P1[14], P1[15], 0.f, 0.f,       pw3[2] = PKW(P1, 12), pw3[3] = PKW(P1, 14), pw3); \
    l_reg += sacc; \
    if (GK) { DMA_K((t) + 3, sl_cur); } if (GV) { DMA_V((t) + 1, sl_next); } \
    { float a = MX3(C0[0], C0[1], C1[0]), b = MX3(C0[2], C0[3], C1[1]); a = MX3(a, C1[2], C1[3]); \
      _Pragma("unroll") for (int r = 4; r < 16; r += 4) { a = MX3(a, C0[r], C0[r + 1]); b = MX3(b, C0[r + 2], C0[r + 3]); a = MX3(a, C1[r], C1[r + 1]); b = MX3(b, C1[r + 2], C1[r + 3]); } \
      float rm = __builtin_fmaxf(a, b); { auto rr = __builtin_amdgcn_permlane32_swap(__float_as_uint(rm), __float_as_uint(rm), false, false); rm = __builtin_fmaxf(__uint_as_float(rr[0]), __uint_as_float(rr[1])); } \
      resc = false; \
      if (__builtin_expect(__any(rm > (float)THRL), 0)) { const float dl = __builtin_fmaxf(rm, 0.f); mhat += dl; \
        _Pragma("unroll") for (int r = 0; r < 16; ++r) { C0[r] -= dl; C1[r] -= dl; } \
        _Pragma("unroll") for (int r = 0; r < 16; ++r) negm[r] = -mhat; asm volatile("" : "+v"(negm)); \
        const float f = __builtin_amdgcn_exp2f(-dl); l_reg *= f; if (hi == 0) wsf[r32] = f; resc = true; } } \
    SBAR(); \
    GAPB(o[0] = AMFMA(PAF(0), VFR(0), o[0]), C0, 0); \
    GAPB(o[1] = AMFMA(PAF(0), VFR(4), o[1]), C0, 4); \
    KRD(GL, 0); GAPB(o[0] = AMFMA(PAF(1), VFR(1), o[0]), C0, 8); \
    KRD(GL, 1); GAPB(o[1] = AMFMA(PAF(1), VFR(5), o[1]), C0, 12); \
    KRD(GL, 2); GAPB(o[0] = AMFMA(PAF(2), VFR(2), o[0]), C1, 0); \
    KRD(GL, 3); GAPB(o[1] = AMFMA(PAF(2), VFR(6), o[1]), C1, 4); \
    GAPB(o[0] = AMFMA(PAF(3), VFR(3), o[0]), C1, 8); \
    GAPB(o[1] = AMFMA(PAF(3), VFR(7), o[1]), C1, 12); \
    } while (0)
    int t = 1;
    for (; t + 5 < NT; t += 2) {
        STEP(pB0, pB1, pA0, pA1, t, true, true, true);     WAIT_BAR(2); RESC(); ROT();
        STEP(pA0, pA1, pB0, pB1, t + 1, true, true, true); WAIT_BAR(2); RESC(); ROT();
    }
#define ENDW(tt) do { if ((tt) + 3 < NT) { WAIT_BAR(2); } else if ((tt) + 2 < NT) { WAIT_BAR(1); } else { WAIT_BAR(0); } } while (0)
    for (; t + 1 < NT; t += 2) {
        STEP(pB0, pB1, pA0, pA1, t, (t + 3 < NT), (t + 1 < NT), (t + 1 < NT));         ENDW(t);     RESC(); ROT();
        STEP(pA0, pA1, pB0, pB1, t + 1, (t + 4 < NT), (t + 2 < NT), (t + 2 < NT));     ENDW(t + 1); RESC(); ROT();
    }
    STEP(pB0, pB1, pA0, pA1, NT - 1, false, false, false); RESC();
    { float sacc = pB0[0] + pB0[1]; _Pragma("unroll") for (int r = 2; r < 16; ++r) sacc += pB0[r]; _Pragma("unroll") for (int r = 0; r < 16; ++r) sacc += pB1[r]; l_reg += sacc;
      pw0 = (u32x4){PKW(pB0, 0), PKW(pB0, 2), PKW(pB0, 4), PKW(pB0, 6)}; pw1 = (u32x4){PKW(pB0, 8), PKW(pB0, 10), PKW(pB0, 12), PKW(pB0, 14)}; pw2 = (u32x4){PKW(pB1, 0), PKW(pB1, 2), PKW(pB1, 4), PKW(pB1, 6)}; pw3 = (u32x4){PKW(pB1, 8), PKW(pB1, 10), PKW(pB1, 12), PKW(pB1, 14)};
      SBAR(); pv(o, vb0 + sl_cur, PAF(0), PAF(1), PAF(2), PAF(3)); }
#undef PKW
#undef PAF
#undef VFR
#undef PIN
#undef MX3
#undef GAPA
#undef GAPB
#undef EX
#undef VRD
#undef KRD
#undef STEP
#undef ENDW
    { auto rr = __builtin_amdgcn_permlane32_swap(__float_as_uint(l_reg), __float_as_uint(l_reg), false, false); l_reg = __uint_as_float(rr[0]) + __uint_as_float(rr[1]); }
    if (hi == 0) wsf[32 + r32] = l_reg; asm volatile("s_waitcnt lgkmcnt(0)" ::: "memory");
    float rli[16];
#pragma unroll
    for (int r = 0; r < 16; ++r) rli[r] = __builtin_amdgcn_rcpf(wsf[32 + crow(r, hi)]);
    h16* Ow = Ou + (size_t)(wid * QBLK) * OP;
    { h16* stg = (h16*)(shm + LDS_OST) + wid * 2048;
#pragma unroll
      for (int r = 0; r < 16; ++r) { const int orow = crow(r, hi);
#pragma unroll
        for (int d0 = 0; d0 < 2; ++d0) stg[orow * 64 + d0 * 32 + r32] = (h16)(o[d0][r] * rli[r]); }
      asm volatile("s_waitcnt lgkmcnt(0)" ::: "memory");
#pragma unroll
      for (int i = 0; i < 4; ++i) { const int row = i * 8 + (lane >> 3), ch = lane & 7; const u32x4 v = *(const u32x4*)(stg + row * 64 + ch * 8); *(u32x4*)(Ow + (long)row * OP + ch * 8) = v; } }
    asm volatile("s_waitcnt lgkmcnt(0)\n\ts_barrier" ::: "memory");
#undef DMA_K
#undef DMA_V
#undef START
#undef RESC
#undef ROT
}
#undef SBAR
#undef WAIT_BAR
#undef AMFMA
}

__device__ __forceinline__ void ph_attn(const Params& p, char* shm, int l, int G, int c) {
    const h16* Qh = WSP(h16, OFF_QH); const h16* Kh = WSP(h16, OFF_KH); const h16* Vh = WSP(h16, OFF_VH); h16* A = WSP(h16, OFF_A);
    const int x = c & 7, j0 = c >> 3, nx = (G + 7 - x) >> 3;
    for (int j = j0; j < 128; j += nx) {
        const int set = 2 * x + (j >> 6), un = j & 63, b = set >> 1, kvh = set & 1, hq = kvh * 4 + (un >> 4), qb = un & 15;
        const size_t qrow = (size_t)MC + (size_t)b * SEQ + (size_t)qb * 256;
        attn_body::attn_unit<8>(Qh + qrow * 512 + hq * 64, Kh + (size_t)b * SB * 128 + kvh * 64, Vh + (size_t)b * SB * 128 + kvh * 64, A + qrow * AW + AY1 + hq * 64, SB / 64, shm);
    }
    if (l == 0) for (int u = c; u < 64; u += G) {
        const int b = u >> 3, hq = u & 7, kvh = hq >> 2; const size_t qrow = (size_t)b * CTX;
        attn_body::attn_unit<8>(Qh + qrow * 512 + hq * 64, Kh + (size_t)b * SB * 128 + kvh * 64, Vh + (size_t)b * SB * 128 + kvh * 64, A + qrow * AW + AY1 + hq * 64, CTX / 64, shm);
    }
}
template <int PH> __global__ void __launch_bounds__(512, 2) k_fast(Params p, int l, int a0) {
    extern __shared__ __attribute__((aligned(16))) unsigned char shm[];
    LAS unsigned char* lds = (LAS unsigned char*)shm;
    const int G = gridDim.x, c = blockIdx.x;
    if constexpr (PH == 0) ph_gemm_in(p, lds, l, G, c);
    if constexpr (PH == 1) ph_merge(p, lds, l, G, c);
    if constexpr (PH == 2) ph_wout(p, lds, l, G, c);
    if constexpr (PH == 3) ph_ffn_gu(p, lds, G, c);
    if constexpr (PH == 4) ph_ffn_down(p, lds, G, c);
    if constexpr (PH == 5) ph_moe_gu(p, lds, a0, G, c);
    if constexpr (PH == 6) ph_moe_down(p, lds, a0, G, c);
    if constexpr (PH == 7) ph_attn(p, (char*)shm, l, G, c);
}

#define XB_TMO      128
#define XB_XCNT(j)  (256  + 64 * (j))
#define XB_XSUB(j)  (1280 + 64 * (j))
#define XB_XGEN(j)  (2304 + 64 * (j))
#define XB_TOP      3328
#define XB_TOPGEN   3392
#define XCD_BAR_WORDS 3456
#define XB_SPIN_CAP (1u << 18)
__device__ __forceinline__ unsigned xb_ld(unsigned* p)              { return __hip_atomic_load(p, __ATOMIC_RELAXED, __HIP_MEMORY_SCOPE_AGENT); }
__device__ __forceinline__ unsigned xb_add(unsigned* p, unsigned v) { return __hip_atomic_fetch_add(p, v, __ATOMIC_RELAXED, __HIP_MEMORY_SCOPE_AGENT); }
__device__ __forceinline__ unsigned xb_xcc_id() { return (unsigned)__builtin_amdgcn_s_getreg((3 << 11) | 20) & 0xFu; }
#define XB_SPIN(cond, bar) do { unsigned _sp = 0; while (cond) { __builtin_amdgcn_s_sleep(1); \
    if ((++_sp & 255u) == 0u) { if (xb_ld(&(bar)[XB_TMO])) break; if (_sp > XB_SPIN_CAP) { atomicAdd(&(bar)[XB_TMO], 1u); break; } } } } while (0)
struct XcdBarrier { unsigned* bar; unsigned x; volatile LAS unsigned* st; };
__device__ __forceinline__ XcdBarrier xcd_barrier_post(unsigned* bar, volatile LAS unsigned* st) {
    XcdBarrier b; b.bar = bar; b.x = xb_xcc_id(); b.st = st;
    if (threadIdx.x == 0) (void)xb_add(&bar[XB_XCNT(b.x)], 1u);
    return b;
}
__device__ __forceinline__ void xcd_barrier_complete(unsigned* bar, unsigned x, unsigned& nloc, unsigned& nx) {
    const unsigned G = gridDim.x * gridDim.y * gridDim.z;
    unsigned sum, cnt, mine, sp = 0u;
    for (;;) {
        sum = 0u; cnt = 0u; mine = 0u;
#pragma unroll
        for (unsigned j = 0; j < 16; ++j) { const unsigned c = xb_ld(&bar[XB_XCNT(j)]); sum += c; cnt += (c > 0u) ? 1u : 0u; mine = (j == x) ? c : mine; }
        if (sum == G) break;
        __builtin_amdgcn_s_sleep(1);
        if ((++sp & 255u) == 0u) { if (xb_ld(&bar[XB_TMO])) break; if (sp > XB_SPIN_CAP) { atomicAdd(&bar[XB_TMO], 1u); break; } }
    }
    nloc = mine > 0u ? mine : 1u; nx = cnt > 0u ? cnt : 1u;
}
__device__ __forceinline__ void xcd_barrier(const XcdBarrier& b) {
    asm volatile("s_waitcnt vmcnt(0)" ::: "memory");
    __syncthreads();
    if (threadIdx.x == 0) {
        unsigned* bar = b.bar;
        __builtin_amdgcn_s_waitcnt(0);
        unsigned nloc = b.st[0], nx = b.st[1];
        if (nloc == 0u) { xcd_barrier_complete(bar, b.x, nloc, nx); b.st[0] = nloc; b.st[1] = nx; }
        const unsigned old = xb_add(&bar[XB_XSUB(b.x)], 1u);
        const unsigned gen = old / nloc;
        if (old + 1u == (gen + 1u) * nloc) {
            __builtin_amdgcn_fence(__ATOMIC_RELEASE, "agent");
            asm volatile("s_waitcnt vmcnt(0)" ::: "memory");
            const unsigned og = xb_add(&bar[XB_TOP], 1u);
            const unsigned tg = og / nx;
            if (og + 1u == (tg + 1u) * nx) xb_add(&bar[XB_TOPGEN], 1u);
            else XB_SPIN(xb_ld(&bar[XB_TOPGEN]) == tg, bar);
            __builtin_amdgcn_fence(__ATOMIC_ACQUIRE, "agent");
            xb_add(&bar[XB_XGEN(b.x)], 1u);
            asm volatile("s_waitcnt vmcnt(0)" ::: "memory");
        } else {
            XB_SPIN(xb_ld(&bar[XB_XGEN(b.x)]) == gen, bar);
            __builtin_amdgcn_fence(__ATOMIC_ACQUIRE, "agent");
            asm volatile("s_waitcnt vmcnt(0)" ::: "memory");
        }
    }
    __syncthreads();
}

constexpr int NTH = 512;
template <int NT> __device__ __forceinline__ void poolfold_unit(const Params& p, int u, float (*Ws)[129]) {
    const int l = u / 64, g = (u / 16) % 4, k0 = (u % 16) * 64, tid = threadIdx.x;
    __syncthreads();
    for (int i = tid; i < 64 * 128; i += NT) Ws[i >> 7][i & 127] = p.w_in[(size_t)l * 1024 * WIN + (size_t)(k0 + (i >> 7)) * WIN + g * 128 + (i & 127)];
    __syncthreads();
    const float* pw = p.pool_w + (size_t)(l * 4 + g) * 128 * 128;
    h16* wint = WSP(h16, OFF_W16 + l * SZ_LAYERW);
    const int jj = tid & 127;
    const float sc = p.pool_scale[l * 512 + g * 128 + jj];
    for (int kk = tid >> 7; kk < 64; kk += NT / 128) {
        float acc = 0.f;
        for (int c2 = 0; c2 < 128; ++c2) acc += Ws[kk][c2] * pw[c2 * 128 + jj];
        wint[(size_t)(g * 128 + jj) * 1024 + k0 + kk] = (h16)(acc * sc);
    }
}
__device__ __forceinline__ void cvt_jobs(const Params& p, int j0, int j1, int ubase, int G, int c, float (*tile)[65]) {
    int base = ubase;
    for (int j = j0; j < j1; ++j) {
        const CvtJob q = get_job(p, j); const int nt = job_tiles(q);
        const int first = ((c - base % G) + G) % G;
        for (int t = first; t < nt; t += G) cvt_tile<NTH>(q, t, tile);
        base += nt;
    }
}
__device__ __forceinline__ void lru_wt_prep(const Params& p, int G, int c);
__device__ __forceinline__ void ph_prologue(const Params& p, char* shm, int G, int c) {
    if (c == 0 && threadIdx.x < 8) WSP(int, OFF_CNT)[threadIdx.x] = 0;
    for (int u = c; u < 192; u += G) mod_unit<NTH>(p, u, (float*)shm, (float*)shm + 9 * 1024);
    for (int u = c; u < 128; u += G) poolfold_unit<NTH>(p, (u + 64) % 128, (float (*)[129])shm);
    cvt_jobs(p, 0, NJOBS_SMALL, 320, G, c, (float (*)[65])shm);
    lru_wt_prep(p, G, (c + 128) % G);
}
__device__ __forceinline__ void ph_h0(const Params& p, int G, int c) {
    const float* mod = WSP(float, OFF_MOD); h16* A = WSP(h16, OFF_A); const int tid = threadIdx.x;
    for (int r = c * 2 + (tid >> 8); r < MT; r += G * 2) {
        const int g = row_group(r), d = (tid & 255) * 4; const float* xr = xin_row(p, r);
        const float4 xv = *(const float4*)(xr + d); const float4 m0 = *(const float4*)(mod + (size_t)g * 6144 + d); const float4 m1 = *(const float4*)(mod + (size_t)g * 6144 + 1024 + d);
        h16x4 o; o[0] = (h16)(xv.x * (1.f + m1.x) + m0.x); o[1] = (h16)(xv.y * (1.f + m1.y) + m0.y); o[2] = (h16)(xv.z * (1.f + m1.z) + m0.z); o[3] = (h16)(xv.w * (1.f + m1.w) + m0.w);
        *(h16x4*)(A + (size_t)r * AW + AH + d) = o;
    }
}
__device__ __forceinline__ void ph_qkv(const Params& p, int l, int G, int c) {
    const h16* Z = WSP(h16, OFF_Z); h16* Qh = WSP(h16, OFF_QH); h16* Kh = WSP(h16, OFF_KH); h16* Vh = WSP(h16, OFF_VH);
    const int lane = threadIdx.x & 63, wv = threadIdx.x >> 6;
    const int nitems = MT * 12;
    for (int it = c * 8 + wv; it < nitems; it += G * 8) {
        const int r = it / 12, s = it % 12; int s0, len, pos; row_seq(r, s0, len, pos);
        const bool lat = r >= MC; const int b = lat ? (r - MC) >> 12 : r >> 8; const size_t krow = (size_t)b * SB + (lat ? CTX + pos : pos);
        if (s >= 10) { Vh[krow * 128 + (s - 10) * 64 + lane] = Z[(size_t)r * ZW + ZV + (s - 10) * 64 + lane]; continue; }
        const int zc = s < 8 ? ZQ + s * 64 : ZK + (s - 8) * 64;
        const float z = (float)Z[(size_t)r * ZW + zc + lane];
        float ss = z * z;
#pragma unroll
        for (int o = 32; o >= 1; o >>= 1) ss += __shfl_xor(ss, o);
        const float g = s < 8 ? p.q_norm[l * 64 + lane] : p.k_norm[l * 64 + lane];
        float y = z * rsqrtf(ss * (1.0f / 64.0f) + 1e-6f) * g;
        const float yp = __shfl_xor(y, 16);
        if (lat) {
            const float posf = (lane < 32) ? (float)(pos >> 6) : (float)(pos & 63);
            const float inv = exp2f(-(float)(lane & 15) * (13.287712379549449f / 16.0f));
            float sn, cs; sincosf(posf * inv, &sn, &cs);
            y = (lane & 16) ? (y * cs + yp * sn) : (y * cs - yp * sn);
        }
        if (s < 8) Qh[(size_t)r * 512 + s * 64 + lane] = (h16)(y * QSCALE);
        else Kh[krow * 128 + (s - 8) * 64 + lane] = (h16)y;
    }
}
__device__ __forceinline__ void ph_pool(const Params& p, int r_begin, int G, int c) {
    const h16* Z = WSP(h16, OFF_Z); h16* A = WSP(h16, OFF_A); const int j = threadIdx.x;
    for (int r = r_begin + c; r < MT; r += G) {
        int s0, len, pos; row_seq(r, s0, len, pos);
        const int w = 2 << (j >> 7), lo = pos - (w >> 1); const int a = lo < 0 ? 0 : lo, e = (lo + w) > len ? len : (lo + w);
        float s = 0.f; for (int t = a; t < e; ++t) s += (float)Z[(size_t)(s0 + t) * ZW + ZP + j];
        A[(size_t)r * AW + AY0 + j] = (h16)(s / (float)(e - a) - (float)Z[(size_t)r * ZW + ZP + j]);
    }
}
__device__ __forceinline__ void ph_lru_naive(const Params& p, char* shm, int l, int c) {
    if (c >= 64 || threadIdx.x >= 64) return;
    volatile float* xs = (volatile float*)shm;
    const int b = c >> 3, blk = c & 7, j = threadIdx.x, ch = blk * 64 + j;
    const h16* Z = WSP(h16, OFF_Z); h16* A = WSP(h16, OFF_A); float* HF = p.out;
    for (int dir = 0; dir < 2; ++dir) {
        float wa[64], wx[64];
        const float* pwa = p.lru_wa + ((size_t)(l * 2 + dir) * 8 + blk) * 4096; const float* pwx = p.lru_wx + ((size_t)(l * 2 + dir) * 8 + blk) * 4096;
#pragma unroll
        for (int i = 0; i < 64; ++i) { wa[i] = pwa[i * 64 + j]; wx[i] = pwx[i * 64 + j]; }
        const float ba = p.lru_ba[(l * 2 + dir) * 512 + ch], bx = p.lru_bx[(l * 2 + dir) * 512 + ch], lam = p.lru_lambda[(l * 2 + dir) * 512 + ch];
        const float sp = log1pf(expf(-lam));
        float cw[4]; for (int k = 0; k < 4; ++k) cw[k] = p.conv_w[(l * 4 + k) * 512 + ch];
        const float cb = p.conv_b[l * 512 + ch];
        float h = 0.f;
        for (int idx = 0; idx < SB; ++idx) {
            int s0, len, pos;
            if (idx < CTX) { s0 = b * CTX; len = CTX; pos = dir ? CTX - 1 - idx : idx; } else { s0 = MC + b * SEQ; len = SEQ; pos = dir ? SEQ - 1 - (idx - CTX) : idx - CTX; }
            float xc = cb;
#pragma unroll
            for (int k = 0; k < 4; ++k) { const int t = pos + k - 2; if (t >= 0 && t < len) xc += cw[k] * (float)Z[(size_t)(s0 + t) * ZW + ZLX + ch]; }
            __builtin_amdgcn_wave_barrier(); xs[j] = xc; asm volatile("s_waitcnt lgkmcnt(0)" ::: "memory"); __builtin_amdgcn_wave_barrier();
            float ra = ba, ri = bx;
#pragma unroll
            for (int i = 0; i < 64; ++i) { const float xv = xs[i]; ra += xv * wa[i]; ri += xv * wx[i]; }
            const float rg = sigmoidf_(ra), ig = sigmoidf_(ri), la = -8.0f * rg * sp, a = expf(la), u = sqrtf(-expm1f(2.0f * la)) * ig * xc;
            h = a * h + u;
            const int r = s0 + pos;
            if (dir == 0) HF[(size_t)r * 512 + ch] = h;
            else { const float tot = HF[(size_t)r * 512 + ch] + h; A[(size_t)r * AW + AY2 + ch] = (h16)(tot * gelu_tanh((float)Z[(size_t)r * ZW + ZLG + ch])); }
        }
    }
}
__device__ __forceinline__ void ph_ln(const Params& p, int mode, int r_begin, const float* __restrict__ gam, const float* __restrict__ bet, int lm, int sh, int sc, int G, int c) {
    float* X = WSP(float, OFF_X); h16* A = WSP(h16, OFF_A); const float* mod = WSP(float, OFF_MOD) + (size_t)lm * 9 * 6144;
    const int lane = threadIdx.x & 63, wv = threadIdx.x >> 6;
    for (int r = r_begin + c * 8 + wv; r < MT; r += G * 8) {
        const int g = row_group(r); float v[16];
#pragma unroll
        for (int i = 0; i < 4; ++i) { const float4 t = *(const float4*)(X + (size_t)r * D + i * 256 + lane * 4); v[i * 4] = t.x; v[i * 4 + 1] = t.y; v[i * 4 + 2] = t.z; v[i * 4 + 3] = t.w; }
        if (mode == 2) {
            const h16* o0 = WSP(h16, OFF_OUT2) + (size_t)(r - MC) * 1024; const h16* o1 = o0 + (size_t)ML * 1024; const float* m5 = WSP(float, OFF_MOD) + (size_t)(1 * 9 + g) * 6144 + 5 * 1024;
#pragma unroll
            for (int i = 0; i < 4; ++i) { const h16x4 a = *(const h16x4*)(o0 + i * 256 + lane * 4), b2 = *(const h16x4*)(o1 + i * 256 + lane * 4); const float4 mm = *(const float4*)(m5 + i * 256 + lane * 4);
                const float mv[4] = {mm.x, mm.y, mm.z, mm.w};
#pragma unroll
                for (int j = 0; j < 4; ++j) v[i * 4 + j] = ALPHA * v[i * 4 + j] + mv[j] * ((float)a[j] + (float)b2[j]); }
        }
        float s = 0.f;
#pragma unroll
        for (int i = 0; i < 16; ++i) s += v[i];
#pragma unroll
        for (int o = 32; o >= 1; o >>= 1) s += __shfl_xor(s, o);
        const float mean = s * (1.0f / 1024.0f); float q = 0.f;
#pragma unroll
        for (int i = 0; i < 16; ++i) { const float dlt = v[i] - mean; q += dlt * dlt; }
#pragma unroll
        for (int o = 32; o >= 1; o >>= 1) q += __shfl_xor(q, o);
        const float rstd = rsqrtf(q * (1.0f / 1024.0f) + 1e-5f);
        float lg8[8];
#pragma unroll
        for (int e = 0; e < 8; ++e) lg8[e] = 0.f;
#pragma unroll
        for (int i = 0; i < 4; ++i) {
            const int d = i * 256 + lane * 4; const float4 gg = *(const float4*)(gam + d), bb = *(const float4*)(bet + d);
            const float gv[4] = {gg.x, gg.y, gg.z, gg.w}, bv[4] = {bb.x, bb.y, bb.z, bb.w}; float y[4];
#pragma unroll
            for (int j = 0; j < 4; ++j) y[j] = (v[i * 4 + j] - mean) * rstd * gv[j] + bv[j];
            if (mode == 2) { *(float4*)(p.out + (size_t)(r - MC) * D + d) = make_float4(y[0], y[1], y[2], y[3]); continue; }
            *(float4*)(X + (size_t)r * D + d) = make_float4(y[0], y[1], y[2], y[3]);
            const float4 ms = *(const float4*)(mod + (size_t)g * 6144 + sh * 1024 + d), mc = *(const float4*)(mod + (size_t)g * 6144 + sc * 1024 + d);
            const float msv[4] = {ms.x, ms.y, ms.z, ms.w}, mcv[4] = {mc.x, mc.y, mc.z, mc.w}; float hh[4]; h16x4 ho;
#pragma unroll
            for (int j = 0; j < 4; ++j) { hh[j] = y[j] * (1.f + mcv[j]) + msv[j]; ho[j] = (h16)hh[j]; }
            *(h16x4*)(A + (size_t)r * AW + AH + d) = ho;
            if (mode == 1) {
#pragma unroll
                for (int j = 0; j < 4; ++j) { const float4 r0 = *(const float4*)(p.moe_router + (size_t)(d + j) * 8), r1 = *(const float4*)(p.moe_router + (size_t)(d + j) * 8 + 4);
                    lg8[0] += hh[j] * r0.x; lg8[1] += hh[j] * r0.y; lg8[2] += hh[j] * r0.z; lg8[3] += hh[j] * r0.w; lg8[4] += hh[j] * r1.x; lg8[5] += hh[j] * r1.y; lg8[6] += hh[j] * r1.z; lg8[7] += hh[j] * r1.w; }
            }
        }
        if (mode == 1) {
#pragma unroll
            for (int e = 0; e < 8; ++e) {
#pragma unroll
                for (int o = 32; o >= 1; o >>= 1) lg8[e] += __shfl_xor(lg8[e], o);
                lg8[e] += p.moe_router_b[e]; }
            if (lane == 0) {
                int i0 = 0; float v0 = lg8[0];
#pragma unroll
                for (int e = 1; e < 8; ++e) if (lg8[e] > v0) { v0 = lg8[e]; i0 = e; }
                int i1 = -1; float v1 = -INFINITY;
#pragma unroll
                for (int e = 0; e < 8; ++e) if (e != i0 && lg8[e] > v1) { v1 = lg8[e]; i1 = e; }
                const float p1 = 1.0f / (1.0f + expf(v0 - v1)), p0 = 1.0f - p1;
                const int t = r - MC; int* cnt = WSP(int, OFF_CNT);
                const int k0 = atomicAdd(&cnt[i0], 1), k1 = atomicAdd(&cnt[i1], 1);
                WSP(int, OFF_TOKE)[t * 2] = i0; WSP(int, OFF_TOKE)[t * 2 + 1] = i1; WSP(float, OFF_TOKP)[t * 2] = p0; WSP(float, OFF_TOKP)[t * 2 + 1] = p1; WSP(int, OFF_TOKR)[t * 2] = k0; WSP(int, OFF_TOKR)[t * 2 + 1] = k1;
            }
        }
    }
}
__device__ __forceinline__ void ph_moe_gather(const Params& p, char* shm, int G, int c) {
    int* sp = (int*)shm; int* plan = WSP(int, OFF_PLAN); const int* cnt = WSP(int, OFF_CNT); int* rowT = WSP(int, OFF_ROWT);
    const int tid = threadIdx.x;
    __syncthreads();
    if (tid == 0) { int acc = 0; for (int e = 0; e < 8; ++e) { sp[e] = acc; const int np = (cnt[e] + 255) / 256; if (c == 0) { plan[e] = acc; for (int q = 0; q < np; ++q) plan[16 + acc / 256 + q] = e; } acc += np * 256; } sp[8] = acc; if (c == 0) plan[8] = acc / 256; }
    __syncthreads();
    if (c == 0) for (int e = 0; e < 8; ++e) { const int a = sp[e] + cnt[e], b = sp[e + 1]; for (int i = a + tid; i < b; i += NTH) rowT[i] = -1; }
    const h16* A = WSP(h16, OFF_A); h16* Xg = WSP(h16, OFF_XG);
    const int lane = tid & 63, wv = tid >> 6;
    for (int it = c * 8 + wv; it < ML * 2; it += G * 8) {
        const int t = it >> 1, e = WSP(int, OFF_TOKE)[it], pos = sp[e] + WSP(int, OFF_TOKR)[it];
        const h16* src = A + (size_t)(MC + t) * AW + AH; h16* dst = Xg + (size_t)pos * 1024;
        *(h16x8*)(dst + lane * 8) = *(const h16x8*)(src + lane * 8); *(h16x8*)(dst + 512 + lane * 8) = *(const h16x8*)(src + 512 + lane * 8);
        if (lane == 0) { WSP(int, OFF_ROWT)[pos] = it; WSP(float, OFF_ROWP)[pos] = WSP(float, OFF_TOKP)[it]; }
    }
}


typedef float f32x16 __attribute__((ext_vector_type(16)));
constexpr int XCP = 520;
constexpr int LRU_XC = 0, LRU_LG = 64 * XCP * 2, LRU_CIN = 2 * 64 * XCP * 2;
__device__ __forceinline__ void lru_wt_prep(const Params& p, int G, int c) {
    h16* WT = WSP(h16, OFF_LRUWT);
    for (int u = c; u < 64; u += G) {
        const int blk = u & 7, gate = (u >> 3) & 1, ld = u >> 4;
        const float* W = (gate ? p.lru_wx : p.lru_wa) + ((size_t)ld * 8 + blk) * 4096;
        for (int o = threadIdx.x; o < 4096; o += NTH) { const int j = o >> 6, i = o & 63; WT[(size_t)u * 4096 + o] = (h16)W[i * 64 + j]; }
    }
}
template <int PASS> __device__ __forceinline__ void lru_unit(const Params& p, char* shm, int l, int b, int k) {
    const int tid = threadIdx.x, lane = tid & 63, h = __builtin_amdgcn_readfirstlane(tid >> 6), n = lane & 31, hi = lane >> 5;
    const h16* Z = WSP(h16, OFF_Z);
    const bool isctx = k < 4; const int s0 = isctx ? b * CTX : MC + b * SEQ, len = isctx ? CTX : SEQ, t0 = isctx ? k * 64 : (k - 4) * 64, row0 = s0 + t0;
    h16* xcs = (h16*)(shm + LRU_XC); h16* lgs = (h16*)(shm + LRU_LG); float* cins = (float*)(shm + LRU_CIN);
    __syncthreads();
    {
        const int cg = tid & 63, ts = tid >> 6, ch0 = cg * 8;
        float cw[4][8], cb[8];
#pragma unroll
        for (int q = 0; q < 4; ++q) { const float4 a = *(const float4*)(p.conv_w + (size_t)(l * 4 + q) * 512 + ch0), b2 = *(const float4*)(p.conv_w + (size_t)(l * 4 + q) * 512 + ch0 + 4);
            cw[q][0] = a.x; cw[q][1] = a.y; cw[q][2] = a.z; cw[q][3] = a.w; cw[q][4] = b2.x; cw[q][5] = b2.y; cw[q][6] = b2.z; cw[q][7] = b2.w; }
        { const float4 a = *(const float4*)(p.conv_b + l * 512 + ch0), b2 = *(const float4*)(p.conv_b + l * 512 + ch0 + 4); cb[0] = a.x; cb[1] = a.y; cb[2] = a.z; cb[3] = a.w; cb[4] = b2.x; cb[5] = b2.y; cb[6] = b2.z; cb[7] = b2.w; }
        h16x8 v[11];
#pragma unroll
        for (int i = 0; i < 11; ++i) { const int pos = t0 + ts * 8 - 2 + i; const bool ok = pos >= 0 && pos < len;
            h16x8 z8 = {0, 0, 0, 0, 0, 0, 0, 0}; if (ok) z8 = *(const h16x8*)(Z + (size_t)(s0 + pos) * ZW + ZLX + ch0); v[i] = z8; }
#pragma unroll
        for (int tt = 0; tt < 8; ++tt) { h16x8 o;
#pragma unroll
            for (int j = 0; j < 8; ++j) { float acc = cb[j];
#pragma unroll
                for (int q = 0; q < 4; ++q) acc += cw[q][j] * (float)v[tt + q][j];
                o[j] = (h16)acc; }
            *(h16x8*)(xcs + (ts * 8 + tt) * XCP + ch0) = o; }
        if (PASS == 3) {
#pragma unroll
            for (int tt = 0; tt < 8; ++tt) *(h16x8*)(lgs + (ts * 8 + tt) * XCP + ch0) = *(const h16x8*)(Z + (size_t)(row0 + ts * 8 + tt) * ZW + ZLG + ch0);
            const float* P0 = WSP(float, OFF_LRUP) + (size_t)(b * 2 + 0) * 68 * 512 + tid; const float* H0 = WSP(float, OFF_LRUH) + (size_t)(b * 2 + 0) * 68 * 512 + tid;
            float S = 0.f;
            for (int j = 0; j < k; ++j) S = P0[(size_t)j * 512] * S + H0[(size_t)j * 512];
            cins[tid] = S;
            const float* P1 = P0 + (size_t)68 * 512; const float* H1 = H0 + (size_t)68 * 512;
            S = 0.f;
            if (isctx) { for (int j = 3; j > k; --j) S = P1[(size_t)j * 512] * S + H1[(size_t)j * 512]; }
            else { for (int j = 3; j >= 0; --j) S = P1[(size_t)j * 512] * S + H1[(size_t)j * 512]; for (int j = 67; j > k; --j) S = P1[(size_t)j * 512] * S + H1[(size_t)j * 512]; }
            cins[512 + tid] = S;
        }
    }
    __syncthreads();
    const h16* WT = WSP(h16, OFF_LRUWT) + (size_t)l * 4 * 8 * 4096;
#define LMFMA(a, b, c) __builtin_amdgcn_mfma_f32_32x32x16_f16(a, b, c, 0, 0, 0)
#pragma unroll 1
    for (int ct = 0; ct < 2; ++ct) {
        const int cbase = h * 64 + ct * 32, ch = cbase + n;
        f32x16 xD[2], gD[2], hs[2];
#pragma unroll
        for (int rt = 0; rt < 2; ++rt) { xD[rt] = f32x16{}; gD[rt] = f32x16{}; hs[rt] = f32x16{}; }
#pragma unroll
        for (int s = 0; s < 2; ++s) { h16x8 id;
#pragma unroll
            for (int j = 0; j < 8; ++j) id[j] = (n == s * 16 + hi * 8 + j) ? (h16)1.0f : (h16)0.0f;
#pragma unroll
            for (int rt = 0; rt < 2; ++rt) { const h16x8 a = *(const h16x8*)(xcs + (rt * 32 + n) * XCP + cbase + s * 16 + hi * 8); xD[rt] = LMFMA(a, id, xD[rt]); } }
#pragma unroll
        for (int dir = 0; dir < 2; ++dir) {
            f32x16 R[2], I[2];
#pragma unroll
            for (int rt = 0; rt < 2; ++rt) { R[rt] = f32x16{}; I[rt] = f32x16{}; }
            const h16* wa = WT + ((size_t)(dir * 2 + 0) * 8 + h) * 4096 + (ct * 32 + n) * 64 + hi * 8;
            const h16* wx = WT + ((size_t)(dir * 2 + 1) * 8 + h) * 4096 + (ct * 32 + n) * 64 + hi * 8;
#pragma unroll
            for (int ks = 0; ks < 4; ++ks) { const h16x8 ba8 = *(const h16x8*)(wa + ks * 16), bx8 = *(const h16x8*)(wx + ks * 16);
#pragma unroll
                for (int rt = 0; rt < 2; ++rt) { const h16x8 a = *(const h16x8*)(xcs + (rt * 32 + n) * XCP + h * 64 + ks * 16 + hi * 8); R[rt] = LMFMA(a, ba8, R[rt]); I[rt] = LMFMA(a, bx8, I[rt]); } }
            const int pi = (l * 2 + dir) * 512 + ch;
            const float ba = p.lru_ba[pi], bx = p.lru_bx[pi], spl = log1pf(__expf(-p.lru_lambda[pi])) * (-8.0f * 1.4426950408889634f);
#pragma unroll
            for (int rt = 0; rt < 2; ++rt)
#pragma unroll
                for (int r = 0; r < 16; ++r) { const float rg = 1.0f / (1.0f + __expf(-(R[rt][r] + ba))), ig = 1.0f / (1.0f + __expf(-(I[rt][r] + bx)));
                    const float a = exp2f(rg * spl); R[rt][r] = a; I[rt][r] = sqrtf(fmaxf(1.0f - a * a, 0.f)) * ig * xD[rt][r]; }
            float Pg[8], Hg[8], Po[8], Ho[8];
#pragma unroll
            for (int q = 0; q < 8; ++q) { const int rt = q >> 2, r0 = (q & 3) * 4; float P = 1.f, H = 0.f;
#pragma unroll
                for (int i = 0; i < 4; ++i) { const int r = r0 + (dir ? 3 - i : i); P *= R[rt][r]; H = R[rt][r] * H + I[rt][r]; }
                Pg[q] = P; Hg[q] = H; }
#pragma unroll
            for (int q = 0; q < 8; ++q) { Po[q] = __shfl_xor(Pg[q], 32); Ho[q] = __shfl_xor(Hg[q], 32); }
            float S = (PASS == 3) ? cins[dir * 512 + ch] : 0.f, Pt = 1.f; float cg[8];
#pragma unroll
            for (int s2 = 0; s2 < 16; ++s2) { const int Gi = dir ? 15 - s2 : s2, q = Gi >> 1, own = Gi & 1;
                const float Pq = (hi == own) ? Pg[q] : Po[q], Hq = (hi == own) ? Hg[q] : Ho[q];
                if (hi == own) cg[q] = S;
                S = Pq * S + Hq; Pt *= Pq; }
            if (PASS == 1) { if (hi == 0) { WSP(float, OFF_LRUP)[((size_t)(b * 2 + dir) * 68 + k) * 512 + ch] = Pt; WSP(float, OFF_LRUH)[((size_t)(b * 2 + dir) * 68 + k) * 512 + ch] = S; } }
            else {
#pragma unroll
                for (int q = 0; q < 8; ++q) { const int rt = q >> 2, r0 = (q & 3) * 4; float hh = cg[q];
#pragma unroll
                    for (int i = 0; i < 4; ++i) { const int r = r0 + (dir ? 3 - i : i); hh = R[rt][r] * hh + I[rt][r]; hs[rt][r] += hh; } }
            }
        }
        if (PASS == 3) {
#pragma unroll
            for (int s = 0; s < 2; ++s) { h16x8 id;
#pragma unroll
                for (int j = 0; j < 8; ++j) id[j] = (n == s * 16 + hi * 8 + j) ? (h16)1.0f : (h16)0.0f;
#pragma unroll
                for (int rt = 0; rt < 2; ++rt) { const h16x8 a2 = *(const h16x8*)(lgs + (rt * 32 + n) * XCP + cbase + s * 16 + hi * 8); gD[rt] = LMFMA(a2, id, gD[rt]); } }
#pragma unroll
            for (int rt = 0; rt < 2; ++rt)
#pragma unroll
                for (int r = 0; r < 16; ++r) { const float x = gD[rt][r]; const float u2 = 1.5957691216057308f * (x + 0.044715f * x * x * x);
                    lgs[(rt * 32 + (r & 3) + 8 * (r >> 2) + 4 * hi) * XCP + ch] = (h16)(hs[rt][r] * x / (1.0f + __expf(-u2))); }
        }
    }
#undef LMFMA
    if (PASS == 3) {
        __syncthreads();
        h16* A = WSP(h16, OFF_A); const int cg = tid & 63, ts = tid >> 6, ch0 = cg * 8;
#pragma unroll
        for (int tt = 0; tt < 8; ++tt) *(h16x8*)(A + (size_t)(row0 + ts * 8 + tt) * AW + AY2 + ch0) = *(const h16x8*)(lgs + (ts * 8 + tt) * XCP + ch0);
    }
}
template <int PASS> __device__ __forceinline__ void ph_lru(const Params& p, char* shm, int l, int G, int c) {
    for (int u = c; u < NB * 68; u += G) lru_unit<PASS>(p, shm, l, u / 68, u % 68);
}

constexpr int XB_LDS_OFF = LDS_BYTES - 16;
__global__ void __launch_bounds__(512, 2) k_mega(Params p, int lo, int hi) {
    extern __shared__ __attribute__((aligned(16))) unsigned char shm[];
    LAS unsigned char* lds = (LAS unsigned char*)shm;
    const int G = gridDim.x, c = blockIdx.x;
    if (threadIdx.x == 0) *(uint4*)(shm + XB_LDS_OFF) = make_uint4(0u, 0u, 0u, 0u);
    __syncthreads();
    XcdBarrier bar = xcd_barrier_post(WSP(unsigned, OFF_BAR), (volatile LAS unsigned*)(lds + XB_LDS_OFF));
    int ph = 0;
#define PHASE(body) do { if (ph >= lo && ph < hi) { body; if (ph + 1 < hi) xcd_barrier(bar); } ++ph; } while (0)
    PHASE(ph_prologue(p, (char*)shm, G, c));
    PHASE(ph_h0(p, G, c));
#define LAYER(l) do { \
        const int rb = (l) == 0 ? 0 : MC; \
        const float* ln1g = p.ln1_g + (l) * D; const float* ln1b = p.ln1_b + (l) * D; const float* ln2g = p.ln2_g + (l) * D; const float* ln2b = p.ln2_b + (l) * D; \
        PHASE(ph_gemm_in(p, lds, (l), G, c)); \
        PHASE(ph_qkv(p, (l), G, c); ph_pool(p, rb, G, c); ph_lru<1>(p, (char*)shm, (l), G, c)); \
        PHASE(ph_attn(p, (char*)shm, (l), G, c); ph_lru<3>(p, (char*)shm, (l), G, c)); \
        PHASE(ph_merge(p, lds, (l), G, c)); \
        PHASE(ph_wout(p, lds, (l), G, c)); \
        if ((l) == 0) { \
            PHASE(ph_ln(p, 0, rb, ln1g, ln1b, 0, 3, 4, G, c)); \
            PHASE(ph_ffn_gu(p, lds, G, c)); \
            PHASE(ph_ffn_down(p, lds, G, c)); \
            PHASE(ph_ln(p, 0, 0, ln2g, ln2b, 1, 0, 1, G, c)); \
        } else { \
            PHASE(ph_ln(p, 1, rb, ln1g, ln1b, 1, 3, 4, G, c); cvt_jobs(p, NJOBS_SMALL, NJOBS_ALL, 0, G, c, (float (*)[65])shm)); \
            PHASE(ph_moe_gather(p, (char*)shm, G, c)); \
            for (int chn = 0; chn < 5; ++chn) { \
                PHASE(ph_moe_gu(p, lds, chn * 64, G, c)); \
                PHASE(ph_moe_down(p, lds, chn * 64, G, c)); \
            } \
            PHASE(ph_ln(p, 2, MC, ln2g, ln2b, 1, 0, 1, G, c)); \
        } } while (0)
    LAYER(0);
    LAYER(1);
#undef LAYER
#undef PHASE
}
constexpr int NPHASES = 2 + 9 + (5 + 2 + 10 + 1);

#ifndef MEGA_LAUNCHES
#define MEGA_LAUNCHES 1
#endif
extern "C" void kernel_launch(void* const* d_in, const int* in_sizes, int n_in, void* d_out, int out_size, void* d_ws, size_t ws_size, hipStream_t stream) {
    (void)in_sizes; (void)n_in; (void)out_size;
    if (ws_size < WS_NEED) return;
    Params p;
    const float** pp = (const float**)&p;
    for (int i = 0; i < 33; ++i) pp[i] = (const float*)d_in[i];
    p.out = (float*)d_out; p.ws = (char*)d_ws;
    static int grid = 0;
    if (!grid) {
        int dev = 0, cus = 0, per_cu = 0;
        hipGetDevice(&dev);
        hipDeviceGetAttribute(&cus, hipDeviceAttributeMultiprocessorCount, dev);
        hipFuncSetAttribute((const void*)k_mega, hipFuncAttributeMaxDynamicSharedMemorySize, LDS_BYTES);
        hipOccupancyMaxActiveBlocksPerMultiprocessor(&per_cu, (const void*)k_mega, 512, LDS_BYTES);
        grid = (per_cu >= 1 && cus > 0) ? cus : -1;
    }
    if (grid <= 0) return;
    hipMemsetAsync(p.ws + OFF_BAR, 0, XCD_BAR_WORDS * sizeof(unsigned), stream);
#if MEGA_LAUNCHES == 1
    k_mega<<<grid, 512, LDS_BYTES, stream>>>(p, 0, NPHASES);
#else
    for (int ph = 0; ph < NPHASES; ++ph) k_mega<<<grid, 512, LDS_BYTES, stream>>>(p, ph, ph + 1);
#endif
}
```

```cpp
#include <hip/hip_runtime.h>
#include <stdint.h>
#include <stddef.h>

#ifndef PROBE_EPI
#define PROBE_EPI 0
#endif
#define PG8_ALIGN 1
typedef _Float16 h16;
typedef _Float16 h16x2 __attribute__((ext_vector_type(2)));
typedef _Float16 h16x4 __attribute__((ext_vector_type(4)));
typedef _Float16 h16x8 __attribute__((ext_vector_type(8)));

constexpr int D = 1024, NB = 8, SEQ = 4096, CTX = 256, SB = CTX + SEQ;
constexpr int MC = NB * CTX, ML = NB * SEQ, MT = MC + ML;
constexpr int WIN = 5376, ZW = 2304, AW = 2560;
constexpr int DFF = 2816, NE = 8, DEX = 3584;
constexpr int PMAX = 264 * 256;
constexpr float ALPHA = 1.41421356237309515f;
constexpr float QSCALE = 0.125f * 1.4426950408889634f;
constexpr int ZP = 0, ZQ = 512, ZK = 1024, ZV = 1152, ZLX = 1280, ZLG = 1792;
constexpr int AH = 0, AY0 = 1024, AY1 = 1536, AY2 = 2048;

constexpr size_t al256(size_t x) { return (x + 255) & ~(size_t)255; }
constexpr size_t OFF_BAR = 0;
constexpr size_t OFF_MOD = 16384;
constexpr size_t OFF_CNT = OFF_MOD + al256((size_t)2 * 9 * 6144 * 4);
constexpr size_t OFF_PLAN = OFF_CNT + 256;
constexpr size_t OFF_TOKE = OFF_PLAN + 2048;
constexpr size_t OFF_TOKP = OFF_TOKE + (size_t)ML * 2 * 4;
constexpr size_t OFF_TOKR = OFF_TOKP + (size_t)ML * 2 * 4;
constexpr size_t OFF_ROWT = OFF_TOKR + (size_t)ML * 2 * 4;
constexpr size_t OFF_ROWP = OFF_ROWT + (size_t)PMAX * 4;
constexpr size_t OFF_LRUP = OFF_ROWP + (size_t)PMAX * 4;
constexpr size_t OFF_LRUH = OFF_LRUP + (size_t)NB * 2 * 68 * 512 * 4;
constexpr size_t OFF_LRUWT = OFF_LRUH + (size_t)NB * 2 * 68 * 512 * 4;
constexpr size_t OFF_TBL_END = OFF_LRUWT + (size_t)2 * 2 * 2 * 8 * 4096 * 2;
constexpr size_t OFF_X = (size_t)8 << 20;
constexpr size_t OFF_A = OFF_X + (size_t)MT * D * 4;
constexpr size_t OFF_BIG = OFF_A + (size_t)MT * AW * 2;
static_assert(OFF_TBL_END <= OFF_X, "tables");
constexpr size_t OFF_Z = OFF_BIG;
constexpr size_t OFF_QH = OFF_Z + (size_t)MT * ZW * 2;
constexpr size_t OFF_KH = OFF_QH + (size_t)MT * 512 * 2;
constexpr size_t OFF_VH = OFF_KH + (size_t)NB * SB * 128 * 2;
constexpr size_t OFF_W16 = OFF_VH + (size_t)NB * SB * 128 * 2;
constexpr size_t SZ_WINT = (size_t)ZW * 1024 * 2, SZ_BTALL = (size_t)3072 * 1536 * 2, SZ_WOUTT = (size_t)1024 * 1024 * 2;
constexpr size_t SZ_LAYERW = SZ_WINT + SZ_BTALL + SZ_WOUTT;
constexpr size_t OFF_WGUT = OFF_W16 + 2 * SZ_LAYERW;
constexpr size_t OFF_WDT = OFF_WGUT + (size_t)2 * DFF * 1024 * 2;
constexpr size_t OFF_W16_END = OFF_WDT + (size_t)1024 * DFF * 2;
constexpr size_t OFF_LAU_TAIL = (OFF_W16_END + 255) & ~(size_t)255;
constexpr size_t OFF_ACT = OFF_BIG;
static_assert(OFF_ACT + (size_t)MT * DFF * 2 <= OFF_W16, "ACT overlay");
constexpr size_t OFF_WMOE_GU = OFF_BIG;
constexpr size_t OFF_WMOE_D = OFF_WMOE_GU + (size_t)NE * 2 * DEX * 1024 * 2;
constexpr size_t OFF_XG = OFF_WMOE_D + (size_t)NE * 1024 * DEX * 2;
constexpr size_t WS_NEED = OFF_XG + (size_t)PMAX * 1024 * 2;
static_assert(WS_NEED <= 646673440ull, "workspace budget");
static_assert(OFF_LAU_TAIL + (size_t)32 * 262144 <= WS_NEED, "lau tail");
static_assert(OFF_W16_END <= WS_NEED, "w16");
constexpr size_t OFF_OUT2 = OFF_A;
constexpr size_t OFF_OUTP = OFF_OUT2 + (size_t)2 * ML * 1024 * 2;
static_assert(OFF_OUTP + (size_t)4 * 2048 * 1024 * 2 <= OFF_A + (size_t)MT * AW * 2, "OUT2/OUTP overlay");
static_assert((size_t)72 * 256 * DEX * 2 <= (size_t)ML * D * 4, "ACTe chunk in d_out");

struct Params {
    const float *x, *c, *ctx, *c_ctx, *w_mod, *b_mod, *w_in, *b_merge, *pool_w, *pool_scale, *q_norm, *k_norm, *conv_w, *conv_b,
        *lru_wa, *lru_ba, *lru_wx, *lru_bx, *lru_lambda, *w_branch, *w_out, *ln1_g, *ln1_b, *ffn_w_gate, *ffn_w_up, *ffn_w_down,
        *moe_router, *moe_router_b, *moe_w_gate, *moe_w_up, *moe_w_down, *ln2_g, *ln2_b;
    float* out;
    char* ws;
};
#define WSP(T, off) ((T*)(p.ws + (off)))

__device__ __forceinline__ int row_group(int r) { return r < MC ? 0 : 1 + ((r - MC) >> 12); }
__device__ __forceinline__ void row_seq(int r, int& s0, int& len, int& pos) {
    if (r < MC) { s0 = r & ~255; len = 256; pos = r & 255; } else { const int q = r - MC; s0 = MC + (q & ~4095); len = 4096; pos = q & 4095; }
}
__device__ __forceinline__ const float* xin_row(const Params& p, int r) { return r < MC ? p.ctx + (size_t)r * D : p.x + (size_t)(r - MC) * D; }
__device__ __forceinline__ float sigmoidf_(float x) { return __builtin_amdgcn_rcpf(1.0f + __builtin_amdgcn_exp2f(-1.4426950408889634f * x)); }
__device__ __forceinline__ float siluf_(float x) { return x * __builtin_amdgcn_rcpf(1.0f + __builtin_amdgcn_exp2f(-1.4426950408889634f * x)); }
__device__ __forceinline__ float gelu_tanh(float x) { const float u = 0.7978845608028654f * (x + 0.044715f * x * x * x); return 0.5f * x * (1.0f + tanhf(u)); }

struct CvtJob { const float* src; int ld_src, K, N; h16* dst; int ldd, col_off, rmode; };
constexpr int NJOBS_L = 6, NJOBS_SMALL = 2 * NJOBS_L + 3, NJOBS_ALL = NJOBS_SMALL + 24;
__device__ __forceinline__ CvtJob get_job(const Params& p, int j) {
    CvtJob q; q.col_off = 0; q.rmode = 0;
    if (j < 2 * NJOBS_L) {
        const int l = j / NJOBS_L, s = j % NJOBS_L;
        h16* wint = WSP(h16, OFF_W16 + l * SZ_LAYERW); h16* btall = WSP(h16, OFF_W16 + l * SZ_LAYERW + SZ_WINT); h16* woutt = WSP(h16, OFF_W16 + l * SZ_LAYERW + SZ_WINT + SZ_BTALL);
        if (s == 0) { q.src = p.w_in + (size_t)l * 1024 * WIN + 512; q.ld_src = WIN; q.K = 1024; q.N = ZW - 512; q.dst = wint + (size_t)512 * 1024; q.ldd = 1024; }
        else if (s == 1) { q.src = p.w_in + (size_t)l * 1024 * WIN + ZW; q.ld_src = WIN; q.K = 1024; q.N = 3072; q.dst = btall; q.ldd = 1536; }
        else if (s < 5) { const int n = s - 2; q.src = p.w_branch + (size_t)(l * 3 + n) * 512 * 1024; q.ld_src = 1024; q.K = 512; q.N = 1024; q.dst = btall + (size_t)n * 1024 * 1536; q.ldd = 1536; q.col_off = 1024; }
        else { q.src = p.w_out + (size_t)l * 1024 * 1024; q.ld_src = 1024; q.K = 1024; q.N = 1024; q.dst = woutt; q.ldd = 1024; }
    } else if (j < NJOBS_SMALL) {
        const int s = j - 2 * NJOBS_L;
        if (s == 0) { q.src = p.ffn_w_gate; q.ld_src = DFF; q.K = 1024; q.N = DFF; q.dst = WSP(h16, OFF_WGUT); q.ldd = 1024; q.rmode = 1; }
        else if (s == 1) { q.src = p.ffn_w_up; q.ld_src = DFF; q.K = 1024; q.N = DFF; q.dst = WSP(h16, OFF_WGUT); q.ldd = 1024; q.rmode = 2; }
        else { q.src = p.ffn_w_down; q.ld_src = 1024; q.K = DFF; q.N = 1024; q.dst = WSP(h16, OFF_WDT); q.ldd = DFF; }
    } else {
        const int s = j - NJOBS_SMALL, e = s / 3, t = s % 3;
        if (t == 0) { q.src = p.moe_w_gate + (size_t)e * 1024 * DEX; q.ld_src = DEX; q.K = 1024; q.N = DEX; q.dst = WSP(h16, OFF_WMOE_GU) + (size_t)e * 2 * DEX * 1024; q.ldd = 1024; q.rmode = 1; }
        else if (t == 1) { q.src = p.moe_w_up + (size_t)e * 1024 * DEX; q.ld_src = DEX; q.K = 1024; q.N = DEX; q.dst = WSP(h16, OFF_WMOE_GU) + (size_t)e * 2 * DEX * 1024; q.ldd = 1024; q.rmode = 2; }
        else { q.src = p.moe_w_down + (size_t)e * DEX * 1024; q.ld_src = 1024; q.K = DEX; q.N = 1024; q.dst = WSP(h16, OFF_WMOE_D) + (size_t)e * 1024 * DEX; q.ldd = DEX; }
    }
    return q;
}
__device__ __forceinline__ int job_tiles(const CvtJob& q) { return (q.K / 128) * (q.N / 128); }
__device__ __forceinline__ int cvt_rowmap(int n, int rmode) { return rmode == 0 ? n : ((n >> 7) * 256 + (n & 127) + (rmode == 2 ? 128 : 0)); }
__device__ __forceinline__ void cvt_load(const CvtJob& q, int t, float4 (&v)[8]) {
    const int nk = q.K / 128, tk = t % nk, tn = t / nk, k0 = tk * 128, n0 = tn * 128, tid = threadIdx.x;
#pragma unroll
    for (int i = 0; i < 8; ++i) v[i] = *(const float4*)(q.src + (size_t)(k0 + i * 16 + (tid >> 5)) * q.ld_src + n0 + (tid & 31) * 4);
}
__device__ __forceinline__ void cvt_store(const CvtJob& q, int t, const float4 (&v)[8], float (*tile)[129]) {
    const int nk = q.K / 128, tk = t % nk, tn = t / nk, k0 = tk * 128, n0 = tn * 128, tid = threadIdx.x;
    __syncthreads();
#pragma unroll
    for (int i = 0; i < 8; ++i) { float* tp = &tile[i * 16 + (tid >> 5)][(tid & 31) * 4]; tp[0] = v[i].x; tp[1] = v[i].y; tp[2] = v[i].z; tp[3] = v[i].w; }
    __syncthreads();
#pragma unroll
    for (int i = 0; i < 4; ++i) { const int n = i * 32 + (tid >> 4), kc = (tid & 15) * 8; h16x8 o;
#pragma unroll
        for (int j = 0; j < 8; ++j) o[j] = (h16)tile[kc + j][n];
        *(h16x8*)(q.dst + (size_t)cvt_rowmap(n0 + n, q.rmode) * q.ldd + q.col_off + k0 + kc) = o; }
}
template <int NT> __device__ __forceinline__ void mod_unit(const Params& p, int u, float* sc  , float* red  ) {
    const int l = u / 96, n0 = (u % 96) * 64, tid = threadIdx.x, n = tid & 63, ks = tid >> 6;
    constexpr int NKS = NT / 64, KPER = 1024 / NKS;
    __syncthreads();
    for (int i = tid; i < 9 * 1024; i += NT) { const int g = i >> 10, k = i & 1023; const float v = g == 0 ? p.c_ctx[k] : p.c[(g - 1) * 1024 + k]; sc[i] = siluf_(v); }
    __syncthreads();
    float acc[9];
#pragma unroll
    for (int g = 0; g < 9; ++g) acc[g] = 0.f;
    const float* w = p.w_mod + (size_t)l * 1024 * 6144 + n0 + n;
#pragma unroll 8
    for (int k = ks * KPER; k < (ks + 1) * KPER; ++k) { const float wv = w[(size_t)k * 6144];
#pragma unroll
        for (int g = 0; g < 9; ++g) acc[g] += sc[g * 1024 + k] * wv; }
#pragma unroll
    for (int g = 0; g < 9; ++g) red[(ks * 9 + g) * 64 + n] = acc[g];
    __syncthreads();
    for (int i = tid; i < 9 * 64; i += NT) { const int g = i >> 6, nn = i & 63; float s = p.b_mod[l * 6144 + n0 + nn];
        for (int k2 = 0; k2 < NKS; ++k2) s += red[(k2 * 9 + g) * 64 + nn];
        WSP(float, OFF_MOD)[(size_t)(l * 9 + g) * 6144 + n0 + nn] = s; }
}

#define LAS __attribute__((address_space(3)))
typedef float f32x4 __attribute__((ext_vector_type(4)));
typedef unsigned u32x4 __attribute__((ext_vector_type(4)));
typedef unsigned u32x2 __attribute__((ext_vector_type(2)));
namespace pg8 {
constexpr int BM = 256, BK = 64, HALF = 128, HTB = HALF * BK * 2, STAGE_BYTES = 8 * HTB;
__host__ __device__ __forceinline__ int lds_byte(int r, int c) { const int st = (r >> 4) * 2 + (c >> 5), rr = r & 15, cc = c & 31, ob = rr * 64 + cc * 2; return st * 1024 + (ob ^ (((ob >> 9) & 1) << 5)); }
__host__ __device__ __forceinline__ void stage_rc(int b, int& R, int& C) { const int st = b / 1024, sb = b % 1024, swz = sb ^ (((sb >> 9) & 1) << 5); R = (st >> 1) * 16 + swz / 64; C = (st & 1) * 32 + (swz % 64) / 2; }
__host__ __device__ __forceinline__ int perm32(int rho) { const int n = rho >> 4, i = rho & 15; return 8 * (i >> 2) + 4 * n + (i & 3); }
struct GUnit { const char* A; const char* B; int nt; int kind; int pm; int pn; int aux; };
__device__ __forceinline__ void tile_map(int L, int nM, int nN, int& pm, int& pn) {
    const int nwg = nM * nN; int wgid = L;
    { const int q = nwg / 8, r = nwg % 8, xcd = wgid % 8, off = wgid / 8; wgid = (xcd < r ? xcd * (q + 1) : r * (q + 1) + (xcd - r) * q) + off; }
    const int nig = 8 * nN, gid = wgid / nig, fm = gid * 8, gsz = (nM - fm) < 8 ? (nM - fm) : 8;
    pm = fm + ((wgid % nig) % gsz); pn = (wgid % nig) / gsz;
}
__device__ __forceinline__ unsigned cvt_pk_f16(float lo, float hi) { typedef float f2 __attribute__((ext_vector_type(2))); const f2 v = {lo, hi}; const h16x2 h = __builtin_convertvector(v, h16x2); return __builtin_bit_cast(unsigned, h); }

template <class Epi, class Sched>
__device__ __forceinline__ void gemm_phase(LAS unsigned char* lds, const int lda, const int ldb, const Sched& S, const Epi& E) {
    constexpr bool GATHER = Sched::GATHER;
    const int tid = threadIdx.x, wid = __builtin_amdgcn_readfirstlane(tid >> 6), lane = tid & 63, wr = wid >> 2, wc = wid & 3, fr = lane & 15, fq = lane >> 4;
    unsigned voffB[2]; int sR[2]; unsigned sC[2];
#pragma unroll
    for (int i = 0; i < 2; ++i) { int R, C; stage_rc(tid * 16 + i * 8192, R, C); const int Rb = Epi::PERM ? ((R & ~31) + perm32(R & 31)) : R;
        sR[i] = R; sC[i] = (unsigned)C * 2u; voffB[i] = (unsigned)(Rb * ldb + C) * 2u; }
    const size_t kstep = (size_t)(BK * 2);
    const size_t hstepB = (size_t)HALF * ldb * 2;
    const unsigned ldsw = (unsigned)wid * 1024u;
    const int aoff = lds_byte(wr * 64 + fr, fq * 8), boff = lds_byte(wc * 32 + fr, fq * 8);
#define PG8_SA(b, h) (((b) * 2 + (h)) * HTB)
#define PG8_SB(b, h) ((4 + (b) * 2 + (h)) * HTB)
#define PG8_STAGE(bufoff, gbase, voff) do { _Pragma("unroll") for (int _i = 0; _i < 2; ++_i) \
        __builtin_amdgcn_global_load_lds((const unsigned*)((const char*)(gbase) + (voff)[_i]), (LAS unsigned*)(lds + (bufoff) + ldsw + _i * 8192), 16, 0, 0); } while (0)
#define PG8_LDA(dst, b, h) do { _Pragma("unroll") for (int m = 0; m < 4; ++m) _Pragma("unroll") for (int k = 0; k < 2; ++k) dst[m][k] = *(const LAS h16x8*)(lds + PG8_SA(b, h) + aoff + m * 2048 + k * 1024); } while (0)
#define PG8_LDB(dst, b, h) do { _Pragma("unroll") for (int n = 0; n < 2; ++n) _Pragma("unroll") for (int k = 0; k < 2; ++k) dst[n][k] = *(const LAS h16x8*)(lds + PG8_SB(b, h) + boff + n * 2048 + k * 1024); } while (0)
#define PG8_MMA(ai, bj, At, Bt) do { __builtin_amdgcn_s_setprio(1); _Pragma("unroll") for (int m = 0; m < 4; ++m) _Pragma("unroll") for (int n = 0; n < 2; ++n) _Pragma("unroll") for (int k = 0; k < 2; ++k) \
        acc[ai][bj][m][n] = __builtin_amdgcn_mfma_f32_16x16x32_f16(Bt[n][k], At[m][k], acc[ai][bj][m][n], 0, 0, 0); __builtin_amdgcn_s_setprio(0); } while (0)
#define PG8_WAIT_V(n) asm volatile("s_waitcnt vmcnt(" #n ")" ::: "memory")
#define PG8_WAIT_L(n) asm volatile("s_waitcnt lgkmcnt(" #n ")" ::: "memory")
#define PG8_BAR __builtin_amdgcn_s_barrier()
#define PG8_SCHED __builtin_amdgcn_sched_barrier(0)
#define PG8_AOFFS(dst, u) do { _Pragma("unroll") for (int _h = 0; _h < 2; ++_h) _Pragma("unroll") for (int _i = 0; _i < 2; ++_i) \
        dst[_h][_i] = (GATHER ? S.a_off(u, _h * HALF + sR[_i]) : (unsigned)(_h * HALF + sR[_i]) * (unsigned)(lda * 2)) + sC[_i]; } while (0)
    GUnit cur, nxt; int ui = 0; unsigned long long probe_t0 = 0ull;
    if (!S.next(0, cur)) return;
    f32x4 acc[2][2][4][2];
#pragma unroll
    for (int a = 0; a < 2; ++a)
#pragma unroll
        for (int b = 0; b < 2; ++b)
#pragma unroll
            for (int m = 0; m < 4; ++m)
#pragma unroll
                for (int n = 0; n < 2; ++n) acc[a][b][m][n] = (f32x4){0.f, 0.f, 0.f, 0.f};
    h16x8 At[4][2], B0[2][2], B1[2][2];
    const char* cA = cur.A; const char* cB = cur.B;
    unsigned oc[2][2], on[2][2];
    PG8_AOFFS(oc, cur);
    PG8_STAGE(PG8_SB(0, 0), cB, voffB); PG8_STAGE(PG8_SB(0, 1), cB + hstepB, voffB); PG8_STAGE(PG8_SA(0, 0), cA, oc[0]); PG8_STAGE(PG8_SA(0, 1), cA, oc[1]);
    if (wr == 1) PG8_BAR;
    PG8_WAIT_V(2); PG8_BAR;
    PG8_STAGE(PG8_SB(1, 0), cB + kstep, voffB); PG8_STAGE(PG8_SA(1, 0), cA + kstep, oc[0]); PG8_STAGE(PG8_SB(1, 1), cB + hstepB + kstep, voffB);
    PG8_WAIT_V(6); PG8_BAR;
    for (;;) {
        const bool has_next = S.next(ui + 1, nxt);
        const char* nA = has_next ? nxt.A : cA; const char* nB = has_next ? nxt.B : cB;
        if (GATHER) { if (has_next) PG8_AOFFS(on, nxt); else { on[0][0] = oc[0][0]; on[0][1] = oc[0][1]; on[1][0] = oc[1][0]; on[1][1] = oc[1][1]; } }
        const int nt = cur.nt;
        for (int t = 0; t < nt; t += 2) {
            const bool last = (t == nt - 2);
            const char* a1 = cA + (size_t)(t + 1) * kstep;
            const char* a2 = last ? nA : cA + (size_t)(t + 2) * kstep; const char* b2 = last ? nB : cB + (size_t)(t + 2) * kstep;
            const char* a3 = a2 + kstep; const char* b3 = b2 + kstep;
            unsigned o2[2][2];
#pragma unroll
            for (int _h = 0; _h < 2; ++_h)
#pragma unroll
                for (int _i = 0; _i < 2; ++_i) o2[_h][_i] = (GATHER && last) ? on[_h][_i] : oc[_h][_i];
            PG8_LDB(B0, 0, 0); PG8_LDB(B1, 0, 1); PG8_SCHED; PG8_LDA(At, 0, 0); PG8_STAGE(PG8_SA(1, 1), a1, oc[1]);
            PG8_WAIT_V(8); PG8_WAIT_L(0); PG8_BAR; PG8_MMA(0, 0, At, B0); PG8_MMA(0, 1, At, B1); PG8_BAR; PG8_SCHED;
            PG8_LDA(At, 0, 1); PG8_STAGE(PG8_SB(0, 0), b2, voffB); PG8_STAGE(PG8_SB(0, 1), b2 + hstepB, voffB); PG8_STAGE(PG8_SA(0, 0), a2, o2[0]);
            PG8_WAIT_V(8); PG8_WAIT_L(0); PG8_BAR; PG8_MMA(1, 0, At, B0); PG8_MMA(1, 1, At, B1); PG8_BAR; PG8_SCHED;
            PG8_LDB(B0, 1, 0); PG8_LDB(B1, 1, 1); PG8_SCHED; PG8_LDA(At, 1, 0); PG8_STAGE(PG8_SA(0, 1), a2, o2[1]);
            PG8_WAIT_V(8); PG8_WAIT_L(0); PG8_BAR; PG8_MMA(0, 0, At, B0); PG8_MMA(0, 1, At, B1); PG8_BAR; PG8_SCHED;
            PG8_LDA(At, 1, 1); PG8_STAGE(PG8_SB(1, 0), b3, voffB); PG8_STAGE(PG8_SB(1, 1), b3 + hstepB, voffB); PG8_STAGE(PG8_SA(1, 0), a3, o2[0]);
            PG8_WAIT_V(8); PG8_WAIT_L(0); PG8_BAR; PG8_MMA(1, 0, At, B0); PG8_MMA(1, 1, At, B1); PG8_BAR; PG8_SCHED;
            if (PROBE_EPI == 2 && t == 0 && probe_t0 != 0ull && blockIdx.x == 0 && tid == 0) ((LAS unsigned long long*)(lds + 147424))[0] += __builtin_amdgcn_s_memrealtime() - probe_t0;
            if (PROBE_EPI == 3 && t == 4) probe_t0 = __builtin_amdgcn_s_memrealtime();
            if (PROBE_EPI == 3 && t == 6 && blockIdx.x == 0 && tid == 0) ((LAS unsigned long long*)(lds + 147424))[0] += __builtin_amdgcn_s_memrealtime() - probe_t0;
        }
        if (wr == 0) PG8_BAR;
        unsigned long long pe0 = 0; if (PROBE_EPI == 1 || PROBE_EPI == 2) pe0 = __builtin_amdgcn_s_memrealtime();
        E(acc, cur, wr, wc, fr, fq);
        if (PROBE_EPI == 1 && blockIdx.x == 0 && tid == 0) ((LAS unsigned long long*)(lds + 147424))[0] += __builtin_amdgcn_s_memrealtime() - pe0;
        if (PROBE_EPI == 2) probe_t0 = pe0;
        if (!has_next) break;
#pragma unroll
        for (int a = 0; a < 2; ++a)
#pragma unroll
            for (int b = 0; b < 2; ++b)
#pragma unroll
                for (int m = 0; m < 4; ++m)
#pragma unroll
                    for (int n = 0; n < 2; ++n) acc[a][b][m][n] = (f32x4){0.f, 0.f, 0.f, 0.f};
        cur = nxt; cA = nA; cB = nB; ++ui;
        if (GATHER) { oc[0][0] = on[0][0]; oc[0][1] = on[0][1]; oc[1][0] = on[1][0]; oc[1][1] = on[1][1]; }
        if (wr == 1) PG8_BAR;
    }
    PG8_WAIT_V(0);
    PG8_BAR;
#undef PG8_AOFFS
#undef PG8_SA
#undef PG8_SB
#undef PG8_STAGE
#undef PG8_LDA
#undef PG8_LDB
#undef PG8_MMA
#undef PG8_WAIT_V
#undef PG8_WAIT_L
#undef PG8_BAR
#undef PG8_SCHED
}
template <class Epi, class Sched>
__device__ __forceinline__ void gemm_phase_h(LAS unsigned char* lds, const int lda, const int ldb, const Sched& S, const Epi& E) {
    const int tid = threadIdx.x, wid = __builtin_amdgcn_readfirstlane(tid >> 6), lane = tid & 63, wr = wid >> 1, wc = wid & 1, hf = wid >> 2, fr = lane & 15, fq = lane >> 4;
    unsigned voffA[2], voffB[2];
#pragma unroll
    for (int i = 0; i < 2; ++i) { int R, C; stage_rc(tid * 16 + i * 8192, R, C); const int Rb = (R & ~31) + perm32(R & 31);
        voffA[i] = (unsigned)(R * lda + C) * 2u; voffB[i] = (unsigned)(Rb * ldb + C) * 2u; }
    const size_t kstep = (size_t)(BK * 2);
    const size_t hstepA = (size_t)HALF * lda * 2;
    const unsigned ldsw = (unsigned)wid * 1024u;
    const int aoff = lds_byte(wr * 32 + fr, fq * 8), boff = lds_byte(wc * 64 + fr, fq * 8);
#define PG8_SA(b, h) (((b) * 2 + (h)) * HTB)
#define PG8_SB(b, h) ((4 + (b) * 2 + (h)) * HTB)
#define PG8_STAGE(bufoff, gbase, voff) do { _Pragma("unroll") for (int _i = 0; _i < 2; ++_i) \
        __builtin_amdgcn_global_load_lds((const unsigned*)((const char*)(gbase) + (voff)[_i]), (LAS unsigned*)(lds + (bufoff) + ldsw + _i * 8192), 16, 0, 0); } while (0)
#define PG8_LDA(dst, b, h) do { _Pragma("unroll") for (int m = 0; m < 2; ++m) _Pragma("unroll") for (int k = 0; k < 2; ++k) dst[m][k] = *(const LAS h16x8*)(lds + PG8_SA(b, h) + aoff + m * 2048 + k * 1024); } while (0)
#define PG8_LDB(dst, b, h) do { _Pragma("unroll") for (int n = 0; n < 4; ++n) _Pragma("unroll") for (int k = 0; k < 2; ++k) dst[n][k] = *(const LAS h16x8*)(lds + PG8_SB(b, h) + boff + n * 2048 + k * 1024); } while (0)
#define PG8_MMA(ai, At, Bt) do { __builtin_amdgcn_s_setprio(1); _Pragma("unroll") for (int m = 0; m < 2; ++m) _Pragma("unroll") for (int n = 0; n < 4; ++n) _Pragma("unroll") for (int k = 0; k < 2; ++k) \
        acc[ai][m][n] = __builtin_amdgcn_mfma_f32_16x16x32_f16(Bt[n][k], At[m][k], acc[ai][m][n], 0, 0, 0); __builtin_amdgcn_s_setprio(0); } while (0)
#define PG8_WAIT_V(n) asm volatile("s_waitcnt vmcnt(" #n ")" ::: "memory")
#define PG8_WAIT_L(n) asm volatile("s_waitcnt lgkmcnt(" #n ")" ::: "memory")
#define PG8_BAR __builtin_amdgcn_s_barrier()
#define PG8_SCHED __builtin_amdgcn_sched_barrier(0)
    GUnit cur, nxt; int ui = 0;
    if (!S.next(0, cur)) return;
    f32x4 acc[2][2][4];
#pragma unroll
    for (int a = 0; a < 2; ++a)
#pragma unroll
        for (int m = 0; m < 2; ++m)
#pragma unroll
            for (int n = 0; n < 4; ++n) acc[a][m][n] = (f32x4){0.f, 0.f, 0.f, 0.f};
    h16x8 At[2][2], B0[4][2];
    const char* cA = cur.A; const char* cB = cur.B;
    PG8_STAGE(PG8_SB(0, 0), cB, voffB); PG8_STAGE(PG8_SA(0, 0), cA, voffA); PG8_STAGE(PG8_SA(0, 1), cA + hstepA, voffA);
    if (hf == 1) PG8_BAR;
    PG8_WAIT_V(2); PG8_BAR;
    PG8_STAGE(PG8_SB(1, 0), cB + kstep, voffB); PG8_STAGE(PG8_SA(1, 0), cA + kstep, voffA);
    PG8_WAIT_V(4); PG8_BAR;
    for (;;) {
        const bool has_next = S.next(ui + 1, nxt);
        const char* nA = has_next ? nxt.A : cA; const char* nB = has_next ? nxt.B : cB;
        const int nt = cur.nt;
        for (int t = 0; t < nt; t += 2) {
            const bool last = (t == nt - 2);
            const char* a1 = cA + (size_t)(t + 1) * kstep;
            const char* a2 = last ? nA : cA + (size_t)(t + 2) * kstep; const char* b2 = last ? nB : cB + (size_t)(t + 2) * kstep;
            const char* a3 = a2 + kstep; const char* b3 = b2 + kstep;
            PG8_LDB(B0, 0, 0); PG8_SCHED; PG8_LDA(At, 0, 0); PG8_STAGE(PG8_SA(1, 1), a1 + hstepA, voffA);
            PG8_WAIT_V(6); PG8_WAIT_L(0); PG8_BAR; PG8_MMA(0, At, B0); PG8_BAR; PG8_SCHED;
            PG8_LDA(At, 0, 1); PG8_STAGE(PG8_SB(0, 0), b2, voffB); PG8_STAGE(PG8_SA(0, 0), a2, voffA);
            PG8_WAIT_V(6); PG8_WAIT_L(0); PG8_BAR; PG8_MMA(1, At, B0); PG8_BAR; PG8_SCHED;
            PG8_LDB(B0, 1, 0); PG8_SCHED; PG8_LDA(At, 1, 0); PG8_STAGE(PG8_SA(0, 1), a2 + hstepA, voffA);
            PG8_WAIT_V(6); PG8_WAIT_L(0); PG8_BAR; PG8_MMA(0, At, B0); PG8_BAR; PG8_SCHED;
            PG8_LDA(At, 1, 1); PG8_STAGE(PG8_SB(1, 0), b3, voffB); PG8_STAGE(PG8_SA(1, 0), a3, voffA);
            PG8_WAIT_V(6); PG8_WAIT_L(0); PG8_BAR; PG8_MMA(1, At, B0); PG8_BAR; PG8_SCHED;
        }
        if (PG8_ALIGN) { if (hf == 0) PG8_BAR; }
        E(acc, cur, wr, wc, fr, fq);
        if (!has_next) break;
        cur = nxt; cA = nA; cB = nB; ++ui;
        if (PG8_ALIGN) { if (hf == 1) PG8_BAR; }
    }
    PG8_WAIT_V(0);
    if (!PG8_ALIGN) { if (hf == 0) PG8_BAR; }
    PG8_BAR;
#undef PG8_SA
#undef PG8_SB
#undef PG8_STAGE
#undef PG8_LDA
#undef PG8_LDB
#undef PG8_MMA
#undef PG8_WAIT_V
#undef PG8_WAIT_L
#undef PG8_BAR
#undef PG8_SCHED
}
}
using pg8::GUnit;

struct SchedPlain {
    static constexpr bool GATHER = false;
    __device__ __forceinline__ unsigned a_off(const GUnit&, int) const { return 0u; }
    const char* A; const char* B; int lda, ldb, nt, pm0, nM, nN, G, c;
    __device__ __forceinline__ bool next(int i, GUnit& u) const {
        const int L = i * G + c; if (L >= nM * nN) return false;
        int pm, pn; pg8::tile_map(L, nM, nN, pm, pn);
        u.pm = pm0 + pm; u.pn = pn; u.kind = 0; u.aux = 0; u.nt = nt;
        u.A = A + (size_t)u.pm * 256 * lda * 2; u.B = B + (size_t)pn * 256 * ldb * 2; return true;
    }
};
struct SchedMerge {
    static constexpr bool GATHER = false;
    __device__ __forceinline__ unsigned a_off(const GUnit&, int) const { return 0u; }
    const char* A; const char* B; int pm0, nM, G, c;
    __device__ __forceinline__ bool next(int i, GUnit& u) const {
        const int ti = i / 6, sub = i - ti * 6, L = ti * G + c; if (L >= nM * 4) return false;
        int pm, pn; pg8::tile_map(L, nM, 4, pm, pn);
        const int n = sub >> 1, br = sub & 1;
        u.pm = pm0 + pm; u.pn = pn; u.kind = sub; u.aux = n; u.nt = br ? 8 : 16;
        u.A = A + ((size_t)u.pm * 256 * AW + (br ? AY0 + n * 512 : AH)) * 2;
        u.B = B + ((size_t)(n * 1024 + pn * 256) * 1536 + (br ? 1024 : 0)) * 2; return true;
    }
};
struct SchedMoe {
    static constexpr bool GATHER = false;
    __device__ __forceinline__ unsigned a_off(const GUnit&, int) const { return 0u; }
    const char* A; const char* B; const int* panelE; int lda, ldb, nt, pm0, arow_pm0, nM, nN, G, c; size_t estride; int ks_shift;
    __device__ __forceinline__ bool next(int i, GUnit& u) const {
        const int Lq = i * G + c; if (Lq >= ((nM * nN) << ks_shift)) return false;
        const int q = Lq & ((1 << ks_shift) - 1), L = Lq >> ks_shift;
        int pm, pn; pg8::tile_map(L, nM, nN, pm, pn);
        u.pm = pm0 + pm; u.pn = pn; u.kind = 0; u.aux = q; u.nt = nt >> ks_shift;
        const int e = panelE[u.pm]; const size_t koff = (size_t)q * (nt >> ks_shift) * 128;
        u.A = A + (size_t)(u.pm - arow_pm0) * 256 * lda * 2 + koff; u.B = B + (size_t)e * estride + (size_t)pn * 256 * ldb * 2 + koff; return true;
    }
};

#define EPI_ARGS const f32x4 (&acc)[2][2][4][2], const GUnit& u, int wr, int wc, int fr, int fq
struct EpiF16 {
    static constexpr bool PERM = true;
    h16* O; int ldc;
    __device__ __forceinline__ void operator()(EPI_ARGS) const {
        const int row0 = u.pm * 256 + wr * 64 + fr, col0 = u.pn * 256 + wc * 32 + 8 * fq;
#pragma unroll
        for (int ai = 0; ai < 2; ++ai)
#pragma unroll
            for (int m = 0; m < 4; ++m) { h16* rowp = O + (size_t)(row0 + ai * 128 + m * 16) * ldc + col0;
#pragma unroll
                for (int bj = 0; bj < 2; ++bj) { const f32x4 v0 = acc[ai][bj][m][0], v1 = acc[ai][bj][m][1];
                    u32x4 w; w.x = pg8::cvt_pk_f16(v0[0], v0[1]); w.y = pg8::cvt_pk_f16(v0[2], v0[3]); w.z = pg8::cvt_pk_f16(v1[0], v1[1]); w.w = pg8::cvt_pk_f16(v1[2], v1[3]);
                    *(u32x4*)(rowp + bj * 128) = w; } }
    }
};
struct EpiMerge {
    static constexpr bool PERM = true;
    const float* bmerge;
    char* priv;
    h16* S16;
    __device__ __forceinline__ void operator()(EPI_ARGS) const {
        unsigned off0 = (unsigned)threadIdx.x * 16u; asm volatile("" : "+v"(off0));
        u32x4* pg = (u32x4*)(priv + off0); u32x4* ps = (u32x4*)(priv + 131072 + off0);
        if ((u.kind & 1) == 0) {
            const float* bb = bmerge + u.aux * 1024 + u.pn * 256 + wc * 32 + 8 * fq;
#pragma unroll
            for (int bj = 0; bj < 2; ++bj) { const f32x4 b0 = *(const f32x4*)(bb + bj * 128), b1 = *(const f32x4*)(bb + bj * 128 + 4);
#pragma unroll
                for (int ai = 0; ai < 2; ++ai)
#pragma unroll
                    for (int m = 0; m < 4; ++m) { f32x4 v0 = acc[ai][bj][m][0] + b0, v1 = acc[ai][bj][m][1] + b1;
#pragma unroll
                        for (int j = 0; j < 4; ++j) { v0[j] = sigmoidf_(v0[j]); v1[j] = sigmoidf_(v1[j]); }
                        u32x4 w; w.x = pg8::cvt_pk_f16(v0[0], v0[1]); w.y = pg8::cvt_pk_f16(v0[2], v0[3]); w.z = pg8::cvt_pk_f16(v1[0], v1[1]); w.w = pg8::cvt_pk_f16(v1[2], v1[3]);
                        pg[((ai * 2 + bj) * 4 + m) * 512] = w; } }
        } else {
            const int row0 = u.pm * 256 + wr * 64 + fr, col0 = u.pn * 256 + wc * 32 + 8 * fq;
#pragma unroll
            for (int ai = 0; ai < 2; ++ai) {
                u32x4 gw[2][4], sw[2][4];
#pragma unroll
                for (int bj = 0; bj < 2; ++bj)
#pragma unroll
                    for (int m = 0; m < 4; ++m) { const int slot = (ai * 2 + bj) * 4 + m; gw[bj][m] = pg[slot * 512]; if (u.kind != 1) sw[bj][m] = ps[slot * 512]; }
#pragma unroll
                for (int bj = 0; bj < 2; ++bj)
#pragma unroll
                    for (int m = 0; m < 4; ++m) { const int slot = (ai * 2 + bj) * 4 + m;
                        const h16x8 g = __builtin_bit_cast(h16x8, gw[bj][m]);
                        f32x4 s0 = acc[ai][bj][m][0], s1 = acc[ai][bj][m][1];
#pragma unroll
                        for (int j = 0; j < 4; ++j) { s0[j] *= (float)g[j]; s1[j] *= (float)g[4 + j]; }
                        if (u.kind != 1) { const h16x8 sp = __builtin_bit_cast(h16x8, sw[bj][m]);
#pragma unroll
                            for (int j = 0; j < 4; ++j) { s0[j] += (float)sp[j]; s1[j] += (float)sp[4 + j]; } }
                        u32x4 o; o.x = pg8::cvt_pk_f16(s0[0], s0[1]); o.y = pg8::cvt_pk_f16(s0[2], s0[3]); o.z = pg8::cvt_pk_f16(s1[0], s1[1]); o.w = pg8::cvt_pk_f16(s1[2], s1[3]);
                        if (u.kind != 5) ps[slot * 512] = o;
                        else *(u32x4*)(S16 + (size_t)(row0 + ai * 128 + m * 16) * 1024 + col0 + bj * 128) = o; }
                asm volatile("" ::: "memory"); }
        }
    }
};
struct SchedMergeH {
    const char* A; const char* B; int pm0, nM, G, c;
    __device__ __forceinline__ bool next(int i, GUnit& u) const {
        const int ti = i / 6, sub = i - ti * 6, L = ti * G + c; if (L >= nM * 8) return false;
        int pm, pn; pg8::tile_map(L, nM, 8, pm, pn);
        const int n = sub >> 1, br = sub & 1;
        u.pm = pm0 + pm; u.pn = pn; u.kind = sub; u.aux = n; u.nt = br ? 8 : 16;
        u.A = A + ((size_t)u.pm * 256 * AW + (br ? AY0 + n * 512 : AH)) * 2;
        u.B = B + ((size_t)(n * 1024 + pn * 128) * 1536 + (br ? 1024 : 0)) * 2; return true;
    }
};
struct EpiMergeH {
    const float* bmerge; h16* S16;
    mutable u32x2 gk[2][2][4];
    mutable f32x4 sk[2][2][4];
    __device__ __forceinline__ void operator()(f32x4 (&acc)[2][2][4], const GUnit& u, int wr, int wc, int fr, int fq) const {
        if ((u.kind & 1) == 0) {
            const float* bb = bmerge + u.aux * 1024 + u.pn * 128 + wc * 64 + 8 * fq;
            f32x4 bv[4];
#pragma unroll
            for (int n = 0; n < 4; ++n) bv[n] = *(const f32x4*)(bb + (n >> 1) * 32 + (n & 1) * 4);
#pragma unroll
            for (int ai = 0; ai < 2; ++ai)
#pragma unroll
                for (int m = 0; m < 2; ++m)
#pragma unroll
                    for (int n = 0; n < 4; ++n) { f32x4 v = acc[ai][m][n] + bv[n];
#pragma unroll
                        for (int j = 0; j < 4; ++j) v[j] = sigmoidf_(v[j]);
                        u32x2 w; w.x = pg8::cvt_pk_f16(v[0], v[1]); w.y = pg8::cvt_pk_f16(v[2], v[3]); gk[ai][m][n] = w; acc[ai][m][n] = (f32x4){0.f, 0.f, 0.f, 0.f}; }
        } else {
            const int row0 = u.pm * 256 + wr * 32 + fr, col0 = u.pn * 128 + wc * 64 + 8 * fq;
#pragma unroll
            for (int ai = 0; ai < 2; ++ai)
#pragma unroll
                for (int m = 0; m < 2; ++m)
#pragma unroll
                    for (int g2 = 0; g2 < 2; ++g2) { f32x4 s[2];
#pragma unroll
                        for (int q = 0; q < 2; ++q) { const int n = g2 * 2 + q; const h16x4 g = __builtin_bit_cast(h16x4, gk[ai][m][n]); f32x4 v = acc[ai][m][n];
#pragma unroll
                            for (int j = 0; j < 4; ++j) v[j] *= (float)g[j];
                            if (u.kind != 1) v += sk[ai][m][n];
                            sk[ai][m][n] = v; s[q] = v; acc[ai][m][n] = (f32x4){0.f, 0.f, 0.f, 0.f}; }
                        if (u.kind == 5) { u32x4 o; o.x = pg8::cvt_pk_f16(s[0][0], s[0][1]); o.y = pg8::cvt_pk_f16(s[0][2], s[0][3]); o.z = pg8::cvt_pk_f16(s[1][0], s[1][1]); o.w = pg8::cvt_pk_f16(s[1][2], s[1][3]);
                            *(u32x4*)(S16 + (size_t)(row0 + ai * 128 + m * 16) * 1024 + col0 + g2 * 32) = o; } }
        }
    }
};
struct EpiScaled {
    static constexpr bool PERM = true;
    h16* Y; const float* modv;
    __device__ __forceinline__ void operator()(EPI_ARGS) const {
        const int row0 = u.pm * 256 + wr * 64 + fr, col0 = u.pn * 256 + wc * 32 + 8 * fq;
        const int g = u.pm < 8 ? 0 : 1 + ((u.pm - 8) >> 4);
        f32x4 mv[2][2];
#pragma unroll
        for (int bj = 0; bj < 2; ++bj)
#pragma unroll
            for (int n = 0; n < 2; ++n) mv[bj][n] = *(const f32x4*)(modv + (size_t)g * 6144 + col0 + bj * 128 + 4 * n);
#pragma unroll
        for (int ai = 0; ai < 2; ++ai)
#pragma unroll
            for (int m = 0; m < 4; ++m) { h16* rowp = Y + (size_t)(row0 + ai * 128 + m * 16) * D + col0;
#pragma unroll
                for (int bj = 0; bj < 2; ++bj) { const f32x4 v0 = acc[ai][bj][m][0] * mv[bj][0], v1 = acc[ai][bj][m][1] * mv[bj][1];
                    u32x4 w; w.x = pg8::cvt_pk_f16(v0[0], v0[1]); w.y = pg8::cvt_pk_f16(v0[2], v0[3]); w.z = pg8::cvt_pk_f16(v1[0], v1[1]); w.w = pg8::cvt_pk_f16(v1[2], v1[3]);
                    *(u32x4*)(rowp + bj * 128) = w; } }
    }
};
struct EpiSwiglu {
    static constexpr bool PERM = true;
    h16* O; int ldc; int orow0;
    __device__ __forceinline__ void operator()(EPI_ARGS) const {
        const int row0 = u.pm * 256 - orow0 + wr * 64 + fr, col0 = u.pn * 128 + wc * 32 + 8 * fq;
#pragma unroll
        for (int ai = 0; ai < 2; ++ai)
#pragma unroll
            for (int m = 0; m < 4; ++m) { float o[8];
#pragma unroll
                for (int n = 0; n < 2; ++n)
#pragma unroll
                    for (int j = 0; j < 4; ++j) o[n * 4 + j] = siluf_(acc[ai][0][m][n][j]) * acc[ai][1][m][n][j];
                u32x4 w; w.x = pg8::cvt_pk_f16(o[0], o[1]); w.y = pg8::cvt_pk_f16(o[2], o[3]); w.z = pg8::cvt_pk_f16(o[4], o[5]); w.w = pg8::cvt_pk_f16(o[6], o[7]);
                *(u32x4*)(O + (size_t)(row0 + ai * 128 + m * 16) * ldc + col0) = w; }
    }
};
struct EpiMoeDown {
    static constexpr bool PERM = true;
    h16* OUT2; const int* rowT; const float* rowP; h16* OUTP; int tail;
    __device__ __forceinline__ void operator()(EPI_ARGS) const {
        const int row0 = u.pm * 256 + wr * 64 + fr, col0 = u.pn * 256 + wc * 32 + 8 * fq;
#pragma unroll
        for (int ai = 0; ai < 2; ++ai)
#pragma unroll
            for (int m = 0; m < 4; ++m) { const int r = row0 + ai * 128 + m * 16; const int tk = rowT[r]; const float pp = rowP[r];
                if (tk < 0) continue;
                h16* rowp = tail ? OUTP + ((size_t)u.aux * 2048 + (r - 65536)) * 1024 + col0 : OUT2 + ((size_t)(tk & 1) * ML + (tk >> 1)) * 1024 + col0;
#pragma unroll
                for (int bj = 0; bj < 2; ++bj) { const f32x4 v0 = acc[ai][bj][m][0] * pp, v1 = acc[ai][bj][m][1] * pp;
                    u32x4 w; w.x = pg8::cvt_pk_f16(v0[0], v0[1]); w.y = pg8::cvt_pk_f16(v0[2], v0[3]); w.z = pg8::cvt_pk_f16(v1[0], v1[1]); w.w = pg8::cvt_pk_f16(v1[2], v1[3]);
                    *(u32x4*)(rowp + bj * 128) = w; } }
    }
};

constexpr int LDS_BYTES = 147456;
constexpr size_t OFF_PRIV = OFF_BIG;
constexpr size_t OFF_YW = OFF_BIG;
__device__ __forceinline__ h16* S16_base(const Params& p, int l) { return l == 0 ? (h16*)p.out : (h16*)p.out - (size_t)MC * D; }
__device__ __forceinline__ h16* YW_base(const Params& p, int l) { return l == 0 ? WSP(h16, OFF_YW) : (h16*)p.out + (size_t)(ML - MC) * D; }
__device__ __forceinline__ void ph_gemm_in(const Params& p, LAS unsigned char* lds, int l, int G, int c) {
    SchedPlain S; S.A = (const char*)(WSP(h16, OFF_A) + AH); S.B = (const char*)WSP(h16, OFF_W16 + l * SZ_LAYERW); S.lda = AW; S.ldb = 1024; S.nt = 16; S.pm0 = 0; S.nM = MT / 256; S.nN = ZW / 256; S.G = G; S.c = c;
    EpiF16 E; E.O = WSP(h16, OFF_Z); E.ldc = ZW;
    pg8::gemm_phase(lds, AW, 1024, S, E);
}
__device__ __forceinline__ void ph_merge(const Params& p, LAS unsigned char* lds, int l, int G, int c) {
    SchedMergeH S; S.A = (const char*)WSP(h16, OFF_A); S.B = (const char*)WSP(h16, OFF_W16 + l * SZ_LAYERW + SZ_WINT); S.pm0 = l == 0 ? 0 : 8; S.nM = MT / 256 - S.pm0; S.G = G; S.c = c;
    EpiMergeH E; E.bmerge = p.b_merge + (size_t)l * 3 * 1024; E.S16 = S16_base(p, l);
    pg8::gemm_phase_h(lds, AW, 1536, S, E);
}
__device__ __forceinline__ void ph_wout(const Params& p, LAS unsigned char* lds, int l, int G, int c) {
    SchedPlain S; S.A = (const char*)S16_base(p, l); S.B = (const char*)WSP(h16, OFF_W16 + l * SZ_LAYERW + SZ_WINT + SZ_BTALL); S.lda = 1024; S.ldb = 1024; S.nt = 16; S.pm0 = l == 0 ? 0 : 8; S.nM = MT / 256 - S.pm0; S.nN = 4; S.G = G; S.c = c;
    EpiScaled E; E.Y = YW_base(p, l); E.modv = WSP(float, OFF_MOD) + (size_t)l * 9 * 6144 + 2 * 1024;
    pg8::gemm_phase(lds, 1024, 1024, S, E);
}
__device__ __forceinline__ void ph_ffn_gu(const Params& p, LAS unsigned char* lds, int G, int c) {
    SchedPlain S; S.A = (const char*)(WSP(h16, OFF_A) + AH); S.B = (const char*)WSP(h16, OFF_WGUT); S.lda = AW; S.ldb = 1024; S.nt = 16; S.pm0 = 0; S.nM = MT / 256; S.nN = 2 * DFF / 256; S.G = G; S.c = c;
    EpiSwiglu E; E.O = WSP(h16, OFF_ACT); E.ldc = DFF; E.orow0 = 0;
    pg8::gemm_phase(lds, AW, 1024, S, E);
}
__device__ __forceinline__ void ph_ffn_down(const Params& p, LAS unsigned char* lds, int G, int c) {
    SchedPlain S; S.A = (const char*)WSP(h16, OFF_ACT); S.B = (const char*)WSP(h16, OFF_WDT); S.lda = DFF; S.ldb = DFF; S.nt = DFF / 64; S.pm0 = 0; S.nM = MT / 256; S.nN = 4; S.G = G; S.c = c;
    EpiScaled E; E.Y = (h16*)p.out; E.modv = WSP(float, OFF_MOD) + 5 * 1024;
    pg8::gemm_phase(lds, DFF, DFF, S, E);
}
__device__ __forceinline__ void ph_moe_gu(const Params& p, LAS unsigned char* lds, int panel0, int G, int c) {
    const int* plan = WSP(int, OFF_PLAN); const int np = plan[8]; int nM = np - panel0; nM = nM > 64 ? 64 : nM; if (nM <= 0) return;
    SchedMoe S; S.A = (const char*)WSP(h16, OFF_XG); S.B = (const char*)WSP(h16, OFF_WMOE_GU); S.panelE = plan + 16; S.lda = 1024; S.ldb = 1024; S.nt = 16; S.pm0 = panel0; S.arow_pm0 = 0; S.nM = nM; S.nN = 2 * DEX / 256; S.G = G; S.c = c; S.estride = (size_t)2 * DEX * 1024 * 2; S.ks_shift = 0;
    EpiSwiglu E; E.O = (h16*)p.out; E.ldc = DEX; E.orow0 = panel0 * 256;
    pg8::gemm_phase(lds, 1024, 1024, S, E);
}
__device__ __forceinline__ void ph_moe_down(const Params& p, LAS unsigned char* lds, int panel0, int G, int c) {
    const int* plan = WSP(int, OFF_PLAN); const int np = plan[8]; int nM = np - panel0; nM = nM > 64 ? 64 : nM; if (nM <= 0) return;
    const int tail = panel0 >= 256;
    SchedMoe S; S.A = (const char*)p.out; S.B = (const char*)WSP(h16, OFF_WMOE_D); S.panelE = plan + 16; S.lda = DEX; S.ldb = DEX; S.nt = DEX / 64; S.pm0 = panel0; S.arow_pm0 = panel0; S.nM = nM; S.nN = 4; S.G = G; S.c = c; S.estride = (size_t)1024 * DEX * 2; S.ks_shift = tail ? 2 : 0;
    EpiMoeDown E; E.OUT2 = WSP(h16, OFF_OUT2); E.rowT = WSP(int, OFF_ROWT); E.rowP = WSP(float, OFF_ROWP); E.OUTP = WSP(h16, OFF_OUTP); E.tail = tail;
    pg8::gemm_phase(lds, DEX, DEX, S, E);
}

namespace attn_body {
using s16x4 = __attribute__((ext_vector_type(4))) short;
using s16x8 = __attribute__((ext_vector_type(8))) short;
using f32x16 = __attribute__((ext_vector_type(16))) float;
constexpr int D64 = 64, NW = 8, QBLK = 32, QB = QBLK * NW, KVBLK = 64;
constexpr int QP = 512, KP = 128, OP = AW;
__device__ __forceinline__ int crow(int r, int hi) { return (r & 3) + 8 * (r >> 2) + 4 * hi; }
#define SBAR() __builtin_amdgcn_sched_barrier(0)
constexpr int NSLOT = 3, SLOTB = 8192;
constexpr int LDS_K = 0, LDS_V = NSLOT * SLOTB, LDS_WS = 2 * NSLOT * SLOTB, LDS_OST = LDS_WS + NW * 64 * 4, ATTN_LDS_BYTES = LDS_OST + NW * 4096;
__device__ __forceinline__ void glds16(const void* gsrc, unsigned lds_dst) { unsigned keep;
    asm volatile("s_mov_b32 %0, m0\n\ts_mov_b32 m0, %2\n\ts_nop 0\n\tglobal_load_lds_dwordx4 %1, off\n\ts_mov_b32 m0, %0" : "=&s"(keep) : "v"(gsrc), "s"(lds_dst) : "memory"); }
__device__ __forceinline__ float max3f(float a, float b, float c) { float r; asm("v_max3_f32 %0, %1, %2, %3" : "=v"(r) : "v"(a), "v"(b), "v"(c)); return r; }
__device__ __forceinline__ float max2f(float a, float b) { float r; asm("v_max_f32_e32 %0, %1, %2" : "=v"(r) : "v"(a), "v"(b)); return r; }
__device__ __forceinline__ float fadd_s(float a, float b) { float r; asm("v_add_f32_e32 %0, %1, %2" : "=v"(r) : "v"(a), "v"(b)); return r; }
__device__ __forceinline__ float fsub_s(float a, float b) { float r; asm("v_sub_f32_e32 %0, %1, %2" : "=v"(r) : "v"(a), "v"(b)); return r; }
__device__ __forceinline__ unsigned cvtpk_s(float lo, float hi) { return pg8::cvt_pk_f16(lo, hi); }
#define WAIT_BAR(N) asm volatile("s_waitcnt vmcnt(" #N ") lgkmcnt(0)\n\ts_barrier" ::: "memory")
#define AMFMA(a, b, c) __builtin_amdgcn_mfma_f32_32x32x16_f16(__builtin_bit_cast(h16x8, a), __builtin_bit_cast(h16x8, b), c, 0, 0, 0)
__device__ __forceinline__ void qkt(f32x16& p0, f32x16& p1, const char* Kslot, const s16x8* qr, const f32x16& negm, int r32, int hi) {
    const char* kb = Kslot + hi * 1024 + r32 * 16;
#pragma unroll
    for (int d0 = 0; d0 < 4; ++d0) {
        const s16x8 b0 = *reinterpret_cast<const s16x8*>(kb + d0 * 2048);
        const s16x8 b1 = *reinterpret_cast<const s16x8*>(kb + d0 * 2048 + 512);
        if (d0 == 0) { p0 = AMFMA(b0, qr[0], negm); p1 = AMFMA(b1, qr[0], negm); }
        else { p0 = AMFMA(b0, qr[d0], p0); p1 = AMFMA(b1, qr[d0], p1); } }
}
typedef __attribute__((address_space(3))) const char* lds_cptr;
typedef short v4i16_t __attribute__((ext_vector_type(4)));
__device__ __forceinline__ void kload8(s16x8* kf, lds_cptr kp) {
    kf[0] = *(const __attribute__((address_space(3))) s16x8*)(kp);        kf[1] = *(const __attribute__((address_space(3))) s16x8*)(kp + 512);
    kf[2] = *(const __attribute__((address_space(3))) s16x8*)(kp + 2048); kf[3] = *(const __attribute__((address_space(3))) s16x8*)(kp + 2560);
    kf[4] = *(const __attribute__((address_space(3))) s16x8*)(kp + 4096); kf[5] = *(const __attribute__((address_space(3))) s16x8*)(kp + 4608);
    kf[6] = *(const __attribute__((address_space(3))) s16x8*)(kp + 6144); kf[7] = *(const __attribute__((address_space(3))) s16x8*)(kp + 6656);
}
__device__ __forceinline__ void kload2(s16x8* kf, lds_cptr kp, int j) { kf[2 * j] = *(const __attribute__((address_space(3))) s16x8*)(kp + j * 2048); kf[2 * j + 1] = *(const __attribute__((address_space(3))) s16x8*)(kp + j * 2048 + 512); }
__device__ __forceinline__ s16x4 vtr(lds_cptr p) { return __builtin_bit_cast(s16x4, __builtin_amdgcn_ds_read_tr16_b64_v4i16((__attribute__((address_space(3))) v4i16_t*)p)); }
__device__ __forceinline__ float rowmax(const f32x16& p0, const f32x16& p1) {
    float a = max3f(p0[0], p0[1], p1[0]), b = max3f(p0[2], p0[3], p1[1]); a = max3f(a, p1[2], p1[3]);
#pragma unroll
    for (int r = 4; r < 16; r += 4) { a = max3f(a, p0[r], p0[r + 1]); b = max3f(b, p0[r + 2], p0[r + 3]); a = max3f(a, p1[r], p1[r + 1]); b = max3f(b, p1[r + 2], p1[r + 3]); }
    const float m = max2f(a, b);
    auto rr = __builtin_amdgcn_permlane32_swap(__float_as_uint(m), __float_as_uint(m), false, false);
    return max2f(__uint_as_float(rr[0]), __uint_as_float(rr[1]));
}
__device__ __forceinline__ void pv(f32x16* o, int vb, s16x8 pa0, s16x8 pa1, s16x8 pa2, s16x8 pa3) {
#pragma unroll
    for (int d0 = 0; d0 < 2; ++d0) { s16x4 lo[4], hi[4];
#pragma unroll
        for (int ks = 0; ks < 4; ++ks) {
            asm volatile("ds_read_b64_tr_b16 %0,%1 offset:%c2" : "=&v"(lo[ks]) : "v"(vb), "i"(d0 * 4096 + ks * 1024) : "memory");
            asm volatile("ds_read_b64_tr_b16 %0,%1 offset:%c2" : "=&v"(hi[ks]) : "v"(vb), "i"(d0 * 4096 + ks * 1024 + 512) : "memory"); }
        asm volatile("s_waitcnt lgkmcnt(0)" ::: "memory"); SBAR();
#define PK(k) (s16x8){lo[k][0], lo[k][1], lo[k][2], lo[k][3], hi[k][0], hi[k][1], hi[k][2], hi[k][3]}
        o[d0] = AMFMA(pa0, PK(0), o[d0]);
        o[d0] = AMFMA(pa1, PK(1), o[d0]);
        o[d0] = AMFMA(pa2, PK(2), o[d0]);
        o[d0] = AMFMA(pa3, PK(3), o[d0]);
#undef PK
    }
}
template <int THRL> __device__ __forceinline__ void attn_unit(const h16* Qu, const h16* __restrict__ Ku, const h16* __restrict__ Vu, h16* Ou, const int NT, char* shm) {
    const int tid = threadIdx.x, lane = tid & 63, r32 = lane & 31, hi = lane >> 5; const int wid = __builtin_amdgcn_readfirstlane(tid >> 6);
    const h16* Qw = Qu + (size_t)(wid * QBLK) * QP;
    const unsigned lds0 = (unsigned)(uintptr_t)shm;
    float* wsf = (float*)(shm + LDS_WS) + wid * 64;
    const h16* ksrc = Ku + (long)lane * KP + wid * 8;
    const h16* vsrc = Vu + (long)(16 * (wid & 3) + (lane >> 2)) * KP + (wid >> 2) * 32 + (lane & 3) * 8;
    const unsigned kdst = lds0 + LDS_K + wid * 1024, vdst = lds0 + LDS_V + wid * 1024;
#define DMA_K(t, slot) glds16(ksrc + (long)(t) * KVBLK * KP, (unsigned)__builtin_amdgcn_readfirstlane(kdst + (slot)))
#define DMA_V(t, slot) glds16(vsrc + (long)(t) * KVBLK * KP, (unsigned)__builtin_amdgcn_readfirstlane(vdst + (slot)))
    const int vb0 = (int)(lds0 + LDS_V) + ((lane >> 4) & 1) * 32 + (lane & 3) * 8 + (4 * hi + ((lane & 15) >> 2)) * 64;
    const char* Kbase = shm + LDS_K; s16x8 kf[8];
    const lds_cptr shm3 = (lds_cptr)shm; const lds_cptr kp0 = shm3 + LDS_K + hi * 1024 + r32 * 16; const lds_cptr vp0 = shm3 + LDS_V + ((lane >> 4) & 1) * 32 + (lane & 3) * 8 + (4 * hi + ((lane & 15) >> 2)) * 64;
    DMA_K(0, 0); DMA_V(0, 0); DMA_K(1, SLOTB);
    s16x8 qr[4];
#pragma unroll
    for (int d0 = 0; d0 < 4; ++d0) qr[d0] = *reinterpret_cast<const s16x8*>(&Qw[(long)r32 * QP + d0 * 16 + hi * 8]);
    float mhat = 0.f, l_reg = 0.f; f32x16 o[2]; o[0] = f32x16{}; o[1] = f32x16{}; f32x16 negm = f32x16{}; asm volatile("" : "+v"(negm));
    bool resc = false;
#define START(P0, P1) do { const float rm = rowmax(P0, P1); resc = false; \
    { const float dl = rm; mhat = fadd_s(mhat, dl); \
      _Pragma("unroll") for (int r = 0; r < 16; ++r) { P0[r] = fsub_s(P0[r], dl); P1[r] = fsub_s(P1[r], dl); } \
      _Pragma("unroll") for (int r = 0; r < 16; ++r) negm[r] = -mhat; asm volatile("" : "+v"(negm)); } \
    _Pragma("unroll") for (int r = 0; r < 16; ++r) P0[r] = __builtin_amdgcn_exp2f(P0[r]); } while (0)
#define RESC() do { if (resc) { asm volatile("s_waitcnt lgkmcnt(0)" ::: "memory"); \
      _Pragma("unroll") for (int d_ = 0; d_ < 2; ++d_) _Pragma("unroll") for (int r = 0; r < 16; ++r) o[d_][r] *= wsf[crow(r, hi)]; } } while (0)
    f32x16 pA0, pA1, pB0, pB1;
    int sl_prev = 0, sl_cur = 0, sl_next = SLOTB;
#define ROT() do { sl_prev = sl_cur; sl_cur = sl_next; sl_next = (sl_next == (NSLOT - 1) * SLOTB) ? 0 : sl_next + SLOTB; } while (0)
    DMA_K(2, 2 * SLOTB);
    WAIT_BAR(3);
    qkt(pA0, pA1, Kbase, qr, negm, r32, hi); asm volatile("s_nop 15\n\ts_nop 7" : "+v"(pA0), "+v"(pA1));
    START(pA0, pA1);
    _Pragma("unroll") for (int r = 0; r < 16; ++r) pA1[r] = __builtin_amdgcn_exp2f(pA1[r]);
    WAIT_BAR(0);
    DMA_K(3, 0); DMA_V(1, SLOTB);
    ROT();
    kload8(kf, kp0 + sl_cur);
    WAIT_BAR(2);
    s16x4 vlo[8], vhi[8]; u32x4 pw0, pw1, pw2, pw3;
#define PKW(P, B) cvtpk_s(P[B], P[B + 1])
#define PAF(k) __builtin_bit_cast(s16x8, pw##k)
#define VFR(i) (s16x8){vlo[i][0], vlo[i][1], vlo[i][2], vlo[i][3], vhi[i][0], vhi[i][1], vhi[i][2], vhi[i][3]}
#define PIN(x) asm volatile("" : "+v"(x))
#define MX3(a, b, c) __builtin_fmaxf(__builtin_fmaxf((a), (b)), (c))
#define GAPA(MF, A0, A1, A2, A3, W0, W1, PW) do { MF; sacc += A0; sacc += A1; sacc += A2; sacc += A3; PIN(sacc); W0; W1; PIN(PW); SBAR(); } while (0)
#define EX(v) __builtin_amdgcn_exp2f(v)
#define GAPB(MF, X, B) do { MF; X[B] = EX(X[B]); X[B + 1] = EX(X[B + 1]); X[B + 2] = EX(X[B + 2]); X[B + 3] = EX(X[B + 3]); PIN(X); SBAR(); } while (0)
#define VRD(i) do { vlo[i] = vtr(vp_ + (((i) >> 2) * 4096 + ((i) & 3) * 1024)); vhi[i] = vtr(vp_ + (((i) >> 2) * 4096 + ((i) & 3) * 1024 + 512)); } while (0)
#define KRD(G, j) do { if (G) { kload2(kf, kp0 + sl_next, j); SBAR(); } } while (0)
#define STEP(C0, C1, P0, P1, t, GK, GV, GL) do { SBAR(); \
    const lds_cptr vp_ = vp0 + sl_prev; \
    VRD(0); SBAR(); float sacc = (P0[0] + P0[1]); \
    GAPA(C0 = AMFMA(kf[0], qr[0], negm), P0[2], P0[3], P0[4], P0[5],     pw0[0] = PKW(P0, 0), pw0[1] = PKW(P0, 2), pw0); \
    VRD(4); SBAR(); GAPA(C1 = AMFMA(kf[1], qr[0], negm), P0[6], P0[7], P0[8], P0[9],     pw0[2] = PKW(P0, 4), pw0[3] = PKW(P0, 6), pw0); \
    VRD(1); SBAR(); GAPA(C0 = AMFMA(kf[2], qr[1], C0),   P0[10], P0[11], P0[12], P0[13], pw1[0] = PKW(P0, 8), pw1[1] = PKW(P0, 10), pw1); \
    VRD(5); SBAR(); GAPA(C1 = AMFMA(kf[3], qr[1], C1),   P0[14], P0[15], P1[0], P1[1],   pw1[2] = PKW(P0, 12), pw1[3] = PKW(P0, 14), pw1); \
    VRD(2); SBAR(); GAPA(C0 = AMFMA(kf[4], qr[2], C0),   P1[2], P1[3], P1[4], P1[5],     pw2[0] = PKW(P1, 0), pw2[1] = PKW(P1, 2), pw2); \
    VRD(6); SBAR(); GAPA(C1 = AMFMA(kf[5], qr[2], C1),   P1[6], P1[7], P1[8], P1[9],     pw2[2] = PKW(P1, 4), pw2[3] = PKW(P1, 6), pw2); \
    VRD(3); SBAR(); GAPA(C0 = AMFMA(kf[6], qr[3], C0),   P1[10], P1[11], P1[12], P1[13], pw3[0] = PKW(P1, 8), pw3[1] = PKW(P1, 10), pw3); \
    VRD(7); SBAR(); GAPA(C1 = AMFMA(kf[7], qr[3], C1),   P1[14], P1[15], 0.f, 0.f,       pw3[2] = PKW(P1, 12), pw3[3] = PKW(P1, 14), pw3); \
    l_reg += sacc; \
    if (GK) { DMA_K((t) + 3, sl_cur); } if (GV) { DMA_V((t) + 1, sl_next); } \
    { float a = MX3(C0[0], C0[1], C1[0]), b = MX3(C0[2], C0[3], C1[1]); a = MX3(a, C1[2], C1[3]); \
      _Pragma("unroll") for (int r = 4; r < 16; r += 4) { a = MX3(a, C0[r], C0[r + 1]); b = MX3(b, C0[r + 2], C0[r + 3]); a = MX3(a, C1[r], C1[r + 1]); b = MX3(b, C1[r + 2], C1[r + 3]); } \
      float rm = __builtin_fmaxf(a, b); { auto rr = __builtin_amdgcn_permlane32_swap(__float_as_uint(rm), __float_as_uint(rm), false, false); rm = __builtin_fmaxf(__uint_as_float(rr[0]), __uint_as_float(rr[1])); } \
      resc = false; \
      if (__builtin_expect(__any(rm > (float)THRL), 0)) { const float dl = __builtin_fmaxf(rm, 0.f); mhat += dl; \
        _Pragma("unroll") for (int r = 0; r < 16; ++r) { C0[r] -= dl; C1[r] -= dl; } \
        _Pragma("unroll") for (int r = 0; r < 16; ++r) negm[r] = -mhat; asm volatile("" : "+v"(negm)); \
        const float f = __builtin_amdgcn_exp2f(-dl); l_reg *= f; if (hi == 0) wsf[r32] = f; resc = true; } } \
    SBAR(); \
    GAPB(o[0] = AMFMA(PAF(0), VFR(0), o[0]), C0, 0); \
    GAPB(o[1] = AMFMA(PAF(0), VFR(4), o[1]), C0, 4); \
    KRD(GL, 0); GAPB(o[0] = AMFMA(PAF(1), VFR(1), o[0]), C0, 8); \
    KRD(GL, 1); GAPB(o[1] = AMFMA(PAF(1), VFR(5), o[1]), C0, 12); \
    KRD(GL, 2); GAPB(o[0] = AMFMA(PAF(2), VFR(2), o[0]), C1, 0); \
    KRD(GL, 3); GAPB(o[1] = AMFMA(PAF(2), VFR(6), o[1]), C1, 4); \
    GAPB(o[0] = AMFMA(PAF(3), VFR(3), o[0]), C1, 8); \
    GAPB(o[1] = AMFMA(PAF(3), VFR(7), o[1]), C1, 12); \
    } while (0)
    int t = 1;
    for (; t + 5 < NT; t += 2) {
        STEP(pB0, pB1, pA0, pA1, t, true, true, true);     WAIT_BAR(2); RESC(); ROT();
        STEP(pA0, pA1, pB0, pB1, t + 1, true, true, true); WAIT_BAR(2); RESC(); ROT();
    }
#define ENDW(tt) do { if ((tt) + 3 < NT) { WAIT_BAR(2); } else if ((tt) + 2 < NT) { WAIT_BAR(1); } else { WAIT_BAR(0); } } while (0)
    for (; t + 1 < NT; t += 2) {
        STEP(pB0, pB1, pA0, pA1, t, (t + 3 < NT), (t + 1 < NT), (t + 1 < NT));         ENDW(t);     RESC(); ROT();
        STEP(pA0, pA1, pB0, pB1, t + 1, (t + 4 < NT), (t + 2 < NT), (t + 2 < NT));     ENDW(t + 1); RESC(); ROT();
    }
    STEP(pB0, pB1, pA0, pA1, NT - 1, false, false, false); RESC();
    { float sacc = pB0[0] + pB0[1]; _Pragma("unroll") for (int r = 2; r < 16; ++r) sacc += pB0[r]; _Pragma("unroll") for (int r = 0; r < 16; ++r) sacc += pB1[r]; l_reg += sacc;
      pw0 = (u32x4){PKW(pB0, 0), PKW(pB0, 2), PKW(pB0, 4), PKW(pB0, 6)}; pw1 = (u32x4){PKW(pB0, 8), PKW(pB0, 10), PKW(pB0, 12), PKW(pB0, 14)}; pw2 = (u32x4){PKW(pB1, 0), PKW(pB1, 2), PKW(pB1, 4), PKW(pB1, 6)}; pw3 = (u32x4){PKW(pB1, 8), PKW(pB1, 10), PKW(pB1, 12), PKW(pB1, 14)};
      SBAR(); pv(o, vb0 + sl_cur, PAF(0), PAF(1), PAF(2), PAF(3)); }
#undef PKW
#undef PAF
#undef VFR
#undef PIN
#undef MX3
#undef GAPA
#undef GAPB
#undef EX
#undef VRD
#undef KRD
#undef STEP
#undef ENDW
    { auto rr = __builtin_amdgcn_permlane32_swap(__float_as_uint(l_reg), __float_as_uint(l_reg), false, false); l_reg = __uint_as_float(rr[0]) + __uint_as_float(rr[1]); }
    if (hi == 0) wsf[32 + r32] = l_reg; asm volatile("s_waitcnt lgkmcnt(0)" ::: "memory");
    float rli[16];
#pragma unroll
    for (int r = 0; r < 16; ++r) rli[r] = __builtin_amdgcn_rcpf(wsf[32 + crow(r, hi)]);
    h16* Ow = Ou + (size_t)(wid * QBLK) * OP;
    { h16* stg = (h16*)(shm + LDS_OST) + wid * 2048;
#pragma unroll
      for (int r = 0; r < 16; ++r) { const int orow = crow(r, hi);
#pragma unroll
        for (int d0 = 0; d0 < 2; ++d0) stg[orow * 64 + d0 * 32 + r32] = (h16)(o[d0][r] * rli[r]); }
      asm volatile("s_waitcnt lgkmcnt(0)" ::: "memory");
#pragma unroll
      for (int i = 0; i < 4; ++i) { const int row = i * 8 + (lane >> 3), ch = lane & 7; const u32x4 v = *(const u32x4*)(stg + row * 64 + ch * 8); *(u32x4*)(Ow + (long)row * OP + ch * 8) = v; } }
    asm volatile("s_waitcnt lgkmcnt(0)\n\ts_barrier" ::: "memory");
#undef DMA_K
#undef DMA_V
#undef START
#undef RESC
#undef ROT
}
#undef SBAR
#undef WAIT_BAR
#undef AMFMA
}

__device__ __forceinline__ void ph_attn(const Params& p, char* shm, int l, int G, int c) {
    const h16* Qh = WSP(h16, OFF_QH); const h16* Kh = WSP(h16, OFF_KH); const h16* Vh = WSP(h16, OFF_VH); h16* A = WSP(h16, OFF_A);
    const int x = c & 7, j0 = c >> 3, nx = (G + 7 - x) >> 3;
    for (int j = j0; j < 128; j += nx) {
        const int set = 2 * x + (j >> 6), un = j & 63, b = set >> 1, kvh = set & 1, hq = kvh * 4 + (un >> 4), qb = un & 15;
        const size_t qrow = (size_t)MC + (size_t)b * SEQ + (size_t)qb * 256;
        attn_body::attn_unit<8>(Qh + qrow * 512 + hq * 64, Kh + (size_t)b * SB * 128 + kvh * 64, Vh + (size_t)b * SB * 128 + kvh * 64, A + qrow * AW + AY1 + hq * 64, SB / 64, shm);
    }
    if (l == 0) for (int u = c; u < 64; u += G) {
        const int b = u >> 3, hq = u & 7, kvh = hq >> 2; const size_t qrow = (size_t)b * CTX;
        attn_body::attn_unit<8>(Qh + qrow * 512 + hq * 64, Kh + (size_t)b * SB * 128 + kvh * 64, Vh + (size_t)b * SB * 128 + kvh * 64, A + qrow * AW + AY1 + hq * 64, CTX / 64, shm);
    }
}

#define XB_TMO      128
#define XB_XCNT(j)  (256  + 64 * (j))
#define XB_XSUB(j)  (1280 + 64 * (j))
#define XB_XGEN(j)  (2304 + 64 * (j))
#define XB_TOP      3328
#define XB_TOPGEN   3392
#define XCD_BAR_WORDS 3456
#define XB_SPIN_CAP (1u << 18)
__device__ __forceinline__ unsigned xb_ld(unsigned* p)              { return __hip_atomic_load(p, __ATOMIC_RELAXED, __HIP_MEMORY_SCOPE_AGENT); }
__device__ __forceinline__ unsigned xb_add(unsigned* p, unsigned v) { return __hip_atomic_fetch_add(p, v, __ATOMIC_RELAXED, __HIP_MEMORY_SCOPE_AGENT); }
__device__ __forceinline__ unsigned xb_xcc_id() { return (unsigned)__builtin_amdgcn_s_getreg((3 << 11) | 20) & 0xFu; }
#define XB_SPIN(cond, bar) do { unsigned _sp = 0; while (cond) { __builtin_amdgcn_s_sleep(1); \
    if ((++_sp & 255u) == 0u) { if (xb_ld(&(bar)[XB_TMO])) break; if (_sp > XB_SPIN_CAP) { atomicAdd(&(bar)[XB_TMO], 1u); break; } } } } while (0)
struct XcdBarrier { unsigned* bar; unsigned x; volatile LAS unsigned* st; };
__device__ __forceinline__ XcdBarrier xcd_barrier_post(unsigned* bar, volatile LAS unsigned* st) {
    XcdBarrier b; b.bar = bar; b.x = xb_xcc_id(); b.st = st;
    if (threadIdx.x == 0) (void)xb_add(&bar[XB_XCNT(b.x)], 1u);
    return b;
}
__device__ __forceinline__ void xcd_barrier_complete(unsigned* bar, unsigned x, unsigned& nloc, unsigned& nx) {
    const unsigned G = gridDim.x * gridDim.y * gridDim.z;
    unsigned sum, cnt, mine, sp = 0u;
    for (;;) {
        sum = 0u; cnt = 0u; mine = 0u;
#pragma unroll
        for (unsigned j = 0; j < 16; ++j) { const unsigned c = xb_ld(&bar[XB_XCNT(j)]); sum += c; cnt += (c > 0u) ? 1u : 0u; mine = (j == x) ? c : mine; }
        if (sum == G) break;
        __builtin_amdgcn_s_sleep(1);
        if ((++sp & 255u) == 0u) { if (xb_ld(&bar[XB_TMO])) break; if (sp > XB_SPIN_CAP) { atomicAdd(&bar[XB_TMO], 1u); break; } }
    }
    nloc = mine > 0u ? mine : 1u; nx = cnt > 0u ? cnt : 1u;
}
__device__ __forceinline__ void xcd_barrier(const XcdBarrier& b) {
    asm volatile("s_waitcnt vmcnt(0)" ::: "memory");
    __syncthreads();
    if (threadIdx.x == 0) {
        unsigned* bar = b.bar;
        __builtin_amdgcn_s_waitcnt(0);
        unsigned nloc = b.st[0], nx = b.st[1];
        if (nloc == 0u) { xcd_barrier_complete(bar, b.x, nloc, nx); b.st[0] = nloc; b.st[1] = nx; }
        const unsigned old = xb_add(&bar[XB_XSUB(b.x)], 1u);
        const unsigned gen = old / nloc;
        if (old + 1u == (gen + 1u) * nloc) {
            __builtin_amdgcn_fence(__ATOMIC_RELEASE, "agent");
            asm volatile("s_waitcnt vmcnt(0)" ::: "memory");
            const unsigned og = xb_add(&bar[XB_TOP], 1u);
            const unsigned tg = og / nx;
            if (og + 1u == (tg + 1u) * nx) xb_add(&bar[XB_TOPGEN], 1u);
            else XB_SPIN(xb_ld(&bar[XB_TOPGEN]) == tg, bar);
            __builtin_amdgcn_fence(__ATOMIC_ACQUIRE, "agent");
            xb_add(&bar[XB_XGEN(b.x)], 1u);
            asm volatile("s_waitcnt vmcnt(0)" ::: "memory");
        } else {
            XB_SPIN(xb_ld(&bar[XB_XGEN(b.x)]) == gen, bar);
            __builtin_amdgcn_fence(__ATOMIC_ACQUIRE, "agent");
            asm volatile("s_waitcnt vmcnt(0)" ::: "memory");
        }
    }
    __syncthreads();
}

constexpr int NTH = 512;
template <int NT> __device__ __forceinline__ void poolfold_unit(const Params& p, int u, float (*Ws)[132]) {
    const int l = u / 64, g = (u / 16) % 4, k0 = (u % 16) * 64, tid = threadIdx.x;
    const float* pw = p.pool_w + (size_t)(l * 4 + g) * 128 * 128;
    const int jj = tid & 127;
    __syncthreads();
    for (int i = tid; i < 64 * 32; i += NT) *(float4*)&Ws[i >> 5][(i & 31) * 4] = *(const float4*)(p.w_in + (size_t)l * 1024 * WIN + (size_t)(k0 + (i >> 5)) * WIN + g * 128 + (i & 31) * 4);
    __syncthreads();
    constexpr int NKK = 64 / (NT / 128);
    float acc[NKK];
#pragma unroll
    for (int q = 0; q < NKK; ++q) acc[q] = 0.f;
#pragma unroll 1
    for (int hf = 0; hf < 2; ++hf) {
        float pcol[64];
#pragma unroll
        for (int c2 = 0; c2 < 64; ++c2) pcol[c2] = pw[(hf * 64 + c2) * 128 + jj];
#pragma unroll
        for (int q = 0; q < NKK; ++q) { const int kk = (tid >> 7) + q * (NT / 128);
#pragma unroll
            for (int c4 = 0; c4 < 16; ++c4) { const float4 w4 = *(const float4*)&Ws[kk][hf * 64 + c4 * 4]; acc[q] += w4.x * pcol[c4 * 4] + w4.y * pcol[c4 * 4 + 1] + w4.z * pcol[c4 * 4 + 2] + w4.w * pcol[c4 * 4 + 3]; } }
    }
    h16* wint = WSP(h16, OFF_W16 + l * SZ_LAYERW);
    const float sc = p.pool_scale[l * 512 + g * 128 + jj];
#pragma unroll
    for (int q = 0; q < NKK; ++q) { const int kk = (tid >> 7) + q * (NT / 128); wint[(size_t)(g * 128 + jj) * 1024 + k0 + kk] = (h16)(acc[q] * sc); }
}
__device__ __forceinline__ void cvt_jobs(const Params& p, int j0, int j1, int ubase, int G, int c, float (*tile)[129]) {
    int base = ubase; bool pend = false; CvtJob qp = get_job(p, j0); int tp = 0; float4 v[8];
    for (int j = j0; j < j1; ++j) {
        const CvtJob q = get_job(p, j); const int nt = job_tiles(q);
        const int first = ((c - base % G) + G) % G;
        base += nt;
        for (int t = first; t < nt; t += G) {
            float4 w[8]; cvt_load(q, t, w);
            if (pend) cvt_store(qp, tp, v, tile);
#pragma unroll
            for (int i = 0; i < 8; ++i) v[i] = w[i];
            qp = q; tp = t; pend = true;
        }
    }
    if (pend) cvt_store(qp, tp, v, tile);
}
__device__ __forceinline__ void lru_wt_prep(const Params& p, int G, int c);
__device__ __forceinline__ void ph_prologue(const Params& p, char* shm, int G, int c) {
    if (c == 0 && threadIdx.x < 32) WSP(int, OFF_CNT)[threadIdx.x] = 0;
    for (int u = c; u < 192; u += G) mod_unit<NTH>(p, u, (float*)shm, (float*)shm + 9 * 1024);
    lru_wt_prep(p, G, (c + 64) % G);
}
__device__ __forceinline__ void ph_h0(const Params& p, char* shm, int G, int c) {
    const float* mod = WSP(float, OFF_MOD); h16* A = WSP(h16, OFF_A); const int tid = threadIdx.x, lane = tid & 63, wv = tid >> 6;
    for (int r = c * 32 + wv * 4; r < MT; r += G * 32) {
        float4 xv[4][4];
#pragma unroll
        for (int q = 0; q < 4; ++q) { const float* xr = xin_row(p, r + q);
#pragma unroll
            for (int i = 0; i < 4; ++i) xv[q][i] = *(const float4*)(xr + i * 256 + lane * 4); }
#pragma unroll
        for (int q = 0; q < 4; ++q) { const int g = row_group(r + q);
#pragma unroll
            for (int i = 0; i < 4; ++i) { const int d = i * 256 + lane * 4; const float4 m0 = *(const float4*)(mod + (size_t)g * 6144 + d), m1 = *(const float4*)(mod + (size_t)g * 6144 + 1024 + d);
                h16x4 o; o[0] = (h16)(xv[q][i].x * (1.f + m1.x) + m0.x); o[1] = (h16)(xv[q][i].y * (1.f + m1.y) + m0.y); o[2] = (h16)(xv[q][i].z * (1.f + m1.z) + m0.z); o[3] = (h16)(xv[q][i].w * (1.f + m1.w) + m0.w);
                *(h16x4*)(A + (size_t)(r + q) * AW + AH + d) = o; } }
    }
    for (int u = c; u < 128; u += G) poolfold_unit<NTH>(p, (u + 128) % 128, (float (*)[132])shm);
    cvt_jobs(p, 0, NJOBS_SMALL, 128, G, c, (float (*)[129])shm);
}
constexpr int ROPE_LDS = 138496;
__device__ __forceinline__ void rope_table(char* shm) {
    float2* tab = (float2*)(shm + ROPE_LDS);
    for (int i = threadIdx.x; i < 1024; i += NTH) { const float inv = exp2f(-(float)(i & 15) * (13.287712379549449f / 16.0f)); float sn, cs; sincosf((float)(i >> 4) * inv, &sn, &cs); tab[i] = make_float2(cs, sn); }
}
__device__ __forceinline__ void qkv_block(const Params& p, char* shm, int l, int rbase) {
    const h16* Z = WSP(h16, OFF_Z); h16* Qh = WSP(h16, OFF_QH); h16* Kh = WSP(h16, OFF_KH); h16* Vh = WSP(h16, OFF_VH);
    const int tid = threadIdx.x, lane = tid & 63, wv = tid >> 6;
    const float2* tab = (const float2*)(shm + ROPE_LDS);
    const int L = lane & 7, j0 = (L & 1) * 8;
    float qn[8], kn[8];
#pragma unroll
    for (int e = 0; e < 8; ++e) { qn[e] = p.q_norm[l * 64 + L * 8 + e] * QSCALE; kn[e] = p.k_norm[l * 64 + L * 8 + e]; }
    for (int r0 = rbase + wv * 8; r0 < rbase + wv * 8 + 8; r0 += 2) {
        h16x8 qv[2], kv[2];
#pragma unroll
        for (int q = 0; q < 2; ++q) { const int r = r0 + q; qv[q] = *(const h16x8*)(Z + (size_t)r * ZW + ZQ + lane * 8); kv[q] = *(const h16x8*)(Z + (size_t)r * ZW + ZK + (lane & 31) * 8); }
#pragma unroll
        for (int q = 0; q < 2; ++q) {
            const int r = r0 + q; int s0, len, pos; row_seq(r, s0, len, pos);
            const bool lat = r >= MC; const int b = lat ? (r - MC) >> 12 : r >> 8; const size_t krow = (size_t)b * SB + (lat ? CTX + pos : pos);
            const int tp = (L < 4) ? (pos >> 6) : (pos & 63);
            float cs[8], sn[8];
#pragma unroll
            for (int e = 0; e < 8; ++e) { const float2 t = tab[tp * 16 + j0 + e]; cs[e] = lat ? t.x : 1.f; sn[e] = lat ? t.y : 0.f; }
            { float y[8], ss = 0.f;
#pragma unroll
              for (int e = 0; e < 8; ++e) { y[e] = (float)qv[q][e]; ss += y[e] * y[e]; }
              ss += __shfl_xor(ss, 1); ss += __shfl_xor(ss, 2); ss += __shfl_xor(ss, 4);
              const float rs = rsqrtf(ss * (1.0f / 64.0f) + 1e-6f); h16x8 o;
#pragma unroll
              for (int e = 0; e < 8; ++e) { y[e] *= rs * qn[e]; }
#pragma unroll
              for (int e = 0; e < 8; ++e) { const float yp = __shfl_xor(y[e], 2); o[e] = (h16)((L & 2) ? (y[e] * cs[e] + yp * sn[e]) : (y[e] * cs[e] - yp * sn[e])); }
              *(h16x8*)(Qh + (size_t)r * 512 + lane * 8) = o; }
            { float y[8], ss = 0.f;
#pragma unroll
              for (int e = 0; e < 8; ++e) { y[e] = (float)kv[q][e]; ss += y[e] * y[e]; }
              ss += __shfl_xor(ss, 1); ss += __shfl_xor(ss, 2); ss += __shfl_xor(ss, 4);
              const float rs = rsqrtf(ss * (1.0f / 64.0f) + 1e-6f); h16x8 o;
#pragma unroll
              for (int e = 0; e < 8; ++e) { y[e] *= rs * kn[e]; }
#pragma unroll
              for (int e = 0; e < 8; ++e) { const float yp = __shfl_xor(y[e], 2); o[e] = (h16)((L & 2) ? (y[e] * cs[e] + yp * sn[e]) : (y[e] * cs[e] - yp * sn[e])); }
              if (lane < 16) *(h16x8*)(Kh + krow * 128 + lane * 8) = o;
              else if (lane < 32) *(h16x8*)(Vh + krow * 128 + (lane - 16) * 8) = kv[q]; }
        }
    }
}
template <int W> __device__ __forceinline__ void pool_slice(const h16* Z, h16* A, int s0, int len, int p0, int col) {
    constexpr int NR = 8 + W - 1;
    h16x8 v[NR];
#pragma unroll
    for (int i = 0; i < NR; ++i) { const int pos = p0 - W / 2 + i; h16x8 z8 = {0, 0, 0, 0, 0, 0, 0, 0}; if (pos >= 0 && pos < len) z8 = *(const h16x8*)(Z + (size_t)(s0 + pos) * ZW + ZP + col); v[i] = z8; }
#pragma unroll
    for (int tt = 0; tt < 8; ++tt) {
        const int lo = p0 + tt - W / 2, a = lo < 0 ? 0 : lo, e = (lo + W) > len ? len : (lo + W); const float icnt = 1.0f / (float)(e - a);
        h16x8 o;
#pragma unroll
        for (int j = 0; j < 8; ++j) { float s = 0.f;
#pragma unroll
            for (int i = 0; i < W; ++i) s += (float)v[tt + i][j];
            o[j] = (h16)(s * icnt - (float)v[tt + W / 2][j]); }
        *(h16x8*)(A + (size_t)(s0 + p0 + tt) * AW + AY0 + col) = o;
    }
}
__device__ __forceinline__ void pool_block(const Params& p, int r0) {
    const h16* Z = WSP(h16, OFF_Z); h16* A = WSP(h16, OFF_A);
    const int tid = threadIdx.x, lane = tid & 63, wv = __builtin_amdgcn_readfirstlane(tid >> 6), g = wv & 3;
    const int col = g * 128 + (lane & 15) * 8, ts = (wv >> 2) * 4 + (lane >> 4);
    int s0, len, pos; row_seq(r0, s0, len, pos);
    const int p0 = pos + ts * 8;
    if (g == 0) pool_slice<2>(Z, A, s0, len, p0, col);
    else if (g == 1) pool_slice<4>(Z, A, s0, len, p0, col);
    else if (g == 2) pool_slice<8>(Z, A, s0, len, p0, col);
    else pool_slice<16>(Z, A, s0, len, p0, col);
}
__device__ __forceinline__ void ph_ln(const Params& p, char* shm, int mode, int r_begin, const float* __restrict__ gam, const float* __restrict__ bet, int lm, int sh, int sc, const h16* __restrict__ Yb, bool from_input, int G, int c) {
    float* X = WSP(float, OFF_X); h16* A = WSP(h16, OFF_A); const float* mod = WSP(float, OFF_MOD) + (size_t)lm * 9 * 6144;
    const int lane = threadIdx.x & 63, wv = threadIdx.x >> 6;
    int* lcnt = (int*)shm; int* lbase = lcnt + 8; int* lrank = lcnt + 16;
    if (mode == 1) { __syncthreads(); if (threadIdx.x < 8) lcnt[threadIdx.x] = 0; __syncthreads(); }
    int trip = 0;
    for (int r0 = r_begin + c * 16 + wv * 2; r0 < MT; r0 += G * 16, ++trip) {
        float v[2][16];
#pragma unroll
        for (int q = 0; q < 2; ++q) { const float* xr = from_input ? xin_row(p, r0 + q) : X + (size_t)(r0 + q) * D;
#pragma unroll
            for (int i = 0; i < 4; ++i) { const float4 t = *(const float4*)(xr + i * 256 + lane * 4); v[q][i * 4] = t.x; v[q][i * 4 + 1] = t.y; v[q][i * 4 + 2] = t.z; v[q][i * 4 + 3] = t.w; } }
        if (mode != 2) {
            h16x4 ya[2][4];
#pragma unroll
            for (int q = 0; q < 2; ++q)
#pragma unroll
                for (int i = 0; i < 4; ++i) ya[q][i] = *(const h16x4*)(Yb + (size_t)(r0 + q) * D + i * 256 + lane * 4);
#pragma unroll
            for (int q = 0; q < 2; ++q)
#pragma unroll
                for (int i = 0; i < 4; ++i)
#pragma unroll
                    for (int j = 0; j < 4; ++j) v[q][i * 4 + j] = ALPHA * v[q][i * 4 + j] + (float)ya[q][i][j];
        }
        if (mode == 2) {
#pragma unroll
            for (int q = 0; q < 2; ++q) { const int t = r0 + q - MC, g = row_group(r0 + q); const float* m5 = WSP(float, OFF_MOD) + (size_t)(1 * 9 + g) * 6144 + 5 * 1024;
                float add[16];
#pragma unroll
                for (int i = 0; i < 16; ++i) add[i] = 0.f;
#pragma unroll
                for (int k2 = 0; k2 < 2; ++k2) {
                    const int pos = WSP(int, OFF_TOKR)[t * 2 + k2];
                    if (pos < 65536) { const h16* o = WSP(h16, OFF_OUT2) + ((size_t)k2 * ML + t) * 1024;
#pragma unroll
                        for (int i = 0; i < 4; ++i) { const h16x4 a = *(const h16x4*)(o + i * 256 + lane * 4);
#pragma unroll
                            for (int j = 0; j < 4; ++j) add[i * 4 + j] += (float)a[j]; } }
                    else {
#pragma unroll
                        for (int kq = 0; kq < 4; ++kq) { const h16* o = WSP(h16, OFF_OUTP) + ((size_t)kq * 2048 + (pos - 65536)) * 1024;
#pragma unroll
                            for (int i = 0; i < 4; ++i) { const h16x4 a = *(const h16x4*)(o + i * 256 + lane * 4);
#pragma unroll
                                for (int j = 0; j < 4; ++j) add[i * 4 + j] += (float)a[j]; } } }
                }
#pragma unroll
                for (int i = 0; i < 4; ++i) { const float4 mm = *(const float4*)(m5 + i * 256 + lane * 4); const float mv[4] = {mm.x, mm.y, mm.z, mm.w};
#pragma unroll
                    for (int j = 0; j < 4; ++j) v[q][i * 4 + j] = ALPHA * v[q][i * 4 + j] + mv[j] * add[i * 4 + j]; } }
        }
#pragma unroll
        for (int q = 0; q < 2; ++q) {
            const int r = r0 + q, g = row_group(r);
            float s = 0.f;
#pragma unroll
            for (int i = 0; i < 16; ++i) s += v[q][i];
#pragma unroll
            for (int o = 32; o >= 1; o >>= 1) s += __shfl_xor(s, o);
            const float mean = s * (1.0f / 1024.0f); float qq = 0.f;
#pragma unroll
            for (int i = 0; i < 16; ++i) { const float dlt = v[q][i] - mean; qq += dlt * dlt; }
#pragma unroll
            for (int o = 32; o >= 1; o >>= 1) qq += __shfl_xor(qq, o);
            const float rstd = rsqrtf(qq * (1.0f / 1024.0f) + 1e-5f);
            float lg8[8];
#pragma unroll
            for (int e = 0; e < 8; ++e) lg8[e] = 0.f;
#pragma unroll
            for (int i = 0; i < 4; ++i) {
                const int d = i * 256 + lane * 4; const float4 gg = *(const float4*)(gam + d), bb = *(const float4*)(bet + d);
                const float gv[4] = {gg.x, gg.y, gg.z, gg.w}, bv[4] = {bb.x, bb.y, bb.z, bb.w}; float y[4];
#pragma unroll
                for (int j = 0; j < 4; ++j) y[j] = (v[q][i * 4 + j] - mean) * rstd * gv[j] + bv[j];
                if (mode == 2) { *(float4*)(p.out + (size_t)(r - MC) * D + d) = make_float4(y[0], y[1], y[2], y[3]); continue; }
                *(float4*)(X + (size_t)r * D + d) = make_float4(y[0], y[1], y[2], y[3]);
                const float4 ms = *(const float4*)(mod + (size_t)g * 6144 + sh * 1024 + d), mc = *(const float4*)(mod + (size_t)g * 6144 + sc * 1024 + d);
                const float msv[4] = {ms.x, ms.y, ms.z, ms.w}, mcv[4] = {mc.x, mc.y, mc.z, mc.w}; float hh[4]; h16x4 ho;
#pragma unroll
                for (int j = 0; j < 4; ++j) { hh[j] = y[j] * (1.f + mcv[j]) + msv[j]; ho[j] = (h16)hh[j]; }
                *(h16x4*)(A + (size_t)r * AW + AH + d) = ho;
                if (mode == 1) {
#pragma unroll
                    for (int j = 0; j < 4; ++j) { const float4 w0 = *(const float4*)(p.moe_router + (size_t)(d + j) * 8), w1 = *(const float4*)(p.moe_router + (size_t)(d + j) * 8 + 4);
                        lg8[0] += hh[j] * w0.x; lg8[1] += hh[j] * w0.y; lg8[2] += hh[j] * w0.z; lg8[3] += hh[j] * w0.w; lg8[4] += hh[j] * w1.x; lg8[5] += hh[j] * w1.y; lg8[6] += hh[j] * w1.z; lg8[7] += hh[j] * w1.w; }
                }
            }
            if (mode == 1) {
#pragma unroll
                for (int e = 0; e < 8; ++e) {
#pragma unroll
                    for (int o = 32; o >= 1; o >>= 1) lg8[e] += __shfl_xor(lg8[e], o);
                    lg8[e] += p.moe_router_b[e]; }
                if (lane == 0) {
                    int i0 = 0; float v0 = lg8[0];
#pragma unroll
                    for (int e = 1; e < 8; ++e) if (lg8[e] > v0) { v0 = lg8[e]; i0 = e; }
                    int i1 = -1; float v1 = -INFINITY;
#pragma unroll
                    for (int e = 0; e < 8; ++e) if (e != i0 && lg8[e] > v1) { v1 = lg8[e]; i1 = e; }
                    const float p1 = 1.0f / (1.0f + expf(v0 - v1)), p0 = 1.0f - p1;
                    const int t = r - MC, li = trip * 16 + wv * 2 + q;
                    const int k0 = atomicAdd(&lcnt[i0], 1), k1 = atomicAdd(&lcnt[i1], 1);
                    WSP(int, OFF_TOKE)[t * 2] = i0; WSP(int, OFF_TOKE)[t * 2 + 1] = i1; WSP(float, OFF_TOKP)[t * 2] = p0; WSP(float, OFF_TOKP)[t * 2 + 1] = p1;
                    lrank[li * 4] = i0; lrank[li * 4 + 1] = k0; lrank[li * 4 + 2] = i1; lrank[li * 4 + 3] = k1;
                }
            }
        }
    }
    if (mode == 1) {
        __syncthreads();
        if (threadIdx.x < 8) lbase[threadIdx.x] = atomicAdd(WSP(int, OFF_CNT) + threadIdx.x, lcnt[threadIdx.x]);
        __syncthreads();
        for (int li = threadIdx.x; li < trip * 16; li += NTH) {
            const int r = r_begin + c * 16 + (li & 15) + (li >> 4) * G * 16; if (r >= MT) continue;
            const int t = r - MC;
            WSP(int, OFF_TOKR)[t * 2] = lbase[lrank[li * 4]] + lrank[li * 4 + 1]; WSP(int, OFF_TOKR)[t * 2 + 1] = lbase[lrank[li * 4 + 2]] + lrank[li * 4 + 3];
        }
    }
}
__device__ __forceinline__ void ph_moe_gather(const Params& p, char* shm, int G, int c) {
    int* sp = (int*)shm; int* plan = WSP(int, OFF_PLAN); const int* cnt = WSP(int, OFF_CNT); int* rowT = WSP(int, OFF_ROWT);
    const int tid = threadIdx.x;
    __syncthreads();
    if (tid == 0) { int acc = 0; for (int e = 0; e < 8; ++e) { sp[e] = acc; const int np = (cnt[e] + 255) / 256; if (c == 0) { plan[e] = acc; for (int q = 0; q < np; ++q) plan[16 + acc / 256 + q] = e; } acc += np * 256; } sp[8] = acc; if (c == 0) plan[8] = acc / 256; }
    __syncthreads();
    if (c == 0) for (int e = 0; e < 8; ++e) { const int a = sp[e] + cnt[e], b = sp[e + 1]; for (int i = a + tid; i < b; i += NTH) rowT[i] = -1; }
    const h16* A = WSP(h16, OFF_A); h16* Xg = WSP(h16, OFF_XG);
    const int lane = tid & 63, wv = tid >> 6;
    for (int it0 = (c * 8 + wv) * 4; it0 < ML * 2; it0 += G * 32) {
        h16x8 v0[4], v1[4]; int pos[4];
#pragma unroll
        for (int q = 0; q < 4; ++q) { const int it = it0 + q, t = it >> 1; pos[q] = sp[WSP(int, OFF_TOKE)[it]] + WSP(int, OFF_TOKR)[it];
            const h16* src = A + (size_t)(MC + t) * AW + AH; v0[q] = *(const h16x8*)(src + lane * 8); v1[q] = *(const h16x8*)(src + 512 + lane * 8); }
#pragma unroll
        for (int q = 0; q < 4; ++q) { h16* dst = Xg + (size_t)pos[q] * 1024; *(h16x8*)(dst + lane * 8) = v0[q]; *(h16x8*)(dst + 512 + lane * 8) = v1[q];
            if (lane == 0) { WSP(int, OFF_ROWT)[pos[q]] = it0 + q; WSP(float, OFF_ROWP)[pos[q]] = WSP(float, OFF_TOKP)[it0 + q]; WSP(int, OFF_TOKR)[it0 + q] = pos[q]; } }
    }
}

typedef float f32x16 __attribute__((ext_vector_type(16)));
constexpr int XCP = 520;
constexpr int LRU_XC = 0, LRU_LG = 64 * XCP * 2, LRU_CIN = 2 * 64 * XCP * 2;
__device__ __forceinline__ void lru_wt_prep(const Params& p, int G, int c) {
    h16* WT = WSP(h16, OFF_LRUWT);
    for (int u = c; u < 64; u += G) {
        const int blk = u & 7, gate = (u >> 3) & 1, ld = u >> 4;
        const float* W = (gate ? p.lru_wx : p.lru_wa) + ((size_t)ld * 8 + blk) * 4096;
        for (int o = threadIdx.x; o < 4096; o += NTH) { const int j = o >> 6, i = o & 63; WT[(size_t)u * 4096 + o] = (h16)W[i * 64 + j]; }
    }
}
template <int PASS> __device__ __forceinline__ void lru_unit(const Params& p, char* shm, int l, int b, int k) {
    const int tid = threadIdx.x, lane = tid & 63, h = __builtin_amdgcn_readfirstlane(tid >> 6), n = lane & 31, hi = lane >> 5;
    const h16* Z = WSP(h16, OFF_Z);
    const bool isctx = k < 4; const int s0 = isctx ? b * CTX : MC + b * SEQ, len = isctx ? CTX : SEQ, t0 = isctx ? k * 64 : (k - 4) * 64, row0 = s0 + t0;
    h16* xcs = (h16*)(shm + LRU_XC); h16* lgs = (h16*)(shm + LRU_LG); float* cins = (float*)(shm + LRU_CIN);
    const int uidx = b * 68 + k; char* lau_base = uidx < 512 ? (char*)p.out + (size_t)uidx * 262144 : p.ws + OFF_LAU_TAIL + (size_t)(uidx - 512) * 262144;
    __syncthreads();
    {
        const int cg = tid & 63, ts = tid >> 6, ch0 = cg * 8;
        if (PASS == 1) {
        float cw[4][8], cb[8];
#pragma unroll
        for (int q = 0; q < 4; ++q) { const float4 a = *(const float4*)(p.conv_w + (size_t)(l * 4 + q) * 512 + ch0), b2 = *(const float4*)(p.conv_w + (size_t)(l * 4 + q) * 512 + ch0 + 4);
            cw[q][0] = a.x; cw[q][1] = a.y; cw[q][2] = a.z; cw[q][3] = a.w; cw[q][4] = b2.x; cw[q][5] = b2.y; cw[q][6] = b2.z; cw[q][7] = b2.w; }
        { const float4 a = *(const float4*)(p.conv_b + l * 512 + ch0), b2 = *(const float4*)(p.conv_b + l * 512 + ch0 + 4); cb[0] = a.x; cb[1] = a.y; cb[2] = a.z; cb[3] = a.w; cb[4] = b2.x; cb[5] = b2.y; cb[6] = b2.z; cb[7] = b2.w; }
        h16x8 v[11];
#pragma unroll
        for (int i = 0; i < 11; ++i) { const int pos = t0 + ts * 8 - 2 + i; const bool ok = pos >= 0 && pos < len;
            h16x8 z8 = {0, 0, 0, 0, 0, 0, 0, 0}; if (ok) z8 = *(const h16x8*)(Z + (size_t)(s0 + pos) * ZW + ZLX + ch0); v[i] = z8; }
#pragma unroll
        for (int tt = 0; tt < 8; ++tt) { h16x8 o;
#pragma unroll
            for (int j = 0; j < 8; ++j) { float acc = cb[j];
#pragma unroll
                for (int q = 0; q < 4; ++q) acc += cw[q][j] * (float)v[tt + q][j];
                o[j] = (h16)acc; }
            *(h16x8*)(xcs + (ts * 8 + tt) * XCP + ch0) = o; }
        }
        if (PASS == 3) {
#pragma unroll
            for (int tt = 0; tt < 8; ++tt) *(h16x8*)(lgs + (ts * 8 + tt) * XCP + ch0) = *(const h16x8*)(Z + (size_t)(row0 + ts * 8 + tt) * ZW + ZLG + ch0);
            const float* P0 = WSP(float, OFF_LRUP) + (size_t)(b * 2 + 0) * 68 * 512 + tid; const float* H0 = WSP(float, OFF_LRUH) + (size_t)(b * 2 + 0) * 68 * 512 + tid;
            float S = 0.f;
            for (int j0 = 0; j0 < k; j0 += 8) { float pp[8], hh[8];
#pragma unroll
                for (int q = 0; q < 8; ++q) { const int j = j0 + q < k ? j0 + q : 0; pp[q] = P0[(size_t)j * 512]; hh[q] = H0[(size_t)j * 512]; }
#pragma unroll
                for (int q = 0; q < 8; ++q) if (j0 + q < k) S = pp[q] * S + hh[q]; }
            cins[tid] = S;
            const float* P1 = P0 + (size_t)68 * 512; const float* H1 = H0 + (size_t)68 * 512;
            const int nb = isctx ? 3 - k : 71 - k;
            S = 0.f;
            for (int s0_ = 0; s0_ < nb; s0_ += 8) { float pp[8], hh[8];
#pragma unroll
                for (int q = 0; q < 8; ++q) { const int s = s0_ + q < nb ? s0_ + q : 0; const int j = s < 4 ? 3 - s : 71 - s; pp[q] = P1[(size_t)j * 512]; hh[q] = H1[(size_t)j * 512]; }
#pragma unroll
                for (int q = 0; q < 8; ++q) if (s0_ + q < nb) S = pp[q] * S + hh[q]; }
            cins[512 + tid] = S;
        }
    }
    __syncthreads();
    const h16* WT = WSP(h16, OFF_LRUWT) + (size_t)l * 4 * 8 * 4096;
#define LMFMA(a, b, c) __builtin_amdgcn_mfma_f32_32x32x16_f16(a, b, c, 0, 0, 0)
#pragma unroll 1
    for (int ct = 0; ct < 2; ++ct) {
        const int cbase = h * 64 + ct * 32, ch = cbase + n;
        f32x16 xD[2], gD[2], hs[2];
#pragma unroll
        for (int rt = 0; rt < 2; ++rt) { xD[rt] = f32x16{}; gD[rt] = f32x16{}; hs[rt] = f32x16{}; }
        if (PASS == 1) {
#pragma unroll
        for (int s = 0; s < 2; ++s) { h16x8 id;
#pragma unroll
            for (int j = 0; j < 8; ++j) id[j] = (n == s * 16 + hi * 8 + j) ? (h16)1.0f : (h16)0.0f;
#pragma unroll
            for (int rt = 0; rt < 2; ++rt) { const h16x8 a = *(const h16x8*)(xcs + (rt * 32 + n) * XCP + cbase + s * 16 + hi * 8); xD[rt] = LMFMA(a, id, xD[rt]); } }
        }
#pragma unroll
        for (int dir = 0; dir < 2; ++dir) {
            f32x16 R[2], I[2];
            unsigned w32[32];
            u32x4* lau = (u32x4*)(lau_base + ((size_t)(h * 4 + ct * 2 + dir)) * 8192 + lane * 16);
            if (PASS == 1) {
#pragma unroll
                for (int rt = 0; rt < 2; ++rt) { R[rt] = f32x16{}; I[rt] = f32x16{}; }
                const h16* wa = WT + ((size_t)(dir * 2 + 0) * 8 + h) * 4096 + (ct * 32 + n) * 64 + hi * 8;
                const h16* wx = WT + ((size_t)(dir * 2 + 1) * 8 + h) * 4096 + (ct * 32 + n) * 64 + hi * 8;
#pragma unroll
                for (int ks = 0; ks < 4; ++ks) { const h16x8 ba8 = *(const h16x8*)(wa + ks * 16), bx8 = *(const h16x8*)(wx + ks * 16);
#pragma unroll
                    for (int rt = 0; rt < 2; ++rt) { const h16x8 a = *(const h16x8*)(xcs + (rt * 32 + n) * XCP + h * 64 + ks * 16 + hi * 8); R[rt] = LMFMA(a, ba8, R[rt]); I[rt] = LMFMA(a, bx8, I[rt]); } }
                const int pi = (l * 2 + dir) * 512 + ch;
                const float ba = p.lru_ba[pi], bx = p.lru_bx[pi], spl = log1pf(__expf(-p.lru_lambda[pi])) * (-8.0f * 1.4426950408889634f);
#pragma unroll
                for (int rt = 0; rt < 2; ++rt)
#pragma unroll
                    for (int r = 0; r < 16; ++r) { const float rg = sigmoidf_(R[rt][r] + ba), ig = sigmoidf_(I[rt][r] + bx);
                        const float la2 = rg * spl, a = __builtin_amdgcn_exp2f(la2), uu = __builtin_amdgcn_sqrtf(fmaxf(1.0f - a * a, 0.f)) * ig * xD[rt][r];
                        w32[rt * 16 + r] = pg8::cvt_pk_f16(la2, uu); }
#pragma unroll
                for (int j = 0; j < 8; ++j) { u32x4 t; t.x = w32[4 * j]; t.y = w32[4 * j + 1]; t.z = w32[4 * j + 2]; t.w = w32[4 * j + 3]; lau[j * 64] = t; }
            } else {
#pragma unroll
                for (int j = 0; j < 8; ++j) { const u32x4 t = lau[j * 64]; w32[4 * j] = t.x; w32[4 * j + 1] = t.y; w32[4 * j + 2] = t.z; w32[4 * j + 3] = t.w; }
            }
#pragma unroll
            for (int rt = 0; rt < 2; ++rt)
#pragma unroll
                for (int r = 0; r < 16; ++r) { const h16x2 pr = __builtin_bit_cast(h16x2, w32[rt * 16 + r]); R[rt][r] = __builtin_amdgcn_exp2f((float)pr[0]); I[rt][r] = (float)pr[1]; }
            float Pg[8], Hg[8], Po[8], Ho[8];
#pragma unroll
            for (int q = 0; q < 8; ++q) { const int rt = q >> 2, r0 = (q & 3) * 4; float P = 1.f, H = 0.f;
#pragma unroll
                for (int i = 0; i < 4; ++i) { const int r = r0 + (dir ? 3 - i : i); P *= R[rt][r]; H = R[rt][r] * H + I[rt][r]; }
                Pg[q] = P; Hg[q] = H; }
#pragma unroll
            for (int q = 0; q < 8; ++q) {
                const auto rp = __builtin_amdgcn_permlane32_swap(__float_as_uint(Pg[q]), __float_as_uint(Pg[q]), false, false); Po[q] = __uint_as_float(hi ? rp[0] : rp[1]);
                const auto rh = __builtin_amdgcn_permlane32_swap(__float_as_uint(Hg[q]), __float_as_uint(Hg[q]), false, false); Ho[q] = __uint_as_float(hi ? rh[0] : rh[1]); }
            float S = (PASS == 3) ? cins[dir * 512 + ch] : 0.f, Pt = 1.f; float cg[8];
#pragma unroll
            for (int s2 = 0; s2 < 16; ++s2) { const int Gi = dir ? 15 - s2 : s2, q = Gi >> 1, own = Gi & 1;
                const float Pq = (hi == own) ? Pg[q] : Po[q], Hq = (hi == own) ? Hg[q] : Ho[q];
                if (hi == own) cg[q] = S;
                S = Pq * S + Hq; Pt *= Pq; }
            if (PASS == 1) { if (hi == 0) { WSP(float, OFF_LRUP)[((size_t)(b * 2 + dir) * 68 + k) * 512 + ch] = Pt; WSP(float, OFF_LRUH)[((size_t)(b * 2 + dir) * 68 + k) * 512 + ch] = S; } }
            else {
#pragma unroll
                for (int q = 0; q < 8; ++q) { const int rt = q >> 2, r0 = (q & 3) * 4; float hh = cg[q];
#pragma unroll
                    for (int i = 0; i < 4; ++i) { const int r = r0 + (dir ? 3 - i : i); hh = R[rt][r] * hh + I[rt][r]; hs[rt][r] += hh; } }
            }
        }
        if (PASS == 3) {
#pragma unroll
            for (int s = 0; s < 2; ++s) { h16x8 id;
#pragma unroll
                for (int j = 0; j < 8; ++j) id[j] = (n == s * 16 + hi * 8 + j) ? (h16)1.0f : (h16)0.0f;
#pragma unroll
                for (int rt = 0; rt < 2; ++rt) { const h16x8 a2 = *(const h16x8*)(lgs + (rt * 32 + n) * XCP + cbase + s * 16 + hi * 8); gD[rt] = LMFMA(a2, id, gD[rt]); } }
#pragma unroll
            for (int rt = 0; rt < 2; ++rt)
#pragma unroll
                for (int r = 0; r < 16; ++r) { const float x = gD[rt][r]; const float u2 = 1.5957691216057308f * (x + 0.044715f * x * x * x);
                    lgs[(rt * 32 + (r & 3) + 8 * (r >> 2) + 4 * hi) * XCP + ch] = (h16)(hs[rt][r] * x * sigmoidf_(u2)); }
        }
    }
#undef LMFMA
    if (PASS == 3) {
        __syncthreads();
        h16* A = WSP(h16, OFF_A); const int cg = tid & 63, ts = tid >> 6, ch0 = cg * 8;
#pragma unroll
        for (int tt = 0; tt < 8; ++tt) *(h16x8*)(A + (size_t)(row0 + ts * 8 + tt) * AW + AY2 + ch0) = *(const h16x8*)(lgs + (ts * 8 + tt) * XCP + ch0);
    }
}
template <int PASS> __device__ __forceinline__ void ph_lru(const Params& p, char* shm, int l, int G, int c) {
    int* head = WSP(int, OFF_CNT) + 16 + l * 2 + (PASS == 3 ? 1 : 0); volatile int* slot = (volatile int*)(shm + 138240);
    for (;;) {
        __syncthreads();
        if (threadIdx.x == 0) *slot = atomicAdd(head, 1);
        __syncthreads();
        const int u = *slot; if (u >= NB * 68) break;
        lru_unit<PASS>(p, shm, l, u / 68, u % 68);
    }
}

__device__ __forceinline__ void ph_thin(const Params& p, char* shm, int l, int rb, int G, int c) {
    int* head = WSP(int, OFF_CNT) + 16 + l * 2; volatile int* slot = (volatile int*)(shm + 138240);
    const int NL = NB * 68, NQ = MT / 64, NP = (MT - rb) / 64;
    __syncthreads();
    rope_table(shm);
    for (;;) {
        __syncthreads();
        if (threadIdx.x == 0) *slot = atomicAdd(head, 1);
        __syncthreads();
        const int u = *slot; if (u >= NL + NQ + NP) break;
        if (u < NL) lru_unit<1>(p, shm, l, u / 68, u % 68);
        else if (u < NL + NQ) qkv_block(p, shm, l, (u - NL) * 64);
        else pool_block(p, rb + (u - NL - NQ) * 64);
    }
}

constexpr int XB_LDS_OFF = LDS_BYTES - 16;
__global__ void __launch_bounds__(512, 2) k_mega(Params p, int lo, int hi) {
    extern __shared__ __attribute__((aligned(16))) unsigned char shm[];
    LAS unsigned char* lds = (LAS unsigned char*)shm;
    const int G = gridDim.x, c = blockIdx.x;
    if (threadIdx.x == 0) { *(uint4*)(shm + XB_LDS_OFF) = make_uint4(0u, 0u, 0u, 0u); *(uint4*)(shm + 147424) = make_uint4(0u, 0u, 0u, 0u); }
    __syncthreads();
    XcdBarrier bar = xcd_barrier_post(WSP(unsigned, OFF_BAR), (volatile LAS unsigned*)(lds + XB_LDS_OFF));
    int ph = 0;
#ifndef REP_MASK
#define REP_MASK 0
#endif
#define REP(bit, call) do { call; if (REP_MASK & (bit)) { __syncthreads(); call; } } while (0)
#ifndef PROBE_MASK
#define PROBE_MASK 0u
#endif
    unsigned long long t_acc = 0ull, t_0 = 0ull;
#define PHASE(body) do { if (ph >= lo && ph < hi) { const bool pr_ = ((PROBE_MASK >> ph) & 1u) != 0u; if (pr_) t_0 = __builtin_amdgcn_s_memrealtime(); \
        body; if (ph + 1 < hi) { xcd_barrier(bar); if (REP_MASK & 8) xcd_barrier(bar); } if (pr_) t_acc += __builtin_amdgcn_s_memrealtime() - t_0; } ++ph; } while (0)
    PHASE(REP(4, ph_prologue(p, (char*)shm, G, c)));
    PHASE(REP(4, ph_h0(p, (char*)shm, G, c)));
#define LAYER(l) do { \
        const int rb = (l) == 0 ? 0 : MC; \
        const float* ln1g = p.ln1_g + (l) * D; const float* ln1b = p.ln1_b + (l) * D; const float* ln2g = p.ln2_g + (l) * D; const float* ln2b = p.ln2_b + (l) * D; \
        PHASE(REP(1, ph_gemm_in(p, lds, (l), G, c))); \
        PHASE(ph_thin(p, (char*)shm, (l), rb, G, c)); \
        PHASE(REP(512, ph_attn(p, (char*)shm, (l), G, c)); REP(256, ph_lru<3>(p, (char*)shm, (l), G, c))); \
        PHASE(REP(1, ph_merge(p, lds, (l), G, c))); \
        PHASE(ph_wout(p, lds, (l), G, c)); \
        if ((l) == 0) { \
            PHASE(ph_ln(p, (char*)shm, 0, rb, ln1g, ln1b, 0, 3, 4, YW_base(p, 0), true, G, c)); \
            PHASE(REP(1, ph_ffn_gu(p, lds, G, c))); \
            PHASE(ph_ffn_down(p, lds, G, c)); \
            PHASE(ph_ln(p, (char*)shm, 0, 0, ln2g, ln2b, 1, 0, 1, (const h16*)p.out, false, G, c)); \
        } else { \
            PHASE(ph_ln(p, (char*)shm, 1, rb, ln1g, ln1b, 1, 3, 4, YW_base(p, 1), false, G, c); REP(16, cvt_jobs(p, NJOBS_SMALL, NJOBS_ALL, 0, G, c, (float (*)[129])shm))); \
            PHASE(REP(16, ph_moe_gather(p, (char*)shm, G, c))); \
            for (int chn = 0; chn < 5; ++chn) { \
                PHASE(REP(1, ph_moe_gu(p, lds, chn * 64, G, c))); \
                PHASE(REP(1, ph_moe_down(p, lds, chn * 64, G, c))); \
            } \
            PHASE(ph_ln(p, (char*)shm, 2, MC, ln2g, ln2b, 1, 0, 1, (const h16*)0, false, G, c)); \
        } } while (0)
    LAYER(0);
    LAYER(1);
#undef LAYER
    if (PROBE_EPI != 0) { t_acc = ((LAS unsigned long long*)(lds + 147424))[0]; }
    if ((PROBE_MASK != 0u || PROBE_EPI != 0) && blockIdx.x == 0 && threadIdx.x == 0) { const unsigned long long t_e = __builtin_amdgcn_s_memrealtime(); while (__builtin_amdgcn_s_memrealtime() - t_e < 3ull * t_acc) __builtin_amdgcn_s_sleep(8); }
#undef PHASE
}
constexpr int NPHASES = 2 + 9 + (5 + 2 + 10 + 1);

#ifndef MEGA_LAUNCHES
#define MEGA_LAUNCHES 1
#endif
extern "C" void kernel_launch(void* const* d_in, const int* in_sizes, int n_in, void* d_out, int out_size, void* d_ws, size_t ws_size, hipStream_t stream) {
    (void)in_sizes; (void)n_in; (void)out_size;
    if (ws_size < WS_NEED) return;
    Params p;
    const float** pp = (const float**)&p;
    for (int i = 0; i < 33; ++i) pp[i] = (const float*)d_in[i];
    p.out = (float*)d_out; p.ws = (char*)d_ws;
    static int grid = 0;
    if (!grid) {
        int dev = 0, cus = 0, per_cu = 0;
        hipGetDevice(&dev);
        hipDeviceGetAttribute(&cus, hipDeviceAttributeMultiprocessorCount, dev);
        hipFuncSetAttribute((const void*)k_mega, hipFuncAttributeMaxDynamicSharedMemorySize, LDS_BYTES);
        hipOccupancyMaxActiveBlocksPerMultiprocessor(&per_cu, (const void*)k_mega, 512, LDS_BYTES);
        grid = (per_cu >= 1 && cus > 0) ? cus : -1;
    }
    if (grid <= 0) return;
    hipMemsetAsync(p.ws + OFF_BAR, 0, XCD_BAR_WORDS * sizeof(unsigned), stream);
#if MEGA_LAUNCHES == 1
    k_mega<<<grid, 512, LDS_BYTES, stream>>>(p, 0, NPHASES);
#else
    for (int ph = 0; ph < NPHASES; ++ph) k_mega<<<grid, 512, LDS_BYTES, stream>>>(p, ph, ph + 1);
#endif
}
```

```cpp
#include <hip/hip_runtime.h>
#include <stdint.h>
#include <stddef.h>

#ifndef PROBE_EPI
#define PROBE_EPI 0
#endif
typedef _Float16 h16;
typedef _Float16 h16x2 __attribute__((ext_vector_type(2)));
typedef _Float16 h16x4 __attribute__((ext_vector_type(4)));
typedef _Float16 h16x8 __attribute__((ext_vector_type(8)));

constexpr int D = 1024, NB = 8, SEQ = 4096, CTX = 256, SB = CTX + SEQ;
constexpr int MC = NB * CTX, ML = NB * SEQ, MT = MC + ML;
constexpr int WIN = 5376, ZW = 2304, AW = 2560;
constexpr int DFF = 2816, NE = 8, DEX = 3584;
constexpr int PMAX = 264 * 256;
constexpr float ALPHA = 1.41421356237309515f;
constexpr float QSCALE = 0.125f * 1.4426950408889634f;
constexpr int ZP = 0, ZQ = 512, ZK = 1024, ZV = 1152, ZLX = 1280, ZLG = 1792;
constexpr int AH = 0, AY0 = 1024, AY1 = 1536, AY2 = 2048;

constexpr size_t al256(size_t x) { return (x + 255) & ~(size_t)255; }
constexpr size_t OFF_BAR = 0;
constexpr size_t OFF_MOD = 16384;
constexpr size_t OFF_CNT = OFF_MOD + al256((size_t)2 * 9 * 6144 * 4);
constexpr size_t OFF_PLAN = OFF_CNT + 256;
constexpr size_t OFF_TOKE = OFF_PLAN + 2048;
constexpr size_t OFF_TOKP = OFF_TOKE + (size_t)ML * 2 * 4;
constexpr size_t OFF_TOKR = OFF_TOKP + (size_t)ML * 2 * 4;
constexpr size_t OFF_ROWT = OFF_TOKR + (size_t)ML * 2 * 4;
constexpr size_t OFF_ROWP = OFF_ROWT + (size_t)PMAX * 4;
constexpr size_t OFF_LRUP = OFF_ROWP + (size_t)PMAX * 4;
constexpr size_t OFF_LRUH = OFF_LRUP + (size_t)NB * 2 * 68 * 512 * 4;
constexpr size_t OFF_LRUWT = OFF_LRUH + (size_t)NB * 2 * 68 * 512 * 4;
constexpr size_t OFF_TBL_END = OFF_LRUWT + (size_t)2 * 2 * 2 * 8 * 4096 * 2;
constexpr size_t OFF_X = (size_t)8 << 20;
constexpr size_t OFF_A = OFF_X + (size_t)MT * D * 4;
constexpr size_t OFF_BIG = OFF_A + (size_t)MT * AW * 2;
static_assert(OFF_TBL_END <= OFF_X, "tables");
constexpr size_t OFF_Z = OFF_BIG;
constexpr size_t OFF_QH = OFF_Z + (size_t)MT * ZW * 2;
constexpr size_t OFF_KH = OFF_QH + (size_t)MT * 512 * 2;
constexpr size_t OFF_VH = OFF_KH + (size_t)NB * SB * 128 * 2;
constexpr size_t OFF_W16 = OFF_VH + (size_t)NB * SB * 128 * 2;
constexpr size_t SZ_WINT = (size_t)ZW * 1024 * 2, SZ_BTALL = (size_t)3072 * 1536 * 2, SZ_WOUTT = (size_t)1024 * 1024 * 2;
constexpr size_t SZ_LAYERW = SZ_WINT + SZ_BTALL + SZ_WOUTT;
constexpr size_t OFF_WGUT = OFF_W16 + 2 * SZ_LAYERW;
constexpr size_t OFF_WDT = OFF_WGUT + (size_t)2 * DFF * 1024 * 2;
constexpr size_t OFF_W16_END = OFF_WDT + (size_t)1024 * DFF * 2;
constexpr size_t OFF_LAU_TAIL = (OFF_W16_END + 255) & ~(size_t)255;
constexpr size_t OFF_ACT = OFF_BIG;
static_assert(OFF_ACT + (size_t)MT * DFF * 2 <= OFF_W16, "ACT overlay");
constexpr size_t OFF_WMOE_GU = OFF_BIG;
constexpr size_t OFF_WMOE_D = OFF_WMOE_GU + (size_t)NE * 2 * DEX * 1024 * 2;
constexpr size_t OFF_XG = OFF_WMOE_D + (size_t)NE * 1024 * DEX * 2;
constexpr size_t WS_NEED = OFF_XG + (size_t)PMAX * 1024 * 2;
static_assert(WS_NEED <= 646673440ull, "workspace budget");
static_assert(OFF_LAU_TAIL + (size_t)32 * 262144 <= WS_NEED, "lau tail");
static_assert(OFF_W16_END <= WS_NEED, "w16");
constexpr size_t OFF_OUT2 = OFF_A;
constexpr size_t OFF_OUTP = OFF_OUT2 + (size_t)2 * ML * 1024 * 2;
static_assert(OFF_OUTP + (size_t)4 * 2048 * 1024 * 2 <= OFF_A + (size_t)MT * AW * 2, "OUT2/OUTP overlay");
static_assert((size_t)72 * 256 * DEX * 2 <= (size_t)ML * D * 4, "ACTe chunk in d_out");

struct Params {
    const float *x, *c, *ctx, *c_ctx, *w_mod, *b_mod, *w_in, *b_merge, *pool_w, *pool_scale, *q_norm, *k_norm, *conv_w, *conv_b,
        *lru_wa, *lru_ba, *lru_wx, *lru_bx, *lru_lambda, *w_branch, *w_out, *ln1_g, *ln1_b, *ffn_w_gate, *ffn_w_up, *ffn_w_down,
        *moe_router, *moe_router_b, *moe_w_gate, *moe_w_up, *moe_w_down, *ln2_g, *ln2_b;
    float* out;
    char* ws;
};
#define WSP(T, off) ((T*)(p.ws + (off)))

__device__ __forceinline__ int row_group(int r) { return r < MC ? 0 : 1 + ((r - MC) >> 12); }
__device__ __forceinline__ void row_seq(int r, int& s0, int& len, int& pos) {
    if (r < MC) { s0 = r & ~255; len = 256; pos = r & 255; } else { const int q = r - MC; s0 = MC + (q & ~4095); len = 4096; pos = q & 4095; }
}
__device__ __forceinline__ const float* xin_row(const Params& p, int r) { return r < MC ? p.ctx + (size_t)r * D : p.x + (size_t)(r - MC) * D; }
__device__ __forceinline__ float sigmoidf_(float x) { return __builtin_amdgcn_rcpf(1.0f + __builtin_amdgcn_exp2f(-1.4426950408889634f * x)); }
__device__ __forceinline__ float siluf_(float x) { return x * __builtin_amdgcn_rcpf(1.0f + __builtin_amdgcn_exp2f(-1.4426950408889634f * x)); }
__device__ __forceinline__ float gelu_tanh(float x) { const float u = 0.7978845608028654f * (x + 0.044715f * x * x * x); return 0.5f * x * (1.0f + tanhf(u)); }

struct CvtJob { const float* src; int ld_src, K, N; h16* dst; int ldd, col_off, rmode; };
constexpr int NJOBS_L = 6, NJOBS_SMALL = 2 * NJOBS_L + 3, NJOBS_ALL = NJOBS_SMALL + 24;
__device__ __forceinline__ CvtJob get_job(const Params& p, int j) {
    CvtJob q; q.col_off = 0; q.rmode = 0;
    if (j < 2 * NJOBS_L) {
        const int l = j / NJOBS_L, s = j % NJOBS_L;
        h16* wint = WSP(h16, OFF_W16 + l * SZ_LAYERW); h16* btall = WSP(h16, OFF_W16 + l * SZ_LAYERW + SZ_WINT); h16* woutt = WSP(h16, OFF_W16 + l * SZ_LAYERW + SZ_WINT + SZ_BTALL);
        if (s == 0) { q.src = p.w_in + (size_t)l * 1024 * WIN + 512; q.ld_src = WIN; q.K = 1024; q.N = ZW - 512; q.dst = wint + (size_t)512 * 1024; q.ldd = 1024; }
        else if (s == 1) { q.src = p.w_in + (size_t)l * 1024 * WIN + ZW; q.ld_src = WIN; q.K = 1024; q.N = 3072; q.dst = btall; q.ldd = 1536; }
        else if (s < 5) { const int n = s - 2; q.src = p.w_branch + (size_t)(l * 3 + n) * 512 * 1024; q.ld_src = 1024; q.K = 512; q.N = 1024; q.dst = btall + (size_t)n * 1024 * 1536; q.ldd = 1536; q.col_off = 1024; }
        else { q.src = p.w_out + (size_t)l * 1024 * 1024; q.ld_src = 1024; q.K = 1024; q.N = 1024; q.dst = woutt; q.ldd = 1024; }
    } else if (j < NJOBS_SMALL) {
        const int s = j - 2 * NJOBS_L;
        if (s == 0) { q.src = p.ffn_w_gate; q.ld_src = DFF; q.K = 1024; q.N = DFF; q.dst = WSP(h16, OFF_WGUT); q.ldd = 1024; q.rmode = 1; }
        else if (s == 1) { q.src = p.ffn_w_up; q.ld_src = DFF; q.K = 1024; q.N = DFF; q.dst = WSP(h16, OFF_WGUT); q.ldd = 1024; q.rmode = 2; }
        else { q.src = p.ffn_w_down; q.ld_src = 1024; q.K = DFF; q.N = 1024; q.dst = WSP(h16, OFF_WDT); q.ldd = DFF; }
    } else {
        const int s = j - NJOBS_SMALL, e = s / 3, t = s % 3;
        if (t == 0) { q.src = p.moe_w_gate + (size_t)e * 1024 * DEX; q.ld_src = DEX; q.K = 1024; q.N = DEX; q.dst = WSP(h16, OFF_WMOE_GU) + (size_t)e * 2 * DEX * 1024; q.ldd = 1024; q.rmode = 1; }
        else if (t == 1) { q.src = p.moe_w_up + (size_t)e * 1024 * DEX; q.ld_src = DEX; q.K = 1024; q.N = DEX; q.dst = WSP(h16, OFF_WMOE_GU) + (size_t)e * 2 * DEX * 1024; q.ldd = 1024; q.rmode = 2; }
        else { q.src = p.moe_w_down + (size_t)e * DEX * 1024; q.ld_src = 1024; q.K = DEX; q.N = 1024; q.dst = WSP(h16, OFF_WMOE_D) + (size_t)e * 1024 * DEX; q.ldd = DEX; }
    }
    return q;
}
__device__ __forceinline__ int job_tiles(const CvtJob& q) { return (q.K / 128) * (q.N / 128); }
__device__ __forceinline__ int cvt_rowmap(int n, int rmode) { return rmode == 0 ? n : ((n >> 7) * 256 + (n & 127) + (rmode == 2 ? 128 : 0)); }
__device__ __forceinline__ void cvt_load(const CvtJob& q, int t, float4 (&v)[8]) {
    const int nk = q.K / 128, tk = t % nk, tn = t / nk, k0 = tk * 128, n0 = tn * 128, tid = threadIdx.x;
#pragma unroll
    for (int i = 0; i < 8; ++i) v[i] = *(const float4*)(q.src + (size_t)(k0 + i * 16 + (tid >> 5)) * q.ld_src + n0 + (tid & 31) * 4);
}
__device__ __forceinline__ void cvt_store(const CvtJob& q, int t, const float4 (&v)[8], float (*tile)[129]) {
    const int nk = q.K / 128, tk = t % nk, tn = t / nk, k0 = tk * 128, n0 = tn * 128, tid = threadIdx.x;
    __syncthreads();
#pragma unroll
    for (int i = 0; i < 8; ++i) { float* tp = &tile[i * 16 + (tid >> 5)][(tid & 31) * 4]; tp[0] = v[i].x; tp[1] = v[i].y; tp[2] = v[i].z; tp[3] = v[i].w; }
    __syncthreads();
#pragma unroll
    for (int i = 0; i < 4; ++i) { const int n = i * 32 + (tid >> 4), kc = (tid & 15) * 8; h16x8 o;
#pragma unroll
        for (int j = 0; j < 8; ++j) o[j] = (h16)tile[kc + j][n];
        *(h16x8*)(q.dst + (size_t)cvt_rowmap(n0 + n, q.rmode) * q.ldd + q.col_off + k0 + kc) = o; }
}
template <int NT> __device__ __forceinline__ void mod_unit(const Params& p, int u, float* sc  , float* red  ) {
    const int l = u / 96, n0 = (u % 96) * 64, tid = threadIdx.x, n = tid & 63, ks = tid >> 6;
    constexpr int NKS = NT / 64, KPER = 1024 / NKS;
    __syncthreads();
    for (int i = tid; i < 9 * 1024; i += NT) { const int g = i >> 10, k = i & 1023; const float v = g == 0 ? p.c_ctx[k] : p.c[(g - 1) * 1024 + k]; sc[i] = siluf_(v); }
    __syncthreads();
    float acc[9];
#pragma unroll
    for (int g = 0; g < 9; ++g) acc[g] = 0.f;
    const float* w = p.w_mod + (size_t)l * 1024 * 6144 + n0 + n;
#pragma unroll 8
    for (int k = ks * KPER; k < (ks + 1) * KPER; ++k) { const float wv = w[(size_t)k * 6144];
#pragma unroll
        for (int g = 0; g < 9; ++g) acc[g] += sc[g * 1024 + k] * wv; }
#pragma unroll
    for (int g = 0; g < 9; ++g) red[(ks * 9 + g) * 64 + n] = acc[g];
    __syncthreads();
    for (int i = tid; i < 9 * 64; i += NT) { const int g = i >> 6, nn = i & 63; float s = p.b_mod[l * 6144 + n0 + nn];
        for (int k2 = 0; k2 < NKS; ++k2) s += red[(k2 * 9 + g) * 64 + nn];
        WSP(float, OFF_MOD)[(size_t)(l * 9 + g) * 6144 + n0 + nn] = s; }
}

#define LAS __attribute__((address_space(3)))
typedef float f32x4 __attribute__((ext_vector_type(4)));
typedef unsigned u32x4 __attribute__((ext_vector_type(4)));
typedef unsigned u32x2 __attribute__((ext_vector_type(2)));
namespace pg8 {
constexpr int BM = 256, BK = 64, HALF = 128, HTB = HALF * BK * 2, STAGE_BYTES = 8 * HTB;
__host__ __device__ __forceinline__ int lds_byte(int r, int c) { const int st = (r >> 4) * 2 + (c >> 5), rr = r & 15, cc = c & 31, ob = rr * 64 + cc * 2; return st * 1024 + (ob ^ (((ob >> 9) & 1) << 5)); }
__host__ __device__ __forceinline__ void stage_rc(int b, int& R, int& C) { const int st = b / 1024, sb = b % 1024, swz = sb ^ (((sb >> 9) & 1) << 5); R = (st >> 1) * 16 + swz / 64; C = (st & 1) * 32 + (swz % 64) / 2; }
__host__ __device__ __forceinline__ int perm32(int rho) { const int n = rho >> 4, i = rho & 15; return 8 * (i >> 2) + 4 * n + (i & 3); }
struct GUnit { const char* A; const char* B; int nt; int kind; int pm; int pn; int aux; };
__device__ __forceinline__ void tile_map(int L, int nM, int nN, int& pm, int& pn) {
    const int nwg = nM * nN; int wgid = L;
    { const int q = nwg / 8, r = nwg % 8, xcd = wgid % 8, off = wgid / 8; wgid = (xcd < r ? xcd * (q + 1) : r * (q + 1) + (xcd - r) * q) + off; }
    const int nig = 8 * nN, gid = wgid / nig, fm = gid * 8, gsz = (nM - fm) < 8 ? (nM - fm) : 8;
    pm = fm + ((wgid % nig) % gsz); pn = (wgid % nig) / gsz;
}
__device__ __forceinline__ unsigned cvt_pk_f16(float lo, float hi) { typedef float f2 __attribute__((ext_vector_type(2))); const f2 v = {lo, hi}; const h16x2 h = __builtin_convertvector(v, h16x2); return __builtin_bit_cast(unsigned, h); }

template <class Epi, class Sched>
__device__ __forceinline__ void gemm_phase(LAS unsigned char* lds, const int lda, const int ldb, const Sched& S, const Epi& E) {
    const int tid = threadIdx.x, wid = __builtin_amdgcn_readfirstlane(tid >> 6), lane = tid & 63, wr = wid >> 2, wc = wid & 3, fr = lane & 15, fq = lane >> 4;
    unsigned voffA[2], voffB[2];
#pragma unroll
    for (int i = 0; i < 2; ++i) { int R, C; stage_rc(tid * 16 + i * 8192, R, C); const int Rb = Epi::PERM ? ((R & ~31) + perm32(R & 31)) : R;
        voffA[i] = (unsigned)(R * lda + C) * 2u; voffB[i] = (unsigned)(Rb * ldb + C) * 2u; }
    const size_t kstep = (size_t)(BK * 2);
    const size_t hstepA = (size_t)HALF * lda * 2, hstepB = (size_t)HALF * ldb * 2;
    const unsigned ldsw = (unsigned)wid * 1024u;
    const int aoff = lds_byte(wr * 64 + fr, fq * 8), boff = lds_byte(wc * 32 + fr, fq * 8);
#define PG8_SA(b, h) (((b) * 2 + (h)) * HTB)
#define PG8_SB(b, h) ((4 + (b) * 2 + (h)) * HTB)
#define PG8_STAGE(bufoff, gbase, voff) do { _Pragma("unroll") for (int _i = 0; _i < 2; ++_i) \
        __builtin_amdgcn_global_load_lds((const unsigned*)((const char*)(gbase) + (voff)[_i]), (LAS unsigned*)(lds + (bufoff) + ldsw + _i * 8192), 16, 0, 0); } while (0)
#define PG8_LDA(dst, b, h) do { _Pragma("unroll") for (int m = 0; m < 4; ++m) _Pragma("unroll") for (int k = 0; k < 2; ++k) dst[m][k] = *(const LAS h16x8*)(lds + PG8_SA(b, h) + aoff + m * 2048 + k * 1024); } while (0)
#define PG8_LDB(dst, b, h) do { _Pragma("unroll") for (int n = 0; n < 2; ++n) _Pragma("unroll") for (int k = 0; k < 2; ++k) dst[n][k] = *(const LAS h16x8*)(lds + PG8_SB(b, h) + boff + n * 2048 + k * 1024); } while (0)
#define PG8_MMA(ai, bj, At, Bt) do { __builtin_amdgcn_s_setprio(1); _Pragma("unroll") for (int m = 0; m < 4; ++m) _Pragma("unroll") for (int n = 0; n < 2; ++n) _Pragma("unroll") for (int k = 0; k < 2; ++k) \
        acc[ai][bj][m][n] = __builtin_amdgcn_mfma_f32_16x16x32_f16(Bt[n][k], At[m][k], acc[ai][bj][m][n], 0, 0, 0); __builtin_amdgcn_s_setprio(0); } while (0)
#define PG8_WAIT_V(n) asm volatile("s_waitcnt vmcnt(" #n ")" ::: "memory")
#define PG8_WAIT_L(n) asm volatile("s_waitcnt lgkmcnt(" #n ")" ::: "memory")
#define PG8_BAR __builtin_amdgcn_s_barrier()
#define PG8_SCHED __builtin_amdgcn_sched_barrier(0)
    GUnit cur, nxt; int ui = 0; unsigned long long probe_t0 = 0ull;
    if (!S.next(0, cur)) return;
    f32x4 acc[2][2][4][2];
#pragma unroll
    for (int a = 0; a < 2; ++a)
#pragma unroll
        for (int b = 0; b < 2; ++b)
#pragma unroll
            for (int m = 0; m < 4; ++m)
#pragma unroll
                for (int n = 0; n < 2; ++n) acc[a][b][m][n] = (f32x4){0.f, 0.f, 0.f, 0.f};
    h16x8 At[4][2], B0[2][2], B1[2][2];
    const char* cA = cur.A; const char* cB = cur.B;
#ifndef PG8_SP2
#define PG8_SP2 1
#endif
    if (PG8_SP2) {
        PG8_STAGE(PG8_SB(0, 0), cB, voffB); PG8_STAGE(PG8_SB(0, 1), cB + hstepB, voffB); PG8_STAGE(PG8_SA(0, 0), cA, voffA); PG8_STAGE(PG8_SA(0, 1), cA + hstepA, voffA);
        if (wr == 1) PG8_BAR;
        PG8_WAIT_V(2); PG8_BAR;
        PG8_STAGE(PG8_SB(1, 0), cB + kstep, voffB); PG8_STAGE(PG8_SA(1, 0), cA + kstep, voffA); PG8_STAGE(PG8_SB(1, 1), cB + hstepB + kstep, voffB);
        PG8_WAIT_V(6); PG8_BAR;
    } else {
    PG8_STAGE(PG8_SB(0, 0), cB, voffB); PG8_STAGE(PG8_SA(0, 0), cA, voffA); PG8_STAGE(PG8_SB(0, 1), cB + hstepB, voffB); PG8_STAGE(PG8_SA(0, 1), cA + hstepA, voffA);
    if (wr == 1) PG8_BAR;
    PG8_WAIT_V(4); PG8_BAR;
    PG8_STAGE(PG8_SB(1, 0), cB + kstep, voffB); PG8_STAGE(PG8_SA(1, 0), cA + kstep, voffA); PG8_STAGE(PG8_SB(1, 1), cB + hstepB + kstep, voffB);
    PG8_WAIT_V(6); PG8_BAR;
    }
    for (;;) {
        const bool has_next = S.next(ui + 1, nxt);
        const char* nA = has_next ? nxt.A : cA; const char* nB = has_next ? nxt.B : cB;
        const int nt = cur.nt;
        for (int t = 0; t < nt; t += 2) {
            const bool last = (t == nt - 2);
            const char* a1 = cA + (size_t)(t + 1) * kstep;
            const char* a2 = last ? nA : cA + (size_t)(t + 2) * kstep; const char* b2 = last ? nB : cB + (size_t)(t + 2) * kstep;
            const char* a3 = a2 + kstep; const char* b3 = b2 + kstep;
            if (PG8_SP2) {
            PG8_LDB(B0, 0, 0); PG8_LDB(B1, 0, 1); PG8_SCHED; PG8_LDA(At, 0, 0); PG8_STAGE(PG8_SA(1, 1), a1 + hstepA, voffA);
            PG8_WAIT_V(8); PG8_WAIT_L(0); PG8_BAR; PG8_MMA(0, 0, At, B0); PG8_MMA(0, 1, At, B1); PG8_BAR; PG8_SCHED;
            PG8_LDA(At, 0, 1); PG8_STAGE(PG8_SB(0, 0), b2, voffB); PG8_STAGE(PG8_SB(0, 1), b2 + hstepB, voffB); PG8_STAGE(PG8_SA(0, 0), a2, voffA);
            PG8_WAIT_V(8); PG8_WAIT_L(0); PG8_BAR; PG8_MMA(1, 0, At, B0); PG8_MMA(1, 1, At, B1); PG8_BAR; PG8_SCHED;
            PG8_LDB(B0, 1, 0); PG8_LDB(B1, 1, 1); PG8_SCHED; PG8_LDA(At, 1, 0); PG8_STAGE(PG8_SA(0, 1), a2 + hstepA, voffA);
            PG8_WAIT_V(8); PG8_WAIT_L(0); PG8_BAR; PG8_MMA(0, 0, At, B0); PG8_MMA(0, 1, At, B1); PG8_BAR; PG8_SCHED;
            PG8_LDA(At, 1, 1); PG8_STAGE(PG8_SB(1, 0), b3, voffB); PG8_STAGE(PG8_SB(1, 1), b3 + hstepB, voffB); PG8_STAGE(PG8_SA(1, 0), a3, voffA);
            PG8_WAIT_V(8); PG8_WAIT_L(0); PG8_BAR; PG8_MMA(1, 0, At, B0); PG8_MMA(1, 1, At, B1); PG8_BAR; PG8_SCHED;
            } else {
            PG8_LDB(B0, 0, 0); PG8_SCHED; PG8_LDA(At, 0, 0); PG8_STAGE(PG8_SA(1, 1), a1 + hstepA, voffA);
            PG8_WAIT_L(8); PG8_BAR; PG8_WAIT_L(0); PG8_MMA(0, 0, At, B0); PG8_BAR; PG8_SCHED;
            PG8_LDB(B1, 0, 1); PG8_STAGE(PG8_SB(0, 0), b2, voffB);
            PG8_BAR; PG8_WAIT_L(0); PG8_MMA(0, 1, At, B1); PG8_BAR;
            PG8_LDA(At, 0, 1); PG8_STAGE(PG8_SA(0, 0), a2, voffA);
            PG8_BAR; PG8_WAIT_L(0); PG8_MMA(1, 0, At, B0); PG8_BAR; PG8_SCHED;
            PG8_STAGE(PG8_SB(0, 1), b2 + hstepB, voffB);
            PG8_WAIT_V(6); PG8_BAR; PG8_MMA(1, 1, At, B1); PG8_BAR;
            PG8_LDB(B0, 1, 0); PG8_SCHED; PG8_LDA(At, 1, 0); PG8_STAGE(PG8_SA(0, 1), a2 + hstepA, voffA);
            PG8_WAIT_L(8); PG8_BAR; PG8_WAIT_L(0); PG8_MMA(0, 0, At, B0); PG8_BAR; PG8_SCHED;
            PG8_LDB(B1, 1, 1); PG8_STAGE(PG8_SB(1, 0), b3, voffB);
            PG8_BAR; PG8_WAIT_L(0); PG8_MMA(0, 1, At, B1); PG8_BAR;
            PG8_LDA(At, 1, 1); PG8_STAGE(PG8_SA(1, 0), a3, voffA);
            PG8_BAR; PG8_WAIT_L(0); PG8_MMA(1, 0, At, B0); PG8_BAR; PG8_SCHED;
            PG8_STAGE(PG8_SB(1, 1), b3 + hstepB, voffB);
            PG8_WAIT_V(6); PG8_BAR; PG8_MMA(1, 1, At, B1); PG8_BAR;
            }
            if (PROBE_EPI == 2 && t == 0 && probe_t0 != 0ull && blockIdx.x == 0 && tid == 0) ((LAS unsigned long long*)(lds + 147424))[0] += __builtin_amdgcn_s_memrealtime() - probe_t0;
            if (PROBE_EPI == 3 && t == 4) probe_t0 = __builtin_amdgcn_s_memrealtime();
            if (PROBE_EPI == 3 && t == 6 && blockIdx.x == 0 && tid == 0) ((LAS unsigned long long*)(lds + 147424))[0] += __builtin_amdgcn_s_memrealtime() - probe_t0;
        }
#ifndef PG8_ALIGN
#define PG8_ALIGN 1
#endif
        if (PG8_ALIGN) { if (wr == 0) PG8_BAR; }
        unsigned long long pe0 = 0; if (PROBE_EPI == 1 || PROBE_EPI == 2) pe0 = __builtin_amdgcn_s_memrealtime();
        E(acc, cur, wr, wc, fr, fq);
        if (PROBE_EPI == 1 && blockIdx.x == 0 && tid == 0) ((LAS unsigned long long*)(lds + 147424))[0] += __builtin_amdgcn_s_memrealtime() - pe0;
        if (PROBE_EPI == 2) probe_t0 = pe0;
        if (!has_next) break;
#pragma unroll
        for (int a = 0; a < 2; ++a)
#pragma unroll
            for (int b = 0; b < 2; ++b)
#pragma unroll
                for (int m = 0; m < 4; ++m)
#pragma unroll
                    for (int n = 0; n < 2; ++n) acc[a][b][m][n] = (f32x4){0.f, 0.f, 0.f, 0.f};
        cur = nxt; cA = nA; cB = nB; ++ui;
        if (PG8_ALIGN) { if (wr == 1) PG8_BAR; }
    }
    PG8_WAIT_V(0);
    if (!PG8_ALIGN) { if (wr == 0) PG8_BAR; }
    PG8_BAR;
#undef PG8_SA
#undef PG8_SB
#undef PG8_STAGE
#undef PG8_LDA
#undef PG8_LDB
#undef PG8_MMA
#undef PG8_WAIT_V
#undef PG8_WAIT_L
#undef PG8_BAR
#undef PG8_SCHED
}

template <class Epi, class Sched>
__device__ __forceinline__ void gemm_phase_h(LAS unsigned char* lds, const int lda, const int ldb, const Sched& S, const Epi& E) {
    const int tid = threadIdx.x, wid = __builtin_amdgcn_readfirstlane(tid >> 6), lane = tid & 63, wr = wid >> 1, wc = wid & 1, hf = wid >> 2, fr = lane & 15, fq = lane >> 4;
    unsigned voffA[2], voffB[2];
#pragma unroll
    for (int i = 0; i < 2; ++i) { int R, C; stage_rc(tid * 16 + i * 8192, R, C); const int Rb = (R & ~31) + perm32(R & 31);
        voffA[i] = (unsigned)(R * lda + C) * 2u; voffB[i] = (unsigned)(Rb * ldb + C) * 2u; }
    const size_t kstep = (size_t)(BK * 2);
    const size_t hstepA = (size_t)HALF * lda * 2;
    const unsigned ldsw = (unsigned)wid * 1024u;
    const int aoff = lds_byte(wr * 32 + fr, fq * 8), boff = lds_byte(wc * 64 + fr, fq * 8);
#define PG8_SA(b, h) (((b) * 2 + (h)) * HTB)
#define PG8_SB(b, h) ((4 + (b) * 2 + (h)) * HTB)
#define PG8_STAGE(bufoff, gbase, voff) do { _Pragma("unroll") for (int _i = 0; _i < 2; ++_i) \
        __builtin_amdgcn_global_load_lds((const unsigned*)((const char*)(gbase) + (voff)[_i]), (LAS unsigned*)(lds + (bufoff) + ldsw + _i * 8192), 16, 0, 0); } while (0)
#define PG8_LDA(dst, b, h) do { _Pragma("unroll") for (int m = 0; m < 2; ++m) _Pragma("unroll") for (int k = 0; k < 2; ++k) dst[m][k] = *(const LAS h16x8*)(lds + PG8_SA(b, h) + aoff + m * 2048 + k * 1024); } while (0)
#define PG8_LDB(dst, b, h) do { _Pragma("unroll") for (int n = 0; n < 4; ++n) _Pragma("unroll") for (int k = 0; k < 2; ++k) dst[n][k] = *(const LAS h16x8*)(lds + PG8_SB(b, h) + boff + n * 2048 + k * 1024); } while (0)
#define PG8_MMA(ai, At, Bt) do { __builtin_amdgcn_s_setprio(1); _Pragma("unroll") for (int m = 0; m < 2; ++m) _Pragma("unroll") for (int n = 0; n < 4; ++n) _Pragma("unroll") for (int k = 0; k < 2; ++k) \
        acc[ai][m][n] = __builtin_amdgcn_mfma_f32_16x16x32_f16(Bt[n][k], At[m][k], acc[ai][m][n], 0, 0, 0); __builtin_amdgcn_s_setprio(0); } while (0)
#define PG8_WAIT_V(n) asm volatile("s_waitcnt vmcnt(" #n ")" ::: "memory")
#define PG8_WAIT_L(n) asm volatile("s_waitcnt lgkmcnt(" #n ")" ::: "memory")
#define PG8_BAR __builtin_amdgcn_s_barrier()
#define PG8_SCHED __builtin_amdgcn_sched_barrier(0)
    GUnit cur, nxt; int ui = 0;
    if (!S.next(0, cur)) return;
    f32x4 acc[2][2][4];
#pragma unroll
    for (int a = 0; a < 2; ++a)
#pragma unroll
        for (int m = 0; m < 2; ++m)
#pragma unroll
            for (int n = 0; n < 4; ++n) acc[a][m][n] = (f32x4){0.f, 0.f, 0.f, 0.f};
    h16x8 At[2][2], B0[4][2];
    const char* cA = cur.A; const char* cB = cur.B;
    PG8_STAGE(PG8_SB(0, 0), cB, voffB); PG8_STAGE(PG8_SA(0, 0), cA, voffA); PG8_STAGE(PG8_SA(0, 1), cA + hstepA, voffA);
    if (hf == 1) PG8_BAR;
    PG8_WAIT_V(2); PG8_BAR;
    PG8_STAGE(PG8_SB(1, 0), cB + kstep, voffB); PG8_STAGE(PG8_SA(1, 0), cA + kstep, voffA);
    PG8_WAIT_V(4); PG8_BAR;
    for (;;) {
        const bool has_next = S.next(ui + 1, nxt);
        const char* nA = has_next ? nxt.A : cA; const char* nB = has_next ? nxt.B : cB;
        const int nt = cur.nt;
        for (int t = 0; t < nt; t += 2) {
            const bool last = (t == nt - 2);
            const char* a1 = cA + (size_t)(t + 1) * kstep;
            const char* a2 = last ? nA : cA + (size_t)(t + 2) * kstep; const char* b2 = last ? nB : cB + (size_t)(t + 2) * kstep;
            const char* a3 = a2 + kstep; const char* b3 = b2 + kstep;
            PG8_LDB(B0, 0, 0); PG8_SCHED; PG8_LDA(At, 0, 0); PG8_STAGE(PG8_SA(1, 1), a1 + hstepA, voffA);
            PG8_WAIT_V(6); PG8_WAIT_L(0); PG8_BAR; PG8_MMA(0, At, B0); PG8_BAR; PG8_SCHED;
            PG8_LDA(At, 0, 1); PG8_STAGE(PG8_SB(0, 0), b2, voffB); PG8_STAGE(PG8_SA(0, 0), a2, voffA);
            PG8_WAIT_V(6); PG8_WAIT_L(0); PG8_BAR; PG8_MMA(1, At, B0); PG8_BAR; PG8_SCHED;
            PG8_LDB(B0, 1, 0); PG8_SCHED; PG8_LDA(At, 1, 0); PG8_STAGE(PG8_SA(0, 1), a2 + hstepA, voffA);
            PG8_WAIT_V(6); PG8_WAIT_L(0); PG8_BAR; PG8_MMA(0, At, B0); PG8_BAR; PG8_SCHED;
            PG8_LDA(At, 1, 1); PG8_STAGE(PG8_SB(1, 0), b3, voffB); PG8_STAGE(PG8_SA(1, 0), a3, voffA);
            PG8_WAIT_V(6); PG8_WAIT_L(0); PG8_BAR; PG8_MMA(1, At, B0); PG8_BAR; PG8_SCHED;
        }
        if (PG8_ALIGN) { if (hf == 0) PG8_BAR; }
        E(acc, cur, wr, wc, fr, fq);
        if (!has_next) break;
        cur = nxt; cA = nA; cB = nB; ++ui;
        if (PG8_ALIGN) { if (hf == 1) PG8_BAR; }
    }
    PG8_WAIT_V(0);
    if (!PG8_ALIGN) { if (hf == 0) PG8_BAR; }
    PG8_BAR;
#undef PG8_SA
#undef PG8_SB
#undef PG8_STAGE
#undef PG8_LDA
#undef PG8_LDB
#undef PG8_MMA
#undef PG8_WAIT_V
#undef PG8_WAIT_L
#undef PG8_BAR
#undef PG8_SCHED
}
}
using pg8::GUnit;

struct SchedPlain {
    const char* A; const char* B; int lda, ldb, nt, pm0, nM, nN, G, c;
    __device__ __forceinline__ bool next(int i, GUnit& u) const {
        const int L = i * G + c; if (L >= nM * nN) return false;
        int pm, pn; pg8::tile_map(L, nM, nN, pm, pn);
        u.pm = pm0 + pm; u.pn = pn; u.kind = 0; u.aux = 0; u.nt = nt;
        u.A = A + (size_t)u.pm * 256 * lda * 2; u.B = B + (size_t)pn * 256 * ldb * 2; return true;
    }
};
struct SchedMerge {
    const char* A; const char* B; int pm0, nM, G, c;
    __device__ __forceinline__ bool next(int i, GUnit& u) const {
        const int ti = i / 6, sub = i - ti * 6, L = ti * G + c; if (L >= nM * 4) return false;
        int pm, pn; pg8::tile_map(L, nM, 4, pm, pn);
        const int n = sub >> 1, br = sub & 1;
        u.pm = pm0 + pm; u.pn = pn; u.kind = sub; u.aux = n; u.nt = br ? 8 : 16;
        u.A = A + ((size_t)u.pm * 256 * AW + (br ? AY0 + n * 512 : AH)) * 2;
        u.B = B + ((size_t)(n * 1024 + pn * 256) * 1536 + (br ? 1024 : 0)) * 2; return true;
    }
};
struct SchedMoe {
    const char* A; const char* B; const int* panelE; int lda, ldb, nt, pm0, arow_pm0, nM, nN, G, c; size_t estride; int ks_shift;
    __device__ __forceinline__ bool next(int i, GUnit& u) const {
        const int Lq = i * G + c; if (Lq >= ((nM * nN) << ks_shift)) return false;
        const int q = Lq & ((1 << ks_shift) - 1), L = Lq >> ks_shift;
        int pm, pn; pg8::tile_map(L, nM, nN, pm, pn);
        u.pm = pm0 + pm; u.pn = pn; u.kind = 0; u.aux = q; u.nt = nt >> ks_shift;
        const int e = panelE[u.pm]; const size_t koff = (size_t)q * (nt >> ks_shift) * 128;
        u.A = A + (size_t)(u.pm - arow_pm0) * 256 * lda * 2 + koff; u.B = B + (size_t)e * estride + (size_t)pn * 256 * ldb * 2 + koff; return true;
    }
};

#define EPI_ARGS const f32x4 (&acc)[2][2][4][2], const GUnit& u, int wr, int wc, int fr, int fq
struct EpiF16 {
    static constexpr bool PERM = true;
    h16* O; int ldc;
    __device__ __forceinline__ void operator()(EPI_ARGS) const {
        const int row0 = u.pm * 256 + wr * 64 + fr, col0 = u.pn * 256 + wc * 32 + 8 * fq;
#pragma unroll
        for (int ai = 0; ai < 2; ++ai)
#pragma unroll
            for (int m = 0; m < 4; ++m) { h16* rowp = O + (size_t)(row0 + ai * 128 + m * 16) * ldc + col0;
#pragma unroll
                for (int bj = 0; bj < 2; ++bj) { const f32x4 v0 = acc[ai][bj][m][0], v1 = acc[ai][bj][m][1];
                    u32x4 w; w.x = pg8::cvt_pk_f16(v0[0], v0[1]); w.y = pg8::cvt_pk_f16(v0[2], v0[3]); w.z = pg8::cvt_pk_f16(v1[0], v1[1]); w.w = pg8::cvt_pk_f16(v1[2], v1[3]);
                    *(u32x4*)(rowp + bj * 128) = w; } }
    }
};
struct EpiMerge {
    static constexpr bool PERM = true;
    const float* bmerge;
    char* priv;
    h16* S16;
    __device__ __forceinline__ void operator()(EPI_ARGS) const {
        unsigned off0 = (unsigned)threadIdx.x * 16u; asm volatile("" : "+v"(off0));
        u32x4* pg = (u32x4*)(priv + off0); u32x4* ps = (u32x4*)(priv + 131072 + off0);
        if ((u.kind & 1) == 0) {
            const float* bb = bmerge + u.aux * 1024 + u.pn * 256 + wc * 32 + 8 * fq;
#pragma unroll
            for (int bj = 0; bj < 2; ++bj) { const f32x4 b0 = *(const f32x4*)(bb + bj * 128), b1 = *(const f32x4*)(bb + bj * 128 + 4);
#pragma unroll
                for (int ai = 0; ai < 2; ++ai)
#pragma unroll
                    for (int m = 0; m < 4; ++m) { f32x4 v0 = acc[ai][bj][m][0] + b0, v1 = acc[ai][bj][m][1] + b1;
#pragma unroll
                        for (int j = 0; j < 4; ++j) { v0[j] = sigmoidf_(v0[j]); v1[j] = sigmoidf_(v1[j]); }
                        u32x4 w; w.x = pg8::cvt_pk_f16(v0[0], v0[1]); w.y = pg8::cvt_pk_f16(v0[2], v0[3]); w.z = pg8::cvt_pk_f16(v1[0], v1[1]); w.w = pg8::cvt_pk_f16(v1[2], v1[3]);
                        pg[((ai * 2 + bj) * 4 + m) * 512] = w; } }
        } else {
            const int row0 = u.pm * 256 + wr * 64 + fr, col0 = u.pn * 256 + wc * 32 + 8 * fq;
#pragma unroll
            for (int ai = 0; ai < 2; ++ai) {
                u32x4 gw[2][4], sw[2][4];
#pragma unroll
                for (int bj = 0; bj < 2; ++bj)
#pragma unroll
                    for (int m = 0; m < 4; ++m) { const int slot = (ai * 2 + bj) * 4 + m; gw[bj][m] = pg[slot * 512]; if (u.kind != 1) sw[bj][m] = ps[slot * 512]; }
#pragma unroll
                for (int bj = 0; bj < 2; ++bj)
#pragma unroll
                    for (int m = 0; m < 4; ++m) { const int slot = (ai * 2 + bj) * 4 + m;
                        const h16x8 g = __builtin_bit_cast(h16x8, gw[bj][m]);
                        f32x4 s0 = acc[ai][bj][m][0], s1 = acc[ai][bj][m][1];
#pragma unroll
                        for (int j = 0; j < 4; ++j) { s0[j] *= (float)g[j]; s1[j] *= (float)g[4 + j]; }
                        if (u.kind != 1) { const h16x8 sp = __builtin_bit_cast(h16x8, sw[bj][m]);
#pragma unroll
                            for (int j = 0; j < 4; ++j) { s0[j] += (float)sp[j]; s1[j] += (float)sp[4 + j]; } }
                        u32x4 o; o.x = pg8::cvt_pk_f16(s0[0], s0[1]); o.y = pg8::cvt_pk_f16(s0[2], s0[3]); o.z = pg8::cvt_pk_f16(s1[0], s1[1]); o.w = pg8::cvt_pk_f16(s1[2], s1[3]);
                        if (u.kind != 5) ps[slot * 512] = o;
                        else *(u32x4*)(S16 + (size_t)(row0 + ai * 128 + m * 16) * 1024 + col0 + bj * 128) = o; }
                asm volatile("" ::: "memory"); }
        }
    }
};
struct SchedMergeH {
    const char* A; const char* B; int pm0, nM, G, c;
    __device__ __forceinline__ bool next(int i, GUnit& u) const {
        const int ti = i / 6, sub = i - ti * 6, L = ti * G + c; if (L >= nM * 8) return false;
        int pm, pn; pg8::tile_map(L, nM, 8, pm, pn);
        const int n = sub >> 1, br = sub & 1;
        u.pm = pm0 + pm; u.pn = pn; u.kind = sub; u.aux = n; u.nt = br ? 8 : 16;
        u.A = A + ((size_t)u.pm * 256 * AW + (br ? AY0 + n * 512 : AH)) * 2;
        u.B = B + ((size_t)(n * 1024 + pn * 128) * 1536 + (br ? 1024 : 0)) * 2; return true;
    }
};
struct EpiMergeH {
    const float* bmerge; h16* S16;
    mutable u32x2 gk[2][2][4];
    mutable f32x4 sk[2][2][4];
    __device__ __forceinline__ void operator()(f32x4 (&acc)[2][2][4], const GUnit& u, int wr, int wc, int fr, int fq) const {
        if ((u.kind & 1) == 0) {
            const float* bb = bmerge + u.aux * 1024 + u.pn * 128 + wc * 64 + 8 * fq;
            f32x4 bv[4];
#pragma unroll
            for (int n = 0; n < 4; ++n) bv[n] = *(const f32x4*)(bb + (n >> 1) * 32 + (n & 1) * 4);
#pragma unroll
            for (int ai = 0; ai < 2; ++ai)
#pragma unroll
                for (int m = 0; m < 2; ++m)
#pragma unroll
                    for (int n = 0; n < 4; ++n) { f32x4 v = acc[ai][m][n] + bv[n];
#pragma unroll
                        for (int j = 0; j < 4; ++j) v[j] = sigmoidf_(v[j]);
                        u32x2 w; w.x = pg8::cvt_pk_f16(v[0], v[1]); w.y = pg8::cvt_pk_f16(v[2], v[3]); gk[ai][m][n] = w; acc[ai][m][n] = (f32x4){0.f, 0.f, 0.f, 0.f}; }
        } else {
            const int row0 = u.pm * 256 + wr * 32 + fr, col0 = u.pn * 128 + wc * 64 + 8 * fq;
#pragma unroll
            for (int ai = 0; ai < 2; ++ai)
#pragma unroll
                for (int m = 0; m < 2; ++m)
#pragma unroll
                    for (int g2 = 0; g2 < 2; ++g2) { f32x4 s[2];
#pragma unroll
                        for (int q = 0; q < 2; ++q) { const int n = g2 * 2 + q; const h16x4 g = __builtin_bit_cast(h16x4, gk[ai][m][n]); f32x4 v = acc[ai][m][n];
#pragma unroll
                            for (int j = 0; j < 4; ++j) v[j] *= (float)g[j];
                            if (u.kind != 1) v += sk[ai][m][n];
                            sk[ai][m][n] = v; s[q] = v; acc[ai][m][n] = (f32x4){0.f, 0.f, 0.f, 0.f}; }
                        if (u.kind == 5) { u32x4 o; o.x = pg8::cvt_pk_f16(s[0][0], s[0][1]); o.y = pg8::cvt_pk_f16(s[0][2], s[0][3]); o.z = pg8::cvt_pk_f16(s[1][0], s[1][1]); o.w = pg8::cvt_pk_f16(s[1][2], s[1][3]);
                            *(u32x4*)(S16 + (size_t)(row0 + ai * 128 + m * 16) * 1024 + col0 + g2 * 32) = o; } }
        }
    }
};
struct EpiScaled {
    static constexpr bool PERM = true;
    h16* Y; const float* modv;
    __device__ __forceinline__ void operator()(EPI_ARGS) const {
        const int row0 = u.pm * 256 + wr * 64 + fr, col0 = u.pn * 256 + wc * 32 + 8 * fq;
        const int g = u.pm < 8 ? 0 : 1 + ((u.pm - 8) >> 4);
        f32x4 mv[2][2];
#pragma unroll
        for (int bj = 0; bj < 2; ++bj)
#pragma unroll
            for (int n = 0; n < 2; ++n) mv[bj][n] = *(const f32x4*)(modv + (size_t)g * 6144 + col0 + bj * 128 + 4 * n);
#pragma unroll
        for (int ai = 0; ai < 2; ++ai)
#pragma unroll
            for (int m = 0; m < 4; ++m) { h16* rowp = Y + (size_t)(row0 + ai * 128 + m * 16) * D + col0;
#pragma unroll
                for (int bj = 0; bj < 2; ++bj) { const f32x4 v0 = acc[ai][bj][m][0] * mv[bj][0], v1 = acc[ai][bj][m][1] * mv[bj][1];
                    u32x4 w; w.x = pg8::cvt_pk_f16(v0[0], v0[1]); w.y = pg8::cvt_pk_f16(v0[2], v0[3]); w.z = pg8::cvt_pk_f16(v1[0], v1[1]); w.w = pg8::cvt_pk_f16(v1[2], v1[3]);
                    *(u32x4*)(rowp + bj * 128) = w; } }
    }
};
struct EpiSwiglu {
    static constexpr bool PERM = true;
    h16* O; int ldc; int orow0;
    __device__ __forceinline__ void operator()(EPI_ARGS) const {
        const int row0 = u.pm * 256 - orow0 + wr * 64 + fr, col0 = u.pn * 128 + wc * 32 + 8 * fq;
#pragma unroll
        for (int ai = 0; ai < 2; ++ai)
#pragma unroll
            for (int m = 0; m < 4; ++m) { float o[8];
#pragma unroll
                for (int n = 0; n < 2; ++n)
#pragma unroll
                    for (int j = 0; j < 4; ++j) o[n * 4 + j] = siluf_(acc[ai][0][m][n][j]) * acc[ai][1][m][n][j];
                u32x4 w; w.x = pg8::cvt_pk_f16(o[0], o[1]); w.y = pg8::cvt_pk_f16(o[2], o[3]); w.z = pg8::cvt_pk_f16(o[4], o[5]); w.w = pg8::cvt_pk_f16(o[6], o[7]);
                *(u32x4*)(O + (size_t)(row0 + ai * 128 + m * 16) * ldc + col0) = w; }
    }
};
struct EpiMoeDown {
    static constexpr bool PERM = true;
    h16* OUT2; const int* rowT; const float* rowP; h16* OUTP; int tail;
    __device__ __forceinline__ void operator()(EPI_ARGS) const {
        const int row0 = u.pm * 256 + wr * 64 + fr, col0 = u.pn * 256 + wc * 32 + 8 * fq;
#pragma unroll
        for (int ai = 0; ai < 2; ++ai)
#pragma unroll
            for (int m = 0; m < 4; ++m) { const int r = row0 + ai * 128 + m * 16; const int tk = rowT[r]; const float pp = rowP[r];
                if (tk < 0) continue;
                h16* rowp = tail ? OUTP + ((size_t)u.aux * 2048 + (r - 65536)) * 1024 + col0 : OUT2 + ((size_t)(tk & 1) * ML + (tk >> 1)) * 1024 + col0;
#pragma unroll
                for (int bj = 0; bj < 2; ++bj) { const f32x4 v0 = acc[ai][bj][m][0] * pp, v1 = acc[ai][bj][m][1] * pp;
                    u32x4 w; w.x = pg8::cvt_pk_f16(v0[0], v0[1]); w.y = pg8::cvt_pk_f16(v0[2], v0[3]); w.z = pg8::cvt_pk_f16(v1[0], v1[1]); w.w = pg8::cvt_pk_f16(v1[2], v1[3]);
                    *(u32x4*)(rowp + bj * 128) = w; } }
    }
};

constexpr int LDS_BYTES = 147456;
constexpr size_t OFF_PRIV = OFF_BIG;
constexpr size_t OFF_YW = OFF_BIG;
__device__ __forceinline__ h16* S16_base(const Params& p, int l) { return l == 0 ? (h16*)p.out : (h16*)p.out - (size_t)MC * D; }
__device__ __forceinline__ h16* YW_base(const Params& p, int l) { return l == 0 ? WSP(h16, OFF_YW) : (h16*)p.out + (size_t)(ML - MC) * D; }
__device__ __forceinline__ void ph_gemm_in(const Params& p, LAS unsigned char* lds, int l, int G, int c) {
    SchedPlain S; S.A = (const char*)(WSP(h16, OFF_A) + AH); S.B = (const char*)WSP(h16, OFF_W16 + l * SZ_LAYERW); S.lda = AW; S.ldb = 1024; S.nt = 16; S.pm0 = 0; S.nM = MT / 256; S.nN = ZW / 256; S.G = G; S.c = c;
    EpiF16 E; E.O = WSP(h16, OFF_Z); E.ldc = ZW;
    pg8::gemm_phase(lds, AW, 1024, S, E);
}
__device__ __forceinline__ void ph_merge(const Params& p, LAS unsigned char* lds, int l, int G, int c) {
    SchedMergeH S; S.A = (const char*)WSP(h16, OFF_A); S.B = (const char*)WSP(h16, OFF_W16 + l * SZ_LAYERW + SZ_WINT); S.pm0 = l == 0 ? 0 : 8; S.nM = MT / 256 - S.pm0; S.G = G; S.c = c;
    EpiMergeH E; E.bmerge = p.b_merge + (size_t)l * 3 * 1024; E.S16 = S16_base(p, l);
    pg8::gemm_phase_h(lds, AW, 1536, S, E);
}
__device__ __forceinline__ void ph_wout(const Params& p, LAS unsigned char* lds, int l, int G, int c) {
    SchedPlain S; S.A = (const char*)S16_base(p, l); S.B = (const char*)WSP(h16, OFF_W16 + l * SZ_LAYERW + SZ_WINT + SZ_BTALL); S.lda = 1024; S.ldb = 1024; S.nt = 16; S.pm0 = l == 0 ? 0 : 8; S.nM = MT / 256 - S.pm0; S.nN = 4; S.G = G; S.c = c;
    EpiScaled E; E.Y = YW_base(p, l); E.modv = WSP(float, OFF_MOD) + (size_t)l * 9 * 6144 + 2 * 1024;
    pg8::gemm_phase(lds, 1024, 1024, S, E);
}
__device__ __forceinline__ void ph_ffn_gu(const Params& p, LAS unsigned char* lds, int G, int c) {
    SchedPlain S; S.A = (const char*)(WSP(h16, OFF_A) + AH); S.B = (const char*)WSP(h16, OFF_WGUT); S.lda = AW; S.ldb = 1024; S.nt = 16; S.pm0 = 0; S.nM = MT / 256; S.nN = 2 * DFF / 256; S.G = G; S.c = c;
    EpiSwiglu E; E.O = WSP(h16, OFF_ACT); E.ldc = DFF; E.orow0 = 0;
    pg8::gemm_phase(lds, AW, 1024, S, E);
}
__device__ __forceinline__ void ph_ffn_down(const Params& p, LAS unsigned char* lds, int G, int c) {
    SchedPlain S; S.A = (const char*)WSP(h16, OFF_ACT); S.B = (const char*)WSP(h16, OFF_WDT); S.lda = DFF; S.ldb = DFF; S.nt = DFF / 64; S.pm0 = 0; S.nM = MT / 256; S.nN = 4; S.G = G; S.c = c;
    EpiScaled E; E.Y = (h16*)p.out; E.modv = WSP(float, OFF_MOD) + 5 * 1024;
    pg8::gemm_phase(lds, DFF, DFF, S, E);
}
__device__ __forceinline__ void ph_moe_gu(const Params& p, LAS unsigned char* lds, int panel0, int G, int c) {
    const int* plan = WSP(int, OFF_PLAN); const int np = plan[8]; int nM = np - panel0; nM = nM > 64 ? 64 : nM; if (nM <= 0) return;
    SchedMoe S; S.A = (const char*)WSP(h16, OFF_XG); S.B = (const char*)WSP(h16, OFF_WMOE_GU); S.panelE = plan + 16; S.lda = 1024; S.ldb = 1024; S.nt = 16; S.pm0 = panel0; S.arow_pm0 = 0; S.nM = nM; S.nN = 2 * DEX / 256; S.G = G; S.c = c; S.estride = (size_t)2 * DEX * 1024 * 2; S.ks_shift = 0;
    EpiSwiglu E; E.O = (h16*)p.out; E.ldc = DEX; E.orow0 = panel0 * 256;
    pg8::gemm_phase(lds, 1024, 1024, S, E);
}
__device__ __forceinline__ void ph_moe_down(const Params& p, LAS unsigned char* lds, int panel0, int G, int c) {
    const int* plan = WSP(int, OFF_PLAN); const int np = plan[8]; int nM = np - panel0; nM = nM > 64 ? 64 : nM; if (nM <= 0) return;
    const int tail = panel0 >= 256;
    SchedMoe S; S.A = (const char*)p.out; S.B = (const char*)WSP(h16, OFF_WMOE_D); S.panelE = plan + 16; S.lda = DEX; S.ldb = DEX; S.nt = DEX / 64; S.pm0 = panel0; S.arow_pm0 = panel0; S.nM = nM; S.nN = 4; S.G = G; S.c = c; S.estride = (size_t)1024 * DEX * 2; S.ks_shift = tail ? 2 : 0;
    EpiMoeDown E; E.OUT2 = WSP(h16, OFF_OUT2); E.rowT = WSP(int, OFF_ROWT); E.rowP = WSP(float, OFF_ROWP); E.OUTP = WSP(h16, OFF_OUTP); E.tail = tail;
    pg8::gemm_phase(lds, DEX, DEX, S, E);
}

namespace attn_body {
using s16x4 = __attribute__((ext_vector_type(4))) short;
using s16x8 = __attribute__((ext_vector_type(8))) short;
using f32x16 = __attribute__((ext_vector_type(16))) float;
constexpr int D64 = 64, NW = 8, QBLK = 32, QB = QBLK * NW, KVBLK = 64;
constexpr int QP = 512, KP = 128, OP = AW;
__device__ __forceinline__ int crow(int r, int hi) { return (r & 3) + 8 * (r >> 2) + 4 * hi; }
#define SBAR() __builtin_amdgcn_sched_barrier(0)
constexpr int NSLOT = 3, SLOTB = 8192;
constexpr int LDS_K = 0, LDS_V = NSLOT * SLOTB, LDS_WS = 2 * NSLOT * SLOTB, LDS_OST = LDS_WS + NW * 64 * 4, ATTN_LDS_BYTES = LDS_OST + NW * 4096;
__device__ __forceinline__ void glds16(const void* gsrc, unsigned lds_dst) { unsigned keep;
    asm volatile("s_mov_b32 %0, m0\n\ts_mov_b32 m0, %2\n\ts_nop 0\n\tglobal_load_lds_dwordx4 %1, off\n\ts_mov_b32 m0, %0" : "=&s"(keep) : "v"(gsrc), "s"(lds_dst) : "memory"); }
__device__ __forceinline__ float max3f(float a, float b, float c) { float r; asm("v_max3_f32 %0, %1, %2, %3" : "=v"(r) : "v"(a), "v"(b), "v"(c)); return r; }
__device__ __forceinline__ float max2f(float a, float b) { float r; asm("v_max_f32_e32 %0, %1, %2" : "=v"(r) : "v"(a), "v"(b)); return r; }
__device__ __forceinline__ float fadd_s(float a, float b) { float r; asm("v_add_f32_e32 %0, %1, %2" : "=v"(r) : "v"(a), "v"(b)); return r; }
__device__ __forceinline__ float fsub_s(float a, float b) { float r; asm("v_sub_f32_e32 %0, %1, %2" : "=v"(r) : "v"(a), "v"(b)); return r; }
__device__ __forceinline__ unsigned cvtpk_s(float lo, float hi) { return pg8::cvt_pk_f16(lo, hi); }
#define WAIT_BAR(N) asm volatile("s_waitcnt vmcnt(" #N ") lgkmcnt(0)\n\ts_barrier" ::: "memory")
#define AMFMA(a, b, c) __builtin_amdgcn_mfma_f32_32x32x16_f16(__builtin_bit_cast(h16x8, a), __builtin_bit_cast(h16x8, b), c, 0, 0, 0)
__device__ __forceinline__ void qkt(f32x16& p0, f32x16& p1, const char* Kslot, const s16x8* qr, const f32x16& negm, int r32, int hi) {
    const char* kb = Kslot + hi * 1024 + r32 * 16;
#pragma unroll
    for (int d0 = 0; d0 < 4; ++d0) {
        const s16x8 b0 = *reinterpret_cast<const s16x8*>(kb + d0 * 2048);
        const s16x8 b1 = *reinterpret_cast<const s16x8*>(kb + d0 * 2048 + 512);
        if (d0 == 0) { p0 = AMFMA(b0, qr[0], negm); p1 = AMFMA(b1, qr[0], negm); }
        else { p0 = AMFMA(b0, qr[d0], p0); p1 = AMFMA(b1, qr[d0], p1); } }
}
typedef __attribute__((address_space(3))) const char* lds_cptr;
typedef short v4i16_t __attribute__((ext_vector_type(4)));
__device__ __forceinline__ void kload8(s16x8* kf, lds_cptr kp) {
    kf[0] = *(const __attribute__((address_space(3))) s16x8*)(kp);        kf[1] = *(const __attribute__((address_space(3))) s16x8*)(kp + 512);
    kf[2] = *(const __attribute__((address_space(3))) s16x8*)(kp + 2048); kf[3] = *(const __attribute__((address_space(3))) s16x8*)(kp + 2560);
    kf[4] = *(const __attribute__((address_space(3))) s16x8*)(kp + 4096); kf[5] = *(const __attribute__((address_space(3))) s16x8*)(kp + 4608);
    kf[6] = *(const __attribute__((address_space(3))) s16x8*)(kp + 6144); kf[7] = *(const __attribute__((address_space(3))) s16x8*)(kp + 6656);
}
__device__ __forceinline__ void kload2(s16x8* kf, lds_cptr kp, int j) { kf[2 * j] = *(const __attribute__((address_space(3))) s16x8*)(kp + j * 2048); kf[2 * j + 1] = *(const __attribute__((address_space(3))) s16x8*)(kp + j * 2048 + 512); }
__device__ __forceinline__ s16x4 vtr(lds_cptr p) { return __builtin_bit_cast(s16x4, __builtin_amdgcn_ds_read_tr16_b64_v4i16((__attribute__((address_space(3))) v4i16_t*)p)); }
__device__ __forceinline__ float rowmax(const f32x16& p0, const f32x16& p1) {
    float a = max3f(p0[0], p0[1], p1[0]), b = max3f(p0[2], p0[3], p1[1]); a = max3f(a, p1[2], p1[3]);
#pragma unroll
    for (int r = 4; r < 16; r += 4) { a = max3f(a, p0[r], p0[r + 1]); b = max3f(b, p0[r + 2], p0[r + 3]); a = max3f(a, p1[r], p1[r + 1]); b = max3f(b, p1[r + 2], p1[r + 3]); }
    const float m = max2f(a, b);
    auto rr = __builtin_amdgcn_permlane32_swap(__float_as_uint(m), __float_as_uint(m), false, false);
    return max2f(__uint_as_float(rr[0]), __uint_as_float(rr[1]));
}
__device__ __forceinline__ void pv(f32x16* o, int vb, s16x8 pa0, s16x8 pa1, s16x8 pa2, s16x8 pa3) {
#pragma unroll
    for (int d0 = 0; d0 < 2; ++d0) { s16x4 lo[4], hi[4];
#pragma unroll
        for (int ks = 0; ks < 4; ++ks) {
            asm volatile("ds_read_b64_tr_b16 %0,%1 offset:%c2" : "=&v"(lo[ks]) : "v"(vb), "i"(d0 * 4096 + ks * 1024) : "memory");
            asm volatile("ds_read_b64_tr_b16 %0,%1 offset:%c2" : "=&v"(hi[ks]) : "v"(vb), "i"(d0 * 4096 + ks * 1024 + 512) : "memory"); }
        asm volatile("s_waitcnt lgkmcnt(0)" ::: "memory"); SBAR();
#define PK(k) (s16x8){lo[k][0], lo[k][1], lo[k][2], lo[k][3], hi[k][0], hi[k][1], hi[k][2], hi[k][3]}
        o[d0] = AMFMA(pa0, PK(0), o[d0]);
        o[d0] = AMFMA(pa1, PK(1), o[d0]);
        o[d0] = AMFMA(pa2, PK(2), o[d0]);
        o[d0] = AMFMA(pa3, PK(3), o[d0]);
#undef PK
    }
}
template <int THRL> __device__ __forceinline__ void attn_unit(const h16* Qu, const h16* __restrict__ Ku, const h16* __restrict__ Vu, h16* Ou, const int NT, char* shm) {
    const int tid = threadIdx.x, lane = tid & 63, r32 = lane & 31, hi = lane >> 5; const int wid = __builtin_amdgcn_readfirstlane(tid >> 6);
    const h16* Qw = Qu + (size_t)(wid * QBLK) * QP;
    const unsigned lds0 = (unsigned)(uintptr_t)shm;
    float* wsf = (float*)(shm + LDS_WS) + wid * 64;
    const h16* ksrc = Ku + (long)lane * KP + wid * 8;
    const h16* vsrc = Vu + (long)(16 * (wid & 3) + (lane >> 2)) * KP + (wid >> 2) * 32 + (lane & 3) * 8;
    const unsigned kdst = lds0 + LDS_K + wid * 1024, vdst = lds0 + LDS_V + wid * 1024;
#define DMA_K(t, slot) glds16(ksrc + (long)(t) * KVBLK * KP, (unsigned)__builtin_amdgcn_readfirstlane(kdst + (slot)))
#define DMA_V(t, slot) glds16(vsrc + (long)(t) * KVBLK * KP, (unsigned)__builtin_amdgcn_readfirstlane(vdst + (slot)))
    const int vb0 = (int)(lds0 + LDS_V) + ((lane >> 4) & 1) * 32 + (lane & 3) * 8 + (4 * hi + ((lane & 15) >> 2)) * 64;
    const char* Kbase = shm + LDS_K; s16x8 kf[8];
    const lds_cptr shm3 = (lds_cptr)shm; const lds_cptr kp0 = shm3 + LDS_K + hi * 1024 + r32 * 16; const lds_cptr vp0 = shm3 + LDS_V + ((lane >> 4) & 1) * 32 + (lane & 3) * 8 + (4 * hi + ((lane & 15) >> 2)) * 64;
    DMA_K(0, 0); DMA_V(0, 0); DMA_K(1, SLOTB);
    s16x8 qr[4];
#pragma unroll
    for (int d0 = 0; d0 < 4; ++d0) qr[d0] = *reinterpret_cast<const s16x8*>(&Qw[(long)r32 * QP + d0 * 16 + hi * 8]);
    float mhat = 0.f, l_reg = 0.f; f32x16 o[2]; o[0] = f32x16{}; o[1] = f32x16{}; f32x16 negm = f32x16{}; asm volatile("" : "+v"(negm));
    bool resc = false;
#define START(P0, P1) do { const float rm = rowmax(P0, P1); resc = false; \
    { const float dl = rm; mhat = fadd_s(mhat, dl); \
      _Pragma("unroll") for (int r = 0; r < 16; ++r) { P0[r] = fsub_s(P0[r], dl); P1[r] = fsub_s(P1[r], dl); } \
      _Pragma("unroll") for (int r = 0; r < 16; ++r) negm[r] = -mhat; asm volatile("" : "+v"(negm)); } \
    _Pragma("unroll") for (int r = 0; r < 16; ++r) P0[r] = __builtin_amdgcn_exp2f(P0[r]); } while (0)
#define RESC() do { if (resc) { asm volatile("s_waitcnt lgkmcnt(0)" ::: "memory"); \
      _Pragma("unroll") for (int d_ = 0; d_ < 2; ++d_) _Pragma("unroll") for (int r = 0; r < 16; ++r) o[d_][r] *= wsf[crow(r, hi)]; } } while (0)
    f32x16 pA0, pA1, pB0, pB1;
    int sl_prev = 0, sl_cur = 0, sl_next = SLOTB;
#define ROT() do { sl_prev = sl_cur; sl_cur = sl_next; sl_next = (sl_next == (NSLOT - 1) * SLOTB) ? 0 : sl_next + SLOTB; } while (0)
    DMA_K(2, 2 * SLOTB);
    WAIT_BAR(3);
    qkt(pA0, pA1, Kbase, qr, negm, r32, hi); asm volatile("s_nop 15\n\ts_nop 7" : "+v"(pA0), "+v"(pA1));
    START(pA0, pA1);
    _Pragma("unroll") for (int r = 0; r < 16; ++r) pA1[r] = __builtin_amdgcn_exp2f(pA1[r]);
    WAIT_BAR(0);
    DMA_K(3, 0); DMA_V(1, SLOTB);
    ROT();
    kload8(kf, kp0 + sl_cur);
    WAIT_BAR(2);
    s16x4 vlo[8], vhi[8]; u32x4 pw0, pw1, pw2, pw3;
#define PKW(P, B) cvtpk_s(P[B], P[B + 1])
#define PAF(k) __builtin_bit_cast(s16x8, pw##k)
#define VFR(i) (s16x8){vlo[i][0], vlo[i][1], vlo[i][2], vlo[i][3], vhi[i][0], vhi[i][1], vhi[i][2], vhi[i][3]}
#define PIN(x) asm volatile("" : "+v"(x))
#define MX3(a, b, c) __builtin_fmaxf(__builtin_fmaxf((a), (b)), (c))
#define GAPA(MF, A0, A1, A2, A3, W0, W1, PW) do { MF; sacc += A0; sacc += A1; sacc += A2; sacc += A3; PIN(sacc); W0; W1; PIN(PW); SBAR(); } while (0)
#define EX(v) __builtin_amdgcn_exp2f(v)
#define GAPB(MF, X, B) do { MF; X[B] = EX(X[B]); X[B + 1] = EX(X[B + 1]); X[B + 2] = EX(X[B + 2]); X[B + 3] = EX(X[B + 3]); PIN(X); SBAR(); } while (0)
#define VRD(i) do { vlo[i] = vtr(vp_ + (((i) >> 2) * 4096 + ((i) & 3) * 1024)); vhi[i] = vtr(vp_ + (((i) >> 2) * 4096 + ((i) & 3) * 1024 + 512)); } while (0)
#define KRD(G, j) do { if (G) { kload2(kf, kp0 + sl_next, j); SBAR(); } } while (0)
#define STEP(C0, C1, P0, P1, t, GK, GV, GL) do { SBAR(); \
    const lds_cptr vp_ = vp0 + sl_prev; \
    VRD(0); SBAR(); float sacc = (P0[0] + P0[1]); \
    GAPA(C0 = AMFMA(kf[0], qr[0], negm), P0[2], P0[3], P0[4], P0[5],     pw0[0] = PKW(P0, 0), pw0[1] = PKW(P0, 2), pw0); \
    VRD(4); SBAR(); GAPA(C1 = AMFMA(kf[1], qr[0], negm), P0[6], P0[7], P0[8], P0[9],     pw0[2] = PKW(P0, 4), pw0[3] = PKW(P0, 6), pw0); \
    VRD(1); SBAR(); GAPA(C0 = AMFMA(kf[2], qr[1], C0),   P0[10], P0[11], P0[12], P0[13], pw1[0] = PKW(P0, 8), pw1[1] = PKW(P0, 10), pw1); \
    VRD(5); SBAR(); GAPA(C1 = AMFMA(kf[3], qr[1], C1),   P0[14], P0[15], P1[0], P1[1],   pw1[2] = PKW(P0, 12), pw1[3] = PKW(P0, 14), pw1); \
    VRD(2); SBAR(); GAPA(C0 = AMFMA(kf[4], qr[2], C0),   P1[2], P1[3], P1[4], P1[5],     pw2[0] = PKW(P1, 0), pw2[1] = PKW(P1, 2), pw2); \
    VRD(6); SBAR(); GAPA(C1 = AMFMA(kf[5], qr[2], C1),   P1[6], P1[7], P1[8], P1[9],     pw2[2] = PKW(P1, 4), pw2[3] = PKW(P1, 6), pw2); \
    VRD(3); SBAR(); GAPA(C0 = AMFMA(kf[6], qr[3], C0),   P1[10], P1[11], P1[12], P1[13], pw3[0] = PKW(P1, 8), pw3[1] = PKW(P1, 10), pw3); \
    VRD(7); SBAR(); GAPA(C1 = AMFMA(kf[7], qr[3], C1),   P1[14], P1[15], 0.f, 0.f,       pw3[2] = PKW(P1, 12), pw3[3] = PKW(P1, 14), pw3); \
    l_reg += sacc; \
    if (GK) { DMA_K((t) + 3, sl_cur); } if (GV) { DMA_V((t) + 1, sl_next); } \
    { float a = MX3(C0[0], C0[1], C1[0]), b = MX3(C0[2], C0[3], C1[1]); a = MX3(a, C1[2], C1[3]); \
      _Pragma("unroll") for (int r = 4; r < 16; r += 4) { a = MX3(a, C0[r], C0[r + 1]); b = MX3(b, C0[r + 2], C0[r + 3]); a = MX3(a, C1[r], C1[r + 1]); b = MX3(b, C1[r + 2], C1[r + 3]); } \
      float rm = __builtin_fmaxf(a, b); { auto rr = __builtin_amdgcn_permlane32_swap(__float_as_uint(rm), __float_as_uint(rm), false, false); rm = __builtin_fmaxf(__uint_as_float(rr[0]), __uint_as_float(rr[1])); } \
      resc = false; \
      if (__builtin_expect(__any(rm > (float)THRL), 0)) { const float dl = __builtin_fmaxf(rm, 0.f); mhat += dl; \
        _Pragma("unroll") for (int r = 0; r < 16; ++r) { C0[r] -= dl; C1[r] -= dl; } \
        _Pragma("unroll") for (int r = 0; r < 16; ++r) negm[r] = -mhat; asm volatile("" : "+v"(negm)); \
        const float f = __builtin_amdgcn_exp2f(-dl); l_reg *= f; if (hi == 0) wsf[r32] = f; resc = true; } } \
    SBAR(); \
    GAPB(o[0] = AMFMA(PAF(0), VFR(0), o[0]), C0, 0); \
    GAPB(o[1] = AMFMA(PAF(0), VFR(4), o[1]), C0, 4); \
    KRD(GL, 0); GAPB(o[0] = AMFMA(PAF(1), VFR(1), o[0]), C0, 8); \
    KRD(GL, 1); GAPB(o[1] = AMFMA(PAF(1), VFR(5), o[1]), C0, 12); \
    KRD(GL, 2); GAPB(o[0] = AMFMA(PAF(2), VFR(2), o[0]), C1, 0); \
    KRD(GL, 3); GAPB(o[1] = AMFMA(PAF(2), VFR(6), o[1]), C1, 4); \
    GAPB(o[0] = AMFMA(PAF(3), VFR(3), o[0]), C1, 8); \
    GAPB(o[1] = AMFMA(PAF(3), VFR(7), o[1]), C1, 12); \
    } while (0)
    int t = 1;
    for (; t + 5 < NT; t += 2) {
        STEP(pB0, pB1, pA0, pA1, t, true, true, true);     WAIT_BAR(2); RESC(); ROT();
        STEP(pA0, pA1, pB0, pB1, t + 1, true, true, true); WAIT_BAR(2); RESC(); ROT();
    }
#define ENDW(tt) do { if ((tt) + 3 < NT) { WAIT_BAR(2); } else if ((tt) + 2 < NT) { WAIT_BAR(1); } else { WAIT_BAR(0); } } while (0)
    for (; t + 1 < NT; t += 2) {
        STEP(pB0, pB1, pA0, pA1, t, (t + 3 < NT), (t + 1 < NT), (t + 1 < NT));         ENDW(t);     RESC(); ROT();
        STEP(pA0, pA1, pB0, pB1, t + 1, (t + 4 < NT), (t + 2 < NT), (t + 2 < NT));     ENDW(t + 1); RESC(); ROT();
    }
    STEP(pB0, pB1, pA0, pA1, NT - 1, false, false, false); RESC();
    { float sacc = pB0[0] + pB0[1]; _Pragma("unroll") for (int r = 2; r < 16; ++r) sacc += pB0[r]; _Pragma("unroll") for (int r = 0; r < 16; ++r) sacc += pB1[r]; l_reg += sacc;
      pw0 = (u32x4){PKW(pB0, 0), PKW(pB0, 2), PKW(pB0, 4), PKW(pB0, 6)}; pw1 = (u32x4){PKW(pB0, 8), PKW(pB0, 10), PKW(pB0, 12), PKW(pB0, 14)}; pw2 = (u32x4){PKW(pB1, 0), PKW(pB1, 2), PKW(pB1, 4), PKW(pB1, 6)}; pw3 = (u32x4){PKW(pB1, 8), PKW(pB1, 10), PKW(pB1, 12), PKW(pB1, 14)};
      SBAR(); pv(o, vb0 + sl_cur, PAF(0), PAF(1), PAF(2), PAF(3)); }
#undef PKW
#undef PAF
#undef VFR
#undef PIN
#undef MX3
#undef GAPA
#undef GAPB
#undef EX
#undef VRD
#undef KRD
#undef STEP
#undef ENDW
    { auto rr = __builtin_amdgcn_permlane32_swap(__float_as_uint(l_reg), __float_as_uint(l_reg), false, false); l_reg = __uint_as_float(rr[0]) + __uint_as_float(rr[1]); }
    if (hi == 0) wsf[32 + r32] = l_reg; asm volatile("s_waitcnt lgkmcnt(0)" ::: "memory");
    float rli[16];
#pragma unroll
    for (int r = 0; r < 16; ++r) rli[r] = __builtin_amdgcn_rcpf(wsf[32 + crow(r, hi)]);
    h16* Ow = Ou + (size_t)(wid * QBLK) * OP;
    { h16* stg = (h16*)(shm + LDS_OST) + wid * 2048;
#pragma unroll
      for (int r = 0; r < 16; ++r) { const int orow = crow(r, hi);
#pragma unroll
        for (int d0 = 0; d0 < 2; ++d0) stg[orow * 64 + d0 * 32 + r32] = (h16)(o[d0][r] * rli[r]); }
      asm volatile("s_waitcnt lgkmcnt(0)" ::: "memory");
#pragma unroll
      for (int i = 0; i < 4; ++i) { const int row = i * 8 + (lane >> 3), ch = lane & 7; const u32x4 v = *(const u32x4*)(stg + row * 64 + ch * 8); *(u32x4*)(Ow + (long)row * OP + ch * 8) = v; } }
    asm volatile("s_waitcnt lgkmcnt(0)\n\ts_barrier" ::: "memory");
#undef DMA_K
#undef DMA_V
#undef START
#undef RESC
#undef ROT
}
#undef SBAR
#undef WAIT_BAR
#undef AMFMA
}

__device__ __forceinline__ void ph_attn(const Params& p, char* shm, int l, int G, int c) {
    const h16* Qh = WSP(h16, OFF_QH); const h16* Kh = WSP(h16, OFF_KH); const h16* Vh = WSP(h16, OFF_VH); h16* A = WSP(h16, OFF_A);
    const int x = c & 7, j0 = c >> 3, nx = (G + 7 - x) >> 3;
    for (int j = j0; j < 128; j += nx) {
        const int set = 2 * x + (j >> 6), un = j & 63, b = set >> 1, kvh = set & 1, hq = kvh * 4 + (un >> 4), qb = un & 15;
        const size_t qrow = (size_t)MC + (size_t)b * SEQ + (size_t)qb * 256;
        attn_body::attn_unit<8>(Qh + qrow * 512 + hq * 64, Kh + (size_t)b * SB * 128 + kvh * 64, Vh + (size_t)b * SB * 128 + kvh * 64, A + qrow * AW + AY1 + hq * 64, SB / 64, shm);
    }
    if (l == 0) for (int u = c; u < 64; u += G) {
        const int b = u >> 3, hq = u & 7, kvh = hq >> 2; const size_t qrow = (size_t)b * CTX;
        attn_body::attn_unit<8>(Qh + qrow * 512 + hq * 64, Kh + (size_t)b * SB * 128 + kvh * 64, Vh + (size_t)b * SB * 128 + kvh * 64, A + qrow * AW + AY1 + hq * 64, CTX / 64, shm);
    }
}

#define XB_TMO      128
#define XB_XCNT(j)  (256  + 64 * (j))
#define XB_XSUB(j)  (1280 + 64 * (j))
#define XB_XGEN(j)  (2304 + 64 * (j))
#define XB_TOP      3328
#define XB_TOPGEN   3392
#define XCD_BAR_WORDS 3456
#define XB_SPIN_CAP (1u << 18)
__device__ __forceinline__ unsigned xb_ld(unsigned* p)              { return __hip_atomic_load(p, __ATOMIC_RELAXED, __HIP_MEMORY_SCOPE_AGENT); }
__device__ __forceinline__ unsigned xb_add(unsigned* p, unsigned v) { return __hip_atomic_fetch_add(p, v, __ATOMIC_RELAXED, __HIP_MEMORY_SCOPE_AGENT); }
__device__ __forceinline__ unsigned xb_xcc_id() { return (unsigned)__builtin_amdgcn_s_getreg((3 << 11) | 20) & 0xFu; }
#define XB_SPIN(cond, bar) do { unsigned _sp = 0; while (cond) { __builtin_amdgcn_s_sleep(1); \
    if ((++_sp & 255u) == 0u) { if (xb_ld(&(bar)[XB_TMO])) break; if (_sp > XB_SPIN_CAP) { atomicAdd(&(bar)[XB_TMO], 1u); break; } } } } while (0)
struct XcdBarrier { unsigned* bar; unsigned x; volatile LAS unsigned* st; };
__device__ __forceinline__ XcdBarrier xcd_barrier_post(unsigned* bar, volatile LAS unsigned* st) {
    XcdBarrier b; b.bar = bar; b.x = xb_xcc_id(); b.st = st;
    if (threadIdx.x == 0) (void)xb_add(&bar[XB_XCNT(b.x)], 1u);
    return b;
}
__device__ __forceinline__ void xcd_barrier_complete(unsigned* bar, unsigned x, unsigned& nloc, unsigned& nx) {
    const unsigned G = gridDim.x * gridDim.y * gridDim.z;
    unsigned sum, cnt, mine, sp = 0u;
    for (;;) {
        sum = 0u; cnt = 0u; mine = 0u;
#pragma unroll
        for (unsigned j = 0; j < 16; ++j) { const unsigned c = xb_ld(&bar[XB_XCNT(j)]); sum += c; cnt += (c > 0u) ? 1u : 0u; mine = (j == x) ? c : mine; }
        if (sum == G) break;
        __builtin_amdgcn_s_sleep(1);
        if ((++sp & 255u) == 0u) { if (xb_ld(&bar[XB_TMO])) break; if (sp > XB_SPIN_CAP) { atomicAdd(&bar[XB_TMO], 1u); break; } }
    }
    nloc = mine > 0u ? mine : 1u; nx = cnt > 0u ? cnt : 1u;
}
__device__ __forceinline__ void xcd_barrier(const XcdBarrier& b) {
    asm volatile("s_waitcnt vmcnt(0)" ::: "memory");
    __syncthreads();
    if (threadIdx.x == 0) {
        unsigned* bar = b.bar;
        __builtin_amdgcn_s_waitcnt(0);
        unsigned nloc = b.st[0], nx = b.st[1];
        if (nloc == 0u) { xcd_barrier_complete(bar, b.x, nloc, nx); b.st[0] = nloc; b.st[1] = nx; }
        const unsigned old = xb_add(&bar[XB_XSUB(b.x)], 1u);
        const unsigned gen = old / nloc;
        if (old + 1u == (gen + 1u) * nloc) {
            __builtin_amdgcn_fence(__ATOMIC_RELEASE, "agent");
            asm volatile("s_waitcnt vmcnt(0)" ::: "memory");
            const unsigned og = xb_add(&bar[XB_TOP], 1u);
            const unsigned tg = og / nx;
            if (og + 1u == (tg + 1u) * nx) xb_add(&bar[XB_TOPGEN], 1u);
            else XB_SPIN(xb_ld(&bar[XB_TOPGEN]) == tg, bar);
            __builtin_amdgcn_fence(__ATOMIC_ACQUIRE, "agent");
            xb_add(&bar[XB_XGEN(b.x)], 1u);
            asm volatile("s_waitcnt vmcnt(0)" ::: "memory");
        } else {
            XB_SPIN(xb_ld(&bar[XB_XGEN(b.x)]) == gen, bar);
            __builtin_amdgcn_fence(__ATOMIC_ACQUIRE, "agent");
            asm volatile("s_waitcnt vmcnt(0)" ::: "memory");
        }
    }
    __syncthreads();
}

constexpr int NTH = 512;
template <int NT> __device__ __forceinline__ void poolfold_unit(const Params& p, int u, float (*Ws)[132]) {
    const int l = u / 64, g = (u / 16) % 4, k0 = (u % 16) * 64, tid = threadIdx.x;
    const float* pw = p.pool_w + (size_t)(l * 4 + g) * 128 * 128;
    const int jj = tid & 127;
    __syncthreads();
    for (int i = tid; i < 64 * 32; i += NT) *(float4*)&Ws[i >> 5][(i & 31) * 4] = *(const float4*)(p.w_in + (size_t)l * 1024 * WIN + (size_t)(k0 + (i >> 5)) * WIN + g * 128 + (i & 31) * 4);
    __syncthreads();
    constexpr int NKK = 64 / (NT / 128);
    float acc[NKK];
#pragma unroll
    for (int q = 0; q < NKK; ++q) acc[q] = 0.f;
#pragma unroll 1
    for (int hf = 0; hf < 2; ++hf) {
        float pcol[64];
#pragma unroll
        for (int c2 = 0; c2 < 64; ++c2) pcol[c2] = pw[(hf * 64 + c2) * 128 + jj];
#pragma unroll
        for (int q = 0; q < NKK; ++q) { const int kk = (tid >> 7) + q * (NT / 128);
#pragma unroll
            for (int c4 = 0; c4 < 16; ++c4) { const float4 w4 = *(const float4*)&Ws[kk][hf * 64 + c4 * 4]; acc[q] += w4.x * pcol[c4 * 4] + w4.y * pcol[c4 * 4 + 1] + w4.z * pcol[c4 * 4 + 2] + w4.w * pcol[c4 * 4 + 3]; } }
    }
    h16* wint = WSP(h16, OFF_W16 + l * SZ_LAYERW);
    const float sc = p.pool_scale[l * 512 + g * 128 + jj];
#pragma unroll
    for (int q = 0; q < NKK; ++q) { const int kk = (tid >> 7) + q * (NT / 128); wint[(size_t)(g * 128 + jj) * 1024 + k0 + kk] = (h16)(acc[q] * sc); }
}
__device__ __forceinline__ void cvt_jobs(const Params& p, int j0, int j1, int ubase, int G, int c, float (*tile)[129]) {
    int base = ubase; bool pend = false; CvtJob qp = get_job(p, j0); int tp = 0; float4 v[8];
    for (int j = j0; j < j1; ++j) {
        const CvtJob q = get_job(p, j); const int nt = job_tiles(q);
        const int first = ((c - base % G) + G) % G;
        base += nt;
        for (int t = first; t < nt; t += G) {
            float4 w[8]; cvt_load(q, t, w);
            if (pend) cvt_store(qp, tp, v, tile);
#pragma unroll
            for (int i = 0; i < 8; ++i) v[i] = w[i];
            qp = q; tp = t; pend = true;
        }
    }
    if (pend) cvt_store(qp, tp, v, tile);
}
__device__ __forceinline__ void lru_wt_prep(const Params& p, int G, int c);
__device__ __forceinline__ void ph_prologue(const Params& p, char* shm, int G, int c) {
    if (c == 0 && threadIdx.x < 32) WSP(int, OFF_CNT)[threadIdx.x] = 0;
    for (int u = c; u < 192; u += G) mod_unit<NTH>(p, u, (float*)shm, (float*)shm + 9 * 1024);
    lru_wt_prep(p, G, (c + 64) % G);
}
__device__ __forceinline__ void ph_h0(const Params& p, char* shm, int G, int c) {
    const float* mod = WSP(float, OFF_MOD); h16* A = WSP(h16, OFF_A); const int tid = threadIdx.x, lane = tid & 63, wv = tid >> 6;
    for (int r = c * 32 + wv * 4; r < MT; r += G * 32) {
        float4 xv[4][4];
#pragma unroll
        for (int q = 0; q < 4; ++q) { const float* xr = xin_row(p, r + q);
#pragma unroll
            for (int i = 0; i < 4; ++i) xv[q][i] = *(const float4*)(xr + i * 256 + lane * 4); }
#pragma unroll
        for (int q = 0; q < 4; ++q) { const int g = row_group(r + q);
#pragma unroll
            for (int i = 0; i < 4; ++i) { const int d = i * 256 + lane * 4; const float4 m0 = *(const float4*)(mod + (size_t)g * 6144 + d), m1 = *(const float4*)(mod + (size_t)g * 6144 + 1024 + d);
                h16x4 o; o[0] = (h16)(xv[q][i].x * (1.f + m1.x) + m0.x); o[1] = (h16)(xv[q][i].y * (1.f + m1.y) + m0.y); o[2] = (h16)(xv[q][i].z * (1.f + m1.z) + m0.z); o[3] = (h16)(xv[q][i].w * (1.f + m1.w) + m0.w);
                *(h16x4*)(A + (size_t)(r + q) * AW + AH + d) = o; } }
    }
    for (int u = c; u < 128; u += G) poolfold_unit<NTH>(p, (u + 128) % 128, (float (*)[132])shm);
    cvt_jobs(p, 0, NJOBS_SMALL, 128, G, c, (float (*)[129])shm);
}
constexpr int ROPE_LDS = 138496;
__device__ __forceinline__ void rope_table(char* shm) {
    float2* tab = (float2*)(shm + ROPE_LDS);
    for (int i = threadIdx.x; i < 1024; i += NTH) { const float inv = exp2f(-(float)(i & 15) * (13.287712379549449f / 16.0f)); float sn, cs; sincosf((float)(i >> 4) * inv, &sn, &cs); tab[i] = make_float2(cs, sn); }
}
__device__ __forceinline__ void qkv_block(const Params& p, char* shm, int l, int rbase) {
    const h16* Z = WSP(h16, OFF_Z); h16* Qh = WSP(h16, OFF_QH); h16* Kh = WSP(h16, OFF_KH); h16* Vh = WSP(h16, OFF_VH);
    const int tid = threadIdx.x, lane = tid & 63, wv = tid >> 6;
    const float2* tab = (const float2*)(shm + ROPE_LDS);
    const int L = lane & 7, j0 = (L & 1) * 8;
    float qn[8], kn[8];
#pragma unroll
    for (int e = 0; e < 8; ++e) { qn[e] = p.q_norm[l * 64 + L * 8 + e] * QSCALE; kn[e] = p.k_norm[l * 64 + L * 8 + e]; }
    for (int r0 = rbase + wv * 8; r0 < rbase + wv * 8 + 8; r0 += 2) {
        h16x8 qv[2], kv[2];
#pragma unroll
        for (int q = 0; q < 2; ++q) { const int r = r0 + q; qv[q] = *(const h16x8*)(Z + (size_t)r * ZW + ZQ + lane * 8); kv[q] = *(const h16x8*)(Z + (size_t)r * ZW + ZK + (lane & 31) * 8); }
#pragma unroll
        for (int q = 0; q < 2; ++q) {
            const int r = r0 + q; int s0, len, pos; row_seq(r, s0, len, pos);
            const bool lat = r >= MC; const int b = lat ? (r - MC) >> 12 : r >> 8; const size_t krow = (size_t)b * SB + (lat ? CTX + pos : pos);
            const int tp = (L < 4) ? (pos >> 6) : (pos & 63);
            float cs[8], sn[8];
#pragma unroll
            for (int e = 0; e < 8; ++e) { const float2 t = tab[tp * 16 + j0 + e]; cs[e] = lat ? t.x : 1.f; sn[e] = lat ? t.y : 0.f; }
            { float y[8], ss = 0.f;
#pragma unroll
              for (int e = 0; e < 8; ++e) { y[e] = (float)qv[q][e]; ss += y[e] * y[e]; }
              ss += __shfl_xor(ss, 1); ss += __shfl_xor(ss, 2); ss += __shfl_xor(ss, 4);
              const float rs = rsqrtf(ss * (1.0f / 64.0f) + 1e-6f); h16x8 o;
#pragma unroll
              for (int e = 0; e < 8; ++e) { y[e] *= rs * qn[e]; }
#pragma unroll
              for (int e = 0; e < 8; ++e) { const float yp = __shfl_xor(y[e], 2); o[e] = (h16)((L & 2) ? (y[e] * cs[e] + yp * sn[e]) : (y[e] * cs[e] - yp * sn[e])); }
              *(h16x8*)(Qh + (size_t)r * 512 + lane * 8) = o; }
            { float y[8], ss = 0.f;
#pragma unroll
              for (int e = 0; e < 8; ++e) { y[e] = (float)kv[q][e]; ss += y[e] * y[e]; }
              ss += __shfl_xor(ss, 1); ss += __shfl_xor(ss, 2); ss += __shfl_xor(ss, 4);
              const float rs = rsqrtf(ss * (1.0f / 64.0f) + 1e-6f); h16x8 o;
#pragma unroll
              for (int e = 0; e < 8; ++e) { y[e] *= rs * kn[e]; }
#pragma unroll
              for (int e = 0; e < 8; ++e) { const float yp = __shfl_xor(y[e], 2); o[e] = (h16)((L & 2) ? (y[e] * cs[e] + yp * sn[e]) : (y[e] * cs[e] - yp * sn[e])); }
              if (lane < 16) *(h16x8*)(Kh + krow * 128 + lane * 8) = o;
              else if (lane < 32) *(h16x8*)(Vh + krow * 128 + (lane - 16) * 8) = kv[q]; }
        }
    }
}
template <int W> __device__ __forceinline__ void pool_slice(const h16* Z, h16* A, int s0, int len, int p0, int col) {
    constexpr int NR = 8 + W - 1;
    h16x8 v[NR];
#pragma unroll
    for (int i = 0; i < NR; ++i) { const int pos = p0 - W / 2 + i; h16x8 z8 = {0, 0, 0, 0, 0, 0, 0, 0}; if (pos >= 0 && pos < len) z8 = *(const h16x8*)(Z + (size_t)(s0 + pos) * ZW + ZP + col); v[i] = z8; }
#pragma unroll
    for (int tt = 0; tt < 8; ++tt) {
        const int lo = p0 + tt - W / 2, a = lo < 0 ? 0 : lo, e = (lo + W) > len ? len : (lo + W); const float icnt = 1.0f / (float)(e - a);
        h16x8 o;
#pragma unroll
        for (int j = 0; j < 8; ++j) { float s = 0.f;
#pragma unroll
            for (int i = 0; i < W; ++i) s += (float)v[tt + i][j];
            o[j] = (h16)(s * icnt - (float)v[tt + W / 2][j]); }
        *(h16x8*)(A + (size_t)(s0 + p0 + tt) * AW + AY0 + col) = o;
    }
}
__device__ __forceinline__ void pool_block(const Params& p, int r0) {
    const h16* Z = WSP(h16, OFF_Z); h16* A = WSP(h16, OFF_A);
    const int tid = threadIdx.x, lane = tid & 63, wv = __builtin_amdgcn_readfirstlane(tid >> 6), g = wv & 3;
    const int col = g * 128 + (lane & 15) * 8, ts = (wv >> 2) * 4 + (lane >> 4);
    int s0, len, pos; row_seq(r0, s0, len, pos);
    const int p0 = pos + ts * 8;
    if (g == 0) pool_slice<2>(Z, A, s0, len, p0, col);
    else if (g == 1) pool_slice<4>(Z, A, s0, len, p0, col);
    else if (g == 2) pool_slice<8>(Z, A, s0, len, p0, col);
    else pool_slice<16>(Z, A, s0, len, p0, col);
}
__device__ __forceinline__ void ph_ln(const Params& p, char* shm, int mode, int r_begin, const float* __restrict__ gam, const float* __restrict__ bet, int lm, int sh, int sc, const h16* __restrict__ Yb, bool from_input, int G, int c) {
    float* X = WSP(float, OFF_X); h16* A = WSP(h16, OFF_A); const float* mod = WSP(float, OFF_MOD) + (size_t)lm * 9 * 6144;
    const int lane = threadIdx.x & 63, wv = threadIdx.x >> 6;
    int* lcnt = (int*)shm; int* lbase = lcnt + 8; int* lrank = lcnt + 16;
    if (mode == 1) { __syncthreads(); if (threadIdx.x < 8) lcnt[threadIdx.x] = 0; __syncthreads(); }
    int trip = 0;
    for (int r0 = r_begin + c * 16 + wv * 2; r0 < MT; r0 += G * 16, ++trip) {
        float v[2][16];
#pragma unroll
        for (int q = 0; q < 2; ++q) { const float* xr = from_input ? xin_row(p, r0 + q) : X + (size_t)(r0 + q) * D;
#pragma unroll
            for (int i = 0; i < 4; ++i) { const float4 t = *(const float4*)(xr + i * 256 + lane * 4); v[q][i * 4] = t.x; v[q][i * 4 + 1] = t.y; v[q][i * 4 + 2] = t.z; v[q][i * 4 + 3] = t.w; } }
        if (mode != 2) {
            h16x4 ya[2][4];
#pragma unroll
            for (int q = 0; q < 2; ++q)
#pragma unroll
                for (int i = 0; i < 4; ++i) ya[q][i] = *(const h16x4*)(Yb + (size_t)(r0 + q) * D + i * 256 + lane * 4);
#pragma unroll
            for (int q = 0; q < 2; ++q)
#pragma unroll
                for (int i = 0; i < 4; ++i)
#pragma unroll
                    for (int j = 0; j < 4; ++j) v[q][i * 4 + j] = ALPHA * v[q][i * 4 + j] + (float)ya[q][i][j];
        }
        if (mode == 2) {
#pragma unroll
            for (int q = 0; q < 2; ++q) { const int t = r0 + q - MC, g = row_group(r0 + q); const float* m5 = WSP(float, OFF_MOD) + (size_t)(1 * 9 + g) * 6144 + 5 * 1024;
                float add[16];
#pragma unroll
                for (int i = 0; i < 16; ++i) add[i] = 0.f;
#pragma unroll
                for (int k2 = 0; k2 < 2; ++k2) {
                    const int pos = WSP(int, OFF_TOKR)[t * 2 + k2];
                    if (pos < 65536) { const h16* o = WSP(h16, OFF_OUT2) + ((size_t)k2 * ML + t) * 1024;
#pragma unroll
                        for (int i = 0; i < 4; ++i) { const h16x4 a = *(const h16x4*)(o + i * 256 + lane * 4);
#pragma unroll
                            for (int j = 0; j < 4; ++j) add[i * 4 + j] += (float)a[j]; } }
                    else {
#pragma unroll
                        for (int kq = 0; kq < 4; ++kq) { const h16* o = WSP(h16, OFF_OUTP) + ((size_t)kq * 2048 + (pos - 65536)) * 1024;
#pragma unroll
                            for (int i = 0; i < 4; ++i) { const h16x4 a = *(const h16x4*)(o + i * 256 + lane * 4);
#pragma unroll
                                for (int j = 0; j < 4; ++j) add[i * 4 + j] += (float)a[j]; } } }
                }
#pragma unroll
                for (int i = 0; i < 4; ++i) { const float4 mm = *(const float4*)(m5 + i * 256 + lane * 4); const float mv[4] = {mm.x, mm.y, mm.z, mm.w};
#pragma unroll
                    for (int j = 0; j < 4; ++j) v[q][i * 4 + j] = ALPHA * v[q][i * 4 + j] + mv[j] * add[i * 4 + j]; } }
        }
#pragma unroll
        for (int q = 0; q < 2; ++q) {
            const int r = r0 + q, g = row_group(r);
            float s = 0.f;
#pragma unroll
            for (int i = 0; i < 16; ++i) s += v[q][i];
#pragma unroll
            for (int o = 32; o >= 1; o >>= 1) s += __shfl_xor(s, o);
            const float mean = s * (1.0f / 1024.0f); float qq = 0.f;
#pragma unroll
            for (int i = 0; i < 16; ++i) { const float dlt = v[q][i] - mean; qq += dlt * dlt; }
#pragma unroll
            for (int o = 32; o >= 1; o >>= 1) qq += __shfl_xor(qq, o);
            const float rstd = rsqrtf(qq * (1.0f / 1024.0f) + 1e-5f);
            float lg8[8];
#pragma unroll
            for (int e = 0; e < 8; ++e) lg8[e] = 0.f;
#pragma unroll
            for (int i = 0; i < 4; ++i) {
                const int d = i * 256 + lane * 4; const float4 gg = *(const float4*)(gam + d), bb = *(const float4*)(bet + d);
                const float gv[4] = {gg.x, gg.y, gg.z, gg.w}, bv[4] = {bb.x, bb.y, bb.z, bb.w}; float y[4];
#pragma unroll
                for (int j = 0; j < 4; ++j) y[j] = (v[q][i * 4 + j] - mean) * rstd * gv[j] + bv[j];
                if (mode == 2) { *(float4*)(p.out + (size_t)(r - MC) * D + d) = make_float4(y[0], y[1], y[2], y[3]); continue; }
                *(float4*)(X + (size_t)r * D + d) = make_float4(y[0], y[1], y[2], y[3]);
                const float4 ms = *(const float4*)(mod + (size_t)g * 6144 + sh * 1024 + d), mc = *(const float4*)(mod + (size_t)g * 6144 + sc * 1024 + d);
                const float msv[4] = {ms.x, ms.y, ms.z, ms.w}, mcv[4] = {mc.x, mc.y, mc.z, mc.w}; float hh[4]; h16x4 ho;
#pragma unroll
                for (int j = 0; j < 4; ++j) { hh[j] = y[j] * (1.f + mcv[j]) + msv[j]; ho[j] = (h16)hh[j]; }
                *(h16x4*)(A + (size_t)r * AW + AH + d) = ho;
                if (mode == 1) {
#pragma unroll
                    for (int j = 0; j < 4; ++j) { const float4 w0 = *(const float4*)(p.moe_router + (size_t)(d + j) * 8), w1 = *(const float4*)(p.moe_router + (size_t)(d + j) * 8 + 4);
                        lg8[0] += hh[j] * w0.x; lg8[1] += hh[j] * w0.y; lg8[2] += hh[j] * w0.z; lg8[3] += hh[j] * w0.w; lg8[4] += hh[j] * w1.x; lg8[5] += hh[j] * w1.y; lg8[6] += hh[j] * w1.z; lg8[7] += hh[j] * w1.w; }
                }
            }
            if (mode == 1) {
#pragma unroll
                for (int e = 0; e < 8; ++e) {
#pragma unroll
                    for (int o = 32; o >= 1; o >>= 1) lg8[e] += __shfl_xor(lg8[e], o);
                    lg8[e] += p.moe_router_b[e]; }
                if (lane == 0) {
                    int i0 = 0; float v0 = lg8[0];
#pragma unroll
                    for (int e = 1; e < 8; ++e) if (lg8[e] > v0) { v0 = lg8[e]; i0 = e; }
                    int i1 = -1; float v1 = -INFINITY;
#pragma unroll
                    for (int e = 0; e < 8; ++e) if (e != i0 && lg8[e] > v1) { v1 = lg8[e]; i1 = e; }
                    const float p1 = 1.0f / (1.0f + expf(v0 - v1)), p0 = 1.0f - p1;
                    const int t = r - MC, li = trip * 16 + wv * 2 + q;
                    const int k0 = atomicAdd(&lcnt[i0], 1), k1 = atomicAdd(&lcnt[i1], 1);
                    WSP(int, OFF_TOKE)[t * 2] = i0; WSP(int, OFF_TOKE)[t * 2 + 1] = i1; WSP(float, OFF_TOKP)[t * 2] = p0; WSP(float, OFF_TOKP)[t * 2 + 1] = p1;
                    lrank[li * 4] = i0; lrank[li * 4 + 1] = k0; lrank[li * 4 + 2] = i1; lrank[li * 4 + 3] = k1;
                }
            }
        }
    }
    if (mode == 1) {
        __syncthreads();
        if (threadIdx.x < 8) lbase[threadIdx.x] = atomicAdd(WSP(int, OFF_CNT) + threadIdx.x, lcnt[threadIdx.x]);
        __syncthreads();
        for (int li = threadIdx.x; li < trip * 16; li += NTH) {
            const int r = r_begin + c * 16 + (li & 15) + (li >> 4) * G * 16; if (r >= MT) continue;
            const int t = r - MC;
            WSP(int, OFF_TOKR)[t * 2] = lbase[lrank[li * 4]] + lrank[li * 4 + 1]; WSP(int, OFF_TOKR)[t * 2 + 1] = lbase[lrank[li * 4 + 2]] + lrank[li * 4 + 3];
        }
    }
}
__device__ __forceinline__ void ph_moe_gather(const Params& p, char* shm, int G, int c) {
    int* sp = (int*)shm; int* plan = WSP(int, OFF_PLAN); const int* cnt = WSP(int, OFF_CNT); int* rowT = WSP(int, OFF_ROWT);
    const int tid = threadIdx.x;
    __syncthreads();
    if (tid == 0) { int acc = 0; for (int e = 0; e < 8; ++e) { sp[e] = acc; const int np = (cnt[e] + 255) / 256; if (c == 0) { plan[e] = acc; for (int q = 0; q < np; ++q) plan[16 + acc / 256 + q] = e; } acc += np * 256; } sp[8] = acc; if (c == 0) plan[8] = acc / 256; }
    __syncthreads();
    if (c == 0) for (int e = 0; e < 8; ++e) { const int a = sp[e] + cnt[e], b = sp[e + 1]; for (int i = a + tid; i < b; i += NTH) rowT[i] = -1; }
    const h16* A = WSP(h16, OFF_A); h16* Xg = WSP(h16, OFF_XG);
    const int lane = tid & 63, wv = tid >> 6;
    for (int it0 = (c * 8 + wv) * 4; it0 < ML * 2; it0 += G * 32) {
        h16x8 v0[4], v1[4]; int pos[4];
#pragma unroll
        for (int q = 0; q < 4; ++q) { const int it = it0 + q, t = it >> 1; pos[q] = sp[WSP(int, OFF_TOKE)[it]] + WSP(int, OFF_TOKR)[it];
            const h16* src = A + (size_t)(MC + t) * AW + AH; v0[q] = *(const h16x8*)(src + lane * 8); v1[q] = *(const h16x8*)(src + 512 + lane * 8); }
#pragma unroll
        for (int q = 0; q < 4; ++q) { h16* dst = Xg + (size_t)pos[q] * 1024; *(h16x8*)(dst + lane * 8) = v0[q]; *(h16x8*)(dst + 512 + lane * 8) = v1[q];
            if (lane == 0) { WSP(int, OFF_ROWT)[pos[q]] = it0 + q; WSP(float, OFF_ROWP)[pos[q]] = WSP(float, OFF_TOKP)[it0 + q]; WSP(int, OFF_TOKR)[it0 + q] = pos[q]; } }
    }
}

typedef float f32x16 __attribute__((ext_vector_type(16)));
constexpr int XCP = 520;
constexpr int LRU_XC = 0, LRU_LG = 64 * XCP * 2, LRU_CIN = 2 * 64 * XCP * 2;
__device__ __forceinline__ void lru_wt_prep(const Params& p, int G, int c) {
    h16* WT = WSP(h16, OFF_LRUWT);
    for (int u = c; u < 64; u += G) {
        const int blk = u & 7, gate = (u >> 3) & 1, ld = u >> 4;
        const float* W = (gate ? p.lru_wx : p.lru_wa) + ((size_t)ld * 8 + blk) * 4096;
        for (int o = threadIdx.x; o < 4096; o += NTH) { const int j = o >> 6, i = o & 63; WT[(size_t)u * 4096 + o] = (h16)W[i * 64 + j]; }
    }
}
template <int PASS> __device__ __forceinline__ void lru_unit(const Params& p, char* shm, int l, int b, int k) {
    const int tid = threadIdx.x, lane = tid & 63, h = __builtin_amdgcn_readfirstlane(tid >> 6), n = lane & 31, hi = lane >> 5;
    const h16* Z = WSP(h16, OFF_Z);
    const bool isctx = k < 4; const int s0 = isctx ? b * CTX : MC + b * SEQ, len = isctx ? CTX : SEQ, t0 = isctx ? k * 64 : (k - 4) * 64, row0 = s0 + t0;
    h16* xcs = (h16*)(shm + LRU_XC); h16* lgs = (h16*)(shm + LRU_LG); float* cins = (float*)(shm + LRU_CIN);
    const int uidx = b * 68 + k; char* lau_base = uidx < 512 ? (char*)p.out + (size_t)uidx * 262144 : p.ws + OFF_LAU_TAIL + (size_t)(uidx - 512) * 262144;
    __syncthreads();
    {
        const int cg = tid & 63, ts = tid >> 6, ch0 = cg * 8;
        if (PASS == 1) {
        float cw[4][8], cb[8];
#pragma unroll
        for (int q = 0; q < 4; ++q) { const float4 a = *(const float4*)(p.conv_w + (size_t)(l * 4 + q) * 512 + ch0), b2 = *(const float4*)(p.conv_w + (size_t)(l * 4 + q) * 512 + ch0 + 4);
            cw[q][0] = a.x; cw[q][1] = a.y; cw[q][2] = a.z; cw[q][3] = a.w; cw[q][4] = b2.x; cw[q][5] = b2.y; cw[q][6] = b2.z; cw[q][7] = b2.w; }
        { const float4 a = *(const float4*)(p.conv_b + l * 512 + ch0), b2 = *(const float4*)(p.conv_b + l * 512 + ch0 + 4); cb[0] = a.x; cb[1] = a.y; cb[2] = a.z; cb[3] = a.w; cb[4] = b2.x; cb[5] = b2.y; cb[6] = b2.z; cb[7] = b2.w; }
        h16x8 v[11];
#pragma unroll
        for (int i = 0; i < 11; ++i) { const int pos = t0 + ts * 8 - 2 + i; const bool ok = pos >= 0 && pos < len;
            h16x8 z8 = {0, 0, 0, 0, 0, 0, 0, 0}; if (ok) z8 = *(const h16x8*)(Z + (size_t)(s0 + pos) * ZW + ZLX + ch0); v[i] = z8; }
#pragma unroll
        for (int tt = 0; tt < 8; ++tt) { h16x8 o;
#pragma unroll
            for (int j = 0; j < 8; ++j) { float acc = cb[j];
#pragma unroll
                for (int q = 0; q < 4; ++q) acc += cw[q][j] * (float)v[tt + q][j];
                o[j] = (h16)acc; }
            *(h16x8*)(xcs + (ts * 8 + tt) * XCP + ch0) = o; }
        }
        if (PASS == 3) {
#pragma unroll
            for (int tt = 0; tt < 8; ++tt) *(h16x8*)(lgs + (ts * 8 + tt) * XCP + ch0) = *(const h16x8*)(Z + (size_t)(row0 + ts * 8 + tt) * ZW + ZLG + ch0);
            const float* P0 = WSP(float, OFF_LRUP) + (size_t)(b * 2 + 0) * 68 * 512 + tid; const float* H0 = WSP(float, OFF_LRUH) + (size_t)(b * 2 + 0) * 68 * 512 + tid;
            float S = 0.f;
            for (int j0 = 0; j0 < k; j0 += 8) { float pp[8], hh[8];
#pragma unroll
                for (int q = 0; q < 8; ++q) { const int j = j0 + q < k ? j0 + q : 0; pp[q] = P0[(size_t)j * 512]; hh[q] = H0[(size_t)j * 512]; }
#pragma unroll
                for (int q = 0; q < 8; ++q) if (j0 + q < k) S = pp[q] * S + hh[q]; }
            cins[tid] = S;
            const float* P1 = P0 + (size_t)68 * 512; const float* H1 = H0 + (size_t)68 * 512;
            const int nb = isctx ? 3 - k : 71 - k;
            S = 0.f;
            for (int s0_ = 0; s0_ < nb; s0_ += 8) { float pp[8], hh[8];
#pragma unroll
                for (int q = 0; q < 8; ++q) { const int s = s0_ + q < nb ? s0_ + q : 0; const int j = s < 4 ? 3 - s : 71 - s; pp[q] = P1[(size_t)j * 512]; hh[q] = H1[(size_t)j * 512]; }
#pragma unroll
                for (int q = 0; q < 8; ++q) if (s0_ + q < nb) S = pp[q] * S + hh[q]; }
            cins[512 + tid] = S;
        }
    }
    __syncthreads();
    const h16* WT = WSP(h16, OFF_LRUWT) + (size_t)l * 4 * 8 * 4096;
#define LMFMA(a, b, c) __builtin_amdgcn_mfma_f32_32x32x16_f16(a, b, c, 0, 0, 0)
#pragma unroll 1
    for (int ct = 0; ct < 2; ++ct) {
        const int cbase = h * 64 + ct * 32, ch = cbase + n;
        f32x16 xD[2], gD[2], hs[2];
#pragma unroll
        for (int rt = 0; rt < 2; ++rt) { xD[rt] = f32x16{}; gD[rt] = f32x16{}; hs[rt] = f32x16{}; }
        if (PASS == 1) {
#pragma unroll
        for (int s = 0; s < 2; ++s) { h16x8 id;
#pragma unroll
            for (int j = 0; j < 8; ++j) id[j] = (n == s * 16 + hi * 8 + j) ? (h16)1.0f : (h16)0.0f;
#pragma unroll
            for (int rt = 0; rt < 2; ++rt) { const h16x8 a = *(const h16x8*)(xcs + (rt * 32 + n) * XCP + cbase + s * 16 + hi * 8); xD[rt] = LMFMA(a, id, xD[rt]); } }
        }
#pragma unroll
        for (int dir = 0; dir < 2; ++dir) {
            f32x16 R[2], I[2];
            unsigned w32[32];
            u32x4* lau = (u32x4*)(lau_base + ((size_t)(h * 4 + ct * 2 + dir)) * 8192 + lane * 16);
            if (PASS == 1) {
#pragma unroll
                for (int rt = 0; rt < 2; ++rt) { R[rt] = f32x16{}; I[rt] = f32x16{}; }
                const h16* wa = WT + ((size_t)(dir * 2 + 0) * 8 + h) * 4096 + (ct * 32 + n) * 64 + hi * 8;
                const h16* wx = WT + ((size_t)(dir * 2 + 1) * 8 + h) * 4096 + (ct * 32 + n) * 64 + hi * 8;
#pragma unroll
                for (int ks = 0; ks < 4; ++ks) { const h16x8 ba8 = *(const h16x8*)(wa + ks * 16), bx8 = *(const h16x8*)(wx + ks * 16);
#pragma unroll
                    for (int rt = 0; rt < 2; ++rt) { const h16x8 a = *(const h16x8*)(xcs + (rt * 32 + n) * XCP + h * 64 + ks * 16 + hi * 8); R[rt] = LMFMA(a, ba8, R[rt]); I[rt] = LMFMA(a, bx8, I[rt]); } }
                const int pi = (l * 2 + dir) * 512 + ch;
                const float ba = p.lru_ba[pi], bx = p.lru_bx[pi], spl = log1pf(__expf(-p.lru_lambda[pi])) * (-8.0f * 1.4426950408889634f);
#pragma unroll
                for (int rt = 0; rt < 2; ++rt)
#pragma unroll
                    for (int r = 0; r < 16; ++r) { const float rg = sigmoidf_(R[rt][r] + ba), ig = sigmoidf_(I[rt][r] + bx);
                        const float la2 = rg * spl, a = __builtin_amdgcn_exp2f(la2), uu = __builtin_amdgcn_sqrtf(fmaxf(1.0f - a * a, 0.f)) * ig * xD[rt][r];
                        w32[rt * 16 + r] = pg8::cvt_pk_f16(la2, uu); }
#pragma unroll
                for (int j = 0; j < 8; ++j) { u32x4 t; t.x = w32[4 * j]; t.y = w32[4 * j + 1]; t.z = w32[4 * j + 2]; t.w = w32[4 * j + 3]; lau[j * 64] = t; }
            } else {
#pragma unroll
                for (int j = 0; j < 8; ++j) { const u32x4 t = lau[j * 64]; w32[4 * j] = t.x; w32[4 * j + 1] = t.y; w32[4 * j + 2] = t.z; w32[4 * j + 3] = t.w; }
            }
#pragma unroll
            for (int rt = 0; rt < 2; ++rt)
#pragma unroll
                for (int r = 0; r < 16; ++r) { const h16x2 pr = __builtin_bit_cast(h16x2, w32[rt * 16 + r]); R[rt][r] = __builtin_amdgcn_exp2f((float)pr[0]); I[rt][r] = (float)pr[1]; }
            float Pg[8], Hg[8], Po[8], Ho[8];
#pragma unroll
            for (int q = 0; q < 8; ++q) { const int rt = q >> 2, r0 = (q & 3) * 4; float P = 1.f, H = 0.f;
#pragma unroll
                for (int i = 0; i < 4; ++i) { const int r = r0 + (dir ? 3 - i : i); P *= R[rt][r]; H = R[rt][r] * H + I[rt][r]; }
                Pg[q] = P; Hg[q] = H; }
#pragma unroll
            for (int q = 0; q < 8; ++q) {
                const auto rp = __builtin_amdgcn_permlane32_swap(__float_as_uint(Pg[q]), __float_as_uint(Pg[q]), false, false); Po[q] = __uint_as_float(hi ? rp[0] : rp[1]);
                const auto rh = __builtin_amdgcn_permlane32_swap(__float_as_uint(Hg[q]), __float_as_uint(Hg[q]), false, false); Ho[q] = __uint_as_float(hi ? rh[0] : rh[1]); }
            float S = (PASS == 3) ? cins[dir * 512 + ch] : 0.f, Pt = 1.f; float cg[8];
#pragma unroll
            for (int s2 = 0; s2 < 16; ++s2) { const int Gi = dir ? 15 - s2 : s2, q = Gi >> 1, own = Gi & 1;
                const float Pq = (hi == own) ? Pg[q] : Po[q], Hq = (hi == own) ? Hg[q] : Ho[q];
                if (hi == own) cg[q] = S;
                S = Pq * S + Hq; Pt *= Pq; }
            if (PASS == 1) { if (hi == 0) { WSP(float, OFF_LRUP)[((size_t)(b * 2 + dir) * 68 + k) * 512 + ch] = Pt; WSP(float, OFF_LRUH)[((size_t)(b * 2 + dir) * 68 + k) * 512 + ch] = S; } }
            else {
#pragma unroll
                for (int q = 0; q < 8; ++q) { const int rt = q >> 2, r0 = (q & 3) * 4; float hh = cg[q];
#pragma unroll
                    for (int i = 0; i < 4; ++i) { const int r = r0 + (dir ? 3 - i : i); hh = R[rt][r] * hh + I[rt][r]; hs[rt][r] += hh; } }
            }
        }
        if (PASS == 3) {
#pragma unroll
            for (int s = 0; s < 2; ++s) { h16x8 id;
#pragma unroll
                for (int j = 0; j < 8; ++j) id[j] = (n == s * 16 + hi * 8 + j) ? (h16)1.0f : (h16)0.0f;
#pragma unroll
                for (int rt = 0; rt < 2; ++rt) { const h16x8 a2 = *(const h16x8*)(lgs + (rt * 32 + n) * XCP + cbase + s * 16 + hi * 8); gD[rt] = LMFMA(a2, id, gD[rt]); } }
#pragma unroll
            for (int rt = 0; rt < 2; ++rt)
#pragma unroll
                for (int r = 0; r < 16; ++r) { const float x = gD[rt][r]; const float u2 = 1.5957691216057308f * (x + 0.044715f * x * x * x);
                    lgs[(rt * 32 + (r & 3) + 8 * (r >> 2) + 4 * hi) * XCP + ch] = (h16)(hs[rt][r] * x * sigmoidf_(u2)); }
        }
    }
#undef LMFMA
    if (PASS == 3) {
        __syncthreads();
        h16* A = WSP(h16, OFF_A); const int cg = tid & 63, ts = tid >> 6, ch0 = cg * 8;
#pragma unroll
        for (int tt = 0; tt < 8; ++tt) *(h16x8*)(A + (size_t)(row0 + ts * 8 + tt) * AW + AY2 + ch0) = *(const h16x8*)(lgs + (ts * 8 + tt) * XCP + ch0);
    }
}
template <int PASS> __device__ __forceinline__ void ph_lru(const Params& p, char* shm, int l, int G, int c) {
    int* head = WSP(int, OFF_CNT) + 16 + l * 2 + (PASS == 3 ? 1 : 0); volatile int* slot = (volatile int*)(shm + 138240);
    for (;;) {
        __syncthreads();
        if (threadIdx.x == 0) *slot = atomicAdd(head, 1);
        __syncthreads();
        const int u = *slot; if (u >= NB * 68) break;
        lru_unit<PASS>(p, shm, l, u / 68, u % 68);
    }
}

__device__ __forceinline__ void ph_thin(const Params& p, char* shm, int l, int rb, int G, int c) {
    int* head = WSP(int, OFF_CNT) + 16 + l * 2; volatile int* slot = (volatile int*)(shm + 138240);
    const int NL = NB * 68, NQ = MT / 64, NP = (MT - rb) / 64;
    __syncthreads();
    rope_table(shm);
    for (;;) {
        __syncthreads();
        if (threadIdx.x == 0) *slot = atomicAdd(head, 1);
        __syncthreads();
        const int u = *slot; if (u >= NL + NQ + NP) break;
        if (u < NL) lru_unit<1>(p, shm, l, u / 68, u % 68);
        else if (u < NL + NQ) qkv_block(p, shm, l, (u - NL) * 64);
        else pool_block(p, rb + (u - NL - NQ) * 64);
    }
}

constexpr int XB_LDS_OFF = LDS_BYTES - 16;
__global__ void __launch_bounds__(512, 2) k_mega(Params p, int lo, int hi) {
    extern __shared__ __attribute__((aligned(16))) unsigned char shm[];
    LAS unsigned char* lds = (LAS unsigned char*)shm;
    const int G = gridDim.x, c = blockIdx.x;
    if (threadIdx.x == 0) { *(uint4*)(shm + XB_LDS_OFF) = make_uint4(0u, 0u, 0u, 0u); *(uint4*)(shm + 147424) = make_uint4(0u, 0u, 0u, 0u); }
    __syncthreads();
    XcdBarrier bar = xcd_barrier_post(WSP(unsigned, OFF_BAR), (volatile LAS unsigned*)(lds + XB_LDS_OFF));
    int ph = 0;
#ifndef REP_MASK
#define REP_MASK 0
#endif
#define REP(bit, call) do { call; if (REP_MASK & (bit)) { __syncthreads(); call; } } while (0)
#ifndef PROBE_MASK
#define PROBE_MASK 0u
#endif
    unsigned long long t_acc = 0ull, t_0 = 0ull;
#define PHASE(body) do { if (ph >= lo && ph < hi) { const bool pr_ = ((PROBE_MASK >> ph) & 1u) != 0u; if (pr_) t_0 = __builtin_amdgcn_s_memrealtime(); \
        body; if (ph + 1 < hi) { xcd_barrier(bar); if (REP_MASK & 8) xcd_barrier(bar); } if (pr_) t_acc += __builtin_amdgcn_s_memrealtime() - t_0; } ++ph; } while (0)
    PHASE(REP(4, ph_prologue(p, (char*)shm, G, c)));
    PHASE(REP(4, ph_h0(p, (char*)shm, G, c)));
#define LAYER(l) do { \
        const int rb = (l) == 0 ? 0 : MC; \
        const float* ln1g = p.ln1_g + (l) * D; const float* ln1b = p.ln1_b + (l) * D; const float* ln2g = p.ln2_g + (l) * D; const float* ln2b = p.ln2_b + (l) * D; \
        PHASE(REP(1, ph_gemm_in(p, lds, (l), G, c))); \
        PHASE(ph_thin(p, (char*)shm, (l), rb, G, c)); \
        PHASE(REP(512, ph_attn(p, (char*)shm, (l), G, c)); REP(256, ph_lru<3>(p, (char*)shm, (l), G, c))); \
        PHASE(REP(1, ph_merge(p, lds, (l), G, c))); \
        PHASE(ph_wout(p, lds, (l), G, c)); \
        if ((l) == 0) { \
            PHASE(ph_ln(p, (char*)shm, 0, rb, ln1g, ln1b, 0, 3, 4, YW_base(p, 0), true, G, c)); \
            PHASE(REP(1, ph_ffn_gu(p, lds, G, c))); \
            PHASE(ph_ffn_down(p, lds, G, c)); \
            PHASE(ph_ln(p, (char*)shm, 0, 0, ln2g, ln2b, 1, 0, 1, (const h16*)p.out, false, G, c)); \
        } else { \
            PHASE(ph_ln(p, (char*)shm, 1, rb, ln1g, ln1b, 1, 3, 4, YW_base(p, 1), false, G, c); REP(16, cvt_jobs(p, NJOBS_SMALL, NJOBS_ALL, 0, G, c, (float (*)[129])shm))); \
            PHASE(REP(16, ph_moe_gather(p, (char*)shm, G, c))); \
            for (int chn = 0; chn < 5; ++chn) { \
                PHASE(REP(1, ph_moe_gu(p, lds, chn * 64, G, c))); \
                PHASE(REP(1, ph_moe_down(p, lds, chn * 64, G, c))); \
            } \
            PHASE(ph_ln(p, (char*)shm, 2, MC, ln2g, ln2b, 1, 0, 1, (const h16*)0, false, G, c)); \
        } } while (0)
    LAYER(0);
    LAYER(1);
#undef LAYER
    if (PROBE_EPI != 0) { t_acc = ((LAS unsigned long long*)(lds + 147424))[0]; }
    if ((PROBE_MASK != 0u || PROBE_EPI != 0) && blockIdx.x == 0 && threadIdx.x == 0) { const unsigned long long t_e = __builtin_amdgcn_s_memrealtime(); while (__builtin_amdgcn_s_memrealtime() - t_e < 3ull * t_acc) __builtin_amdgcn_s_sleep(8); }
#undef PHASE
}
constexpr int NPHASES = 2 + 9 + (5 + 2 + 10 + 1);

#ifndef MEGA_LAUNCHES
#define MEGA_LAUNCHES 1
#endif
extern "C" void kernel_launch(void* const* d_in, const int* in_sizes, int n_in, void* d_out, int out_size, void* d_ws, size_t ws_size, hipStream_t stream) {
    (void)in_sizes; (void)n_in; (void)out_size;
    if (ws_size < WS_NEED) return;
    Params p;
    const float** pp = (const float**)&p;
    for (int i = 0; i < 33; ++i) pp[i] = (const float*)d_in[i];
    p.out = (float*)d_out; p.ws = (char*)d_ws;
    static int grid = 0;
    if (!grid) {
        int dev = 0, cus = 0, per_cu = 0;
        hipGetDevice(&dev);
        hipDeviceGetAttribute(&cus, hipDeviceAttributeMultiprocessorCount, dev);
        hipFuncSetAttribute((const void*)k_mega, hipFuncAttributeMaxDynamicSharedMemorySize, LDS_BYTES);
        hipOccupancyMaxActiveBlocksPerMultiprocessor(&per_cu, (const void*)k_mega, 512, LDS_BYTES);
        grid = (per_cu >= 1 && cus > 0) ? cus : -1;
    }
    if (grid <= 0) return;
    hipMemsetAsync(p.ws + OFF_BAR, 0, XCD_BAR_WORDS * sizeof(unsigned), stream);
#if MEGA_LAUNCHES == 1
    k_mega<<<grid, 512, LDS_BYTES, stream>>>(p, 0, NPHASES);
#else
    for (int ph = 0; ph < NPHASES; ++ph) k_mega<<<grid, 512, LDS_BYTES, stream>>>(p, ph, ph + 1);
#endif
}
```

```cpp
#include <hip/hip_runtime.h>
#include <stdint.h>
#include <stddef.h>

#ifndef PROBE_EPI
#define PROBE_EPI 0
#endif
typedef _Float16 h16;
typedef _Float16 h16x2 __attribute__((ext_vector_type(2)));
typedef _Float16 h16x4 __attribute__((ext_vector_type(4)));
typedef _Float16 h16x8 __attribute__((ext_vector_type(8)));

constexpr int D = 1024, NB = 8, SEQ = 4096, CTX = 256, SB = CTX + SEQ;
constexpr int MC = NB * CTX, ML = NB * SEQ, MT = MC + ML;
constexpr int WIN = 5376, ZW = 2304, AW = 2560;
constexpr int DFF = 2816, NE = 8, DEX = 3584;
constexpr int PMAX = 264 * 256;
constexpr float ALPHA = 1.41421356237309515f;
constexpr float QSCALE = 0.125f * 1.4426950408889634f;
constexpr int ZP = 0, ZQ = 512, ZK = 1024, ZV = 1152, ZLX = 1280, ZLG = 1792;
constexpr int AH = 0, AY0 = 1024, AY1 = 1536, AY2 = 2048;

constexpr size_t al256(size_t x) { return (x + 255) & ~(size_t)255; }
constexpr size_t OFF_BAR = 0;
constexpr size_t OFF_MOD = 16384;
constexpr size_t OFF_CNT = OFF_MOD + al256((size_t)2 * 9 * 6144 * 4);
constexpr size_t OFF_PLAN = OFF_CNT + 256;
constexpr size_t OFF_TOKE = OFF_PLAN + 2048;
constexpr size_t OFF_TOKP = OFF_TOKE + (size_t)ML * 2 * 4;
constexpr size_t OFF_TOKR = OFF_TOKP + (size_t)ML * 2 * 4;
constexpr size_t OFF_ROWT = OFF_TOKR + (size_t)ML * 2 * 4;
constexpr size_t OFF_ROWP = OFF_ROWT + (size_t)PMAX * 4;
constexpr size_t OFF_LRUP = OFF_ROWP + (size_t)PMAX * 4;
constexpr size_t OFF_LRUH = OFF_LRUP + (size_t)NB * 2 * 68 * 512 * 4;
constexpr size_t OFF_LRUWT = OFF_LRUH + (size_t)NB * 2 * 68 * 512 * 4;
constexpr size_t OFF_TBL_END = OFF_LRUWT + (size_t)2 * 2 * 2 * 8 * 4096 * 2;
constexpr size_t OFF_X = (size_t)8 << 20;
constexpr size_t OFF_A = OFF_X + (size_t)MT * D * 4;
constexpr size_t OFF_BIG = OFF_A + (size_t)MT * AW * 2;
static_assert(OFF_TBL_END <= OFF_X, "tables");
constexpr size_t OFF_Z = OFF_BIG;
constexpr size_t OFF_QH = OFF_Z + (size_t)MT * ZW * 2;
constexpr size_t OFF_KH = OFF_QH + (size_t)MT * 512 * 2;
constexpr size_t OFF_VH = OFF_KH + (size_t)NB * SB * 128 * 2;
constexpr size_t OFF_W16 = OFF_VH + (size_t)NB * SB * 128 * 2;
constexpr size_t SZ_WINT = (size_t)ZW * 1024 * 2, SZ_BTALL = (size_t)3072 * 1536 * 2, SZ_WOUTT = (size_t)1024 * 1024 * 2;
constexpr size_t SZ_LAYERW = SZ_WINT + SZ_BTALL + SZ_WOUTT;
constexpr size_t OFF_WGUT = OFF_W16 + 2 * SZ_LAYERW;
constexpr size_t OFF_WDT = OFF_WGUT + (size_t)2 * DFF * 1024 * 2;
constexpr size_t OFF_W16_END = OFF_WDT + (size_t)1024 * DFF * 2;
constexpr size_t OFF_LAU_TAIL = (OFF_W16_END + 255) & ~(size_t)255;
constexpr size_t OFF_ACT = OFF_BIG;
static_assert(OFF_ACT + (size_t)MT * DFF * 2 <= OFF_W16, "ACT overlay");
constexpr size_t OFF_WMOE_GU = OFF_BIG;
constexpr size_t OFF_WMOE_D = OFF_WMOE_GU + (size_t)NE * 2 * DEX * 1024 * 2;
constexpr size_t OFF_XG = OFF_WMOE_D + (size_t)NE * 1024 * DEX * 2;
constexpr size_t WS_NEED = OFF_XG + (size_t)PMAX * 1024 * 2;
static_assert(WS_NEED <= 646673440ull, "workspace budget");
static_assert(OFF_LAU_TAIL + (size_t)32 * 262144 <= WS_NEED, "lau tail");
static_assert(OFF_W16_END <= WS_NEED, "w16");
constexpr size_t OFF_OUT2 = OFF_A;
constexpr size_t OFF_OUTP = OFF_OUT2 + (size_t)2 * ML * 1024 * 2;
static_assert(OFF_OUTP + (size_t)4 * 2048 * 1024 * 2 <= OFF_A + (size_t)MT * AW * 2, "OUT2/OUTP overlay");
static_assert((size_t)72 * 256 * DEX * 2 <= (size_t)ML * D * 4, "ACTe chunk in d_out");

struct Params {
    const float *x, *c, *ctx, *c_ctx, *w_mod, *b_mod, *w_in, *b_merge, *pool_w, *pool_scale, *q_norm, *k_norm, *conv_w, *conv_b,
        *lru_wa, *lru_ba, *lru_wx, *lru_bx, *lru_lambda, *w_branch, *w_out, *ln1_g, *ln1_b, *ffn_w_gate, *ffn_w_up, *ffn_w_down,
        *moe_router, *moe_router_b, *moe_w_gate, *moe_w_up, *moe_w_down, *ln2_g, *ln2_b;
    float* out;
    char* ws;
};
#define WSP(T, off) ((T*)(p.ws + (off)))

__device__ __forceinline__ int row_group(int r) { return r < MC ? 0 : 1 + ((r - MC) >> 12); }
__device__ __forceinline__ void row_seq(int r, int& s0, int& len, int& pos) {
    if (r < MC) { s0 = r & ~255; len = 256; pos = r & 255; } else { const int q = r - MC; s0 = MC + (q & ~4095); len = 4096; pos = q & 4095; }
}
__device__ __forceinline__ const float* xin_row(const Params& p, int r) { return r < MC ? p.ctx + (size_t)r * D : p.x + (size_t)(r - MC) * D; }
__device__ __forceinline__ float sigmoidf_(float x) { return __builtin_amdgcn_rcpf(1.0f + __builtin_amdgcn_exp2f(-1.4426950408889634f * x)); }
__device__ __forceinline__ float siluf_(float x) { return x * __builtin_amdgcn_rcpf(1.0f + __builtin_amdgcn_exp2f(-1.4426950408889634f * x)); }
__device__ __forceinline__ float gelu_tanh(float x) { const float u = 0.7978845608028654f * (x + 0.044715f * x * x * x); return 0.5f * x * (1.0f + tanhf(u)); }

struct CvtJob { const float* src; int ld_src, K, N; h16* dst; int ldd, col_off, rmode; };
constexpr int NJOBS_L = 6, NJOBS_SMALL = 2 * NJOBS_L + 3, NJOBS_ALL = NJOBS_SMALL + 24;
__device__ __forceinline__ CvtJob get_job(const Params& p, int j) {
    CvtJob q; q.col_off = 0; q.rmode = 0;
    if (j < 2 * NJOBS_L) {
        const int l = j / NJOBS_L, s = j % NJOBS_L;
        h16* wint = WSP(h16, OFF_W16 + l * SZ_LAYERW); h16* btall = WSP(h16, OFF_W16 + l * SZ_LAYERW + SZ_WINT); h16* woutt = WSP(h16, OFF_W16 + l * SZ_LAYERW + SZ_WINT + SZ_BTALL);
        if (s == 0) { q.src = p.w_in + (size_t)l * 1024 * WIN + 512; q.ld_src = WIN; q.K = 1024; q.N = ZW - 512; q.dst = wint + (size_t)512 * 1024; q.ldd = 1024; }
        else if (s == 1) { q.src = p.w_in + (size_t)l * 1024 * WIN + ZW; q.ld_src = WIN; q.K = 1024; q.N = 3072; q.dst = btall; q.ldd = 1536; }
        else if (s < 5) { const int n = s - 2; q.src = p.w_branch + (size_t)(l * 3 + n) * 512 * 1024; q.ld_src = 1024; q.K = 512; q.N = 1024; q.dst = btall + (size_t)n * 1024 * 1536; q.ldd = 1536; q.col_off = 1024; }
        else { q.src = p.w_out + (size_t)l * 1024 * 1024; q.ld_src = 1024; q.K = 1024; q.N = 1024; q.dst = woutt; q.ldd = 1024; }
    } else if (j < NJOBS_SMALL) {
        const int s = j - 2 * NJOBS_L;
        if (s == 0) { q.src = p.ffn_w_gate; q.ld_src = DFF; q.K = 1024; q.N = DFF; q.dst = WSP(h16, OFF_WGUT); q.ldd = 1024; q.rmode = 1; }
        else if (s == 1) { q.src = p.ffn_w_up; q.ld_src = DFF; q.K = 1024; q.N = DFF; q.dst = WSP(h16, OFF_WGUT); q.ldd = 1024; q.rmode = 2; }
        else { q.src = p.ffn_w_down; q.ld_src = 1024; q.K = DFF; q.N = 1024; q.dst = WSP(h16, OFF_WDT); q.ldd = DFF; }
    } else {
        const int s = j - NJOBS_SMALL, e = s / 3, t = s % 3;
        if (t == 0) { q.src = p.moe_w_gate + (size_t)e * 1024 * DEX; q.ld_src = DEX; q.K = 1024; q.N = DEX; q.dst = WSP(h16, OFF_WMOE_GU) + (size_t)e * 2 * DEX * 1024; q.ldd = 1024; q.rmode = 1; }
        else if (t == 1) { q.src = p.moe_w_up + (size_t)e * 1024 * DEX; q.ld_src = DEX; q.K = 1024; q.N = DEX; q.dst = WSP(h16, OFF_WMOE_GU) + (size_t)e * 2 * DEX * 1024; q.ldd = 1024; q.rmode = 2; }
        else { q.src = p.moe_w_down + (size_t)e * DEX * 1024; q.ld_src = 1024; q.K = DEX; q.N = 1024; q.dst = WSP(h16, OFF_WMOE_D) + (size_t)e * 1024 * DEX; q.ldd = DEX; }
    }
    return q;
}
__device__ __forceinline__ int job_tiles(const CvtJob& q) { return (q.K / 128) * (q.N / 128); }
__device__ __forceinline__ int cvt_rowmap(int n, int rmode) { return rmode == 0 ? n : ((n >> 7) * 256 + (n & 127) + (rmode == 2 ? 128 : 0)); }
__device__ __forceinline__ void cvt_load(const CvtJob& q, int t, float4 (&v)[8]) {
    const int nk = q.K / 128, tk = t % nk, tn = t / nk, k0 = tk * 128, n0 = tn * 128, tid = threadIdx.x;
#pragma unroll
    for (int i = 0; i < 8; ++i) v[i] = *(const float4*)(q.src + (size_t)(k0 + i * 16 + (tid >> 5)) * q.ld_src + n0 + (tid & 31) * 4);
}
__device__ __forceinline__ void cvt_store(const CvtJob& q, int t, const float4 (&v)[8], float (*tile)[129]) {
    const int nk = q.K / 128, tk = t % nk, tn = t / nk, k0 = tk * 128, n0 = tn * 128, tid = threadIdx.x;
    __syncthreads();
#pragma unroll
    for (int i = 0; i < 8; ++i) { float* tp = &tile[i * 16 + (tid >> 5)][(tid & 31) * 4]; tp[0] = v[i].x; tp[1] = v[i].y; tp[2] = v[i].z; tp[3] = v[i].w; }
    __syncthreads();
#pragma unroll
    for (int i = 0; i < 4; ++i) { const int n = i * 32 + (tid >> 4), kc = (tid & 15) * 8; h16x8 o;
#pragma unroll
        for (int j = 0; j < 8; ++j) o[j] = (h16)tile[kc + j][n];
        *(h16x8*)(q.dst + (size_t)cvt_rowmap(n0 + n, q.rmode) * q.ldd + q.col_off + k0 + kc) = o; }
}
template <int NT> __device__ __forceinline__ void mod_unit(const Params& p, int u, float* sc  , float* red  ) {
    const int l = u / 96, n0 = (u % 96) * 64, tid = threadIdx.x, n = tid & 63, ks = tid >> 6;
    constexpr int NKS = NT / 64, KPER = 1024 / NKS;
    __syncthreads();
    for (int i = tid; i < 9 * 1024; i += NT) { const int g = i >> 10, k = i & 1023; const float v = g == 0 ? p.c_ctx[k] : p.c[(g - 1) * 1024 + k]; sc[i] = siluf_(v); }
    __syncthreads();
    float acc[9];
#pragma unroll
    for (int g = 0; g < 9; ++g) acc[g] = 0.f;
    const float* w = p.w_mod + (size_t)l * 1024 * 6144 + n0 + n;
#pragma unroll 8
    for (int k = ks * KPER; k < (ks + 1) * KPER; ++k) { const float wv = w[(size_t)k * 6144];
#pragma unroll
        for (int g = 0; g < 9; ++g) acc[g] += sc[g * 1024 + k] * wv; }
#pragma unroll
    for (int g = 0; g < 9; ++g) red[(ks * 9 + g) * 64 + n] = acc[g];
    __syncthreads();
    for (int i = tid; i < 9 * 64; i += NT) { const int g = i >> 6, nn = i & 63; float s = p.b_mod[l * 6144 + n0 + nn];
        for (int k2 = 0; k2 < NKS; ++k2) s += red[(k2 * 9 + g) * 64 + nn];
        WSP(float, OFF_MOD)[(size_t)(l * 9 + g) * 6144 + n0 + nn] = s; }
}

#define LAS __attribute__((address_space(3)))
typedef float f32x4 __attribute__((ext_vector_type(4)));
typedef unsigned u32x4 __attribute__((ext_vector_type(4)));
typedef unsigned u32x2 __attribute__((ext_vector_type(2)));
namespace pg8 {
constexpr int BM = 256, BK = 64, HALF = 128, HTB = HALF * BK * 2, STAGE_BYTES = 8 * HTB;
__host__ __device__ __forceinline__ int lds_byte(int r, int c) { const int st = (r >> 4) * 2 + (c >> 5), rr = r & 15, cc = c & 31, ob = rr * 64 + cc * 2; return st * 1024 + (ob ^ (((ob >> 9) & 1) << 5)); }
__host__ __device__ __forceinline__ void stage_rc(int b, int& R, int& C) { const int st = b / 1024, sb = b % 1024, swz = sb ^ (((sb >> 9) & 1) << 5); R = (st >> 1) * 16 + swz / 64; C = (st & 1) * 32 + (swz % 64) / 2; }
__host__ __device__ __forceinline__ int perm32(int rho) { const int n = rho >> 4, i = rho & 15; return 8 * (i >> 2) + 4 * n + (i & 3); }
struct GUnit { const char* A; const char* B; int nt; int kind; int pm; int pn; int aux; };
__device__ __forceinline__ void tile_map(int L, int nM, int nN, int& pm, int& pn) {
    const int nwg = nM * nN; int wgid = L;
    { const int q = nwg / 8, r = nwg % 8, xcd = wgid % 8, off = wgid / 8; wgid = (xcd < r ? xcd * (q + 1) : r * (q + 1) + (xcd - r) * q) + off; }
    const int nig = 8 * nN, gid = wgid / nig, fm = gid * 8, gsz = (nM - fm) < 8 ? (nM - fm) : 8;
    pm = fm + ((wgid % nig) % gsz); pn = (wgid % nig) / gsz;
}
__device__ __forceinline__ unsigned cvt_pk_f16(float lo, float hi) { typedef float f2 __attribute__((ext_vector_type(2))); const f2 v = {lo, hi}; const h16x2 h = __builtin_convertvector(v, h16x2); return __builtin_bit_cast(unsigned, h); }

template <class Epi, class Sched>
__device__ __forceinline__ void gemm_phase(LAS unsigned char* lds, const int lda, const int ldb, const Sched& S, const Epi& E) {
    const int tid = threadIdx.x, wid = __builtin_amdgcn_readfirstlane(tid >> 6), lane = tid & 63, wr = wid >> 2, wc = wid & 3, fr = lane & 15, fq = lane >> 4;
    unsigned voffA[2], voffB[2];
#pragma unroll
    for (int i = 0; i < 2; ++i) { int R, C; stage_rc(tid * 16 + i * 8192, R, C); const int Rb = Epi::PERM ? ((R & ~31) + perm32(R & 31)) : R;
        voffA[i] = (unsigned)(R * lda + C) * 2u; voffB[i] = (unsigned)(Rb * ldb + C) * 2u; }
    const size_t kstep = (size_t)(BK * 2);
    const size_t hstepA = (size_t)HALF * lda * 2, hstepB = (size_t)HALF * ldb * 2;
    const unsigned ldsw = (unsigned)wid * 1024u;
    const int aoff = lds_byte(wr * 64 + fr, fq * 8), boff = lds_byte(wc * 32 + fr, fq * 8);
#define PG8_SA(b, h) (((b) * 2 + (h)) * HTB)
#define PG8_SB(b, h) ((4 + (b) * 2 + (h)) * HTB)
#define PG8_STAGE(bufoff, gbase, voff) do { _Pragma("unroll") for (int _i = 0; _i < 2; ++_i) \
        __builtin_amdgcn_global_load_lds((const unsigned*)((const char*)(gbase) + (voff)[_i]), (LAS unsigned*)(lds + (bufoff) + ldsw + _i * 8192), 16, 0, 0); } while (0)
#define PG8_LDA(dst, b, h) do { _Pragma("unroll") for (int m = 0; m < 4; ++m) _Pragma("unroll") for (int k = 0; k < 2; ++k) dst[m][k] = *(const LAS h16x8*)(lds + PG8_SA(b, h) + aoff + m * 2048 + k * 1024); } while (0)
#define PG8_LDB(dst, b, h) do { _Pragma("unroll") for (int n = 0; n < 2; ++n) _Pragma("unroll") for (int k = 0; k < 2; ++k) dst[n][k] = *(const LAS h16x8*)(lds + PG8_SB(b, h) + boff + n * 2048 + k * 1024); } while (0)
#define PG8_MMA(ai, bj, At, Bt) do { __builtin_amdgcn_s_setprio(1); _Pragma("unroll") for (int m = 0; m < 4; ++m) _Pragma("unroll") for (int n = 0; n < 2; ++n) _Pragma("unroll") for (int k = 0; k < 2; ++k) \
        acc[ai][bj][m][n] = __builtin_amdgcn_mfma_f32_16x16x32_f16(Bt[n][k], At[m][k], acc[ai][bj][m][n], 0, 0, 0); __builtin_amdgcn_s_setprio(0); } while (0)
#define PG8_WAIT_V(n) asm volatile("s_waitcnt vmcnt(" #n ")" ::: "memory")
#define PG8_WAIT_L(n) asm volatile("s_waitcnt lgkmcnt(" #n ")" ::: "memory")
#define PG8_BAR __builtin_amdgcn_s_barrier()
#define PG8_SCHED __builtin_amdgcn_sched_barrier(0)
    GUnit cur, nxt; int ui = 0; unsigned long long probe_t0 = 0ull;
    if (!S.next(0, cur)) return;
    f32x4 acc[2][2][4][2];
#pragma unroll
    for (int a = 0; a < 2; ++a)
#pragma unroll
        for (int b = 0; b < 2; ++b)
#pragma unroll
            for (int m = 0; m < 4; ++m)
#pragma unroll
                for (int n = 0; n < 2; ++n) acc[a][b][m][n] = (f32x4){0.f, 0.f, 0.f, 0.f};
    h16x8 At[4][2], B0[2][2], B1[2][2];
    const char* cA = cur.A; const char* cB = cur.B;
#ifndef PG8_SP2
#define PG8_SP2 1
#endif
    if (PG8_SP2) {
        PG8_STAGE(PG8_SB(0, 0), cB, voffB); PG8_STAGE(PG8_SB(0, 1), cB + hstepB, voffB); PG8_STAGE(PG8_SA(0, 0), cA, voffA); PG8_STAGE(PG8_SA(0, 1), cA + hstepA, voffA);
        if (wr == 1) PG8_BAR;
        PG8_WAIT_V(2); PG8_BAR;
        PG8_STAGE(PG8_SB(1, 0), cB + kstep, voffB); PG8_STAGE(PG8_SA(1, 0), cA + kstep, voffA); PG8_STAGE(PG8_SB(1, 1), cB + hstepB + kstep, voffB);
        PG8_WAIT_V(6); PG8_BAR;
    } else {
    PG8_STAGE(PG8_SB(0, 0), cB, voffB); PG8_STAGE(PG8_SA(0, 0), cA, voffA); PG8_STAGE(PG8_SB(0, 1), cB + hstepB, voffB); PG8_STAGE(PG8_SA(0, 1), cA + hstepA, voffA);
    if (wr == 1) PG8_BAR;
    PG8_WAIT_V(4); PG8_BAR;
    PG8_STAGE(PG8_SB(1, 0), cB + kstep, voffB); PG8_STAGE(PG8_SA(1, 0), cA + kstep, voffA); PG8_STAGE(PG8_SB(1, 1), cB + hstepB + kstep, voffB);
    PG8_WAIT_V(6); PG8_BAR;
    }
    for (;;) {
        const bool has_next = S.next(ui + 1, nxt);
        const char* nA = has_next ? nxt.A : cA; const char* nB = has_next ? nxt.B : cB;
        const int nt = cur.nt;
        for (int t = 0; t < nt; t += 2) {
            const bool last = (t == nt - 2);
            const char* a1 = cA + (size_t)(t + 1) * kstep;
            const char* a2 = last ? nA : cA + (size_t)(t + 2) * kstep; const char* b2 = last ? nB : cB + (size_t)(t + 2) * kstep;
            const char* a3 = a2 + kstep; const char* b3 = b2 + kstep;
            if (PG8_SP2) {
            PG8_LDB(B0, 0, 0); PG8_LDB(B1, 0, 1); PG8_SCHED; PG8_LDA(At, 0, 0); PG8_STAGE(PG8_SA(1, 1), a1 + hstepA, voffA);
            PG8_WAIT_V(8); PG8_WAIT_L(0); PG8_BAR; PG8_MMA(0, 0, At, B0); PG8_MMA(0, 1, At, B1); PG8_BAR; PG8_SCHED;
            PG8_LDA(At, 0, 1); PG8_STAGE(PG8_SB(0, 0), b2, voffB); PG8_STAGE(PG8_SB(0, 1), b2 + hstepB, voffB); PG8_STAGE(PG8_SA(0, 0), a2, voffA);
            PG8_WAIT_V(8); PG8_WAIT_L(0); PG8_BAR; PG8_MMA(1, 0, At, B0); PG8_MMA(1, 1, At, B1); PG8_BAR; PG8_SCHED;
            PG8_LDB(B0, 1, 0); PG8_LDB(B1, 1, 1); PG8_SCHED; PG8_LDA(At, 1, 0); PG8_STAGE(PG8_SA(0, 1), a2 + hstepA, voffA);
            PG8_WAIT_V(8); PG8_WAIT_L(0); PG8_BAR; PG8_MMA(0, 0, At, B0); PG8_MMA(0, 1, At, B1); PG8_BAR; PG8_SCHED;
            PG8_LDA(At, 1, 1); PG8_STAGE(PG8_SB(1, 0), b3, voffB); PG8_STAGE(PG8_SB(1, 1), b3 + hstepB, voffB); PG8_STAGE(PG8_SA(1, 0), a3, voffA);
            PG8_WAIT_V(8); PG8_WAIT_L(0); PG8_BAR; PG8_MMA(1, 0, At, B0); PG8_MMA(1, 1, At, B1); PG8_BAR; PG8_SCHED;
            } else {
            PG8_LDB(B0, 0, 0); PG8_SCHED; PG8_LDA(At, 0, 0); PG8_STAGE(PG8_SA(1, 1), a1 + hstepA, voffA);
            PG8_WAIT_L(8); PG8_BAR; PG8_WAIT_L(0); PG8_MMA(0, 0, At, B0); PG8_BAR; PG8_SCHED;
            PG8_LDB(B1, 0, 1); PG8_STAGE(PG8_SB(0, 0), b2, voffB);
            PG8_BAR; PG8_WAIT_L(0); PG8_MMA(0, 1, At, B1); PG8_BAR;
            PG8_LDA(At, 0, 1); PG8_STAGE(PG8_SA(0, 0), a2, voffA);
            PG8_BAR; PG8_WAIT_L(0); PG8_MMA(1, 0, At, B0); PG8_BAR; PG8_SCHED;
            PG8_STAGE(PG8_SB(0, 1), b2 + hstepB, voffB);
            PG8_WAIT_V(6); PG8_BAR; PG8_MMA(1, 1, At, B1); PG8_BAR;
            PG8_LDB(B0, 1, 0); PG8_SCHED; PG8_LDA(At, 1, 0); PG8_STAGE(PG8_SA(0, 1), a2 + hstepA, voffA);
            PG8_WAIT_L(8); PG8_BAR; PG8_WAIT_L(0); PG8_MMA(0, 0, At, B0); PG8_BAR; PG8_SCHED;
            PG8_LDB(B1, 1, 1); PG8_STAGE(PG8_SB(1, 0), b3, voffB);
            PG8_BAR; PG8_WAIT_L(0); PG8_MMA(0, 1, At, B1); PG8_BAR;
            PG8_LDA(At, 1, 1); PG8_STAGE(PG8_SA(1, 0), a3, voffA);
            PG8_BAR; PG8_WAIT_L(0); PG8_MMA(1, 0, At, B0); PG8_BAR; PG8_SCHED;
            PG8_STAGE(PG8_SB(1, 1), b3 + hstepB, voffB);
            PG8_WAIT_V(6); PG8_BAR; PG8_MMA(1, 1, At, B1); PG8_BAR;
            }
            if (PROBE_EPI == 2 && t == 0 && probe_t0 != 0ull && blockIdx.x == 0 && tid == 0) ((LAS unsigned long long*)(lds + 147424))[0] += __builtin_amdgcn_s_memrealtime() - probe_t0;
            if (PROBE_EPI == 3 && t == 4) probe_t0 = __builtin_amdgcn_s_memrealtime();
            if (PROBE_EPI == 3 && t == 6 && blockIdx.x == 0 && tid == 0) ((LAS unsigned long long*)(lds + 147424))[0] += __builtin_amdgcn_s_memrealtime() - probe_t0;
        }
#ifndef PG8_ALIGN
#define PG8_ALIGN 1
#endif
        if (PG8_ALIGN) { if (wr == 0) PG8_BAR; }
        unsigned long long pe0 = 0; if (PROBE_EPI == 1 || PROBE_EPI == 2) pe0 = __builtin_amdgcn_s_memrealtime();
        E(acc, cur, wr, wc, fr, fq);
        if (PROBE_EPI == 1 && blockIdx.x == 0 && tid == 0) ((LAS unsigned long long*)(lds + 147424))[0] += __builtin_amdgcn_s_memrealtime() - pe0;
        if (PROBE_EPI == 2) probe_t0 = pe0;
        if (!has_next) break;
#pragma unroll
        for (int a = 0; a < 2; ++a)
#pragma unroll
            for (int b = 0; b < 2; ++b)
#pragma unroll
                for (int m = 0; m < 4; ++m)
#pragma unroll
                    for (int n = 0; n < 2; ++n) acc[a][b][m][n] = (f32x4){0.f, 0.f, 0.f, 0.f};
        cur = nxt; cA = nA; cB = nB; ++ui;
        if (PG8_ALIGN) { if (wr == 1) PG8_BAR; }
    }
    PG8_WAIT_V(0);
    if (!PG8_ALIGN) { if (wr == 0) PG8_BAR; }
    PG8_BAR;
#undef PG8_SA
#undef PG8_SB
#undef PG8_STAGE
#undef PG8_LDA
#undef PG8_LDB
#undef PG8_MMA
#undef PG8_WAIT_V
#undef PG8_WAIT_L
#undef PG8_BAR
#undef PG8_SCHED
}

template <class Epi, class Sched>
__device__ __forceinline__ void gemm_phase_h(LAS unsigned char* lds, const int lda, const int ldb, const Sched& S, const Epi& E) {
    const int tid = threadIdx.x, wid = __builtin_amdgcn_readfirstlane(tid >> 6), lane = tid & 63, wr = wid >> 1, wc = wid & 1, hf = wid >> 2, fr = lane & 15, fq = lane >> 4;
    unsigned voffA[2], voffB[2];
#pragma unroll
    for (int i = 0; i < 2; ++i) { int R, C; stage_rc(tid * 16 + i * 8192, R, C); const int Rb = (R & ~31) + perm32(R & 31);
        voffA[i] = (unsigned)(R * lda + C) * 2u; voffB[i] = (unsigned)(Rb * ldb + C) * 2u; }
    const size_t kstep = (size_t)(BK * 2);
    const size_t hstepA = (size_t)HALF * lda * 2;
    const unsigned ldsw = (unsigned)wid * 1024u;
    const int aoff = lds_byte(wr * 32 + fr, fq * 8), boff = lds_byte(wc * 64 + fr, fq * 8);
#define PG8_SA(b, h) (((b) * 2 + (h)) * HTB)
#define PG8_SB(b, h) ((4 + (b) * 2 + (h)) * HTB)
#define PG8_STAGE(bufoff, gbase, voff) do { _Pragma("unroll") for (int _i = 0; _i < 2; ++_i) \
        __builtin_amdgcn_global_load_lds((const unsigned*)((const char*)(gbase) + (voff)[_i]), (LAS unsigned*)(lds + (bufoff) + ldsw + _i * 8192), 16, 0, 0); } while (0)
#define PG8_LDA(dst, b, h) do { _Pragma("unroll") for (int m = 0; m < 2; ++m) _Pragma("unroll") for (int k = 0; k < 2; ++k) dst[m][k] = *(const LAS h16x8*)(lds + PG8_SA(b, h) + aoff + m * 2048 + k * 1024); } while (0)
#define PG8_LDB(dst, b, h) do { _Pragma("unroll") for (int n = 0; n < 4; ++n) _Pragma("unroll") for (int k = 0; k < 2; ++k) dst[n][k] = *(const LAS h16x8*)(lds + PG8_SB(b, h) + boff + n * 2048 + k * 1024); } while (0)
#define PG8_MMA(ai, At, Bt) do { __builtin_amdgcn_s_setprio(1); _Pragma("unroll") for (int m = 0; m < 2; ++m) _Pragma("unroll") for (int n = 0; n < 4; ++n) _Pragma("unroll") for (int k = 0; k < 2; ++k) \
        acc[ai][m][n] = __builtin_amdgcn_mfma_f32_16x16x32_f16(Bt[n][k], At[m][k], acc[ai][m][n], 0, 0, 0); __builtin_amdgcn_s_setprio(0); } while (0)
#define PG8_WAIT_V(n) asm volatile("s_waitcnt vmcnt(" #n ")" ::: "memory")
#define PG8_WAIT_L(n) asm volatile("s_waitcnt lgkmcnt(" #n ")" ::: "memory")
#define PG8_BAR __builtin_amdgcn_s_barrier()
#define PG8_SCHED __builtin_amdgcn_sched_barrier(0)
    GUnit cur, nxt; int ui = 0;
    if (!S.next(0, cur)) return;
    f32x4 acc[2][2][4];
#pragma unroll
    for (int a = 0; a < 2; ++a)
#pragma unroll
        for (int m = 0; m < 2; ++m)
#pragma unroll
            for (int n = 0; n < 4; ++n) acc[a][m][n] = (f32x4){0.f, 0.f, 0.f, 0.f};
    h16x8 At[2][2], B0[4][2];
    const char* cA = cur.A; const char* cB = cur.B;
    PG8_STAGE(PG8_SB(0, 0), cB, voffB); PG8_STAGE(PG8_SA(0, 0), cA, voffA); PG8_STAGE(PG8_SA(0, 1), cA + hstepA, voffA);
    if (hf == 1) PG8_BAR;
    PG8_WAIT_V(2); PG8_BAR;
    PG8_STAGE(PG8_SB(1, 0), cB + kstep, voffB); PG8_STAGE(PG8_SA(1, 0), cA + kstep, voffA);
    PG8_WAIT_V(4); PG8_BAR;
    for (;;) {
        const bool has_next = S.next(ui + 1, nxt);
        const char* nA = has_next ? nxt.A : cA; const char* nB = has_next ? nxt.B : cB;
        const int nt = cur.nt;
        for (int t = 0; t < nt; t += 2) {
            const bool last = (t == nt - 2);
            const char* a1 = cA + (size_t)(t + 1) * kstep;
            const char* a2 = last ? nA : cA + (size_t)(t + 2) * kstep; const char* b2 = last ? nB : cB + (size_t)(t + 2) * kstep;
            const char* a3 = a2 + kstep; const char* b3 = b2 + kstep;
            PG8_LDB(B0, 0, 0); PG8_SCHED; PG8_LDA(At, 0, 0); PG8_STAGE(PG8_SA(1, 1), a1 + hstepA, voffA);
            PG8_WAIT_V(6); PG8_WAIT_L(0); PG8_BAR; PG8_MMA(0, At, B0); PG8_BAR; PG8_SCHED;
            PG8_LDA(At, 0, 1); PG8_STAGE(PG8_SB(0, 0), b2, voffB); PG8_STAGE(PG8_SA(0, 0), a2, voffA);
            PG8_WAIT_V(6); PG8_WAIT_L(0); PG8_BAR; PG8_MMA(1, At, B0); PG8_BAR; PG8_SCHED;
            PG8_LDB(B0, 1, 0); PG8_SCHED; PG8_LDA(At, 1, 0); PG8_STAGE(PG8_SA(0, 1), a2 + hstepA, voffA);
            PG8_WAIT_V(6); PG8_WAIT_L(0); PG8_BAR; PG8_MMA(0, At, B0); PG8_BAR; PG8_SCHED;
            PG8_LDA(At, 1, 1); PG8_STAGE(PG8_SB(1, 0), b3, voffB); PG8_STAGE(PG8_SA(1, 0), a3, voffA);
            PG8_WAIT_V(6); PG8_WAIT_L(0); PG8_BAR; PG8_MMA(1, At, B0); PG8_BAR; PG8_SCHED;
        }
        if (PG8_ALIGN) { if (hf == 0) PG8_BAR; }
        E(acc, cur, wr, wc, fr, fq);
        if (!has_next) break;
        cur = nxt; cA = nA; cB = nB; ++ui;
        if (PG8_ALIGN) { if (hf == 1) PG8_BAR; }
    }
    PG8_WAIT_V(0);
    if (!PG8_ALIGN) { if (hf == 0) PG8_BAR; }
    PG8_BAR;
#undef PG8_SA
#undef PG8_SB
#undef PG8_STAGE
#undef PG8_LDA
#undef PG8_LDB
#undef PG8_MMA
#undef PG8_WAIT_V
#undef PG8_WAIT_L
#undef PG8_BAR
#undef PG8_SCHED
}
}
using pg8::GUnit;

struct SchedPlain {
    const char* A; const char* B; int lda, ldb, nt, pm0, nM, nN, G, c;
    __device__ __forceinline__ bool next(int i, GUnit& u) const {
        const int L = i * G + c; if (L >= nM * nN) return false;
        int pm, pn; pg8::tile_map(L, nM, nN, pm, pn);
        u.pm = pm0 + pm; u.pn = pn; u.kind = 0; u.aux = 0; u.nt = nt;
        u.A = A + (size_t)u.pm * 256 * lda * 2; u.B = B + (size_t)pn * 256 * ldb * 2; return true;
    }
};
struct SchedMerge {
    const char* A; const char* B; int pm0, nM, G, c;
    __device__ __forceinline__ bool next(int i, GUnit& u) const {
        const int ti = i / 6, sub = i - ti * 6, L = ti * G + c; if (L >= nM * 4) return false;
        int pm, pn; pg8::tile_map(L, nM, 4, pm, pn);
        const int n = sub >> 1, br = sub & 1;
        u.pm = pm0 + pm; u.pn = pn; u.kind = sub; u.aux = n; u.nt = br ? 8 : 16;
        u.A = A + ((size_t)u.pm * 256 * AW + (br ? AY0 + n * 512 : AH)) * 2;
        u.B = B + ((size_t)(n * 1024 + pn * 256) * 1536 + (br ? 1024 : 0)) * 2; return true;
    }
};
struct SchedMoe {
    const char* A; const char* B; const int* panelE; int lda, ldb, nt, pm0, arow_pm0, nM, nN, G, c; size_t estride; int ks_shift;
    __device__ __forceinline__ bool next(int i, GUnit& u) const {
        const int Lq = i * G + c; if (Lq >= ((nM * nN) << ks_shift)) return false;
        const int q = Lq & ((1 << ks_shift) - 1), L = Lq >> ks_shift;
        int pm, pn; pg8::tile_map(L, nM, nN, pm, pn);
        u.pm = pm0 + pm; u.pn = pn; u.kind = 0; u.aux = q; u.nt = nt >> ks_shift;
        const int e = panelE[u.pm]; const size_t koff = (size_t)q * (nt >> ks_shift) * 128;
        u.A = A + (size_t)(u.pm - arow_pm0) * 256 * lda * 2 + koff; u.B = B + (size_t)e * estride + (size_t)pn * 256 * ldb * 2 + koff; return true;
    }
};

#define EPI_ARGS const f32x4 (&acc)[2][2][4][2], const GUnit& u, int wr, int wc, int fr, int fq
struct EpiF16 {
    static constexpr bool PERM = true;
    h16* O; int ldc;
    __device__ __forceinline__ void operator()(EPI_ARGS) const {
        const int row0 = u.pm * 256 + wr * 64 + fr, col0 = u.pn * 256 + wc * 32 + 8 * fq;
#pragma unroll
        for (int ai = 0; ai < 2; ++ai)
#pragma unroll
            for (int m = 0; m < 4; ++m) { h16* rowp = O + (size_t)(row0 + ai * 128 + m * 16) * ldc + col0;
#pragma unroll
                for (int bj = 0; bj < 2; ++bj) { const f32x4 v0 = acc[ai][bj][m][0], v1 = acc[ai][bj][m][1];
                    u32x4 w; w.x = pg8::cvt_pk_f16(v0[0], v0[1]); w.y = pg8::cvt_pk_f16(v0[2], v0[3]); w.z = pg8::cvt_pk_f16(v1[0], v1[1]); w.w = pg8::cvt_pk_f16(v1[2], v1[3]);
                    *(u32x4*)(rowp + bj * 128) = w; } }
    }
};
struct EpiMerge {
    static constexpr bool PERM = true;
    const float* bmerge;
    char* priv;
    h16* S16;
    __device__ __forceinline__ void operator()(EPI_ARGS) const {
        unsigned off0 = (unsigned)threadIdx.x * 16u; asm volatile("" : "+v"(off0));
        u32x4* pg = (u32x4*)(priv + off0); u32x4* ps = (u32x4*)(priv + 131072 + off0);
        if ((u.kind & 1) == 0) {
            const float* bb = bmerge + u.aux * 1024 + u.pn * 256 + wc * 32 + 8 * fq;
#pragma unroll
            for (int bj = 0; bj < 2; ++bj) { const f32x4 b0 = *(const f32x4*)(bb + bj * 128), b1 = *(const f32x4*)(bb + bj * 128 + 4);
#pragma unroll
                for (int ai = 0; ai < 2; ++ai)
#pragma unroll
                    for (int m = 0; m < 4; ++m) { f32x4 v0 = acc[ai][bj][m][0] + b0, v1 = acc[ai][bj][m][1] + b1;
#pragma unroll
                        for (int j = 0; j < 4; ++j) { v0[j] = sigmoidf_(v0[j]); v1[j] = sigmoidf_(v1[j]); }
                        u32x4 w; w.x = pg8::cvt_pk_f16(v0[0], v0[1]); w.y = pg8::cvt_pk_f16(v0[2], v0[3]); w.z = pg8::cvt_pk_f16(v1[0], v1[1]); w.w = pg8::cvt_pk_f16(v1[2], v1[3]);
                        pg[((ai * 2 + bj) * 4 + m) * 512] = w; } }
        } else {
            const int row0 = u.pm * 256 + wr * 64 + fr, col0 = u.pn * 256 + wc * 32 + 8 * fq;
#pragma unroll
            for (int ai = 0; ai < 2; ++ai) {
                u32x4 gw[2][4], sw[2][4];
#pragma unroll
                for (int bj = 0; bj < 2; ++bj)
#pragma unroll
                    for (int m = 0; m < 4; ++m) { const int slot = (ai * 2 + bj) * 4 + m; gw[bj][m] = pg[slot * 512]; if (u.kind != 1) sw[bj][m] = ps[slot * 512]; }
#pragma unroll
                for (int bj = 0; bj < 2; ++bj)
#pragma unroll
                    for (int m = 0; m < 4; ++m) { const int slot = (ai * 2 + bj) * 4 + m;
                        const h16x8 g = __builtin_bit_cast(h16x8, gw[bj][m]);
                        f32x4 s0 = acc[ai][bj][m][0], s1 = acc[ai][bj][m][1];
#pragma unroll
                        for (int j = 0; j < 4; ++j) { s0[j] *= (float)g[j]; s1[j] *= (float)g[4 + j]; }
                        if (u.kind != 1) { const h16x8 sp = __builtin_bit_cast(h16x8, sw[bj][m]);
#pragma unroll
                            for (int j = 0; j < 4; ++j) { s0[j] += (float)sp[j]; s1[j] += (float)sp[4 + j]; } }
                        u32x4 o; o.x = pg8::cvt_pk_f16(s0[0], s0[1]); o.y = pg8::cvt_pk_f16(s0[2], s0[3]); o.z = pg8::cvt_pk_f16(s1[0], s1[1]); o.w = pg8::cvt_pk_f16(s1[2], s1[3]);
                        if (u.kind != 5) ps[slot * 512] = o;
                        else *(u32x4*)(S16 + (size_t)(row0 + ai * 128 + m * 16) * 1024 + col0 + bj * 128) = o; }
                asm volatile("" ::: "memory"); }
        }
    }
};
struct SchedMergeH {
    const char* A; const char* B; int pm0, nM, G, c;
    __device__ __forceinline__ bool next(int i, GUnit& u) const {
        const int ti = i / 6, sub = i - ti * 6, L = ti * G + c; if (L >= nM * 8) return false;
        int pm, pn; pg8::tile_map(L, nM, 8, pm, pn);
        const int n = sub >> 1, br = sub & 1;
        u.pm = pm0 + pm; u.pn = pn; u.kind = sub; u.aux = n; u.nt = br ? 8 : 16;
        u.A = A + ((size_t)u.pm * 256 * AW + (br ? AY0 + n * 512 : AH)) * 2;
        u.B = B + ((size_t)(n * 1024 + pn * 128) * 1536 + (br ? 1024 : 0)) * 2; return true;
    }
};
struct EpiMergeH {
    const float* bmerge; h16* S16;
    mutable u32x2 gk[2][2][4];
    mutable f32x4 sk[2][2][4];
    __device__ __forceinline__ void operator()(f32x4 (&acc)[2][2][4], const GUnit& u, int wr, int wc, int fr, int fq) const {
        if ((u.kind & 1) == 0) {
            const float* bb = bmerge + u.aux * 1024 + u.pn * 128 + wc * 64 + 8 * fq;
            f32x4 bv[4];
#pragma unroll
            for (int n = 0; n < 4; ++n) bv[n] = *(const f32x4*)(bb + (n >> 1) * 32 + (n & 1) * 4);
#pragma unroll
            for (int ai = 0; ai < 2; ++ai)
#pragma unroll
                for (int m = 0; m < 2; ++m)
#pragma unroll
                    for (int n = 0; n < 4; ++n) { f32x4 v = acc[ai][m][n] + bv[n];
#pragma unroll
                        for (int j = 0; j < 4; ++j) v[j] = sigmoidf_(v[j]);
                        u32x2 w; w.x = pg8::cvt_pk_f16(v[0], v[1]); w.y = pg8::cvt_pk_f16(v[2], v[3]); gk[ai][m][n] = w; acc[ai][m][n] = (f32x4){0.f, 0.f, 0.f, 0.f}; }
        } else {
            const int row0 = u.pm * 256 + wr * 32 + fr, col0 = u.pn * 128 + wc * 64 + 8 * fq;
#pragma unroll
            for (int ai = 0; ai < 2; ++ai)
#pragma unroll
                for (int m = 0; m < 2; ++m)
#pragma unroll
                    for (int g2 = 0; g2 < 2; ++g2) { f32x4 s[2];
#pragma unroll
                        for (int q = 0; q < 2; ++q) { const int n = g2 * 2 + q; const h16x4 g = __builtin_bit_cast(h16x4, gk[ai][m][n]); f32x4 v = acc[ai][m][n];
#pragma unroll
                            for (int j = 0; j < 4; ++j) v[j] *= (float)g[j];
                            if (u.kind != 1) v += sk[ai][m][n];
                            sk[ai][m][n] = v; s[q] = v; acc[ai][m][n] = (f32x4){0.f, 0.f, 0.f, 0.f}; }
                        if (u.kind == 5) { u32x4 o; o.x = pg8::cvt_pk_f16(s[0][0], s[0][1]); o.y = pg8::cvt_pk_f16(s[0][2], s[0][3]); o.z = pg8::cvt_pk_f16(s[1][0], s[1][1]); o.w = pg8::cvt_pk_f16(s[1][2], s[1][3]);
                            *(u32x4*)(S16 + (size_t)(row0 + ai * 128 + m * 16) * 1024 + col0 + g2 * 32) = o; } }
        }
    }
};
struct EpiScaled {
    static constexpr bool PERM = true;
    h16* Y; const float* modv;
    __device__ __forceinline__ void operator()(EPI_ARGS) const {
        const int row0 = u.pm * 256 + wr * 64 + fr, col0 = u.pn * 256 + wc * 32 + 8 * fq;
        const int g = u.pm < 8 ? 0 : 1 + ((u.pm - 8) >> 4);
        f32x4 mv[2][2];
#pragma unroll
        for (int bj = 0; bj < 2; ++bj)
#pragma unroll
            for (int n = 0; n < 2; ++n) mv[bj][n] = *(const f32x4*)(modv + (size_t)g * 6144 + col0 + bj * 128 + 4 * n);
#pragma unroll
        for (int ai = 0; ai < 2; ++ai)
#pragma unroll
            for (int m = 0; m < 4; ++m) { h16* rowp = Y + (size_t)(row0 + ai * 128 + m * 16) * D + col0;
#pragma unroll
                for (int bj = 0; bj < 2; ++bj) { const f32x4 v0 = acc[ai][bj][m][0] * mv[bj][0], v1 = acc[ai][bj][m][1] * mv[bj][1];
                    u32x4 w; w.x = pg8::cvt_pk_f16(v0[0], v0[1]); w.y = pg8::cvt_pk_f16(v0[2], v0[3]); w.z = pg8::cvt_pk_f16(v1[0], v1[1]); w.w = pg8::cvt_pk_f16(v1[2], v1[3]);
                    *(u32x4*)(rowp + bj * 128) = w; } }
    }
};
struct EpiSwiglu {
    static constexpr bool PERM = true;
    h16* O; int ldc; int orow0;
    __device__ __forceinline__ void operator()(EPI_ARGS) const {
        const int row0 = u.pm * 256 - orow0 + wr * 64 + fr, col0 = u.pn * 128 + wc * 32 + 8 * fq;
#pragma unroll
        for (int ai = 0; ai < 2; ++ai)
#pragma unroll
            for (int m = 0; m < 4; ++m) { float o[8];
#pragma unroll
                for (int n = 0; n < 2; ++n)
#pragma unroll
                    for (int j = 0; j < 4; ++j) o[n * 4 + j] = siluf_(acc[ai][0][m][n][j]) * acc[ai][1][m][n][j];
                u32x4 w; w.x = pg8::cvt_pk_f16(o[0], o[1]); w.y = pg8::cvt_pk_f16(o[2], o[3]); w.z = pg8::cvt_pk_f16(o[4], o[5]); w.w = pg8::cvt_pk_f16(o[6], o[7]);
                *(u32x4*)(O + (size_t)(row0 + ai * 128 + m * 16) * ldc + col0) = w; }
    }
};
struct EpiMoeDown {
    static constexpr bool PERM = true;
    h16* OUT2; const int* rowT; const float* rowP; h16* OUTP; int tail;
    __device__ __forceinline__ void operator()(EPI_ARGS) const {
        const int row0 = u.pm * 256 + wr * 64 + fr, col0 = u.pn * 256 + wc * 32 + 8 * fq;
#pragma unroll
        for (int ai = 0; ai < 2; ++ai)
#pragma unroll
            for (int m = 0; m < 4; ++m) { const int r = row0 + ai * 128 + m * 16; const int tk = rowT[r]; const float pp = rowP[r];
                if (tk < 0) continue;
                h16* rowp = tail ? OUTP + ((size_t)u.aux * 2048 + (r - 65536)) * 1024 + col0 : OUT2 + ((size_t)(tk & 1) * ML + (tk >> 1)) * 1024 + col0;
#pragma unroll
                for (int bj = 0; bj < 2; ++bj) { const f32x4 v0 = acc[ai][bj][m][0] * pp, v1 = acc[ai][bj][m][1] * pp;
                    u32x4 w; w.x = pg8::cvt_pk_f16(v0[0], v0[1]); w.y = pg8::cvt_pk_f16(v0[2], v0[3]); w.z = pg8::cvt_pk_f16(v1[0], v1[1]); w.w = pg8::cvt_pk_f16(v1[2], v1[3]);
                    *(u32x4*)(rowp + bj * 128) = w; } }
    }
};

constexpr int LDS_BYTES = 147456;
constexpr size_t OFF_PRIV = OFF_BIG;
constexpr size_t OFF_YW = OFF_BIG;
__device__ __forceinline__ h16* S16_base(const Params& p, int l) { return l == 0 ? (h16*)p.out : (h16*)p.out - (size_t)MC * D; }
__device__ __forceinline__ h16* YW_base(const Params& p, int l) { return l == 0 ? WSP(h16, OFF_YW) : (h16*)p.out + (size_t)(ML - MC) * D; }
__device__ __forceinline__ void ph_gemm_in(const Params& p, LAS unsigned char* lds, int l, int G, int c) {
    SchedPlain S; S.A = (const char*)(WSP(h16, OFF_A) + AH); S.B = (const char*)WSP(h16, OFF_W16 + l * SZ_LAYERW); S.lda = AW; S.ldb = 1024; S.nt = 16; S.pm0 = 0; S.nM = MT / 256; S.nN = ZW / 256; S.G = G; S.c = c;
    EpiF16 E; E.O = WSP(h16, OFF_Z); E.ldc = ZW;
    pg8::gemm_phase(lds, AW, 1024, S, E);
}
__device__ __forceinline__ void ph_merge(const Params& p, LAS unsigned char* lds, int l, int G, int c) {
    SchedMergeH S; S.A = (const char*)WSP(h16, OFF_A); S.B = (const char*)WSP(h16, OFF_W16 + l * SZ_LAYERW + SZ_WINT); S.pm0 = l == 0 ? 0 : 8; S.nM = MT / 256 - S.pm0; S.G = G; S.c = c;
    EpiMergeH E; E.bmerge = p.b_merge + (size_t)l * 3 * 1024; E.S16 = S16_base(p, l);
    pg8::gemm_phase_h(lds, AW, 1536, S, E);
}
__device__ __forceinline__ void ph_wout(const Params& p, LAS unsigned char* lds, int l, int G, int c) {
    SchedPlain S; S.A = (const char*)S16_base(p, l); S.B = (const char*)WSP(h16, OFF_W16 + l * SZ_LAYERW + SZ_WINT + SZ_BTALL); S.lda = 1024; S.ldb = 1024; S.nt = 16; S.pm0 = l == 0 ? 0 : 8; S.nM = MT / 256 - S.pm0; S.nN = 4; S.G = G; S.c = c;
    EpiScaled E; E.Y = YW_base(p, l); E.modv = WSP(float, OFF_MOD) + (size_t)l * 9 * 6144 + 2 * 1024;
    pg8::gemm_phase(lds, 1024, 1024, S, E);
}
__device__ __forceinline__ void ph_ffn_gu(const Params& p, LAS unsigned char* lds, int G, int c) {
    SchedPlain S; S.A = (const char*)(WSP(h16, OFF_A) + AH); S.B = (const char*)WSP(h16, OFF_WGUT); S.lda = AW; S.ldb = 1024; S.nt = 16; S.pm0 = 0; S.nM = MT / 256; S.nN = 2 * DFF / 256; S.G = G; S.c = c;
    EpiSwiglu E; E.O = WSP(h16, OFF_ACT); E.ldc = DFF; E.orow0 = 0;
    pg8::gemm_phase(lds, AW, 1024, S, E);
}
__device__ __forceinline__ void ph_ffn_down(const Params& p, LAS unsigned char* lds, int G, int c) {
    SchedPlain S; S.A = (const char*)WSP(h16, OFF_ACT); S.B = (const char*)WSP(h16, OFF_WDT); S.lda = DFF; S.ldb = DFF; S.nt = DFF / 64; S.pm0 = 0; S.nM = MT / 256; S.nN = 4; S.G = G; S.c = c;
    EpiScaled E; E.Y = (h16*)p.out; E.modv = WSP(float, OFF_MOD) + 5 * 1024;
    pg8::gemm_phase(lds, DFF, DFF, S, E);
}
__device__ __forceinline__ void ph_moe_gu(const Params& p, LAS unsigned char* lds, int panel0, int G, int c) {
    const int* plan = WSP(int, OFF_PLAN); const int np = plan[8]; int nM = np - panel0; nM = nM > 64 ? 64 : nM; if (nM <= 0) return;
    SchedMoe S; S.A = (const char*)WSP(h16, OFF_XG); S.B = (const char*)WSP(h16, OFF_WMOE_GU); S.panelE = plan + 16; S.lda = 1024; S.ldb = 1024; S.nt = 16; S.pm0 = panel0; S.arow_pm0 = 0; S.nM = nM; S.nN = 2 * DEX / 256; S.G = G; S.c = c; S.estride = (size_t)2 * DEX * 1024 * 2; S.ks_shift = 0;
    EpiSwiglu E; E.O = (h16*)p.out; E.ldc = DEX; E.orow0 = panel0 * 256;
    pg8::gemm_phase(lds, 1024, 1024, S, E);
}
__device__ __forceinline__ void ph_moe_down(const Params& p, LAS unsigned char* lds, int panel0, int G, int c) {
    const int* plan = WSP(int, OFF_PLAN); const int np = plan[8]; int nM = np - panel0; nM = nM > 64 ? 64 : nM; if (nM <= 0) return;
    const int tail = panel0 >= 256;
    SchedMoe S; S.A = (const char*)p.out; S.B = (const char*)WSP(h16, OFF_WMOE_D); S.panelE = plan + 16; S.lda = DEX; S.ldb = DEX; S.nt = DEX / 64; S.pm0 = panel0; S.arow_pm0 = panel0; S.nM = nM; S.nN = 4; S.G = G; S.c = c; S.estride = (size_t)1024 * DEX * 2; S.ks_shift = tail ? 2 : 0;
    EpiMoeDown E; E.OUT2 = WSP(h16, OFF_OUT2); E.rowT = WSP(int, OFF_ROWT); E.rowP = WSP(float, OFF_ROWP); E.OUTP = WSP(h16, OFF_OUTP); E.tail = tail;
    pg8::gemm_phase(lds, DEX, DEX, S, E);
}

namespace attn_body {
using s16x4 = __attribute__((ext_vector_type(4))) short;
using s16x8 = __attribute__((ext_vector_type(8))) short;
using f32x16 = __attribute__((ext_vector_type(16))) float;
constexpr int D64 = 64, NW = 8, QBLK = 32, QB = QBLK * NW, KVBLK = 64;
constexpr int QP = 512, KP = 128, OP = AW;
__device__ __forceinline__ int crow(int r, int hi) { return (r & 3) + 8 * (r >> 2) + 4 * hi; }
#define SBAR() __builtin_amdgcn_sched_barrier(0)
constexpr int NSLOT = 3, SLOTB = 8192;
constexpr int LDS_K = 0, LDS_V = NSLOT * SLOTB, LDS_WS = 2 * NSLOT * SLOTB, LDS_OST = LDS_WS + NW * 64 * 4, ATTN_LDS_BYTES = LDS_OST + NW * 4096;
__device__ __forceinline__ void glds16(const void* gsrc, unsigned lds_dst) { unsigned keep;
    asm volatile("s_mov_b32 %0, m0\n\ts_mov_b32 m0, %2\n\ts_nop 0\n\tglobal_load_lds_dwordx4 %1, off\n\ts_mov_b32 m0, %0" : "=&s"(keep) : "v"(gsrc), "s"(lds_dst) : "memory"); }
__device__ __forceinline__ float max3f(float a, float b, float c) { float r; asm("v_max3_f32 %0, %1, %2, %3" : "=v"(r) : "v"(a), "v"(b), "v"(c)); return r; }
__device__ __forceinline__ float max2f(float a, float b) { float r; asm("v_max_f32_e32 %0, %1, %2" : "=v"(r) : "v"(a), "v"(b)); return r; }
__device__ __forceinline__ float fadd_s(float a, float b) { float r; asm("v_add_f32_e32 %0, %1, %2" : "=v"(r) : "v"(a), "v"(b)); return r; }
__device__ __forceinline__ float fsub_s(float a, float b) { float r; asm("v_sub_f32_e32 %0, %1, %2" : "=v"(r) : "v"(a), "v"(b)); return r; }
__device__ __forceinline__ unsigned cvtpk_s(float lo, float hi) { return pg8::cvt_pk_f16(lo, hi); }
#define WAIT_BAR(N) asm volatile("s_waitcnt vmcnt(" #N ") lgkmcnt(0)\n\ts_barrier" ::: "memory")
#define AMFMA(a, b, c) __builtin_amdgcn_mfma_f32_32x32x16_f16(__builtin_bit_cast(h16x8, a), __builtin_bit_cast(h16x8, b), c, 0, 0, 0)
__device__ __forceinline__ void qkt(f32x16& p0, f32x16& p1, const char* Kslot, const s16x8* qr, const f32x16& negm, int r32, int hi) {
    const char* kb = Kslot + hi * 1024 + r32 * 16;
#pragma unroll
    for (int d0 = 0; d0 < 4; ++d0) {
        const s16x8 b0 = *reinterpret_cast<const s16x8*>(kb + d0 * 2048);
        const s16x8 b1 = *reinterpret_cast<const s16x8*>(kb + d0 * 2048 + 512);
        if (d0 == 0) { p0 = AMFMA(b0, qr[0], negm); p1 = AMFMA(b1, qr[0], negm); }
        else { p0 = AMFMA(b0, qr[d0], p0); p1 = AMFMA(b1, qr[d0], p1); } }
}
typedef __attribute__((address_space(3))) const char* lds_cptr;
typedef short v4i16_t __attribute__((ext_vector_type(4)));
__device__ __forceinline__ void kload8(s16x8* kf, lds_cptr kp) {
    kf[0] = *(const __attribute__((address_space(3))) s16x8*)(kp);        kf[1] = *(const __attribute__((address_space(3))) s16x8*)(kp + 512);
    kf[2] = *(const __attribute__((address_space(3))) s16x8*)(kp + 2048); kf[3] = *(const __attribute__((address_space(3))) s16x8*)(kp + 2560);
    kf[4] = *(const __attribute__((address_space(3))) s16x8*)(kp + 4096); kf[5] = *(const __attribute__((address_space(3))) s16x8*)(kp + 4608);
    kf[6] = *(const __attribute__((address_space(3))) s16x8*)(kp + 6144); kf[7] = *(const __attribute__((address_space(3))) s16x8*)(kp + 6656);
}
__device__ __forceinline__ void kload2(s16x8* kf, lds_cptr kp, int j) { kf[2 * j] = *(const __attribute__((address_space(3))) s16x8*)(kp + j * 2048); kf[2 * j + 1] = *(const __attribute__((address_space(3))) s16x8*)(kp + j * 2048 + 512); }
__device__ __forceinline__ s16x4 vtr(lds_cptr p) { return __builtin_bit_cast(s16x4, __builtin_amdgcn_ds_read_tr16_b64_v4i16((__attribute__((address_space(3))) v4i16_t*)p)); }
__device__ __forceinline__ float rowmax(const f32x16& p0, const f32x16& p1) {
    float a = max3f(p0[0], p0[1], p1[0]), b = max3f(p0[2], p0[3], p1[1]); a = max3f(a, p1[2], p1[3]);
#pragma unroll
    for (int r = 4; r < 16; r += 4) { a = max3f(a, p0[r], p0[r + 1]); b = max3f(b, p0[r + 2], p0[r + 3]); a = max3f(a, p1[r], p1[r + 1]); b = max3f(b, p1[r + 2], p1[r + 3]); }
    const float m = max2f(a, b);
    auto rr = __builtin_amdgcn_permlane32_swap(__float_as_uint(m), __float_as_uint(m), false, false);
    return max2f(__uint_as_float(rr[0]), __uint_as_float(rr[1]));
}
__device__ __forceinline__ void pv(f32x16* o, int vb, s16x8 pa0, s16x8 pa1, s16x8 pa2, s16x8 pa3) {
#pragma unroll
    for (int d0 = 0; d0 < 2; ++d0) { s16x4 lo[4], hi[4];
#pragma unroll
        for (int ks = 0; ks < 4; ++ks) {
            asm volatile("ds_read_b64_tr_b16 %0,%1 offset:%c2" : "=&v"(lo[ks]) : "v"(vb), "i"(d0 * 4096 + ks * 1024) : "memory");
            asm volatile("ds_read_b64_tr_b16 %0,%1 offset:%c2" : "=&v"(hi[ks]) : "v"(vb), "i"(d0 * 4096 + ks * 1024 + 512) : "memory"); }
        asm volatile("s_waitcnt lgkmcnt(0)" ::: "memory"); SBAR();
#define PK(k) (s16x8){lo[k][0], lo[k][1], lo[k][2], lo[k][3], hi[k][0], hi[k][1], hi[k][2], hi[k][3]}
        o[d0] = AMFMA(pa0, PK(0), o[d0]);
        o[d0] = AMFMA(pa1, PK(1), o[d0]);
        o[d0] = AMFMA(pa2, PK(2), o[d0]);
        o[d0] = AMFMA(pa3, PK(3), o[d0]);
#undef PK
    }
}
template <int THRL> __device__ __forceinline__ void attn_unit(const h16* Qu, const h16* __restrict__ Ku, const h16* __restrict__ Vu, h16* Ou, const int NT, char* shm) {
    const int tid = threadIdx.x, lane = tid & 63, r32 = lane & 31, hi = lane >> 5; const int wid = __builtin_amdgcn_readfirstlane(tid >> 6);
    const h16* Qw = Qu + (size_t)(wid * QBLK) * QP;
    const unsigned lds0 = (unsigned)(uintptr_t)shm;
    float* wsf = (float*)(shm + LDS_WS) + wid * 64;
    const h16* ksrc = Ku + (long)lane * KP + wid * 8;
    const h16* vsrc = Vu + (long)(16 * (wid & 3) + (lane >> 2)) * KP + (wid >> 2) * 32 + (lane & 3) * 8;
    const unsigned kdst = lds0 + LDS_K + wid * 1024, vdst = lds0 + LDS_V + wid * 1024;
#define DMA_K(t, slot) glds16(ksrc + (long)(t) * KVBLK * KP, (unsigned)__builtin_amdgcn_readfirstlane(kdst + (slot)))
#define DMA_V(t, slot) glds16(vsrc + (long)(t) * KVBLK * KP, (unsigned)__builtin_amdgcn_readfirstlane(vdst + (slot)))
    const int vb0 = (int)(lds0 + LDS_V) + ((lane >> 4) & 1) * 32 + (lane & 3) * 8 + (4 * hi + ((lane & 15) >> 2)) * 64;
    const char* Kbase = shm + LDS_K; s16x8 kf[8];
    const lds_cptr shm3 = (lds_cptr)shm; const lds_cptr kp0 = shm3 + LDS_K + hi * 1024 + r32 * 16; const lds_cptr vp0 = shm3 + LDS_V + ((lane >> 4) & 1) * 32 + (lane & 3) * 8 + (4 * hi + ((lane & 15) >> 2)) * 64;
    DMA_K(0, 0); DMA_V(0, 0); DMA_K(1, SLOTB);
    s16x8 qr[4];
#pragma unroll
    for (int d0 = 0; d0 < 4; ++d0) qr[d0] = *reinterpret_cast<const s16x8*>(&Qw[(long)r32 * QP + d0 * 16 + hi * 8]);
    float mhat = 0.f, l_reg = 0.f; f32x16 o[2]; o[0] = f32x16{}; o[1] = f32x16{}; f32x16 negm = f32x16{}; asm volatile("" : "+v"(negm));
    bool resc = false;
#define START(P0, P1) do { const float rm = rowmax(P0, P1); resc = false; \
    { const float dl = rm; mhat = fadd_s(mhat, dl); \
      _Pragma("unroll") for (int r = 0; r < 16; ++r) { P0[r] = fsub_s(P0[r], dl); P1[r] = fsub_s(P1[r], dl); } \
      _Pragma("unroll") for (int r = 0; r < 16; ++r) negm[r] = -mhat; asm volatile("" : "+v"(negm)); } \
    _Pragma("unroll") for (int r = 0; r < 16; ++r) P0[r] = __builtin_amdgcn_exp2f(P0[r]); } while (0)
#define RESC() do { if (resc) { asm volatile("s_waitcnt lgkmcnt(0)" ::: "memory"); \
      _Pragma("unroll") for (int d_ = 0; d_ < 2; ++d_) _Pragma("unroll") for (int r = 0; r < 16; ++r) o[d_][r] *= wsf[crow(r, hi)]; } } while (0)
    f32x16 pA0, pA1, pB0, pB1;
    int sl_prev = 0, sl_cur = 0, sl_next = SLOTB;
#define ROT() do { sl_prev = sl_cur; sl_cur = sl_next; sl_next = (sl_next == (NSLOT - 1) * SLOTB) ? 0 : sl_next + SLOTB; } while (0)
    DMA_K(2, 2 * SLOTB);
    WAIT_BAR(3);
    qkt(pA0, pA1, Kbase, qr, negm, r32, hi); asm volatile("s_nop 15\n\ts_nop 7" : "+v"(pA0), "+v"(pA1));
    START(pA0, pA1);
    _Pragma("unroll") for (int r = 0; r < 16; ++r) pA1[r] = __builtin_amdgcn_exp2f(pA1[r]);
    WAIT_BAR(0);
    DMA_K(3, 0); DMA_V(1, SLOTB);
    ROT();
    kload8(kf, kp0 + sl_cur);
    WAIT_BAR(2);
    s16x4 vlo[8], vhi[8]; u32x4 pw0, pw1, pw2, pw3;
#define PKW(P, B) cvtpk_s(P[B], P[B + 1])
#define PAF(k) __builtin_bit_cast(s16x8, pw##k)
#define VFR(i) (s16x8){vlo[i][0], vlo[i][1], vlo[i][2], vlo[i][3], vhi[i][0], vhi[i][1], vhi[i][2], vhi[i][3]}
#define PIN(x) asm volatile("" : "+v"(x))
#define MX3(a, b, c) __builtin_fmaxf(__builtin_fmaxf((a), (b)), (c))
#define GAPA(MF, A0, A1, A2, A3, W0, W1, PW) do { MF; sacc += A0; sacc += A1; sacc += A2; sacc += A3; PIN(sacc); W0; W1; PIN(PW); SBAR(); } while (0)
#define EX(v) __builtin_amdgcn_exp2f(v)
#define GAPB(MF, X, B) do { MF; X[B] = EX(X[B]); X[B + 1] = EX(X[B + 1]); X[B + 2] = EX(X[B + 2]); X[B + 3] = EX(X[B + 3]); PIN(X); SBAR(); } while (0)
#define VRD(i) do { vlo[i] = vtr(vp_ + (((i) >> 2) * 4096 + ((i) & 3) * 1024)); vhi[i] = vtr(vp_ + (((i) >> 2) * 4096 + ((i) & 3) * 1024 + 512)); } while (0)
#define KRD(G, j) do { if (G) { kload2(kf, kp0 + sl_next, j); SBAR(); } } while (0)
#define STEP(C0, C1, P0, P1, t, GK, GV, GL) do { SBAR(); \
    const lds_cptr vp_ = vp0 + sl_prev; \
    VRD(0); SBAR(); float sacc = (P0[0] + P0[1]); \
    GAPA(C0 = AMFMA(kf[0], qr[0], negm), P0[2], P0[3], P0[4], P0[5],     pw0[0] = PKW(P0, 0), pw0[1] = PKW(P0, 2), pw0); \
    VRD(4); SBAR(); GAPA(C1 = AMFMA(kf[1], qr[0], negm), P0[6], P0[7], P0[8], P0[9],     pw0[2] = PKW(P0, 4), pw0[3] = PKW(P0, 6), pw0); \
    VRD(1); SBAR(); GAPA(C0 = AMFMA(kf[2], qr[1], C0),   P0[10], P0[11], P0[12], P0[13], pw1[0] = PKW(P0, 8), pw1[1] = PKW(P0, 10), pw1); \
    VRD(5); SBAR(); GAPA(C1 = AMFMA(kf[3], qr[1], C1),   P0[14], P0[15], P1[0], P1[1],   pw1[2] = PKW(P0, 12), pw1[3] = PKW(P0, 14), pw1); \
    VRD(2); SBAR(); GAPA(C0 = AMFMA(kf[4], qr[2], C0),   P1[2], P1[3], P1[4], P1[5],     pw2[0] = PKW(P1, 0), pw2[1] = PKW(P1, 2), pw2); \
    VRD(6); SBAR(); GAPA(C1 = AMFMA(kf[5], qr[2], C1),   P1[6], P1[7], P1[8], P1[9],     pw2[2] = PKW(P1, 4), pw2[3] = PKW(P1, 6), pw2); \
    VRD(3); SBAR(); GAPA(C0 = AMFMA(kf[6], qr[3], C0),   P1[10], P1[11], P1[12], P1[13], pw3[0] = PKW(P1, 8), pw3[1] = PKW(P1, 10), pw3); \
    VRD(7); SBAR(); GAPA(C1 = AMFMA(kf[7], qr[3], C1),   P1[14], P1[15], 0.f, 0.f,       pw3[2] = PKW(P1, 12), pw3[3] = PKW(P1, 14), pw3); \
    l_reg += sacc; \
    if (GK) { DMA_K((t) + 3, sl_cur); } if (GV) { DMA_V((t) + 1, sl_next); } \
    { float a = MX3(C0[0], C0[1], C1[0]), b = MX3(C0[2], C0[3], C1[1]); a = MX3(a, C1[2], C1[3]); \
      _Pragma("unroll") for (int r = 4; r < 16; r += 4) { a = MX3(a, C0[r], C0[r + 1]); b = MX3(b, C0[r + 2], C0[r + 3]); a = MX3(a, C1[r], C1[r + 1]); b = MX3(b, C1[r + 2], C1[r + 3]); } \
      float rm = __builtin_fmaxf(a, b); { auto rr = __builtin_amdgcn_permlane32_swap(__float_as_uint(rm), __float_as_uint(rm), false, false); rm = __builtin_fmaxf(__uint_as_float(rr[0]), __uint_as_float(rr[1])); } \
      resc = false; \
      if (__builtin_expect(__any(rm > (float)THRL), 0)) { const float dl = __builtin_fmaxf(rm, 0.f); mhat += dl; \
        _Pragma("unroll") for (int r = 0; r < 16; ++r) { C0[r] -= dl; C1[r] -= dl; } \
        _Pragma("unroll") for (int r = 0; r < 16; ++r) negm[r] = -mhat; asm volatile("" : "+v"(negm)); \
        const float f = __builtin_amdgcn_exp2f(-dl); l_reg *= f; if (hi == 0) wsf[r32] = f; resc = true; } } \
    SBAR(); \
    GAPB(o[0] = AMFMA(PAF(0), VFR(0), o[0]), C0, 0); \
    GAPB(o[1] = AMFMA(PAF(0), VFR(4), o[1]), C0, 4); \
    KRD(GL, 0); GAPB(o[0] = AMFMA(PAF(1), VFR(1), o[0]), C0, 8); \
    KRD(GL, 1); GAPB(o[1] = AMFMA(PAF(1), VFR(5), o[1]), C0, 12); \
    KRD(GL, 2); GAPB(o[0] = AMFMA(PAF(2), VFR(2), o[0]), C1, 0); \
    KRD(GL, 3); GAPB(o[1] = AMFMA(PAF(2), VFR(6), o[1]), C1, 4); \
    GAPB(o[0] = AMFMA(PAF(3), VFR(3), o[0]), C1, 8); \
    GAPB(o[1] = AMFMA(PAF(3), VFR(7), o[1]), C1, 12); \
    } while (0)
    int t = 1;
    for (; t + 5 < NT; t += 2) {
        STEP(pB0, pB1, pA0, pA1, t, true, true, true);     WAIT_BAR(2); RESC(); ROT();
        STEP(pA0, pA1, pB0, pB1, t + 1, true, true, true); WAIT_BAR(2); RESC(); ROT();
    }
#define ENDW(tt) do { if ((tt) + 3 < NT) { WAIT_BAR(2); } else if ((tt) + 2 < NT) { WAIT_BAR(1); } else { WAIT_BAR(0); } } while (0)
    for (; t + 1 < NT; t += 2) {
        STEP(pB0, pB1, pA0, pA1, t, (t + 3 < NT), (t + 1 < NT), (t + 1 < NT));         ENDW(t);     RESC(); ROT();
        STEP(pA0, pA1, pB0, pB1, t + 1, (t + 4 < NT), (t + 2 < NT), (t + 2 < NT));     ENDW(t + 1); RESC(); ROT();
    }
    STEP(pB0, pB1, pA0, pA1, NT - 1, false, false, false); RESC();
    { float sacc = pB0[0] + pB0[1]; _Pragma("unroll") for (int r = 2; r < 16; ++r) sacc += pB0[r]; _Pragma("unroll") for (int r = 0; r < 16; ++r) sacc += pB1[r]; l_reg += sacc;
      pw0 = (u32x4){PKW(pB0, 0), PKW(pB0, 2), PKW(pB0, 4), PKW(pB0, 6)}; pw1 = (u32x4){PKW(pB0, 8), PKW(pB0, 10), PKW(pB0, 12), PKW(pB0, 14)}; pw2 = (u32x4){PKW(pB1, 0), PKW(pB1, 2), PKW(pB1, 4), PKW(pB1, 6)}; pw3 = (u32x4){PKW(pB1, 8), PKW(pB1, 10), PKW(pB1, 12), PKW(pB1, 14)};
      SBAR(); pv(o, vb0 + sl_cur, PAF(0), PAF(1), PAF(2), PAF(3)); }
#undef PKW
#undef PAF
#undef VFR
#undef PIN
#undef MX3
#undef GAPA
#undef GAPB
#undef EX
#undef VRD
#undef KRD
#undef STEP
#undef ENDW
    { auto rr = __builtin_amdgcn_permlane32_swap(__float_as_uint(l_reg), __float_as_uint(l_reg), false, false); l_reg = __uint_as_float(rr[0]) + __uint_as_float(rr[1]); }
    if (hi == 0) wsf[32 + r32] = l_reg; asm volatile("s_waitcnt lgkmcnt(0)" ::: "memory");
    float rli[16];
#pragma unroll
    for (int r = 0; r < 16; ++r) rli[r] = __builtin_amdgcn_rcpf(wsf[32 + crow(r, hi)]);
    h16* Ow = Ou + (size_t)(wid * QBLK) * OP;
    { h16* stg = (h16*)(shm + LDS_OST) + wid * 2048;
#pragma unroll
      for (int r = 0; r < 16; ++r) { const int orow = crow(r, hi);
#pragma unroll
        for (int d0 = 0; d0 < 2; ++d0) stg[orow * 64 + d0 * 32 + r32] = (h16)(o[d0][r] * rli[r]); }
      asm volatile("s_waitcnt lgkmcnt(0)" ::: "memory");
#pragma unroll
      for (int i = 0; i < 4; ++i) { const int row = i * 8 + (lane >> 3), ch = lane & 7; const u32x4 v = *(const u32x4*)(stg + row * 64 + ch * 8); *(u32x4*)(Ow + (long)row * OP + ch * 8) = v; } }
    asm volatile("s_waitcnt lgkmcnt(0)\n\ts_barrier" ::: "memory");
#undef DMA_K
#undef DMA_V
#undef START
#undef RESC
#undef ROT
}
#undef SBAR
#undef WAIT_BAR
#undef AMFMA
}

__device__ __forceinline__ void ph_attn(const Params& p, char* shm, int l, int G, int c) {
    const h16* Qh = WSP(h16, OFF_QH); const h16* Kh = WSP(h16, OFF_KH); const h16* Vh = WSP(h16, OFF_VH); h16* A = WSP(h16, OFF_A);
    const int x = c & 7, j0 = c >> 3, nx = (G + 7 - x) >> 3;
    for (int j = j0; j < 128; j += nx) {
        const int set = 2 * x + (j >> 6), un = j & 63, b = set >> 1, kvh = set & 1, hq = kvh * 4 + (un >> 4), qb = un & 15;
        const size_t qrow = (size_t)MC + (size_t)b * SEQ + (size_t)qb * 256;
        attn_body::attn_unit<8>(Qh + qrow * 512 + hq * 64, Kh + (size_t)b * SB * 128 + kvh * 64, Vh + (size_t)b * SB * 128 + kvh * 64, A + qrow * AW + AY1 + hq * 64, SB / 64, shm);
    }
    if (l == 0) for (int u = c; u < 64; u += G) {
        const int b = u >> 3, hq = u & 7, kvh = hq >> 2; const size_t qrow = (size_t)b * CTX;
        attn_body::attn_unit<8>(Qh + qrow * 512 + hq * 64, Kh + (size_t)b * SB * 128 + kvh * 64, Vh + (size_t)b * SB * 128 + kvh * 64, A + qrow * AW + AY1 + hq * 64, CTX / 64, shm);
    }
}

#define XB_TMO      128
#define XB_XCNT(j)  (256  + 64 * (j))
#define XB_XSUB(j)  (1280 + 64 * (j))
#define XB_XGEN(j)  (2304 + 64 * (j))
#define XB_TOP      3328
#define XB_TOPGEN   3392
#define XCD_BAR_WORDS 3456
#define XB_SPIN_CAP (1u << 18)
__device__ __forceinline__ unsigned xb_ld(unsigned* p)              { return __hip_atomic_load(p, __ATOMIC_RELAXED, __HIP_MEMORY_SCOPE_AGENT); }
__device__ __forceinline__ unsigned xb_add(unsigned* p, unsigned v) { return __hip_atomic_fetch_add(p, v, __ATOMIC_RELAXED, __HIP_MEMORY_SCOPE_AGENT); }
__device__ __forceinline__ unsigned xb_xcc_id() { return (unsigned)__builtin_amdgcn_s_getreg((3 << 11) | 20) & 0xFu; }
#define XB_SPIN(cond, bar) do { unsigned _sp = 0; while (cond) { __builtin_amdgcn_s_sleep(1); \
    if ((++_sp & 255u) == 0u) { if (xb_ld(&(bar)[XB_TMO])) break; if (_sp > XB_SPIN_CAP) { atomicAdd(&(bar)[XB_TMO], 1u); break; } } } } while (0)
struct XcdBarrier { unsigned* bar; unsigned x; volatile LAS unsigned* st; };
__device__ __forceinline__ XcdBarrier xcd_barrier_post(unsigned* bar, volatile LAS unsigned* st) {
    XcdBarrier b; b.bar = bar; b.x = xb_xcc_id(); b.st = st;
    if (threadIdx.x == 0) (void)xb_add(&bar[XB_XCNT(b.x)], 1u);
    return b;
}
__device__ __forceinline__ void xcd_barrier_complete(unsigned* bar, unsigned x, unsigned& nloc, unsigned& nx) {
    const unsigned G = gridDim.x * gridDim.y * gridDim.z;
    unsigned sum, cnt, mine, sp = 0u;
    for (;;) {
        sum = 0u; cnt = 0u; mine = 0u;
#pragma unroll
        for (unsigned j = 0; j < 16; ++j) { const unsigned c = xb_ld(&bar[XB_XCNT(j)]); sum += c; cnt += (c > 0u) ? 1u : 0u; mine = (j == x) ? c : mine; }
        if (sum == G) break;
        __builtin_amdgcn_s_sleep(1);
        if ((++sp & 255u) == 0u) { if (xb_ld(&bar[XB_TMO])) break; if (sp > XB_SPIN_CAP) { atomicAdd(&bar[XB_TMO], 1u); break; } }
    }
    nloc = mine > 0u ? mine : 1u; nx = cnt > 0u ? cnt : 1u;
}
__device__ __forceinline__ void xcd_barrier(const XcdBarrier& b) {
    asm volatile("s_waitcnt vmcnt(0)" ::: "memory");
    __syncthreads();
    if (threadIdx.x == 0) {
        unsigned* bar = b.bar;
        __builtin_amdgcn_s_waitcnt(0);
        unsigned nloc = b.st[0], nx = b.st[1];
        if (nloc == 0u) { xcd_barrier_complete(bar, b.x, nloc, nx); b.st[0] = nloc; b.st[1] = nx; }
        const unsigned old = xb_add(&bar[XB_XSUB(b.x)], 1u);
        const unsigned gen = old / nloc;
        if (old + 1u == (gen + 1u) * nloc) {
            __builtin_amdgcn_fence(__ATOMIC_RELEASE, "agent");
            asm volatile("s_waitcnt vmcnt(0)" ::: "memory");
            const unsigned og = xb_add(&bar[XB_TOP], 1u);
            const unsigned tg = og / nx;
            if (og + 1u == (tg + 1u) * nx) xb_add(&bar[XB_TOPGEN], 1u);
            else XB_SPIN(xb_ld(&bar[XB_TOPGEN]) == tg, bar);
            __builtin_amdgcn_fence(__ATOMIC_ACQUIRE, "agent");
            xb_add(&bar[XB_XGEN(b.x)], 1u);
            asm volatile("s_waitcnt vmcnt(0)" ::: "memory");
        } else {
            XB_SPIN(xb_ld(&bar[XB_XGEN(b.x)]) == gen, bar);
            __builtin_amdgcn_fence(__ATOMIC_ACQUIRE, "agent");
            asm volatile("s_waitcnt vmcnt(0)" ::: "memory");
        }
    }
    __syncthreads();
}

constexpr int NTH = 512;
template <int NT> __device__ __forceinline__ void poolfold_unit(const Params& p, int u, float (*Ws)[132]) {
    const int l = u / 64, g = (u / 16) % 4, k0 = (u % 16) * 64, tid = threadIdx.x;
    const float* pw = p.pool_w + (size_t)(l * 4 + g) * 128 * 128;
    const int jj = tid & 127;
    __syncthreads();
    for (int i = tid; i < 64 * 32; i += NT) *(float4*)&Ws[i >> 5][(i & 31) * 4] = *(const float4*)(p.w_in + (size_t)l * 1024 * WIN + (size_t)(k0 + (i >> 5)) * WIN + g * 128 + (i & 31) * 4);
    __syncthreads();
    constexpr int NKK = 64 / (NT / 128);
    float acc[NKK];
#pragma unroll
    for (int q = 0; q < NKK; ++q) acc[q] = 0.f;
#pragma unroll 1
    for (int hf = 0; hf < 2; ++hf) {
        float pcol[64];
#pragma unroll
        for (int c2 = 0; c2 < 64; ++c2) pcol[c2] = pw[(hf * 64 + c2) * 128 + jj];
#pragma unroll
        for (int q = 0; q < NKK; ++q) { const int kk = (tid >> 7) + q * (NT / 128);
#pragma unroll
            for (int c4 = 0; c4 < 16; ++c4) { const float4 w4 = *(const float4*)&Ws[kk][hf * 64 + c4 * 4]; acc[q] += w4.x * pcol[c4 * 4] + w4.y * pcol[c4 * 4 + 1] + w4.z * pcol[c4 * 4 + 2] + w4.w * pcol[c4 * 4 + 3]; } }
    }
    h16* wint = WSP(h16, OFF_W16 + l * SZ_LAYERW);
    const float sc = p.pool_scale[l * 512 + g * 128 + jj];
#pragma unroll
    for (int q = 0; q < NKK; ++q) { const int kk = (tid >> 7) + q * (NT / 128); wint[(size_t)(g * 128 + jj) * 1024 + k0 + kk] = (h16)(acc[q] * sc); }
}
__device__ __forceinline__ void cvt_jobs(const Params& p, int j0, int j1, int ubase, int G, int c, float (*tile)[129]) {
    int base = ubase; bool pend = false; CvtJob qp = get_job(p, j0); int tp = 0; float4 v[8];
    for (int j = j0; j < j1; ++j) {
        const CvtJob q = get_job(p, j); const int nt = job_tiles(q);
        const int first = ((c - base % G) + G) % G;
        base += nt;
        for (int t = first; t < nt; t += G) {
            float4 w[8]; cvt_load(q, t, w);
            if (pend) cvt_store(qp, tp, v, tile);
#pragma unroll
            for (int i = 0; i < 8; ++i) v[i] = w[i];
            qp = q; tp = t; pend = true;
        }
    }
    if (pend) cvt_store(qp, tp, v, tile);
}
__device__ __forceinline__ void lru_wt_prep(const Params& p, int G, int c);
__device__ __forceinline__ void ph_prologue(const Params& p, char* shm, int G, int c) {
    if (c == 0 && threadIdx.x < 32) WSP(int, OFF_CNT)[threadIdx.x] = 0;
    for (int u = c; u < 192; u += G) mod_unit<NTH>(p, u, (float*)shm, (float*)shm + 9 * 1024);
    lru_wt_prep(p, G, (c + 64) % G);
}
__device__ __forceinline__ void ph_h0(const Params& p, char* shm, int G, int c) {
    const float* mod = WSP(float, OFF_MOD); h16* A = WSP(h16, OFF_A); const int tid = threadIdx.x, lane = tid & 63, wv = tid >> 6;
    for (int r = c * 32 + wv * 4; r < MT; r += G * 32) {
        float4 xv[4][4];
#pragma unroll
        for (int q = 0; q < 4; ++q) { const float* xr = xin_row(p, r + q);
#pragma unroll
            for (int i = 0; i < 4; ++i) xv[q][i] = *(const float4*)(xr + i * 256 + lane * 4); }
#pragma unroll
        for (int q = 0; q < 4; ++q) { const int g = row_group(r + q);
#pragma unroll
            for (int i = 0; i < 4; ++i) { const int d = i * 256 + lane * 4; const float4 m0 = *(const float4*)(mod + (size_t)g * 6144 + d), m1 = *(const float4*)(mod + (size_t)g * 6144 + 1024 + d);
                h16x4 o; o[0] = (h16)(xv[q][i].x * (1.f + m1.x) + m0.x); o[1] = (h16)(xv[q][i].y * (1.f + m1.y) + m0.y); o[2] = (h16)(xv[q][i].z * (1.f + m1.z) + m0.z); o[3] = (h16)(xv[q][i].w * (1.f + m1.w) + m0.w);
                *(h16x4*)(A + (size_t)(r + q) * AW + AH + d) = o; } }
    }
    for (int u = c; u < 128; u += G) poolfold_unit<NTH>(p, (u + 128) % 128, (float (*)[132])shm);
    cvt_jobs(p, 0, NJOBS_SMALL, 128, G, c, (float (*)[129])shm);
}
constexpr int ROPE_LDS = 138496;
__device__ __forceinline__ void rope_table(char* shm) {
    float2* tab = (float2*)(shm + ROPE_LDS);
    for (int i = threadIdx.x; i < 1024; i += NTH) { const float inv = exp2f(-(float)(i & 15) * (13.287712379549449f / 16.0f)); float sn, cs; sincosf((float)(i >> 4) * inv, &sn, &cs); tab[i] = make_float2(cs, sn); }
}
__device__ __forceinline__ void qkv_block(const Params& p, char* shm, int l, int rbase) {
    const h16* Z = WSP(h16, OFF_Z); h16* Qh = WSP(h16, OFF_QH); h16* Kh = WSP(h16, OFF_KH); h16* Vh = WSP(h16, OFF_VH);
    const int tid = threadIdx.x, lane = tid & 63, wv = tid >> 6;
    const float2* tab = (const float2*)(shm + ROPE_LDS);
    const int L = lane & 7, j0 = (L & 1) * 8;
    float qn[8], kn[8];
#pragma unroll
    for (int e = 0; e < 8; ++e) { qn[e] = p.q_norm[l * 64 + L * 8 + e] * QSCALE; kn[e] = p.k_norm[l * 64 + L * 8 + e]; }
    for (int r0 = rbase + wv * 8; r0 < rbase + wv * 8 + 8; r0 += 2) {
        h16x8 qv[2], kv[2];
#pragma unroll
        for (int q = 0; q < 2; ++q) { const int r = r0 + q; qv[q] = *(const h16x8*)(Z + (size_t)r * ZW + ZQ + lane * 8); kv[q] = *(const h16x8*)(Z + (size_t)r * ZW + ZK + (lane & 31) * 8); }
#pragma unroll
        for (int q = 0; q < 2; ++q) {
            const int r = r0 + q; int s0, len, pos; row_seq(r, s0, len, pos);
            const bool lat = r >= MC; const int b = lat ? (r - MC) >> 12 : r >> 8; const size_t krow = (size_t)b * SB + (lat ? CTX + pos : pos);
            const int tp = (L < 4) ? (pos >> 6) : (pos & 63);
            float cs[8], sn[8];
#pragma unroll
            for (int e = 0; e < 8; ++e) { const float2 t = tab[tp * 16 + j0 + e]; cs[e] = lat ? t.x : 1.f; sn[e] = lat ? t.y : 0.f; }
            { float y[8], ss = 0.f;
#pragma unroll
              for (int e = 0; e < 8; ++e) { y[e] = (float)qv[q][e]; ss += y[e] * y[e]; }
              ss += __shfl_xor(ss, 1); ss += __shfl_xor(ss, 2); ss += __shfl_xor(ss, 4);
              const float rs = rsqrtf(ss * (1.0f / 64.0f) + 1e-6f); h16x8 o;
#pragma unroll
              for (int e = 0; e < 8; ++e) { y[e] *= rs * qn[e]; }
#pragma unroll
              for (int e = 0; e < 8; ++e) { const float yp = __shfl_xor(y[e], 2); o[e] = (h16)((L & 2) ? (y[e] * cs[e] + yp * sn[e]) : (y[e] * cs[e] - yp * sn[e])); }
              *(h16x8*)(Qh + (size_t)r * 512 + lane * 8) = o; }
            { float y[8], ss = 0.f;
#pragma unroll
              for (int e = 0; e < 8; ++e) { y[e] = (float)kv[q][e]; ss += y[e] * y[e]; }
              ss += __shfl_xor(ss, 1); ss += __shfl_xor(ss, 2); ss += __shfl_xor(ss, 4);
              const float rs = rsqrtf(ss * (1.0f / 64.0f) + 1e-6f); h16x8 o;
#pragma unroll
              for (int e = 0; e < 8; ++e) { y[e] *= rs * kn[e]; }
#pragma unroll
              for (int e = 0; e < 8; ++e) { const float yp = __shfl_xor(y[e], 2); o[e] = (h16)((L & 2) ? (y[e] * cs[e] + yp * sn[e]) : (y[e] * cs[e] - yp * sn[e])); }
              if (lane < 16) *(h16x8*)(Kh + krow * 128 + lane * 8) = o;
              else if (lane < 32) *(h16x8*)(Vh + krow * 128 + (lane - 16) * 8) = kv[q]; }
        }
    }
}
template <int W> __device__ __forceinline__ void pool_slice(const h16* Z, h16* A, int s0, int len, int p0, int col) {
    constexpr int NR = 8 + W - 1;
    h16x8 v[NR];
#pragma unroll
    for (int i = 0; i < NR; ++i) { const int pos = p0 - W / 2 + i; h16x8 z8 = {0, 0, 0, 0, 0, 0, 0, 0}; if (pos >= 0 && pos < len) z8 = *(const h16x8*)(Z + (size_t)(s0 + pos) * ZW + ZP + col); v[i] = z8; }
#pragma unroll
    for (int tt = 0; tt < 8; ++tt) {
        const int lo = p0 + tt - W / 2, a = lo < 0 ? 0 : lo, e = (lo + W) > len ? len : (lo + W); const float icnt = 1.0f / (float)(e - a);
        h16x8 o;
#pragma unroll
        for (int j = 0; j < 8; ++j) { float s = 0.f;
#pragma unroll
            for (int i = 0; i < W; ++i) s += (float)v[tt + i][j];
            o[j] = (h16)(s * icnt - (float)v[tt + W / 2][j]); }
        *(h16x8*)(A + (size_t)(s0 + p0 + tt) * AW + AY0 + col) = o;
    }
}
__device__ __forceinline__ void pool_block(const Params& p, int r0) {
    const h16* Z = WSP(h16, OFF_Z); h16* A = WSP(h16, OFF_A);
    const int tid = threadIdx.x, lane = tid & 63, wv = __builtin_amdgcn_readfirstlane(tid >> 6), g = wv & 3;
    const int col = g * 128 + (lane & 15) * 8, ts = (wv >> 2) * 4 + (lane >> 4);
    int s0, len, pos; row_seq(r0, s0, len, pos);
    const int p0 = pos + ts * 8;
    if (g == 0) pool_slice<2>(Z, A, s0, len, p0, col);
    else if (g == 1) pool_slice<4>(Z, A, s0, len, p0, col);
    else if (g == 2) pool_slice<8>(Z, A, s0, len, p0, col);
    else pool_slice<16>(Z, A, s0, len, p0, col);
}
__device__ __forceinline__ void ph_ln(const Params& p, char* shm, int mode, int r_begin, const float* __restrict__ gam, const float* __restrict__ bet, int lm, int sh, int sc, const h16* __restrict__ Yb, bool from_input, int G, int c) {
    float* X = WSP(float, OFF_X); h16* A = WSP(h16, OFF_A); const float* mod = WSP(float, OFF_MOD) + (size_t)lm * 9 * 6144;
    const int lane = threadIdx.x & 63, wv = threadIdx.x >> 6;
    int* lcnt = (int*)shm; int* lbase = lcnt + 8; int* lrank = lcnt + 16;
    float* rtT = (float*)(shm + 4096);
    if (mode == 1) { __syncthreads(); if (threadIdx.x < 8) lcnt[threadIdx.x] = 0;
        for (int i = threadIdx.x; i < 8192; i += NTH) rtT[(i & 7) * 1024 + (i >> 3)] = p.moe_router[i];
        __syncthreads(); }
    int trip = 0;
    for (int r0 = r_begin + c * 16 + wv * 2; r0 < MT; r0 += G * 16, ++trip) {
        float v[2][16];
#pragma unroll
        for (int q = 0; q < 2; ++q) { const float* xr = from_input ? xin_row(p, r0 + q) : X + (size_t)(r0 + q) * D;
#pragma unroll
            for (int i = 0; i < 4; ++i) { const float4 t = *(const float4*)(xr + i * 256 + lane * 4); v[q][i * 4] = t.x; v[q][i * 4 + 1] = t.y; v[q][i * 4 + 2] = t.z; v[q][i * 4 + 3] = t.w; } }
        if (mode != 2) {
            h16x4 ya[2][4];
#pragma unroll
            for (int q = 0; q < 2; ++q)
#pragma unroll
                for (int i = 0; i < 4; ++i) ya[q][i] = *(const h16x4*)(Yb + (size_t)(r0 + q) * D + i * 256 + lane * 4);
#pragma unroll
            for (int q = 0; q < 2; ++q)
#pragma unroll
                for (int i = 0; i < 4; ++i)
#pragma unroll
                    for (int j = 0; j < 4; ++j) v[q][i * 4 + j] = ALPHA * v[q][i * 4 + j] + (float)ya[q][i][j];
        }
        if (mode == 2) {
#pragma unroll
            for (int q = 0; q < 2; ++q) { const int t = r0 + q - MC, g = row_group(r0 + q); const float* m5 = WSP(float, OFF_MOD) + (size_t)(1 * 9 + g) * 6144 + 5 * 1024;
                float add[16];
#pragma unroll
                for (int i = 0; i < 16; ++i) add[i] = 0.f;
#pragma unroll
                for (int k2 = 0; k2 < 2; ++k2) {
                    const int pos = WSP(int, OFF_TOKR)[t * 2 + k2];
                    if (pos < 65536) { const h16* o = WSP(h16, OFF_OUT2) + ((size_t)k2 * ML + t) * 1024;
#pragma unroll
                        for (int i = 0; i < 4; ++i) { const h16x4 a = *(const h16x4*)(o + i * 256 + lane * 4);
#pragma unroll
                            for (int j = 0; j < 4; ++j) add[i * 4 + j] += (float)a[j]; } }
                    else {
#pragma unroll
                        for (int kq = 0; kq < 4; ++kq) { const h16* o = WSP(h16, OFF_OUTP) + ((size_t)kq * 2048 + (pos - 65536)) * 1024;
#pragma unroll
                            for (int i = 0; i < 4; ++i) { const h16x4 a = *(const h16x4*)(o + i * 256 + lane * 4);
#pragma unroll
                                for (int j = 0; j < 4; ++j) add[i * 4 + j] += (float)a[j]; } } }
                }
#pragma unroll
                for (int i = 0; i < 4; ++i) { const float4 mm = *(const float4*)(m5 + i * 256 + lane * 4); const float mv[4] = {mm.x, mm.y, mm.z, mm.w};
#pragma unroll
                    for (int j = 0; j < 4; ++j) v[q][i * 4 + j] = ALPHA * v[q][i * 4 + j] + mv[j] * add[i * 4 + j]; } }
        }
#pragma unroll
        for (int q = 0; q < 2; ++q) {
            const int r = r0 + q, g = row_group(r);
            float s = 0.f;
#pragma unroll
            for (int i = 0; i < 16; ++i) s += v[q][i];
#pragma unroll
            for (int o = 32; o >= 1; o >>= 1) s += __shfl_xor(s, o);
            const float mean = s * (1.0f / 1024.0f); float qq = 0.f;
#pragma unroll
            for (int i = 0; i < 16; ++i) { const float dlt = v[q][i] - mean; qq += dlt * dlt; }
#pragma unroll
            for (int o = 32; o >= 1; o >>= 1) qq += __shfl_xor(qq, o);
            const float rstd = rsqrtf(qq * (1.0f / 1024.0f) + 1e-5f);
            float lg8[8];
#pragma unroll
            for (int e = 0; e < 8; ++e) lg8[e] = 0.f;
#pragma unroll
            for (int i = 0; i < 4; ++i) {
                const int d = i * 256 + lane * 4; const float4 gg = *(const float4*)(gam + d), bb = *(const float4*)(bet + d);
                const float gv[4] = {gg.x, gg.y, gg.z, gg.w}, bv[4] = {bb.x, bb.y, bb.z, bb.w}; float y[4];
#pragma unroll
                for (int j = 0; j < 4; ++j) y[j] = (v[q][i * 4 + j] - mean) * rstd * gv[j] + bv[j];
                if (mode == 2) { *(float4*)(p.out + (size_t)(r - MC) * D + d) = make_float4(y[0], y[1], y[2], y[3]); continue; }
                *(float4*)(X + (size_t)r * D + d) = make_float4(y[0], y[1], y[2], y[3]);
                const float4 ms = *(const float4*)(mod + (size_t)g * 6144 + sh * 1024 + d), mc = *(const float4*)(mod + (size_t)g * 6144 + sc * 1024 + d);
                const float msv[4] = {ms.x, ms.y, ms.z, ms.w}, mcv[4] = {mc.x, mc.y, mc.z, mc.w}; float hh[4]; h16x4 ho;
#pragma unroll
                for (int j = 0; j < 4; ++j) { hh[j] = y[j] * (1.f + mcv[j]) + msv[j]; ho[j] = (h16)hh[j]; }
                *(h16x4*)(A + (size_t)r * AW + AH + d) = ho;
                if (mode == 1) {
#pragma unroll
                    for (int e = 0; e < 8; ++e) { const float4 w = *(const float4*)(rtT + e * 1024 + d); lg8[e] += hh[0] * w.x + hh[1] * w.y + hh[2] * w.z + hh[3] * w.w; if (e & 1) asm volatile("" ::: "memory"); }
                }
            }
            if (mode == 1) {
                float v4[4], v2[2], v1;
#pragma unroll
                for (int i = 0; i < 4; ++i) { const float a = lg8[i], b = lg8[i + 4]; const float snd = (lane & 32) ? a : b, kp = (lane & 32) ? b : a; v4[i] = kp + __shfl_xor(snd, 32); }
#pragma unroll
                for (int i = 0; i < 2; ++i) { const float a = v4[i], b = v4[i + 2]; const float snd = (lane & 16) ? a : b, kp = (lane & 16) ? b : a; v2[i] = kp + __shfl_xor(snd, 16); }
                { const float a = v2[0], b = v2[1]; const float snd = (lane & 8) ? a : b, kp = (lane & 8) ? b : a; v1 = kp + __shfl_xor(snd, 8); }
                v1 += __shfl_xor(v1, 4); v1 += __shfl_xor(v1, 2); v1 += __shfl_xor(v1, 1);
#pragma unroll
                for (int e = 0; e < 8; ++e) lg8[e] = __shfl(v1, (e >> 2) * 32 + ((e >> 1) & 1) * 16 + (e & 1) * 8) + p.moe_router_b[e];
                if (lane == 0) {
                    int i0 = 0; float v0 = lg8[0];
#pragma unroll
                    for (int e = 1; e < 8; ++e) if (lg8[e] > v0) { v0 = lg8[e]; i0 = e; }
                    int i1 = -1; float v1 = -INFINITY;
#pragma unroll
                    for (int e = 0; e < 8; ++e) if (e != i0 && lg8[e] > v1) { v1 = lg8[e]; i1 = e; }
                    const float p1 = 1.0f / (1.0f + expf(v0 - v1)), p0 = 1.0f - p1;
                    const int t = r - MC, li = trip * 16 + wv * 2 + q;
                    const int k0 = atomicAdd(&lcnt[i0], 1), k1 = atomicAdd(&lcnt[i1], 1);
                    WSP(int, OFF_TOKE)[t * 2] = i0; WSP(int, OFF_TOKE)[t * 2 + 1] = i1; WSP(float, OFF_TOKP)[t * 2] = p0; WSP(float, OFF_TOKP)[t * 2 + 1] = p1;
                    lrank[li * 4] = i0; lrank[li * 4 + 1] = k0; lrank[li * 4 + 2] = i1; lrank[li * 4 + 3] = k1;
                }
            }
        }
    }
    if (mode == 1) {
        __syncthreads();
        if (threadIdx.x < 8) lbase[threadIdx.x] = atomicAdd(WSP(int, OFF_CNT) + threadIdx.x, lcnt[threadIdx.x]);
        __syncthreads();
        for (int li = threadIdx.x; li < trip * 16; li += NTH) {
            const int r = r_begin + c * 16 + (li & 15) + (li >> 4) * G * 16; if (r >= MT) continue;
            const int t = r - MC;
            WSP(int, OFF_TOKR)[t * 2] = lbase[lrank[li * 4]] + lrank[li * 4 + 1]; WSP(int, OFF_TOKR)[t * 2 + 1] = lbase[lrank[li * 4 + 2]] + lrank[li * 4 + 3];
        }
    }
}
__device__ __forceinline__ void ph_moe_gather(const Params& p, char* shm, int G, int c) {
    int* sp = (int*)shm; int* plan = WSP(int, OFF_PLAN); const int* cnt = WSP(int, OFF_CNT); int* rowT = WSP(int, OFF_ROWT);
    const int tid = threadIdx.x;
    __syncthreads();
    if (tid == 0) { int acc = 0; for (int e = 0; e < 8; ++e) { sp[e] = acc; const int np = (cnt[e] + 255) / 256; if (c == 0) { plan[e] = acc; for (int q = 0; q < np; ++q) plan[16 + acc / 256 + q] = e; } acc += np * 256; } sp[8] = acc; if (c == 0) plan[8] = acc / 256; }
    __syncthreads();
    if (c == 0) for (int e = 0; e < 8; ++e) { const int a = sp[e] + cnt[e], b = sp[e + 1]; for (int i = a + tid; i < b; i += NTH) rowT[i] = -1; }
    const h16* A = WSP(h16, OFF_A); h16* Xg = WSP(h16, OFF_XG);
    const int lane = tid & 63, wv = tid >> 6;
    for (int it0 = (c * 8 + wv) * 4; it0 < ML * 2; it0 += G * 32) {
        h16x8 v0[4], v1[4]; int pos[4];
#pragma unroll
        for (int q = 0; q < 4; ++q) { const int it = it0 + q, t = it >> 1; pos[q] = sp[WSP(int, OFF_TOKE)[it]] + WSP(int, OFF_TOKR)[it];
            const h16* src = A + (size_t)(MC + t) * AW + AH; v0[q] = *(const h16x8*)(src + lane * 8); v1[q] = *(const h16x8*)(src + 512 + lane * 8); }
#pragma unroll
        for (int q = 0; q < 4; ++q) { h16* dst = Xg + (size_t)pos[q] * 1024; *(h16x8*)(dst + lane * 8) = v0[q]; *(h16x8*)(dst + 512 + lane * 8) = v1[q];
            if (lane == 0) { WSP(int, OFF_ROWT)[pos[q]] = it0 + q; WSP(float, OFF_ROWP)[pos[q]] = WSP(float, OFF_TOKP)[it0 + q]; WSP(int, OFF_TOKR)[it0 + q] = pos[q]; } }
    }
}

typedef float f32x16 __attribute__((ext_vector_type(16)));
constexpr int XCP = 520;
constexpr int LRU_XC = 0, LRU_LG = 64 * XCP * 2, LRU_CIN = 2 * 64 * XCP * 2;
__device__ __forceinline__ void lru_wt_prep(const Params& p, int G, int c) {
    h16* WT = WSP(h16, OFF_LRUWT);
    for (int u = c; u < 64; u += G) {
        const int blk = u & 7, gate = (u >> 3) & 1, ld = u >> 4;
        const float* W = (gate ? p.lru_wx : p.lru_wa) + ((size_t)ld * 8 + blk) * 4096;
        for (int o = threadIdx.x; o < 4096; o += NTH) { const int j = o >> 6, i = o & 63; WT[(size_t)u * 4096 + o] = (h16)W[i * 64 + j]; }
    }
}
template <int PASS> __device__ __forceinline__ void lru_unit(const Params& p, char* shm, int l, int b, int k) {
    const int tid = threadIdx.x, lane = tid & 63, h = __builtin_amdgcn_readfirstlane(tid >> 6), n = lane & 31, hi = lane >> 5;
    const h16* Z = WSP(h16, OFF_Z);
    const bool isctx = k < 4; const int s0 = isctx ? b * CTX : MC + b * SEQ, len = isctx ? CTX : SEQ, t0 = isctx ? k * 64 : (k - 4) * 64, row0 = s0 + t0;
    h16* xcs = (h16*)(shm + LRU_XC); h16* lgs = (h16*)(shm + LRU_LG); float* cins = (float*)(shm + LRU_CIN);
    const int uidx = b * 68 + k; char* lau_base = uidx < 512 ? (char*)p.out + (size_t)uidx * 262144 : p.ws + OFF_LAU_TAIL + (size_t)(uidx - 512) * 262144;
    __syncthreads();
    {
        const int cg = tid & 63, ts = tid >> 6, ch0 = cg * 8;
        if (PASS == 1) {
        float cw[4][8], cb[8];
#pragma unroll
        for (int q = 0; q < 4; ++q) { const float4 a = *(const float4*)(p.conv_w + (size_t)(l * 4 + q) * 512 + ch0), b2 = *(const float4*)(p.conv_w + (size_t)(l * 4 + q) * 512 + ch0 + 4);
            cw[q][0] = a.x; cw[q][1] = a.y; cw[q][2] = a.z; cw[q][3] = a.w; cw[q][4] = b2.x; cw[q][5] = b2.y; cw[q][6] = b2.z; cw[q][7] = b2.w; }
        { const float4 a = *(const float4*)(p.conv_b + l * 512 + ch0), b2 = *(const float4*)(p.conv_b + l * 512 + ch0 + 4); cb[0] = a.x; cb[1] = a.y; cb[2] = a.z; cb[3] = a.w; cb[4] = b2.x; cb[5] = b2.y; cb[6] = b2.z; cb[7] = b2.w; }
        h16x8 v[11];
#pragma unroll
        for (int i = 0; i < 11; ++i) { const int pos = t0 + ts * 8 - 2 + i; const bool ok = pos >= 0 && pos < len;
            h16x8 z8 = {0, 0, 0, 0, 0, 0, 0, 0}; if (ok) z8 = *(const h16x8*)(Z + (size_t)(s0 + pos) * ZW + ZLX + ch0); v[i] = z8; }
#pragma unroll
        for (int tt = 0; tt < 8; ++tt) { h16x8 o;
#pragma unroll
            for (int j = 0; j < 8; ++j) { float acc = cb[j];
#pragma unroll
                for (int q = 0; q < 4; ++q) acc += cw[q][j] * (float)v[tt + q][j];
                o[j] = (h16)acc; }
            *(h16x8*)(xcs + (ts * 8 + tt) * XCP + ch0) = o; }
        }
        if (PASS == 3) {
#pragma unroll
            for (int tt = 0; tt < 8; ++tt) *(h16x8*)(lgs + (ts * 8 + tt) * XCP + ch0) = *(const h16x8*)(Z + (size_t)(row0 + ts * 8 + tt) * ZW + ZLG + ch0);
            const float* P0 = WSP(float, OFF_LRUP) + (size_t)(b * 2 + 0) * 68 * 512 + tid; const float* H0 = WSP(float, OFF_LRUH) + (size_t)(b * 2 + 0) * 68 * 512 + tid;
            float S = 0.f;
            for (int j0 = 0; j0 < k; j0 += 8) { float pp[8], hh[8];
#pragma unroll
                for (int q = 0; q < 8; ++q) { const int j = j0 + q < k ? j0 + q : 0; pp[q] = P0[(size_t)j * 512]; hh[q] = H0[(size_t)j * 512]; }
#pragma unroll
                for (int q = 0; q < 8; ++q) if (j0 + q < k) S = pp[q] * S + hh[q]; }
            cins[tid] = S;
            const float* P1 = P0 + (size_t)68 * 512; const float* H1 = H0 + (size_t)68 * 512;
            const int nb = isctx ? 3 - k : 71 - k;
            S = 0.f;
            for (int s0_ = 0; s0_ < nb; s0_ += 8) { float pp[8], hh[8];
#pragma unroll
                for (int q = 0; q < 8; ++q) { const int s = s0_ + q < nb ? s0_ + q : 0; const int j = s < 4 ? 3 - s : 71 - s; pp[q] = P1[(size_t)j * 512]; hh[q] = H1[(size_t)j * 512]; }
#pragma unroll
                for (int q = 0; q < 8; ++q) if (s0_ + q < nb) S = pp[q] * S + hh[q]; }
            cins[512 + tid] = S;
        }
    }
    __syncthreads();
    const h16* WT = WSP(h16, OFF_LRUWT) + (size_t)l * 4 * 8 * 4096;
#define LMFMA(a, b, c) __builtin_amdgcn_mfma_f32_32x32x16_f16(a, b, c, 0, 0, 0)
#pragma unroll 1
    for (int ct = 0; ct < 2; ++ct) {
        const int cbase = h * 64 + ct * 32, ch = cbase + n;
        f32x16 xD[2], gD[2], hs[2];
#pragma unroll
        for (int rt = 0; rt < 2; ++rt) { xD[rt] = f32x16{}; gD[rt] = f32x16{}; hs[rt] = f32x16{}; }
        if (PASS == 1) {
#pragma unroll
        for (int s = 0; s < 2; ++s) { h16x8 id;
#pragma unroll
            for (int j = 0; j < 8; ++j) id[j] = (n == s * 16 + hi * 8 + j) ? (h16)1.0f : (h16)0.0f;
#pragma unroll
            for (int rt = 0; rt < 2; ++rt) { const h16x8 a = *(const h16x8*)(xcs + (rt * 32 + n) * XCP + cbase + s * 16 + hi * 8); xD[rt] = LMFMA(a, id, xD[rt]); } }
        }
#pragma unroll
        for (int dir = 0; dir < 2; ++dir) {
            f32x16 R[2], I[2];
            unsigned w32[32];
            u32x4* lau = (u32x4*)(lau_base + ((size_t)(h * 4 + ct * 2 + dir)) * 8192 + lane * 16);
            if (PASS == 1) {
#pragma unroll
                for (int rt = 0; rt < 2; ++rt) { R[rt] = f32x16{}; I[rt] = f32x16{}; }
                const h16* wa = WT + ((size_t)(dir * 2 + 0) * 8 + h) * 4096 + (ct * 32 + n) * 64 + hi * 8;
                const h16* wx = WT + ((size_t)(dir * 2 + 1) * 8 + h) * 4096 + (ct * 32 + n) * 64 + hi * 8;
#pragma unroll
                for (int ks = 0; ks < 4; ++ks) { const h16x8 ba8 = *(const h16x8*)(wa + ks * 16), bx8 = *(const h16x8*)(wx + ks * 16);
#pragma unroll
                    for (int rt = 0; rt < 2; ++rt) { const h16x8 a = *(const h16x8*)(xcs + (rt * 32 + n) * XCP + h * 64 + ks * 16 + hi * 8); R[rt] = LMFMA(a, ba8, R[rt]); I[rt] = LMFMA(a, bx8, I[rt]); } }
                const int pi = (l * 2 + dir) * 512 + ch;
                const float ba = p.lru_ba[pi], bx = p.lru_bx[pi], spl = log1pf(__expf(-p.lru_lambda[pi])) * (-8.0f * 1.4426950408889634f);
#pragma unroll
                for (int rt = 0; rt < 2; ++rt)
#pragma unroll
                    for (int r = 0; r < 16; ++r) { const float rg = sigmoidf_(R[rt][r] + ba), ig = sigmoidf_(I[rt][r] + bx);
                        const float la2 = rg * spl, a = __builtin_amdgcn_exp2f(la2), uu = __builtin_amdgcn_sqrtf(fmaxf(1.0f - a * a, 0.f)) * ig * xD[rt][r];
                        w32[rt * 16 + r] = pg8::cvt_pk_f16(la2, uu); }
#pragma unroll
                for (int j = 0; j < 8; ++j) { u32x4 t; t.x = w32[4 * j]; t.y = w32[4 * j + 1]; t.z = w32[4 * j + 2]; t.w = w32[4 * j + 3]; lau[j * 64] = t; }
            } else {
#pragma unroll
                for (int j = 0; j < 8; ++j) { const u32x4 t = lau[j * 64]; w32[4 * j] = t.x; w32[4 * j + 1] = t.y; w32[4 * j + 2] = t.z; w32[4 * j + 3] = t.w; }
            }
#pragma unroll
            for (int rt = 0; rt < 2; ++rt)
#pragma unroll
                for (int r = 0; r < 16; ++r) { const h16x2 pr = __builtin_bit_cast(h16x2, w32[rt * 16 + r]); R[rt][r] = __builtin_amdgcn_exp2f((float)pr[0]); I[rt][r] = (float)pr[1]; }
            float Pg[8], Hg[8], Po[8], Ho[8];
#pragma unroll
            for (int q = 0; q < 8; ++q) { const int rt = q >> 2, r0 = (q & 3) * 4; float P = 1.f, H = 0.f;
#pragma unroll
                for (int i = 0; i < 4; ++i) { const int r = r0 + (dir ? 3 - i : i); P *= R[rt][r]; H = R[rt][r] * H + I[rt][r]; }
                Pg[q] = P; Hg[q] = H; }
#pragma unroll
            for (int q = 0; q < 8; ++q) {
                const auto rp = __builtin_amdgcn_permlane32_swap(__float_as_uint(Pg[q]), __float_as_uint(Pg[q]), false, false); Po[q] = __uint_as_float(hi ? rp[0] : rp[1]);
                const auto rh = __builtin_amdgcn_permlane32_swap(__float_as_uint(Hg[q]), __float_as_uint(Hg[q]), false, false); Ho[q] = __uint_as_float(hi ? rh[0] : rh[1]); }
            float S = (PASS == 3) ? cins[dir * 512 + ch] : 0.f, Pt = 1.f; float cg[8];
#pragma unroll
            for (int s2 = 0; s2 < 16; ++s2) { const int Gi = dir ? 15 - s2 : s2, q = Gi >> 1, own = Gi & 1;
                const float Pq = (hi == own) ? Pg[q] : Po[q], Hq = (hi == own) ? Hg[q] : Ho[q];
                if (hi == own) cg[q] = S;
                S = Pq * S + Hq; Pt *= Pq; }
            if (PASS == 1) { if (hi == 0) { WSP(float, OFF_LRUP)[((size_t)(b * 2 + dir) * 68 + k) * 512 + ch] = Pt; WSP(float, OFF_LRUH)[((size_t)(b * 2 + dir) * 68 + k) * 512 + ch] = S; } }
            else {
#pragma unroll
                for (int q = 0; q < 8; ++q) { const int rt = q >> 2, r0 = (q & 3) * 4; float hh = cg[q];
#pragma unroll
                    for (int i = 0; i < 4; ++i) { const int r = r0 + (dir ? 3 - i : i); hh = R[rt][r] * hh + I[rt][r]; hs[rt][r] += hh; } }
            }
        }
        if (PASS == 3) {
#pragma unroll
            for (int s = 0; s < 2; ++s) { h16x8 id;
#pragma unroll
                for (int j = 0; j < 8; ++j) id[j] = (n == s * 16 + hi * 8 + j) ? (h16)1.0f : (h16)0.0f;
#pragma unroll
                for (int rt = 0; rt < 2; ++rt) { const h16x8 a2 = *(const h16x8*)(lgs + (rt * 32 + n) * XCP + cbase + s * 16 + hi * 8); gD[rt] = LMFMA(a2, id, gD[rt]); } }
#pragma unroll
            for (int rt = 0; rt < 2; ++rt)
#pragma unroll
                for (int r = 0; r < 16; ++r) { const float x = gD[rt][r]; const float u2 = 1.5957691216057308f * (x + 0.044715f * x * x * x);
                    lgs[(rt * 32 + (r & 3) + 8 * (r >> 2) + 4 * hi) * XCP + ch] = (h16)(hs[rt][r] * x * sigmoidf_(u2)); }
        }
    }
#undef LMFMA
    if (PASS == 3) {
        __syncthreads();
        h16* A = WSP(h16, OFF_A); const int cg = tid & 63, ts = tid >> 6, ch0 = cg * 8;
#pragma unroll
        for (int tt = 0; tt < 8; ++tt) *(h16x8*)(A + (size_t)(row0 + ts * 8 + tt) * AW + AY2 + ch0) = *(const h16x8*)(lgs + (ts * 8 + tt) * XCP + ch0);
    }
}
template <int PASS> __device__ __forceinline__ void ph_lru(const Params& p, char* shm, int l, int G, int c) {
    int* head = WSP(int, OFF_CNT) + 16 + l * 2 + (PASS == 3 ? 1 : 0); volatile int* slot = (volatile int*)(shm + 138240);
    for (;;) {
        __syncthreads();
        if (threadIdx.x == 0) *slot = atomicAdd(head, 1);
        __syncthreads();
        const int u = *slot; if (u >= NB * 68) break;
        lru_unit<PASS>(p, shm, l, u / 68, u % 68);
    }
}

__device__ __forceinline__ void ph_thin(const Params& p, char* shm, int l, int rb, int G, int c) {
    int* head = WSP(int, OFF_CNT) + 16 + l * 2; volatile int* slot = (volatile int*)(shm + 138240);
    const int NL = NB * 68, NQ = MT / 64, NP = (MT - rb) / 64;
    __syncthreads();
    rope_table(shm);
    for (;;) {
        __syncthreads();
        if (threadIdx.x == 0) *slot = atomicAdd(head, 1);
        __syncthreads();
        const int u = *slot; if (u >= NL + NQ + NP) break;
        if (u < NL) lru_unit<1>(p, shm, l, u / 68, u % 68);
        else if (u < NL + NQ) qkv_block(p, shm, l, (u - NL) * 64);
        else pool_block(p, rb + (u - NL - NQ) * 64);
    }
}

constexpr int XB_LDS_OFF = LDS_BYTES - 16;
__global__ void __launch_bounds__(512, 2) k_mega(Params p, int lo, int hi) {
    extern __shared__ __attribute__((aligned(16))) unsigned char shm[];
    LAS unsigned char* lds = (LAS unsigned char*)shm;
    const int G = gridDim.x, c = blockIdx.x;
    if (threadIdx.x == 0) { *(uint4*)(shm + XB_LDS_OFF) = make_uint4(0u, 0u, 0u, 0u); *(uint4*)(shm + 147424) = make_uint4(0u, 0u, 0u, 0u); }
    __syncthreads();
    XcdBarrier bar = xcd_barrier_post(WSP(unsigned, OFF_BAR), (volatile LAS unsigned*)(lds + XB_LDS_OFF));
    int ph = 0;
#ifndef REP_MASK
#define REP_MASK 0
#endif
#define REP(bit, call) do { call; if (REP_MASK & (bit)) { __syncthreads(); call; } } while (0)
#ifndef PROBE_MASK
#define PROBE_MASK 0u
#endif
    unsigned long long t_acc = 0ull, t_0 = 0ull;
#define PHASE(body) do { if (ph >= lo && ph < hi) { const bool pr_ = ((PROBE_MASK >> ph) & 1u) != 0u; if (pr_) t_0 = __builtin_amdgcn_s_memrealtime(); \
        body; if (ph + 1 < hi) { xcd_barrier(bar); if (REP_MASK & 8) xcd_barrier(bar); } if (pr_) t_acc += __builtin_amdgcn_s_memrealtime() - t_0; } ++ph; } while (0)
    PHASE(REP(4, ph_prologue(p, (char*)shm, G, c)));
    PHASE(REP(4, ph_h0(p, (char*)shm, G, c)));
#define LAYER(l) do { \
        const int rb = (l) == 0 ? 0 : MC; \
        const float* ln1g = p.ln1_g + (l) * D; const float* ln1b = p.ln1_b + (l) * D; const float* ln2g = p.ln2_g + (l) * D; const float* ln2b = p.ln2_b + (l) * D; \
        PHASE(REP(1, ph_gemm_in(p, lds, (l), G, c))); \
        PHASE(ph_thin(p, (char*)shm, (l), rb, G, c)); \
        PHASE(REP(512, ph_attn(p, (char*)shm, (l), G, c)); REP(256, ph_lru<3>(p, (char*)shm, (l), G, c))); \
        PHASE(REP(1, ph_merge(p, lds, (l), G, c))); \
        PHASE(ph_wout(p, lds, (l), G, c)); \
        if ((l) == 0) { \
            PHASE(ph_ln(p, (char*)shm, 0, rb, ln1g, ln1b, 0, 3, 4, YW_base(p, 0), true, G, c)); \
            PHASE(REP(1, ph_ffn_gu(p, lds, G, c))); \
            PHASE(ph_ffn_down(p, lds, G, c)); \
            PHASE(ph_ln(p, (char*)shm, 0, 0, ln2g, ln2b, 1, 0, 1, (const h16*)p.out, false, G, c)); \
        } else { \
            PHASE(ph_ln(p, (char*)shm, 1, rb, ln1g, ln1b, 1, 3, 4, YW_base(p, 1), false, G, c); REP(16, cvt_jobs(p, NJOBS_SMALL, NJOBS_ALL, 0, G, c, (float (*)[129])shm))); \
            PHASE(REP(16, ph_moe_gather(p, (char*)shm, G, c))); \
            for (int chn = 0; chn < 5; ++chn) { \
                PHASE(REP(1, ph_moe_gu(p, lds, chn * 64, G, c))); \
                PHASE(REP(1, ph_moe_down(p, lds, chn * 64, G, c))); \
            } \
            PHASE(ph_ln(p, (char*)shm, 2, MC, ln2g, ln2b, 1, 0, 1, (const h16*)0, false, G, c)); \
        } } while (0)
    LAYER(0);
    LAYER(1);
#undef LAYER
    if (PROBE_EPI != 0) { t_acc = ((LAS unsigned long long*)(lds + 147424))[0]; }
    if ((PROBE_MASK != 0u || PROBE_EPI != 0) && blockIdx.x == 0 && threadIdx.x == 0) { const unsigned long long t_e = __builtin_amdgcn_s_memrealtime(); while (__builtin_amdgcn_s_memrealtime() - t_e < 3ull * t_acc) __builtin_amdgcn_s_sleep(8); }
#undef PHASE
}
constexpr int NPHASES = 2 + 9 + (5 + 2 + 10 + 1);

#ifndef MEGA_LAUNCHES
#define MEGA_LAUNCHES 1
#endif
extern "C" void kernel_launch(void* const* d_in, const int* in_sizes, int n_in, void* d_out, int out_size, void* d_ws, size_t ws_size, hipStream_t stream) {
    (void)in_sizes; (void)n_in; (void)out_size;
    if (ws_size < WS_NEED) return;
    Params p;
    const float** pp = (const float**)&p;
    for (int i = 0; i < 33; ++i) pp[i] = (const float*)d_in[i];
    p.out = (float*)d_out; p.ws = (char*)d_ws;
    static int grid = 0;
    if (!grid) {
        int dev = 0, cus = 0, per_cu = 0;
        hipGetDevice(&dev);
        hipDeviceGetAttribute(&cus, hipDeviceAttributeMultiprocessorCount, dev);
        hipFuncSetAttribute((const void*)k_mega, hipFuncAttributeMaxDynamicSharedMemorySize, LDS_BYTES);
        hipOccupancyMaxActiveBlocksPerMultiprocessor(&per_cu, (const void*)k_mega, 512, LDS_BYTES);
        grid = (per_cu >= 1 && cus > 0) ? cus : -1;
    }
    if (grid <= 0) return;
    hipMemsetAsync(p.ws + OFF_BAR, 0, XCD_BAR_WORDS * sizeof(unsigned), stream);
#if MEGA_LAUNCHES == 1
    k_mega<<<grid, 512, LDS_BYTES, stream>>>(p, 0, NPHASES);
#else
    for (int ph = 0; ph < NPHASES; ++ph) k_mega<<<grid, 512, LDS_BYTES, stream>>>(p, ph, ph + 1);
#endif
}
```

```cpp
#include <hip/hip_runtime.h>
#include <stdint.h>
#include <stddef.h>

#ifndef PROBE_EPI
#define PROBE_EPI 0
#endif
typedef _Float16 h16;
typedef _Float16 h16x2 __attribute__((ext_vector_type(2)));
typedef _Float16 h16x4 __attribute__((ext_vector_type(4)));
typedef _Float16 h16x8 __attribute__((ext_vector_type(8)));

constexpr int D = 1024, NB = 8, SEQ = 4096, CTX = 256, SB = CTX + SEQ;
constexpr int MC = NB * CTX, ML = NB * SEQ, MT = MC + ML;
constexpr int WIN = 5376, ZW = 2304, AW = 2560;
constexpr int DFF = 2816, NE = 8, DEX = 3584;
constexpr int PMAX = 264 * 256;
constexpr float ALPHA = 1.41421356237309515f;
constexpr float WGU_F8_SCALE = 32.0f;
constexpr float WD_F8_SCALE = 128.0f;
constexpr float QSCALE = 0.125f * 1.4426950408889634f;
constexpr int ZP = 0, ZQ = 512, ZK = 1024, ZV = 1152, ZLX = 1280, ZLG = 1792;
constexpr int AH = 0, AY0 = 1024, AY1 = 1536, AY2 = 2048;

constexpr size_t al256(size_t x) { return (x + 255) & ~(size_t)255; }
constexpr size_t OFF_BAR = 0;
constexpr size_t OFF_MOD = 16384;
constexpr size_t OFF_CNT = OFF_MOD + al256((size_t)2 * 9 * 6144 * 4);
constexpr size_t OFF_PLAN = OFF_CNT + 256;
constexpr size_t OFF_TOKE = OFF_PLAN + 2048;
constexpr size_t OFF_TOKP = OFF_TOKE + (size_t)ML * 2 * 4;
constexpr size_t OFF_TOKR = OFF_TOKP + (size_t)ML * 2 * 4;
constexpr size_t OFF_ROWT = OFF_TOKR + (size_t)ML * 2 * 4;
constexpr size_t OFF_ROWP = OFF_ROWT + (size_t)PMAX * 4;
constexpr size_t OFF_LRUP = OFF_ROWP + (size_t)PMAX * 4;
constexpr size_t OFF_LRUH = OFF_LRUP + (size_t)NB * 2 * 68 * 512 * 4;
constexpr size_t OFF_LRUWT = OFF_LRUH + (size_t)NB * 2 * 68 * 512 * 4;
constexpr size_t OFF_TBL_END = OFF_LRUWT + (size_t)2 * 2 * 2 * 8 * 4096 * 2;
constexpr size_t OFF_X = (size_t)8 << 20;
constexpr size_t OFF_A = OFF_X + (size_t)MT * D * 4;
constexpr size_t OFF_BIG = OFF_A + (size_t)MT * AW * 2;
static_assert(OFF_TBL_END <= OFF_X, "tables");
constexpr size_t OFF_Z = OFF_BIG;
constexpr size_t OFF_QH = OFF_Z + (size_t)MT * ZW * 2;
constexpr size_t OFF_KH = OFF_QH + (size_t)MT * 512 * 2;
constexpr size_t OFF_VH = OFF_KH + (size_t)NB * SB * 128 * 2;
constexpr size_t OFF_W16 = OFF_VH + (size_t)NB * SB * 128 * 2;
constexpr size_t SZ_WINT = (size_t)ZW * 1024 * 2, SZ_BTALL = (size_t)3072 * 1536 * 2, SZ_WOUTT = (size_t)1024 * 1024 * 2;
constexpr size_t SZ_LAYERW = SZ_WINT + SZ_BTALL + SZ_WOUTT;
constexpr size_t OFF_WGUT = OFF_W16 + 2 * SZ_LAYERW;
constexpr size_t OFF_WDT = OFF_WGUT + (size_t)2 * DFF * 1024 * 2;
constexpr size_t OFF_W16_END = OFF_WDT + (size_t)1024 * DFF * 2;
constexpr size_t OFF_LAU_TAIL = (OFF_W16_END + 255) & ~(size_t)255;
constexpr size_t OFF_ACT = OFF_BIG;
static_assert(OFF_ACT + (size_t)MT * DFF * 2 <= OFF_W16, "ACT overlay");
constexpr size_t OFF_WMOE_GU = OFF_BIG;
constexpr size_t OFF_WMOE_D = OFF_WMOE_GU + (size_t)NE * 2 * DEX * 1024 * 2;
constexpr size_t OFF_XG = OFF_WMOE_D + (size_t)NE * 1024 * DEX * 2;
constexpr size_t WS_NEED = OFF_XG + (size_t)PMAX * 1024 * 2;
static_assert(WS_NEED <= 646673440ull, "workspace budget");
static_assert(OFF_LAU_TAIL + (size_t)32 * 262144 <= WS_NEED, "lau tail");
static_assert(OFF_W16_END <= WS_NEED, "w16");
constexpr size_t OFF_OUT2 = OFF_A;
constexpr size_t OFF_OUTP = OFF_OUT2 + (size_t)2 * ML * 1024 * 2;
static_assert(OFF_OUTP + (size_t)4 * 2048 * 1024 * 2 <= OFF_A + (size_t)MT * AW * 2, "OUT2/OUTP overlay");
static_assert((size_t)128 * 256 * DEX <= (size_t)ML * D * 4, "ACTe chunk (e4m3, 128 panels) in d_out");

constexpr size_t OFF_H8 = OFF_X + (size_t)MT * D * 2 + (size_t)MC * D * 2;
constexpr size_t OFF_WG8 = OFF_H8 + (size_t)MT * 1024;
static_assert(OFF_WG8 + (size_t)2 * 3072 * 1024 <= OFF_A, "fp8 gate operands in the X region");
constexpr size_t OFF_G8 = OFF_BIG + (size_t)MT * D * 2;
static_assert(OFF_G8 + (size_t)MT * 3072 <= OFF_KH, "gate bytes overlay");
struct Params {
    const float *x, *c, *ctx, *c_ctx, *w_mod, *b_mod, *w_in, *b_merge, *pool_w, *pool_scale, *q_norm, *k_norm, *conv_w, *conv_b,
        *lru_wa, *lru_ba, *lru_wx, *lru_bx, *lru_lambda, *w_branch, *w_out, *ln1_g, *ln1_b, *ffn_w_gate, *ffn_w_up, *ffn_w_down,
        *moe_router, *moe_router_b, *moe_w_gate, *moe_w_up, *moe_w_down, *ln2_g, *ln2_b;
    float* out;
    char* ws;
};
#define WSP(T, off) ((T*)(p.ws + (off)))

__device__ __forceinline__ int row_group(int r) { return r < MC ? 0 : 1 + ((r - MC) >> 12); }
__device__ __forceinline__ void row_seq(int r, int& s0, int& len, int& pos) {
    if (r < MC) { s0 = r & ~255; len = 256; pos = r & 255; } else { const int q = r - MC; s0 = MC + (q & ~4095); len = 4096; pos = q & 4095; }
}
__device__ __forceinline__ const float* xin_row(const Params& p, int r) { return r < MC ? p.ctx + (size_t)r * D : p.x + (size_t)(r - MC) * D; }
__device__ __forceinline__ float sigmoidf_(float x) { return __builtin_amdgcn_rcpf(1.0f + __builtin_amdgcn_exp2f(-1.4426950408889634f * x)); }
__device__ __forceinline__ float siluf_(float x) { return x * __builtin_amdgcn_rcpf(1.0f + __builtin_amdgcn_exp2f(-1.4426950408889634f * x)); }
__device__ __forceinline__ float gelu_tanh(float x) { const float u = 0.7978845608028654f * (x + 0.044715f * x * x * x); return 0.5f * x * (1.0f + tanhf(u)); }

typedef unsigned u32x2_t_ __attribute__((ext_vector_type(2)));
struct CvtJob { const float* src; int ld_src, K, N; h16* dst; int ldd, col_off, rmode; int f8; float scale; };
constexpr int NJOBS_L = 7, NJOBS_SMALL = 2 * NJOBS_L + 3, NJOBS_ALL = NJOBS_SMALL + 24;
__device__ __forceinline__ CvtJob get_job(const Params& p, int j) {
    CvtJob q; q.col_off = 0; q.rmode = 0; q.f8 = 0; q.scale = 1.f;
    if (j < 2 * NJOBS_L) {
        const int l = j / NJOBS_L, s = j % NJOBS_L;
        h16* wint = WSP(h16, OFF_W16 + l * SZ_LAYERW); h16* btall = WSP(h16, OFF_W16 + l * SZ_LAYERW + SZ_WINT); h16* woutt = WSP(h16, OFF_W16 + l * SZ_LAYERW + SZ_WINT + SZ_BTALL);
        if (s == 0) { q.src = p.w_in + (size_t)l * 1024 * WIN + 512; q.ld_src = WIN; q.K = 1024; q.N = ZW - 512; q.dst = wint + (size_t)512 * 1024; q.ldd = 1024; }
        else if (s == 1) { q.src = p.w_in + (size_t)l * 1024 * WIN + ZW; q.ld_src = WIN; q.K = 1024; q.N = 3072; q.dst = btall; q.ldd = 1536; }
        else if (s == 6) { q.src = p.w_in + (size_t)l * 1024 * WIN + ZW; q.ld_src = WIN; q.K = 1024; q.N = 3072; q.dst = (h16*)(p.ws + OFF_WG8 + (size_t)l * 3072 * 1024); q.ldd = 1024; q.f8 = 1; q.scale = WGU_F8_SCALE; }
        else if (s < 5) { const int n = s - 2; q.src = p.w_branch + (size_t)(l * 3 + n) * 512 * 1024; q.ld_src = 1024; q.K = 512; q.N = 1024; q.dst = btall + (size_t)n * 1024 * 1536; q.ldd = 1536; q.col_off = 1024; }
        else { q.src = p.w_out + (size_t)l * 1024 * 1024; q.ld_src = 1024; q.K = 1024; q.N = 1024; q.dst = woutt; q.ldd = 1024; }
    } else if (j < NJOBS_SMALL) {
        const int s = j - 2 * NJOBS_L;
        if (s == 0) { q.src = p.ffn_w_gate; q.ld_src = DFF; q.K = 1024; q.N = DFF; q.dst = WSP(h16, OFF_WGUT); q.ldd = 1024; q.rmode = 1; q.f8 = 1; q.scale = WGU_F8_SCALE; }
        else if (s == 1) { q.src = p.ffn_w_up; q.ld_src = DFF; q.K = 1024; q.N = DFF; q.dst = WSP(h16, OFF_WGUT); q.ldd = 1024; q.rmode = 2; q.f8 = 1; q.scale = WGU_F8_SCALE; }
        else { q.src = p.ffn_w_down; q.ld_src = 1024; q.K = DFF; q.N = 1024; q.dst = WSP(h16, OFF_WDT); q.ldd = DFF; q.f8 = 1; q.scale = WD_F8_SCALE; }
    } else {
        const int s = j - NJOBS_SMALL, e = s / 3, t = s % 3;
        if (t == 0) { q.src = p.moe_w_gate + (size_t)e * 1024 * DEX; q.ld_src = DEX; q.K = 1024; q.N = DEX; q.dst = (h16*)(WSP(unsigned char, OFF_WMOE_GU) + (size_t)e * 2 * DEX * 1024); q.ldd = 1024; q.rmode = 1; q.f8 = 1; q.scale = WGU_F8_SCALE; }
        else if (t == 1) { q.src = p.moe_w_up + (size_t)e * 1024 * DEX; q.ld_src = DEX; q.K = 1024; q.N = DEX; q.dst = (h16*)(WSP(unsigned char, OFF_WMOE_GU) + (size_t)e * 2 * DEX * 1024); q.ldd = 1024; q.rmode = 2; q.f8 = 1; q.scale = WGU_F8_SCALE; }
        else { q.src = p.moe_w_down + (size_t)e * DEX * 1024; q.ld_src = 1024; q.K = DEX; q.N = 1024; q.dst = (h16*)(WSP(unsigned char, OFF_WMOE_D) + (size_t)e * 1024 * DEX); q.ldd = DEX; q.f8 = 1; q.scale = WD_F8_SCALE; }
    }
    return q;
}
__device__ __forceinline__ int job_tiles(const CvtJob& q) { return (q.K / 128) * (q.N / 128); }
__device__ __forceinline__ u32x2_t_ f8pack8(const float* v) {
    float c[8];
#pragma unroll
    for (int j = 0; j < 8; ++j) c[j] = __builtin_fminf(__builtin_fmaxf(v[j], -448.f), 448.f);
    int lo = __builtin_amdgcn_cvt_pk_fp8_f32(c[0], c[1], 0, false); lo = __builtin_amdgcn_cvt_pk_fp8_f32(c[2], c[3], lo, true);
    int hi = __builtin_amdgcn_cvt_pk_fp8_f32(c[4], c[5], 0, false); hi = __builtin_amdgcn_cvt_pk_fp8_f32(c[6], c[7], hi, true);
    u32x2_t_ r; r.x = (unsigned)lo; r.y = (unsigned)hi; return r;
}
__device__ __forceinline__ int f8pack4(float a, float b, float c, float d) {
    a = __builtin_fminf(__builtin_fmaxf(a, -448.f), 448.f); b = __builtin_fminf(__builtin_fmaxf(b, -448.f), 448.f); c = __builtin_fminf(__builtin_fmaxf(c, -448.f), 448.f); d = __builtin_fminf(__builtin_fmaxf(d, -448.f), 448.f);
    int pk = __builtin_amdgcn_cvt_pk_fp8_f32(a, b, 0, false); return __builtin_amdgcn_cvt_pk_fp8_f32(c, d, pk, true);
}
__device__ __forceinline__ int cvt_rowmap(int n, int rmode) { return rmode == 0 ? n : ((n >> 7) * 256 + (n & 127) + (rmode == 2 ? 128 : 0)); }
__device__ __forceinline__ void cvt_load(const CvtJob& q, int t, float4 (&v)[8]) {
    const int nk = q.K / 128, tk = t % nk, tn = t / nk, k0 = tk * 128, n0 = tn * 128, tid = threadIdx.x;
#pragma unroll
    for (int i = 0; i < 8; ++i) v[i] = *(const float4*)(q.src + (size_t)(k0 + i * 16 + (tid >> 5)) * q.ld_src + n0 + (tid & 31) * 4);
}
__device__ __forceinline__ void cvt_store(const CvtJob& q, int t, const float4 (&v)[8], float (*tile)[129]) {
    const int nk = q.K / 128, tk = t % nk, tn = t / nk, k0 = tk * 128, n0 = tn * 128, tid = threadIdx.x;
    __syncthreads();
#pragma unroll
    for (int i = 0; i < 8; ++i) { float* tp = &tile[i * 16 + (tid >> 5)][(tid & 31) * 4]; tp[0] = v[i].x; tp[1] = v[i].y; tp[2] = v[i].z; tp[3] = v[i].w; }
    __syncthreads();
#pragma unroll
    for (int i = 0; i < 4; ++i) { const int n = i * 32 + (tid >> 4), kc = (tid & 15) * 8; h16x8 o;
#pragma unroll
        for (int j = 0; j < 8; ++j) o[j] = (h16)tile[kc + j][n];
        if (q.f8) { float f[8];
#pragma unroll
            for (int j = 0; j < 8; ++j) f[j] = tile[kc + j][n] * q.scale;
            *(u32x2_t_*)((unsigned char*)q.dst + (size_t)cvt_rowmap(n0 + n, q.rmode) * q.ldd + q.col_off + k0 + kc) = f8pack8(f); }
        else *(h16x8*)(q.dst + (size_t)cvt_rowmap(n0 + n, q.rmode) * q.ldd + q.col_off + k0 + kc) = o; }
}
template <int NT> __device__ __forceinline__ void mod_unit(const Params& p, int u, float* sc  , float* red  ) {
    const int l = u / 96, n0 = (u % 96) * 64, tid = threadIdx.x, n4 = (tid & 15) * 4, ks = tid >> 4;
    constexpr int NKS = NT / 16;
    __syncthreads();
    for (int i = tid; i < 9 * 1024; i += NT) { const int g = i >> 10, k = i & 1023; const float v = g == 0 ? p.c_ctx[k] : p.c[(g - 1) * 1024 + k]; sc[i] = siluf_(v); }
    __syncthreads();
    float acc[9][4];
#pragma unroll
    for (int g = 0; g < 9; ++g) { acc[g][0] = 0.f; acc[g][1] = 0.f; acc[g][2] = 0.f; acc[g][3] = 0.f; }
    const float* w = p.w_mod + (size_t)l * 1024 * 6144 + n0 + n4;
#pragma unroll 8
    for (int k = ks; k < 1024; k += NKS) { const float4 wv = *(const float4*)(w + (size_t)k * 6144);
#pragma unroll
        for (int g = 0; g < 9; ++g) { const float sv = sc[g * 1024 + k]; acc[g][0] += sv * wv.x; acc[g][1] += sv * wv.y; acc[g][2] += sv * wv.z; acc[g][3] += sv * wv.w; } }
#pragma unroll
    for (int g = 0; g < 9; ++g) *(float4*)&red[(ks * 9 + g) * 64 + n4] = make_float4(acc[g][0], acc[g][1], acc[g][2], acc[g][3]);
    __syncthreads();
    for (int i = tid; i < 9 * 64; i += NT) { const int g = i >> 6, nn = i & 63; float s = p.b_mod[l * 6144 + n0 + nn];
        for (int k2 = 0; k2 < NKS; ++k2) s += red[(k2 * 9 + g) * 64 + nn];
        WSP(float, OFF_MOD)[(size_t)(l * 9 + g) * 6144 + n0 + nn] = s; }
}
#define LAS __attribute__((address_space(3)))
typedef float f32x4 __attribute__((ext_vector_type(4)));
typedef unsigned u32x4 __attribute__((ext_vector_type(4)));
typedef unsigned u32x2 __attribute__((ext_vector_type(2)));
typedef int i32x4_t __attribute__((ext_vector_type(4)));
namespace pg8 {
constexpr int BM = 256, BK = 64, HALF = 128, HTB = HALF * BK * 2, STAGE_BYTES = 8 * HTB;
__host__ __device__ __forceinline__ int lds_byte(int r, int c) { const int st = (r >> 4) * 2 + (c >> 5), rr = r & 15, cc = c & 31, ob = rr * 64 + cc * 2; return st * 1024 + (ob ^ (((ob >> 9) & 1) << 5)); }
__host__ __device__ __forceinline__ void stage_rc(int b, int& R, int& C) { const int st = b / 1024, sb = b % 1024, swz = sb ^ (((sb >> 9) & 1) << 5); R = (st >> 1) * 16 + swz / 64; C = (st & 1) * 32 + (swz % 64) / 2; }
__host__ __device__ __forceinline__ int perm32(int rho) { const int n = rho >> 4, i = rho & 15; return 8 * (i >> 2) + 4 * n + (i & 3); }
struct GUnit { const char* A; const char* B; int nt; int kind; int pm; int pn; int aux; };
__device__ __forceinline__ void tile_map(int L, int nM, int nN, int& pm, int& pn) {
    const int nwg = nM * nN; int wgid = L;
    { const int q = nwg / 8, r = nwg % 8, xcd = wgid % 8, off = wgid / 8; wgid = (xcd < r ? xcd * (q + 1) : r * (q + 1) + (xcd - r) * q) + off; }
    const int nig = 8 * nN, gid = wgid / nig, fm = gid * 8, gsz = (nM - fm) < 8 ? (nM - fm) : 8;
    pm = fm + ((wgid % nig) % gsz); pn = (wgid % nig) / gsz;
}
__device__ __forceinline__ unsigned cvt_pk_f16(float lo, float hi) { typedef float f2 __attribute__((ext_vector_type(2))); const f2 v = {lo, hi}; const h16x2 h = __builtin_convertvector(v, h16x2); return __builtin_bit_cast(unsigned, h); }

template <class Epi, class Sched>
__device__ __forceinline__ void gemm_phase(LAS unsigned char* lds, const int lda, const int ldb, const Sched& S, const Epi& E) {
    const int tid = threadIdx.x, wid = __builtin_amdgcn_readfirstlane(tid >> 6), lane = tid & 63, wr = wid >> 2, wc = wid & 3, fr = lane & 15, fq = lane >> 4;
    unsigned voffA[2], voffB[2];
#pragma unroll
    for (int i = 0; i < 2; ++i) { int R, C; stage_rc(tid * 16 + i * 8192, R, C); const int Rb = Epi::PERM ? ((R & ~31) + perm32(R & 31)) : R;
        voffA[i] = (unsigned)(R * lda + C) * 2u; voffB[i] = (unsigned)(Rb * ldb + C) * 2u; }
    const size_t kstep = (size_t)(BK * 2);
    const size_t hstepA = (size_t)HALF * lda * 2, hstepB = (size_t)HALF * ldb * 2;
    const unsigned ldsw = (unsigned)wid * 1024u;
    const int aoff = lds_byte(wr * 64 + fr, fq * 8), boff = lds_byte(wc * 32 + fr, fq * 8);
#define PG8_SA(b, h) (((b) * 2 + (h)) * HTB)
#define PG8_SB(b, h) ((4 + (b) * 2 + (h)) * HTB)
#define PG8_STAGE(bufoff, gbase, voff) do { _Pragma("unroll") for (int _i = 0; _i < 2; ++_i) \
        __builtin_amdgcn_global_load_lds((const unsigned*)((const char*)(gbase) + (voff)[_i]), (LAS unsigned*)(lds + (bufoff) + ldsw + _i * 8192), 16, 0, 0); } while (0)
#define PG8_LDA(dst, b, h) do { _Pragma("unroll") for (int m = 0; m < 4; ++m) _Pragma("unroll") for (int k = 0; k < 2; ++k) dst[m][k] = *(const LAS h16x8*)(lds + PG8_SA(b, h) + aoff + m * 2048 + k * 1024); } while (0)
#define PG8_LDB(dst, b, h) do { _Pragma("unroll") for (int n = 0; n < 2; ++n) _Pragma("unroll") for (int k = 0; k < 2; ++k) dst[n][k] = *(const LAS h16x8*)(lds + PG8_SB(b, h) + boff + n * 2048 + k * 1024); } while (0)
#define PG8_CAT8(x) __builtin_shufflevector(__builtin_bit_cast(i32x4_t, (x)[0]), __builtin_bit_cast(i32x4_t, (x)[1]), 0, 1, 2, 3, 4, 5, 6, 7)
#define PG8_MMA(ai, bj, At, Bt) do { __builtin_amdgcn_s_setprio(1); \
        if constexpr (Epi::F8) { _Pragma("unroll") for (int m = 0; m < 4; ++m) _Pragma("unroll") for (int n = 0; n < 2; ++n) \
            asm volatile("v_mfma_f32_16x16x128_f8f6f4 %0, %1, %2, %0" : "+v"(acc[ai][bj][m][n]) : "v"(PG8_CAT8(Bt[n])), "v"(PG8_CAT8(At[m]))); } \
        else { _Pragma("unroll") for (int m = 0; m < 4; ++m) _Pragma("unroll") for (int n = 0; n < 2; ++n) _Pragma("unroll") for (int k = 0; k < 2; ++k) \
            acc[ai][bj][m][n] = __builtin_amdgcn_mfma_f32_16x16x32_f16(Bt[n][k], At[m][k], acc[ai][bj][m][n], 0, 0, 0); } \
        __builtin_amdgcn_s_setprio(0); } while (0)
#define PG8_WAIT_V(n) asm volatile("s_waitcnt vmcnt(" #n ")" ::: "memory")
#define PG8_WAIT_L(n) asm volatile("s_waitcnt lgkmcnt(" #n ")" ::: "memory")
#define PG8_BAR __builtin_amdgcn_s_barrier()
#define PG8_SCHED __builtin_amdgcn_sched_barrier(0)
    GUnit cur, nxt; int ui = 0; unsigned long long probe_t0 = 0ull;
    if (!S.next(0, cur)) return;
    f32x4 acc[2][2][4][2];
#pragma unroll
    for (int a = 0; a < 2; ++a)
#pragma unroll
        for (int b = 0; b < 2; ++b)
#pragma unroll
            for (int m = 0; m < 4; ++m)
#pragma unroll
                for (int n = 0; n < 2; ++n) acc[a][b][m][n] = (f32x4){0.f, 0.f, 0.f, 0.f};
    h16x8 At[4][2], B0[2][2], B1[2][2];
    const char* cA = cur.A; const char* cB = cur.B;
#ifndef PG8_SP2
#define PG8_SP2 1
#endif
    if (PG8_SP2) {
        PG8_STAGE(PG8_SB(0, 0), cB, voffB); PG8_STAGE(PG8_SB(0, 1), cB + hstepB, voffB); PG8_STAGE(PG8_SA(0, 0), cA, voffA); PG8_STAGE(PG8_SA(0, 1), cA + hstepA, voffA);
        if (wr == 1) PG8_BAR;
        PG8_WAIT_V(2); PG8_BAR;
        PG8_STAGE(PG8_SB(1, 0), cB + kstep, voffB); PG8_STAGE(PG8_SA(1, 0), cA + kstep, voffA); PG8_STAGE(PG8_SB(1, 1), cB + hstepB + kstep, voffB);
        PG8_WAIT_V(6); PG8_BAR;
    } else {
    PG8_STAGE(PG8_SB(0, 0), cB, voffB); PG8_STAGE(PG8_SA(0, 0), cA, voffA); PG8_STAGE(PG8_SB(0, 1), cB + hstepB, voffB); PG8_STAGE(PG8_SA(0, 1), cA + hstepA, voffA);
    if (wr == 1) PG8_BAR;
    PG8_WAIT_V(4); PG8_BAR;
    PG8_STAGE(PG8_SB(1, 0), cB + kstep, voffB); PG8_STAGE(PG8_SA(1, 0), cA + kstep, voffA); PG8_STAGE(PG8_SB(1, 1), cB + hstepB + kstep, voffB);
    PG8_WAIT_V(6); PG8_BAR;
    }
    for (;;) {
        const bool has_next = S.next(ui + 1, nxt);
        const char* nA = has_next ? nxt.A : cA; const char* nB = has_next ? nxt.B : cB;
        const int nt = cur.nt;
        for (int t = 0; t < nt; t += 2) {
            const bool last = (t == nt - 2);
            const char* a1 = cA + (size_t)(t + 1) * kstep;
            const char* a2 = last ? nA : cA + (size_t)(t + 2) * kstep; const char* b2 = last ? nB : cB + (size_t)(t + 2) * kstep;
            const char* a3 = a2 + kstep; const char* b3 = b2 + kstep;
            if (PG8_SP2) {
            PG8_LDB(B0, 0, 0); PG8_LDB(B1, 0, 1); PG8_SCHED; PG8_LDA(At, 0, 0); PG8_STAGE(PG8_SA(1, 1), a1 + hstepA, voffA);
            PG8_WAIT_V(8); PG8_WAIT_L(0); PG8_BAR; PG8_MMA(0, 0, At, B0); PG8_MMA(0, 1, At, B1); PG8_BAR; PG8_SCHED;
            PG8_LDA(At, 0, 1); PG8_STAGE(PG8_SB(0, 0), b2, voffB); PG8_STAGE(PG8_SB(0, 1), b2 + hstepB, voffB); PG8_STAGE(PG8_SA(0, 0), a2, voffA);
            PG8_WAIT_V(8); PG8_WAIT_L(0); PG8_BAR; PG8_MMA(1, 0, At, B0); PG8_MMA(1, 1, At, B1); PG8_BAR; PG8_SCHED;
            PG8_LDB(B0, 1, 0); PG8_LDB(B1, 1, 1); PG8_SCHED; PG8_LDA(At, 1, 0); PG8_STAGE(PG8_SA(0, 1), a2 + hstepA, voffA);
            PG8_WAIT_V(8); PG8_WAIT_L(0); PG8_BAR; PG8_MMA(0, 0, At, B0); PG8_MMA(0, 1, At, B1); PG8_BAR; PG8_SCHED;
            PG8_LDA(At, 1, 1); PG8_STAGE(PG8_SB(1, 0), b3, voffB); PG8_STAGE(PG8_SB(1, 1), b3 + hstepB, voffB); PG8_STAGE(PG8_SA(1, 0), a3, voffA);
            PG8_WAIT_V(8); PG8_WAIT_L(0); PG8_BAR; PG8_MMA(1, 0, At, B0); PG8_MMA(1, 1, At, B1); PG8_BAR; PG8_SCHED;
            } else {
            PG8_LDB(B0, 0, 0); PG8_SCHED; PG8_LDA(At, 0, 0); PG8_STAGE(PG8_SA(1, 1), a1 + hstepA, voffA);
            PG8_WAIT_L(8); PG8_BAR; PG8_WAIT_L(0); PG8_MMA(0, 0, At, B0); PG8_BAR; PG8_SCHED;
            PG8_LDB(B1, 0, 1); PG8_STAGE(PG8_SB(0, 0), b2, voffB);
            PG8_BAR; PG8_WAIT_L(0); PG8_MMA(0, 1, At, B1); PG8_BAR;
            PG8_LDA(At, 0, 1); PG8_STAGE(PG8_SA(0, 0), a2, voffA);
            PG8_BAR; PG8_WAIT_L(0); PG8_MMA(1, 0, At, B0); PG8_BAR; PG8_SCHED;
            PG8_STAGE(PG8_SB(0, 1), b2 + hstepB, voffB);
            PG8_WAIT_V(6); PG8_BAR; PG8_MMA(1, 1, At, B1); PG8_BAR;
            PG8_LDB(B0, 1, 0); PG8_SCHED; PG8_LDA(At, 1, 0); PG8_STAGE(PG8_SA(0, 1), a2 + hstepA, voffA);
            PG8_WAIT_L(8); PG8_BAR; PG8_WAIT_L(0); PG8_MMA(0, 0, At, B0); PG8_BAR; PG8_SCHED;
            PG8_LDB(B1, 1, 1); PG8_STAGE(PG8_SB(1, 0), b3, voffB);
            PG8_BAR; PG8_WAIT_L(0); PG8_MMA(0, 1, At, B1); PG8_BAR;
            PG8_LDA(At, 1, 1); PG8_STAGE(PG8_SA(1, 0), a3, voffA);
            PG8_BAR; PG8_WAIT_L(0); PG8_MMA(1, 0, At, B0); PG8_BAR; PG8_SCHED;
            PG8_STAGE(PG8_SB(1, 1), b3 + hstepB, voffB);
            PG8_WAIT_V(6); PG8_BAR; PG8_MMA(1, 1, At, B1); PG8_BAR;
            }
            if (PROBE_EPI == 2 && t == 0 && probe_t0 != 0ull && blockIdx.x == 0 && tid == 0) ((LAS unsigned long long*)(lds + 147424))[0] += __builtin_amdgcn_s_memrealtime() - probe_t0;
            if (PROBE_EPI == 3 && t == 4) probe_t0 = __builtin_amdgcn_s_memrealtime();
            if (PROBE_EPI == 3 && t == 6 && blockIdx.x == 0 && tid == 0) ((LAS unsigned long long*)(lds + 147424))[0] += __builtin_amdgcn_s_memrealtime() - probe_t0;
        }
#ifndef PG8_ALIGN
#define PG8_ALIGN 1
#endif
        if (PG8_ALIGN) { if (wr == 0) PG8_BAR; }
        unsigned long long pe0 = 0; if (PROBE_EPI == 1 || PROBE_EPI == 2) pe0 = __builtin_amdgcn_s_memrealtime();
        if constexpr (Epi::F8) { PG8_SCHED; asm volatile("s_nop 15\n\ts_nop 15" ::: "memory"); PG8_SCHED; }
        E(acc, cur, wr, wc, fr, fq);
        if (PROBE_EPI == 1 && blockIdx.x == 0 && tid == 0) ((LAS unsigned long long*)(lds + 147424))[0] += __builtin_amdgcn_s_memrealtime() - pe0;
        if (PROBE_EPI == 2) probe_t0 = pe0;
        if (!has_next) break;
#pragma unroll
        for (int a = 0; a < 2; ++a)
#pragma unroll
            for (int b = 0; b < 2; ++b)
#pragma unroll
                for (int m = 0; m < 4; ++m)
#pragma unroll
                    for (int n = 0; n < 2; ++n) acc[a][b][m][n] = (f32x4){0.f, 0.f, 0.f, 0.f};
        cur = nxt; cA = nA; cB = nB; ++ui;
        if (PG8_ALIGN) { if (wr == 1) PG8_BAR; }
    }
    PG8_WAIT_V(0);
    if (!PG8_ALIGN) { if (wr == 0) PG8_BAR; }
    PG8_BAR;
#undef PG8_SA
#undef PG8_SB
#undef PG8_STAGE
#undef PG8_LDA
#undef PG8_LDB
#undef PG8_MMA
#undef PG8_CAT8
#undef PG8_WAIT_V
#undef PG8_WAIT_L
#undef PG8_BAR
#undef PG8_SCHED
}

template <class Epi, class Sched>
__device__ __forceinline__ void gemm_phase_h(LAS unsigned char* lds, const int lda, const int ldb, const Sched& S, const Epi& E) {
    const int tid = threadIdx.x, wid = __builtin_amdgcn_readfirstlane(tid >> 6), lane = tid & 63, wr = wid >> 1, wc = wid & 1, hf = wid >> 2, fr = lane & 15, fq = lane >> 4;
    unsigned voffA[2], voffB[2];
#pragma unroll
    for (int i = 0; i < 2; ++i) { int R, C; stage_rc(tid * 16 + i * 8192, R, C); const int Rb = (R & ~31) + perm32(R & 31);
        voffA[i] = (unsigned)(R * lda + C) * 2u; voffB[i] = (unsigned)(Rb * ldb + C) * 2u; }
    const size_t kstep = (size_t)(BK * 2);
    const size_t hstepA = (size_t)HALF * lda * 2;
    const unsigned ldsw = (unsigned)wid * 1024u;
    const int aoff = lds_byte(wr * 32 + fr, fq * 8), boff = lds_byte(wc * 64 + fr, fq * 8);
#define PG8_SA(b, h) (((b) * 2 + (h)) * HTB)
#define PG8_SB(b, h) ((4 + (b) * 2 + (h)) * HTB)
#define PG8_STAGE(bufoff, gbase, voff) do { _Pragma("unroll") for (int _i = 0; _i < 2; ++_i) \
        __builtin_amdgcn_global_load_lds((const unsigned*)((const char*)(gbase) + (voff)[_i]), (LAS unsigned*)(lds + (bufoff) + ldsw + _i * 8192), 16, 0, 0); } while (0)
#define PG8_LDA(dst, b, h) do { _Pragma("unroll") for (int m = 0; m < 2; ++m) _Pragma("unroll") for (int k = 0; k < 2; ++k) dst[m][k] = *(const LAS h16x8*)(lds + PG8_SA(b, h) + aoff + m * 2048 + k * 1024); } while (0)
#define PG8_LDB(dst, b, h) do { _Pragma("unroll") for (int n = 0; n < 4; ++n) _Pragma("unroll") for (int k = 0; k < 2; ++k) dst[n][k] = *(const LAS h16x8*)(lds + PG8_SB(b, h) + boff + n * 2048 + k * 1024); } while (0)
#define PG8_MMA(ai, At, Bt) do { __builtin_amdgcn_s_setprio(1); _Pragma("unroll") for (int m = 0; m < 2; ++m) _Pragma("unroll") for (int n = 0; n < 4; ++n) _Pragma("unroll") for (int k = 0; k < 2; ++k) \
        acc[ai][m][n] = __builtin_amdgcn_mfma_f32_16x16x32_f16(Bt[n][k], At[m][k], acc[ai][m][n], 0, 0, 0); __builtin_amdgcn_s_setprio(0); } while (0)
#define PG8_WAIT_V(n) asm volatile("s_waitcnt vmcnt(" #n ")" ::: "memory")
#define PG8_WAIT_L(n) asm volatile("s_waitcnt lgkmcnt(" #n ")" ::: "memory")
#define PG8_BAR __builtin_amdgcn_s_barrier()
#define PG8_SCHED __builtin_amdgcn_sched_barrier(0)
    GUnit cur, nxt; int ui = 0;
    if (!S.next(0, cur)) return;
    f32x4 acc[2][2][4];
#pragma unroll
    for (int a = 0; a < 2; ++a)
#pragma unroll
        for (int m = 0; m < 2; ++m)
#pragma unroll
            for (int n = 0; n < 4; ++n) acc[a][m][n] = (f32x4){0.f, 0.f, 0.f, 0.f};
    h16x8 At[2][2], B0[4][2];
    const char* cA = cur.A; const char* cB = cur.B;
    PG8_STAGE(PG8_SB(0, 0), cB, voffB); PG8_STAGE(PG8_SA(0, 0), cA, voffA); PG8_STAGE(PG8_SA(0, 1), cA + hstepA, voffA);
    if (hf == 1) PG8_BAR;
    PG8_WAIT_V(2); PG8_BAR;
    PG8_STAGE(PG8_SB(1, 0), cB + kstep, voffB); PG8_STAGE(PG8_SA(1, 0), cA + kstep, voffA);
    PG8_WAIT_V(4); PG8_BAR;
    for (;;) {
        const bool has_next = S.next(ui + 1, nxt);
        const char* nA = has_next ? nxt.A : cA; const char* nB = has_next ? nxt.B : cB;
        const int nt = cur.nt;
        for (int t = 0; t < nt; t += 2) {
            const bool last = (t == nt - 2);
            const char* a1 = cA + (size_t)(t + 1) * kstep;
            const char* a2 = last ? nA : cA + (size_t)(t + 2) * kstep; const char* b2 = last ? nB : cB + (size_t)(t + 2) * kstep;
            const char* a3 = a2 + kstep; const char* b3 = b2 + kstep;
            PG8_LDB(B0, 0, 0); PG8_SCHED; PG8_LDA(At, 0, 0); PG8_STAGE(PG8_SA(1, 1), a1 + hstepA, voffA);
            PG8_WAIT_V(6); PG8_WAIT_L(0); PG8_BAR; PG8_MMA(0, At, B0); PG8_BAR; PG8_SCHED;
            PG8_LDA(At, 0, 1); PG8_STAGE(PG8_SB(0, 0), b2, voffB); PG8_STAGE(PG8_SA(0, 0), a2, voffA);
            PG8_WAIT_V(6); PG8_WAIT_L(0); PG8_BAR; PG8_MMA(1, At, B0); PG8_BAR; PG8_SCHED;
            PG8_LDB(B0, 1, 0); PG8_SCHED; PG8_LDA(At, 1, 0); PG8_STAGE(PG8_SA(0, 1), a2 + hstepA, voffA);
            PG8_WAIT_V(6); PG8_WAIT_L(0); PG8_BAR; PG8_MMA(0, At, B0); PG8_BAR; PG8_SCHED;
            PG8_LDA(At, 1, 1); PG8_STAGE(PG8_SB(1, 0), b3, voffB); PG8_STAGE(PG8_SA(1, 0), a3, voffA);
            PG8_WAIT_V(6); PG8_WAIT_L(0); PG8_BAR; PG8_MMA(1, At, B0); PG8_BAR; PG8_SCHED;
        }
        if (PG8_ALIGN) { if (hf == 0) PG8_BAR; }
        E(acc, cur, wr, wc, fr, fq);
        if (!has_next) break;
        cur = nxt; cA = nA; cB = nB; ++ui;
        if (PG8_ALIGN) { if (hf == 1) PG8_BAR; }
    }
    PG8_WAIT_V(0);
    if (!PG8_ALIGN) { if (hf == 0) PG8_BAR; }
    PG8_BAR;
#undef PG8_SA
#undef PG8_SB
#undef PG8_STAGE
#undef PG8_LDA
#undef PG8_LDB
#undef PG8_MMA
#undef PG8_WAIT_V
#undef PG8_WAIT_L
#undef PG8_BAR
#undef PG8_SCHED
}
}
using pg8::GUnit;

struct SchedPlain {
    const char* A; const char* B; int lda, ldb, nt, pm0, nM, nN, G, c;
    __device__ __forceinline__ bool next(int i, GUnit& u) const {
        const int L = i * G + c; if (L >= nM * nN) return false;
        int pm, pn; pg8::tile_map(L, nM, nN, pm, pn);
        u.pm = pm0 + pm; u.pn = pn; u.kind = 0; u.aux = 0; u.nt = nt;
        u.A = A + (size_t)u.pm * 256 * lda * 2; u.B = B + (size_t)pn * 256 * ldb * 2; return true;
    }
};
struct SchedPlainK2 {
    const char* A; const char* B; int lda, ldb, nt, pm0, nM, nN, G, c;
    __device__ __forceinline__ bool next(int i, GUnit& u) const {
        const int Lq = i * G + c; if (Lq >= nM * nN * 2) return false;
        const int q = Lq & 1, L = Lq >> 1;
        int pm, pn; pg8::tile_map(L, nM, nN, pm, pn);
        const int h0 = ((nt >> 1) + 1) & ~1;
        u.pm = pm0 + pm; u.pn = pn; u.kind = 0; u.aux = q; u.nt = q ? nt - h0 : h0;
        const size_t koff = (size_t)q * h0 * 128;
        u.A = A + (size_t)u.pm * 256 * lda * 2 + koff; u.B = B + (size_t)pn * 256 * ldb * 2 + koff; return true;
    }
};
struct SchedMerge {
    const char* A; const char* B; int pm0, nM, G, c;
    __device__ __forceinline__ bool next(int i, GUnit& u) const {
        const int ti = i / 6, sub = i - ti * 6, L = ti * G + c; if (L >= nM * 4) return false;
        int pm, pn; pg8::tile_map(L, nM, 4, pm, pn);
        const int n = sub >> 1, br = sub & 1;
        u.pm = pm0 + pm; u.pn = pn; u.kind = sub; u.aux = n; u.nt = br ? 8 : 16;
        u.A = A + ((size_t)u.pm * 256 * AW + (br ? AY0 + n * 512 : AH)) * 2;
        u.B = B + ((size_t)(n * 1024 + pn * 256) * 1536 + (br ? 1024 : 0)) * 2; return true;
    }
};
struct SchedMoe {
    const char* A; const char* B; const int* panelE; int lda, ldb, nt, pm0, arow_pm0, nM, nN, G, c; size_t estride; int ks_shift;
    __device__ __forceinline__ bool next(int i, GUnit& u) const {
        const int Lq = i * G + c; if (Lq >= ((nM * nN) << ks_shift)) return false;
        const int q = Lq & ((1 << ks_shift) - 1), L = Lq >> ks_shift;
        int pm, pn; pg8::tile_map(L, nM, nN, pm, pn);
        u.pm = pm0 + pm; u.pn = pn; u.kind = 0; u.aux = q; u.nt = nt >> ks_shift;
        const int e = panelE[u.pm]; const size_t koff = (size_t)q * (nt >> ks_shift) * 128;
        u.A = A + (size_t)(u.pm - arow_pm0) * 256 * lda * 2 + koff; u.B = B + (size_t)e * estride + (size_t)pn * 256 * ldb * 2 + koff; return true;
    }
};

#define EPI_ARGS const f32x4 (&acc)[2][2][4][2], const GUnit& u, int wr, int wc, int fr, int fq
struct EpiF16 {
    static constexpr bool PERM = true; static constexpr bool F8 = false;
    h16* O; int ldc;
    __device__ __forceinline__ void operator()(EPI_ARGS) const {
        const int row0 = u.pm * 256 + wr * 64 + fr, col0 = u.pn * 256 + wc * 32 + 8 * fq;
#pragma unroll
        for (int ai = 0; ai < 2; ++ai)
#pragma unroll
            for (int m = 0; m < 4; ++m) { h16* rowp = O + (size_t)(row0 + ai * 128 + m * 16) * ldc + col0;
#pragma unroll
                for (int bj = 0; bj < 2; ++bj) { const f32x4 v0 = acc[ai][bj][m][0], v1 = acc[ai][bj][m][1];
                    u32x4 w; w.x = pg8::cvt_pk_f16(v0[0], v0[1]); w.y = pg8::cvt_pk_f16(v0[2], v0[3]); w.z = pg8::cvt_pk_f16(v1[0], v1[1]); w.w = pg8::cvt_pk_f16(v1[2], v1[3]);
                    *(u32x4*)(rowp + bj * 128) = w; } }
    }
};
struct EpiMerge {
    static constexpr bool PERM = true; static constexpr bool F8 = false;
    const float* bmerge;
    char* priv;
    h16* S16;
    __device__ __forceinline__ void operator()(EPI_ARGS) const {
        unsigned off0 = (unsigned)threadIdx.x * 16u; asm volatile("" : "+v"(off0));
        u32x4* pg = (u32x4*)(priv + off0); u32x4* ps = (u32x4*)(priv + 131072 + off0);
        if ((u.kind & 1) == 0) {
            const float* bb = bmerge + u.aux * 1024 + u.pn * 256 + wc * 32 + 8 * fq;
#pragma unroll
            for (int bj = 0; bj < 2; ++bj) { const f32x4 b0 = *(const f32x4*)(bb + bj * 128), b1 = *(const f32x4*)(bb + bj * 128 + 4);
#pragma unroll
                for (int ai = 0; ai < 2; ++ai)
#pragma unroll
                    for (int m = 0; m < 4; ++m) { f32x4 v0 = acc[ai][bj][m][0] + b0, v1 = acc[ai][bj][m][1] + b1;
#pragma unroll
                        for (int j = 0; j < 4; ++j) { v0[j] = sigmoidf_(v0[j]); v1[j] = sigmoidf_(v1[j]); }
                        u32x4 w; w.x = pg8::cvt_pk_f16(v0[0], v0[1]); w.y = pg8::cvt_pk_f16(v0[2], v0[3]); w.z = pg8::cvt_pk_f16(v1[0], v1[1]); w.w = pg8::cvt_pk_f16(v1[2], v1[3]);
                        pg[((ai * 2 + bj) * 4 + m) * 512] = w; } }
        } else {
            const int row0 = u.pm * 256 + wr * 64 + fr, col0 = u.pn * 256 + wc * 32 + 8 * fq;
#pragma unroll
            for (int ai = 0; ai < 2; ++ai) {
                u32x4 gw[2][4], sw[2][4];
#pragma unroll
                for (int bj = 0; bj < 2; ++bj)
#pragma unroll
                    for (int m = 0; m < 4; ++m) { const int slot = (ai * 2 + bj) * 4 + m; gw[bj][m] = pg[slot * 512]; if (u.kind != 1) sw[bj][m] = ps[slot * 512]; }
#pragma unroll
                for (int bj = 0; bj < 2; ++bj)
#pragma unroll
                    for (int m = 0; m < 4; ++m) { const int slot = (ai * 2 + bj) * 4 + m;
                        const h16x8 g = __builtin_bit_cast(h16x8, gw[bj][m]);
                        f32x4 s0 = acc[ai][bj][m][0], s1 = acc[ai][bj][m][1];
#pragma unroll
                        for (int j = 0; j < 4; ++j) { s0[j] *= (float)g[j]; s1[j] *= (float)g[4 + j]; }
                        if (u.kind != 1) { const h16x8 sp = __builtin_bit_cast(h16x8, sw[bj][m]);
#pragma unroll
                            for (int j = 0; j < 4; ++j) { s0[j] += (float)sp[j]; s1[j] += (float)sp[4 + j]; } }
                        u32x4 o; o.x = pg8::cvt_pk_f16(s0[0], s0[1]); o.y = pg8::cvt_pk_f16(s0[2], s0[3]); o.z = pg8::cvt_pk_f16(s1[0], s1[1]); o.w = pg8::cvt_pk_f16(s1[2], s1[3]);
                        if (u.kind != 5) ps[slot * 512] = o;
                        else *(u32x4*)(S16 + (size_t)(row0 + ai * 128 + m * 16) * 1024 + col0 + bj * 128) = o; }
                asm volatile("" ::: "memory"); }
        }
    }
};
struct SchedMergeH {
    const char* A; const char* B; int pm0, nM, G, c;
    __device__ __forceinline__ bool next(int i, GUnit& u) const {
        const int ti = i / 3, n = i - ti * 3, L = ti * G + c; if (L >= nM * 8) return false;
        int pm, pn; pg8::tile_map(L, nM, 8, pm, pn);
        u.pm = pm0 + pm; u.pn = pn; u.kind = 2 * n + 1; u.aux = n; u.nt = 8;
        u.A = A + ((size_t)u.pm * 256 * AW + AY0 + n * 512) * 2;
        u.B = B + ((size_t)(n * 1024 + pn * 128) * 1536 + 1024) * 2; return true;
    }
};
struct EpiMergeH {
    const unsigned char* G8; h16* S16;
    mutable u32x2 gn[2][2][2];
    mutable f32x4 sk[2][2][4];
    __device__ __forceinline__ void operator()(f32x4 (&acc)[2][2][4], const GUnit& u, int wr, int wc, int fr, int fq) const {
        const int row0 = u.pm * 256 + wr * 32 + fr, col0 = u.pn * 128 + wc * 64 + 8 * fq;
        const unsigned char* gbase = G8 + (size_t)row0 * 3072 + col0;
        u32x2 gc[2][2][2];
        if (u.kind == 1) {
#pragma unroll
            for (int ai = 0; ai < 2; ++ai)
#pragma unroll
                for (int m = 0; m < 2; ++m)
#pragma unroll
                    for (int g2 = 0; g2 < 2; ++g2) gc[ai][m][g2] = *(const u32x2*)(gbase + (size_t)(ai * 128 + m * 16) * 3072 + g2 * 32);
        } else {
#pragma unroll
            for (int ai = 0; ai < 2; ++ai)
#pragma unroll
                for (int m = 0; m < 2; ++m)
#pragma unroll
                    for (int g2 = 0; g2 < 2; ++g2) gc[ai][m][g2] = gn[ai][m][g2];
        }
        if (u.kind != 5) { const int nb = (u.kind >> 1) + 1;
#pragma unroll
            for (int ai = 0; ai < 2; ++ai)
#pragma unroll
                for (int m = 0; m < 2; ++m)
#pragma unroll
                    for (int g2 = 0; g2 < 2; ++g2) gn[ai][m][g2] = *(const u32x2*)(gbase + (size_t)(ai * 128 + m * 16) * 3072 + nb * 1024 + g2 * 32);
        }
#pragma unroll
        for (int ai = 0; ai < 2; ++ai)
#pragma unroll
            for (int m = 0; m < 2; ++m)
#pragma unroll
                for (int g2 = 0; g2 < 2; ++g2) { f32x4 s[2];
#pragma unroll
                    for (int q = 0; q < 2; ++q) { const int n = g2 * 2 + q; const unsigned gw = q ? gc[ai][m][g2].y : gc[ai][m][g2].x; f32x4 v = acc[ai][m][n];
#pragma unroll
                        for (int j = 0; j < 4; ++j) v[j] *= (float)((gw >> (8 * j)) & 255u) * (1.0f / 255.0f);
                        if (u.kind != 1) v += sk[ai][m][n];
                        sk[ai][m][n] = v; s[q] = v; acc[ai][m][n] = (f32x4){0.f, 0.f, 0.f, 0.f}; }
                    if (u.kind == 5) { u32x4 o; o.x = pg8::cvt_pk_f16(s[0][0], s[0][1]); o.y = pg8::cvt_pk_f16(s[0][2], s[0][3]); o.z = pg8::cvt_pk_f16(s[1][0], s[1][1]); o.w = pg8::cvt_pk_f16(s[1][2], s[1][3]);
                        *(u32x4*)(S16 + (size_t)(row0 + ai * 128 + m * 16) * 1024 + col0 + g2 * 32) = o; } }
    }
};
struct EpiScaled {
    static constexpr bool PERM = true; static constexpr bool F8 = false;
    h16* Y; const float* modv;
    __device__ __forceinline__ void operator()(EPI_ARGS) const {
        const int row0 = u.pm * 256 + wr * 64 + fr, col0 = u.pn * 256 + wc * 32 + 8 * fq;
        const int g = u.pm < 8 ? 0 : 1 + ((u.pm - 8) >> 4);
        f32x4 mv[2][2];
#pragma unroll
        for (int bj = 0; bj < 2; ++bj)
#pragma unroll
            for (int n = 0; n < 2; ++n) mv[bj][n] = *(const f32x4*)(modv + (size_t)g * 6144 + col0 + bj * 128 + 4 * n);
#pragma unroll
        for (int ai = 0; ai < 2; ++ai)
#pragma unroll
            for (int m = 0; m < 4; ++m) { h16* rowp = Y + (size_t)(row0 + ai * 128 + m * 16) * D + col0;
#pragma unroll
                for (int bj = 0; bj < 2; ++bj) { const f32x4 v0 = acc[ai][bj][m][0] * mv[bj][0], v1 = acc[ai][bj][m][1] * mv[bj][1];
                    u32x4 w; w.x = pg8::cvt_pk_f16(v0[0], v0[1]); w.y = pg8::cvt_pk_f16(v0[2], v0[3]); w.z = pg8::cvt_pk_f16(v1[0], v1[1]); w.w = pg8::cvt_pk_f16(v1[2], v1[3]);
                    *(u32x4*)(rowp + bj * 128) = w; } }
    }
};
struct EpiScaledK2 {
    static constexpr bool PERM = true; static constexpr bool F8 = false;
    h16* Y; h16* Y2; const float* modv;
    __device__ __forceinline__ void operator()(EPI_ARGS) const {
        const int row0 = u.pm * 256 + wr * 64 + fr, col0 = u.pn * 256 + wc * 32 + 8 * fq;
        const int g = u.pm < 8 ? 0 : 1 + ((u.pm - 8) >> 4);
        h16* Yo = u.aux ? Y2 : Y;
        f32x4 mv[2][2];
#pragma unroll
        for (int bj = 0; bj < 2; ++bj)
#pragma unroll
            for (int n = 0; n < 2; ++n) mv[bj][n] = *(const f32x4*)(modv + (size_t)g * 6144 + col0 + bj * 128 + 4 * n);
#pragma unroll
        for (int ai = 0; ai < 2; ++ai)
#pragma unroll
            for (int m = 0; m < 4; ++m) { h16* rowp = Yo + (size_t)(row0 + ai * 128 + m * 16) * D + col0;
#pragma unroll
                for (int bj = 0; bj < 2; ++bj) { const f32x4 v0 = acc[ai][bj][m][0] * mv[bj][0], v1 = acc[ai][bj][m][1] * mv[bj][1];
                    u32x4 w; w.x = pg8::cvt_pk_f16(v0[0], v0[1]); w.y = pg8::cvt_pk_f16(v0[2], v0[3]); w.z = pg8::cvt_pk_f16(v1[0], v1[1]); w.w = pg8::cvt_pk_f16(v1[2], v1[3]);
                    *(u32x4*)(rowp + bj * 128) = w; } }
    }
};
struct EpiScaledK2F8 {
    static constexpr bool PERM = true; static constexpr bool F8 = true;
    h16* Y; h16* Y2; const float* modv; float isc;
    __device__ __forceinline__ void operator()(EPI_ARGS) const {
        const int row0 = u.pm * 256 + wr * 64 + fr, col0 = u.pn * 256 + wc * 32 + 8 * fq;
        const int g = u.pm < 8 ? 0 : 1 + ((u.pm - 8) >> 4);
        h16* Yo = u.aux ? Y2 : Y;
        f32x4 mv[2][2];
#pragma unroll
        for (int bj = 0; bj < 2; ++bj)
#pragma unroll
            for (int n = 0; n < 2; ++n) mv[bj][n] = *(const f32x4*)(modv + (size_t)g * 6144 + col0 + bj * 128 + 4 * n) * isc;
#pragma unroll
        for (int ai = 0; ai < 2; ++ai)
#pragma unroll
            for (int m = 0; m < 4; ++m) { h16* rowp = Yo + (size_t)(row0 + ai * 128 + m * 16) * D + col0;
#pragma unroll
                for (int bj = 0; bj < 2; ++bj) { const f32x4 v0 = acc[ai][bj][m][0] * mv[bj][0], v1 = acc[ai][bj][m][1] * mv[bj][1];
                    u32x4 w; w.x = pg8::cvt_pk_f16(v0[0], v0[1]); w.y = pg8::cvt_pk_f16(v0[2], v0[3]); w.z = pg8::cvt_pk_f16(v1[0], v1[1]); w.w = pg8::cvt_pk_f16(v1[2], v1[3]);
                    *(u32x4*)(rowp + bj * 128) = w; } }
    }
};
struct EpiGateF8 {
    static constexpr bool PERM = true; static constexpr bool F8 = true;
    unsigned char* G8; const float* bmerge; float isc;
    __device__ __forceinline__ void operator()(EPI_ARGS) const {
        const int row0 = u.pm * 256 + wr * 64 + fr, col0 = u.pn * 256 + wc * 32 + 8 * fq;
        f32x4 bv[2][2];
#pragma unroll
        for (int bj = 0; bj < 2; ++bj)
#pragma unroll
            for (int n = 0; n < 2; ++n) bv[bj][n] = *(const f32x4*)(bmerge + col0 + bj * 128 + 4 * n);
#pragma unroll
        for (int ai = 0; ai < 2; ++ai)
#pragma unroll
            for (int m = 0; m < 4; ++m) { unsigned char* rowp = G8 + (size_t)(row0 + ai * 128 + m * 16) * 3072 + col0;
#pragma unroll
                for (int bj = 0; bj < 2; ++bj) { unsigned w[2];
#pragma unroll
                    for (int n = 0; n < 2; ++n) { const f32x4 v = acc[ai][bj][m][n] * isc + bv[bj][n]; unsigned pk = 0u;
#pragma unroll
                        for (int j = 0; j < 4; ++j) pk |= (unsigned)(int)(sigmoidf_(v[j]) * 255.0f + 0.5f) << (8 * j);
                        w[n] = pk; }
                    u32x2 o; o.x = w[0]; o.y = w[1]; *(u32x2*)(rowp + bj * 128) = o; } }
    }
};
struct EpiSwiglu {
    static constexpr bool PERM = true; static constexpr bool F8 = false;
    h16* O; int ldc; int orow0;
    __device__ __forceinline__ void operator()(EPI_ARGS) const {
        const int row0 = u.pm * 256 - orow0 + wr * 64 + fr, col0 = u.pn * 128 + wc * 32 + 8 * fq;
#pragma unroll
        for (int ai = 0; ai < 2; ++ai)
#pragma unroll
            for (int m = 0; m < 4; ++m) { float o[8];
#pragma unroll
                for (int n = 0; n < 2; ++n)
#pragma unroll
                    for (int j = 0; j < 4; ++j) o[n * 4 + j] = siluf_(acc[ai][0][m][n][j]) * acc[ai][1][m][n][j];
                u32x4 w; w.x = pg8::cvt_pk_f16(o[0], o[1]); w.y = pg8::cvt_pk_f16(o[2], o[3]); w.z = pg8::cvt_pk_f16(o[4], o[5]); w.w = pg8::cvt_pk_f16(o[6], o[7]);
                *(u32x4*)(O + (size_t)(row0 + ai * 128 + m * 16) * ldc + col0) = w; }
    }
};
struct EpiSwigluF8 {
    static constexpr bool PERM = true; static constexpr bool F8 = true;
    h16* O; int ldc; int orow0; float osc;
    __device__ __forceinline__ void operator()(EPI_ARGS) const {
        const int row0 = u.pm * 256 - orow0 + wr * 64 + fr, col0 = u.pn * 128 + wc * 32 + 8 * fq;
#pragma unroll
        for (int ai = 0; ai < 2; ++ai)
#pragma unroll
            for (int m = 0; m < 4; ++m) { float o[8];
#pragma unroll
                for (int n = 0; n < 2; ++n)
#pragma unroll
                    for (int j = 0; j < 4; ++j) o[n * 4 + j] = siluf_(acc[ai][0][m][n][j] * osc) * (acc[ai][1][m][n][j] * osc);
                *(u32x2_t_*)((unsigned char*)O + (size_t)(row0 + ai * 128 + m * 16) * ldc + col0) = f8pack8(o); }
    }
};
struct EpiMoeDownF8 {
    static constexpr bool PERM = true; static constexpr bool F8 = true;
    h16* OUT2; const int* rowT; const float* rowP; h16* OUTP; int tail; float isc;
    __device__ __forceinline__ void operator()(EPI_ARGS) const {
        const int row0 = u.pm * 256 + wr * 64 + fr, col0 = u.pn * 256 + wc * 32 + 8 * fq;
#pragma unroll
        for (int ai = 0; ai < 2; ++ai)
#pragma unroll
            for (int m = 0; m < 4; ++m) { const int r = row0 + ai * 128 + m * 16; const int tk = rowT[r]; const float pp = rowP[r] * isc;
                if (tk < 0) continue;
                h16* rowp = tail ? OUTP + ((size_t)u.aux * 2048 + (r - 65536)) * 1024 + col0 : OUT2 + ((size_t)(tk & 1) * ML + (tk >> 1)) * 1024 + col0;
#pragma unroll
                for (int bj = 0; bj < 2; ++bj) { const f32x4 v0 = acc[ai][bj][m][0] * pp, v1 = acc[ai][bj][m][1] * pp;
                    u32x4 w; w.x = pg8::cvt_pk_f16(v0[0], v0[1]); w.y = pg8::cvt_pk_f16(v0[2], v0[3]); w.z = pg8::cvt_pk_f16(v1[0], v1[1]); w.w = pg8::cvt_pk_f16(v1[2], v1[3]);
                    *(u32x4*)(rowp + bj * 128) = w; } }
    }
};
struct EpiMoeDown {
    static constexpr bool PERM = true; static constexpr bool F8 = false;
    h16* OUT2; const int* rowT; const float* rowP; h16* OUTP; int tail;
    __device__ __forceinline__ void operator()(EPI_ARGS) const {
        const int row0 = u.pm * 256 + wr * 64 + fr, col0 = u.pn * 256 + wc * 32 + 8 * fq;
#pragma unroll
        for (int ai = 0; ai < 2; ++ai)
#pragma unroll
            for (int m = 0; m < 4; ++m) { const int r = row0 + ai * 128 + m * 16; const int tk = rowT[r]; const float pp = rowP[r];
                if (tk < 0) continue;
                h16* rowp = tail ? OUTP + ((size_t)u.aux * 2048 + (r - 65536)) * 1024 + col0 : OUT2 + ((size_t)(tk & 1) * ML + (tk >> 1)) * 1024 + col0;
#pragma unroll
                for (int bj = 0; bj < 2; ++bj) { const f32x4 v0 = acc[ai][bj][m][0] * pp, v1 = acc[ai][bj][m][1] * pp;
                    u32x4 w; w.x = pg8::cvt_pk_f16(v0[0], v0[1]); w.y = pg8::cvt_pk_f16(v0[2], v0[3]); w.z = pg8::cvt_pk_f16(v1[0], v1[1]); w.w = pg8::cvt_pk_f16(v1[2], v1[3]);
                    *(u32x4*)(rowp + bj * 128) = w; } }
    }
};

constexpr int LDS_BYTES = 147456;
constexpr size_t OFF_PRIV = OFF_BIG;
constexpr size_t OFF_YW = OFF_BIG;
__device__ __forceinline__ h16* S16_base(const Params& p, int l) { return l == 0 ? (h16*)p.out : (h16*)p.out - (size_t)MC * D; }
__device__ __forceinline__ h16* YW_base(const Params& p, int l) { return l == 0 ? WSP(h16, OFF_YW) : (h16*)p.out + (size_t)(ML - MC) * D; }
__device__ __forceinline__ void ph_gemm_in(const Params& p, LAS unsigned char* lds, int l, int G, int c) {
    SchedPlain S; S.A = (const char*)(WSP(h16, OFF_A) + AH); S.B = (const char*)WSP(h16, OFF_W16 + l * SZ_LAYERW); S.lda = AW; S.ldb = 1024; S.nt = 16; S.pm0 = 0; S.nM = MT / 256; S.nN = ZW / 256; S.G = G; S.c = c;
    EpiF16 E; E.O = WSP(h16, OFF_Z); E.ldc = ZW;
    pg8::gemm_phase(lds, AW, 1024, S, E);
}
__device__ __forceinline__ void ph_merge(const Params& p, LAS unsigned char* lds, int l, int pm0, int nM, int G, int c) {
    SchedMergeH S; S.A = (const char*)WSP(h16, OFF_A); S.B = (const char*)WSP(h16, OFF_W16 + l * SZ_LAYERW + SZ_WINT); S.pm0 = pm0; S.nM = nM; S.G = G; S.c = c;
    EpiMergeH E; E.G8 = WSP(unsigned char, OFF_G8); E.S16 = S16_base(p, l);
    pg8::gemm_phase_h(lds, AW, 1536, S, E);
}
__device__ __forceinline__ void ph_gates(const Params& p, LAS unsigned char* lds, int l, int pm0, int nM, int G, int c) {
    SchedPlain S; S.A = (const char*)WSP(unsigned char, OFF_H8); S.B = (const char*)(WSP(unsigned char, OFF_WG8) + (size_t)l * 3072 * 1024); S.lda = 512; S.ldb = 512; S.nt = 8; S.pm0 = pm0; S.nM = nM; S.nN = 12; S.G = G; S.c = c;
    EpiGateF8 E; E.G8 = WSP(unsigned char, OFF_G8); E.bmerge = p.b_merge + (size_t)l * 3 * 1024; E.isc = 1.0f / WGU_F8_SCALE;
    pg8::gemm_phase(lds, 512, 512, S, E);
}
__device__ __forceinline__ void ph_wout(const Params& p, LAS unsigned char* lds, int l, int pm0, int nM, int G, int c) {
    SchedPlain S; S.A = (const char*)S16_base(p, l); S.B = (const char*)WSP(h16, OFF_W16 + l * SZ_LAYERW + SZ_WINT + SZ_BTALL); S.lda = 1024; S.ldb = 1024; S.nt = 16; S.pm0 = pm0; S.nM = nM; S.nN = 4; S.G = G; S.c = c;
    EpiScaled E; E.Y = YW_base(p, l); E.modv = WSP(float, OFF_MOD) + (size_t)l * 9 * 6144 + 2 * 1024;
    pg8::gemm_phase(lds, 1024, 1024, S, E);
}
__device__ __forceinline__ void ph_ffn_gu(const Params& p, LAS unsigned char* lds, int pm0, int nM, int G, int c) {
    SchedPlain S; S.A = (const char*)(WSP(h16, OFF_A) + AH); S.B = (const char*)WSP(h16, OFF_WGUT); S.lda = AW; S.ldb = 512; S.nt = 8; S.pm0 = pm0; S.nM = nM; S.nN = 2 * DFF / 256; S.G = G; S.c = c;
    EpiSwigluF8 E; E.O = WSP(h16, OFF_ACT); E.ldc = DFF; E.orow0 = 0; E.osc = 1.0f / WGU_F8_SCALE;
    pg8::gemm_phase(lds, AW, 512, S, E);
}
__device__ __forceinline__ void ph_ffn_down(const Params& p, LAS unsigned char* lds, int pm0, int nM, int G, int c) {
    SchedPlain S; S.A = (const char*)WSP(h16, OFF_ACT); S.B = (const char*)WSP(h16, OFF_WDT); S.lda = DFF / 2; S.ldb = DFF / 2; S.nt = DFF / 128; S.pm0 = pm0; S.nM = nM; S.nN = 4; S.G = G; S.c = c;
    EpiScaledK2F8 E; E.Y = (h16*)p.out; E.Y2 = (h16*)p.out; E.modv = WSP(float, OFF_MOD) + 5 * 1024; E.isc = 1.0f / WD_F8_SCALE;
    pg8::gemm_phase(lds, DFF / 2, DFF / 2, S, E);
}
constexpr size_t OFF_Y2CTX = OFF_X + (size_t)MT * D * 2;
static_assert(OFF_H8 == OFF_Y2CTX + (size_t)MC * D * 2, "H8 follows the context Y2 partial");
__device__ __forceinline__ void ph_ffn_down_k2(const Params& p, LAS unsigned char* lds, int pm0, int nM, int G, int c) {
    SchedPlainK2 S; S.A = (const char*)WSP(h16, OFF_ACT); S.B = (const char*)WSP(h16, OFF_WDT); S.lda = DFF / 2; S.ldb = DFF / 2; S.nt = DFF / 128; S.pm0 = pm0; S.nM = nM; S.nN = 4; S.G = G; S.c = c;
    EpiScaledK2F8 E; E.Y = (h16*)p.out; E.Y2 = WSP(h16, OFF_Y2CTX); E.modv = WSP(float, OFF_MOD) + 5 * 1024; E.isc = 1.0f / WD_F8_SCALE;
    pg8::gemm_phase(lds, DFF / 2, DFF / 2, S, E);
}
__device__ __forceinline__ void ph_moe_gu(const Params& p, LAS unsigned char* lds, int panel0, int G, int c) {
    const int* plan = WSP(int, OFF_PLAN); const int np = plan[8]; int nM = np - panel0; nM = nM > 128 ? 128 : nM; if (nM <= 0) return;
    SchedMoe S; S.A = (const char*)WSP(h16, OFF_XG); S.B = (const char*)WSP(h16, OFF_WMOE_GU); S.panelE = plan + 16; S.lda = 512; S.ldb = 512; S.nt = 8; S.pm0 = panel0; S.arow_pm0 = 0; S.nM = nM; S.nN = 2 * DEX / 256; S.G = G; S.c = c; S.estride = (size_t)2 * DEX * 1024; S.ks_shift = 0;
    EpiSwigluF8 E; E.O = (h16*)p.out; E.ldc = DEX; E.orow0 = panel0 * 256; E.osc = 1.0f / WGU_F8_SCALE;
    pg8::gemm_phase(lds, 512, 512, S, E);
}
__device__ __forceinline__ void ph_moe_down(const Params& p, LAS unsigned char* lds, int panel0, int G, int c) {
    const int* plan = WSP(int, OFF_PLAN); const int np = plan[8]; int nM = np - panel0; nM = nM > 128 ? 128 : nM; if (nM <= 0) return;
    const int tail = panel0 >= 256;
    SchedMoe S; S.A = (const char*)p.out; S.B = (const char*)WSP(h16, OFF_WMOE_D); S.panelE = plan + 16; S.lda = DEX / 2; S.ldb = DEX / 2; S.nt = DEX / 128; S.pm0 = panel0; S.arow_pm0 = panel0; S.nM = nM; S.nN = 4; S.G = G; S.c = c; S.estride = (size_t)1024 * DEX; S.ks_shift = tail ? 1 : 0;
    EpiMoeDownF8 E; E.OUT2 = WSP(h16, OFF_OUT2); E.rowT = WSP(int, OFF_ROWT); E.rowP = WSP(float, OFF_ROWP); E.OUTP = WSP(h16, OFF_OUTP); E.tail = tail; E.isc = 1.0f / WD_F8_SCALE;
    pg8::gemm_phase(lds, DEX / 2, DEX / 2, S, E);
}

namespace attn_body {
using s16x4 = __attribute__((ext_vector_type(4))) short;
using s16x8 = __attribute__((ext_vector_type(8))) short;
using f32x16 = __attribute__((ext_vector_type(16))) float;
constexpr int D64 = 64, NW = 8, QBLK = 32, QB = QBLK * NW, KVBLK = 64;
constexpr int QP = 512, KP = 128, OP = AW;
__device__ __forceinline__ int crow(int r, int hi) { return (r & 3) + 8 * (r >> 2) + 4 * hi; }
#define SBAR() __builtin_amdgcn_sched_barrier(0)
constexpr int NSLOT = 3, SLOTB = 8192;
constexpr int LDS_K = 0, LDS_V = NSLOT * SLOTB, LDS_WS = 2 * NSLOT * SLOTB, LDS_OST = LDS_WS + NW * 64 * 4, ATTN_LDS_BYTES = LDS_OST + NW * 4096;
__device__ __forceinline__ void glds16(const void* gsrc, unsigned lds_dst) { unsigned keep;
    asm volatile("s_mov_b32 %0, m0\n\ts_mov_b32 m0, %2\n\ts_nop 0\n\tglobal_load_lds_dwordx4 %1, off\n\ts_mov_b32 m0, %0" : "=&s"(keep) : "v"(gsrc), "s"(lds_dst) : "memory"); }
__device__ __forceinline__ float max3f(float a, float b, float c) { float r; asm("v_max3_f32 %0, %1, %2, %3" : "=v"(r) : "v"(a), "v"(b), "v"(c)); return r; }
__device__ __forceinline__ float max2f(float a, float b) { float r; asm("v_max_f32_e32 %0, %1, %2" : "=v"(r) : "v"(a), "v"(b)); return r; }
__device__ __forceinline__ float fadd_s(float a, float b) { float r; asm("v_add_f32_e32 %0, %1, %2" : "=v"(r) : "v"(a), "v"(b)); return r; }
__device__ __forceinline__ float fsub_s(float a, float b) { float r; asm("v_sub_f32_e32 %0, %1, %2" : "=v"(r) : "v"(a), "v"(b)); return r; }
__device__ __forceinline__ unsigned cvtpk_s(float lo, float hi) { return pg8::cvt_pk_f16(lo, hi); }
#define WAIT_BAR(N) asm volatile("s_waitcnt vmcnt(" #N ") lgkmcnt(0)\n\ts_barrier" ::: "memory")
#define AMFMA(a, b, c) __builtin_amdgcn_mfma_f32_32x32x16_f16(__builtin_bit_cast(h16x8, a), __builtin_bit_cast(h16x8, b), c, 0, 0, 0)
__device__ __forceinline__ void qkt(f32x16& p0, f32x16& p1, const char* Kslot, const s16x8* qr, const f32x16& negm, int r32, int hi) {
    const char* kb = Kslot + hi * 1024 + r32 * 16;
#pragma unroll
    for (int d0 = 0; d0 < 4; ++d0) {
        const s16x8 b0 = *reinterpret_cast<const s16x8*>(kb + d0 * 2048);
        const s16x8 b1 = *reinterpret_cast<const s16x8*>(kb + d0 * 2048 + 512);
        if (d0 == 0) { p0 = AMFMA(b0, qr[0], negm); p1 = AMFMA(b1, qr[0], negm); }
        else { p0 = AMFMA(b0, qr[d0], p0); p1 = AMFMA(b1, qr[d0], p1); } }
}
typedef __attribute__((address_space(3))) const char* lds_cptr;
typedef short v4i16_t __attribute__((ext_vector_type(4)));
__device__ __forceinline__ void kload8(s16x8* kf, lds_cptr kp) {
    kf[0] = *(const __attribute__((address_space(3))) s16x8*)(kp);        kf[1] = *(const __attribute__((address_space(3))) s16x8*)(kp + 512);
    kf[2] = *(const __attribute__((address_space(3))) s16x8*)(kp + 2048); kf[3] = *(const __attribute__((address_space(3))) s16x8*)(kp + 2560);
    kf[4] = *(const __attribute__((address_space(3))) s16x8*)(kp + 4096); kf[5] = *(const __attribute__((address_space(3))) s16x8*)(kp + 4608);
    kf[6] = *(const __attribute__((address_space(3))) s16x8*)(kp + 6144); kf[7] = *(const __attribute__((address_space(3))) s16x8*)(kp + 6656);
}
__device__ __forceinline__ void kload2(s16x8* kf, lds_cptr kp, int j) { kf[2 * j] = *(const __attribute__((address_space(3))) s16x8*)(kp + j * 2048); kf[2 * j + 1] = *(const __attribute__((address_space(3))) s16x8*)(kp + j * 2048 + 512); }
__device__ __forceinline__ s16x4 vtr(lds_cptr p) { return __builtin_bit_cast(s16x4, __builtin_amdgcn_ds_read_tr16_b64_v4i16((__attribute__((address_space(3))) v4i16_t*)p)); }
__device__ __forceinline__ float rowmax(const f32x16& p0, const f32x16& p1) {
    float a = max3f(p0[0], p0[1], p1[0]), b = max3f(p0[2], p0[3], p1[1]); a = max3f(a, p1[2], p1[3]);
#pragma unroll
    for (int r = 4; r < 16; r += 4) { a = max3f(a, p0[r], p0[r + 1]); b = max3f(b, p0[r + 2], p0[r + 3]); a = max3f(a, p1[r], p1[r + 1]); b = max3f(b, p1[r + 2], p1[r + 3]); }
    const float m = max2f(a, b);
    auto rr = __builtin_amdgcn_permlane32_swap(__float_as_uint(m), __float_as_uint(m), false, false);
    return max2f(__uint_as_float(rr[0]), __uint_as_float(rr[1]));
}
__device__ __forceinline__ void pv(f32x16* o, int vb, s16x8 pa0, s16x8 pa1, s16x8 pa2, s16x8 pa3) {
#pragma unroll
    for (int d0 = 0; d0 < 2; ++d0) { s16x4 lo[4], hi[4];
#pragma unroll
        for (int ks = 0; ks < 4; ++ks) {
            asm volatile("ds_read_b64_tr_b16 %0,%1 offset:%c2" : "=&v"(lo[ks]) : "v"(vb), "i"(d0 * 4096 + ks * 1024) : "memory");
            asm volatile("ds_read_b64_tr_b16 %0,%1 offset:%c2" : "=&v"(hi[ks]) : "v"(vb), "i"(d0 * 4096 + ks * 1024 + 512) : "memory"); }
        asm volatile("s_waitcnt lgkmcnt(0)" ::: "memory"); SBAR();
#define PK(k) (s16x8){lo[k][0], lo[k][1], lo[k][2], lo[k][3], hi[k][0], hi[k][1], hi[k][2], hi[k][3]}
        o[d0] = AMFMA(pa0, PK(0), o[d0]);
        o[d0] = AMFMA(pa1, PK(1), o[d0]);
        o[d0] = AMFMA(pa2, PK(2), o[d0]);
        o[d0] = AMFMA(pa3, PK(3), o[d0]);
#undef PK
    }
}
template <int THRL> __device__ __forceinline__ void attn_unit(const h16* Qu, const h16* __restrict__ Ku, const h16* __restrict__ Vu, h16* Ou, const int NT, char* shm) {
    const int tid = threadIdx.x, lane = tid & 63, r32 = lane & 31, hi = lane >> 5; const int wid = __builtin_amdgcn_readfirstlane(tid >> 6);
    const h16* Qw = Qu + (size_t)(wid * QBLK) * QP;
    const unsigned lds0 = (unsigned)(uintptr_t)shm;
    float* wsf = (float*)(shm + LDS_WS) + wid * 64;
    const h16* ksrc = Ku + (long)lane * KP + wid * 8;
    const h16* vsrc = Vu + (long)(16 * (wid & 3) + (lane >> 2)) * KP + (wid >> 2) * 32 + (lane & 3) * 8;
    const unsigned kdst = lds0 + LDS_K + wid * 1024, vdst = lds0 + LDS_V + wid * 1024;
#define DMA_K(t, slot) glds16(ksrc + (long)(t) * KVBLK * KP, (unsigned)__builtin_amdgcn_readfirstlane(kdst + (slot)))
#define DMA_V(t, slot) glds16(vsrc + (long)(t) * KVBLK * KP, (unsigned)__builtin_amdgcn_readfirstlane(vdst + (slot)))
    const int vb0 = (int)(lds0 + LDS_V) + ((lane >> 4) & 1) * 32 + (lane & 3) * 8 + (4 * hi + ((lane & 15) >> 2)) * 64;
    const char* Kbase = shm + LDS_K; s16x8 kf[8];
    const lds_cptr shm3 = (lds_cptr)shm; const lds_cptr kp0 = shm3 + LDS_K + hi * 1024 + r32 * 16; const lds_cptr vp0 = shm3 + LDS_V + ((lane >> 4) & 1) * 32 + (lane & 3) * 8 + (4 * hi + ((lane & 15) >> 2)) * 64;
    DMA_K(0, 0); DMA_V(0, 0); DMA_K(1, SLOTB);
    s16x8 qr[4];
#pragma unroll
    for (int d0 = 0; d0 < 4; ++d0) qr[d0] = *reinterpret_cast<const s16x8*>(&Qw[(long)r32 * QP + d0 * 16 + hi * 8]);
    float mhat = 0.f, l_reg = 0.f; f32x16 o[2]; o[0] = f32x16{}; o[1] = f32x16{}; f32x16 negm = f32x16{}; asm volatile("" : "+v"(negm));
    bool resc = false;
#define START(P0, P1) do { const float rm = rowmax(P0, P1); resc = false; \
    { const float dl = rm; mhat = fadd_s(mhat, dl); \
      _Pragma("unroll") for (int r = 0; r < 16; ++r) { P0[r] = fsub_s(P0[r], dl); P1[r] = fsub_s(P1[r], dl); } \
      _Pragma("unroll") for (int r = 0; r < 16; ++r) negm[r] = -mhat; asm volatile("" : "+v"(negm)); } \
    _Pragma("unroll") for (int r = 0; r < 16; ++r) P0[r] = __builtin_amdgcn_exp2f(P0[r]); } while (0)
#define RESC() do { if (resc) { asm volatile("s_waitcnt lgkmcnt(0)" ::: "memory"); \
      _Pragma("unroll") for (int d_ = 0; d_ < 2; ++d_) _Pragma("unroll") for (int r = 0; r < 16; ++r) o[d_][r] *= wsf[crow(r, hi)]; } } while (0)
    f32x16 pA0, pA1, pB0, pB1;
    int sl_prev = 0, sl_cur = 0, sl_next = SLOTB;
#define ROT() do { sl_prev = sl_cur; sl_cur = sl_next; sl_next = (sl_next == (NSLOT - 1) * SLOTB) ? 0 : sl_next + SLOTB; } while (0)
    DMA_K(2, 2 * SLOTB);
    WAIT_BAR(3);
    qkt(pA0, pA1, Kbase, qr, negm, r32, hi); asm volatile("s_nop 15\n\ts_nop 7" : "+v"(pA0), "+v"(pA1));
    START(pA0, pA1);
    _Pragma("unroll") for (int r = 0; r < 16; ++r) pA1[r] = __builtin_amdgcn_exp2f(pA1[r]);
    WAIT_BAR(0);
    DMA_K(3, 0); DMA_V(1, SLOTB);
    ROT();
    kload8(kf, kp0 + sl_cur);
    WAIT_BAR(2);
    s16x4 vlo[8], vhi[8]; u32x4 pw0, pw1, pw2, pw3;
#define PKW(P, B) cvtpk_s(P[B], P[B + 1])
#define PAF(k) __builtin_bit_cast(s16x8, pw##k)
#define VFR(i) (s16x8){vlo[i][0], vlo[i][1], vlo[i][2], vlo[i][3], vhi[i][0], vhi[i][1], vhi[i][2], vhi[i][3]}
#define PIN(x) asm volatile("" : "+v"(x))
#define MX3(a, b, c) __builtin_fmaxf(__builtin_fmaxf((a), (b)), (c))
#define GAPA(MF, A0, A1, A2, A3, W0, W1, PW) do { MF; sacc += A0; sacc += A1; sacc += A2; sacc += A3; PIN(sacc); W0; W1; PIN(PW); SBAR(); } while (0)
#define EX(v) __builtin_amdgcn_exp2f(v)
#define GAPB(MF, X, B) do { MF; X[B] = EX(X[B]); X[B + 1] = EX(X[B + 1]); X[B + 2] = EX(X[B + 2]); X[B + 3] = EX(X[B + 3]); PIN(X); SBAR(); } while (0)
#define VRD(i) do { vlo[i] = vtr(vp_ + (((i) >> 2) * 4096 + ((i) & 3) * 1024)); vhi[i] = vtr(vp_ + (((i) >> 2) * 4096 + ((i) & 3) * 1024 + 512)); } while (0)
#define KRD(G, j) do { if (G) { kload2(kf, kp0 + sl_next, j); SBAR(); } } while (0)
#define STEP(C0, C1, P0, P1, t, GK, GV, GL) do { SBAR(); \
    const lds_cptr vp_ = vp0 + sl_prev; \
    VRD(0); SBAR(); float sacc = (P0[0] + P0[1]); \
    GAPA(C0 = AMFMA(kf[0], qr[0], negm), P0[2], P0[3], P0[4], P0[5],     pw0[0] = PKW(P0, 0), pw0[1] = PKW(P0, 2), pw0); \
    VRD(4); SBAR(); GAPA(C1 = AMFMA(kf[1], qr[0], negm), P0[6], P0[7], P0[8], P0[9],     pw0[2] = PKW(P0, 4), pw0[3] = PKW(P0, 6), pw0); \
    VRD(1); SBAR(); GAPA(C0 = AMFMA(kf[2], qr[1], C0),   P0[10], P0[11], P0[12], P0[13], pw1[0] = PKW(P0, 8), pw1[1] = PKW(P0, 10), pw1); \
    VRD(5); SBAR(); GAPA(C1 = AMFMA(kf[3], qr[1], C1),   P0[14], P0[15], P1[0], P1[1],   pw1[2] = PKW(P0, 12), pw1[3] = PKW(P0, 14), pw1); \
    VRD(2); SBAR(); GAPA(C0 = AMFMA(kf[4], qr[2], C0),   P1[2], P1[3], P1[4], P1[5],     pw2[0] = PKW(P1, 0), pw2[1] = PKW(P1, 2), pw2); \
    VRD(6); SBAR(); GAPA(C1 = AMFMA(kf[5], qr[2], C1),   P1[6], P1[7], P1[8], P1[9],     pw2[2] = PKW(P1, 4), pw2[3] = PKW(P1, 6), pw2); \
    VRD(3); SBAR(); GAPA(C0 = AMFMA(kf[6], qr[3], C0),   P1[10], P1[11], P1[12], P1[13], pw3[0] = PKW(P1, 8), pw3[1] = PKW(P1, 10), pw3); \
    VRD(7); SBAR(); GAPA(C1 = AMFMA(kf[7], qr[3], C1),   P1[14], P1[15], 0.f, 0.f,       pw3[2] = PKW(P1, 12), pw3[3] = PKW(P1, 14), pw3); \
    l_reg += sacc; \
    if (GK) { DMA_K((t) + 3, sl_cur); } if (GV) { DMA_V((t) + 1, sl_next); } \
    { float a = MX3(C0[0], C0[1], C1[0]), b = MX3(C0[2], C0[3], C1[1]); a = MX3(a, C1[2], C1[3]); \
      _Pragma("unroll") for (int r = 4; r < 16; r += 4) { a = MX3(a, C0[r], C0[r + 1]); b = MX3(b, C0[r + 2], C0[r + 3]); a = MX3(a, C1[r], C1[r + 1]); b = MX3(b, C1[r + 2], C1[r + 3]); } \
      float rm = __builtin_fmaxf(a, b); { auto rr = __builtin_amdgcn_permlane32_swap(__float_as_uint(rm), __float_as_uint(rm), false, false); rm = __builtin_fmaxf(__uint_as_float(rr[0]), __uint_as_float(rr[1])); } \
      resc = false; \
      if (__builtin_expect(__any(rm > (float)THRL), 0)) { const float dl = __builtin_fmaxf(rm, 0.f); mhat += dl; \
        _Pragma("unroll") for (int r = 0; r < 16; ++r) { C0[r] -= dl; C1[r] -= dl; } \
        _Pragma("unroll") for (int r = 0; r < 16; ++r) negm[r] = -mhat; asm volatile("" : "+v"(negm)); \
        const float f = __builtin_amdgcn_exp2f(-dl); l_reg *= f; if (hi == 0) wsf[r32] = f; resc = true; } } \
    SBAR(); \
    GAPB(o[0] = AMFMA(PAF(0), VFR(0), o[0]), C0, 0); \
    GAPB(o[1] = AMFMA(PAF(0), VFR(4), o[1]), C0, 4); \
    KRD(GL, 0); GAPB(o[0] = AMFMA(PAF(1), VFR(1), o[0]), C0, 8); \
    KRD(GL, 1); GAPB(o[1] = AMFMA(PAF(1), VFR(5), o[1]), C0, 12); \
    KRD(GL, 2); GAPB(o[0] = AMFMA(PAF(2), VFR(2), o[0]), C1, 0); \
    KRD(GL, 3); GAPB(o[1] = AMFMA(PAF(2), VFR(6), o[1]), C1, 4); \
    GAPB(o[0] = AMFMA(PAF(3), VFR(3), o[0]), C1, 8); \
    GAPB(o[1] = AMFMA(PAF(3), VFR(7), o[1]), C1, 12); \
    } while (0)
    int t = 1;
    for (; t + 5 < NT; t += 2) {
        STEP(pB0, pB1, pA0, pA1, t, true, true, true);     WAIT_BAR(2); RESC(); ROT();
        STEP(pA0, pA1, pB0, pB1, t + 1, true, true, true); WAIT_BAR(2); RESC(); ROT();
    }
#define ENDW(tt) do { if ((tt) + 3 < NT) { WAIT_BAR(2); } else if ((tt) + 2 < NT) { WAIT_BAR(1); } else { WAIT_BAR(0); } } while (0)
    for (; t + 1 < NT; t += 2) {
        STEP(pB0, pB1, pA0, pA1, t, (t + 3 < NT), (t + 1 < NT), (t + 1 < NT));         ENDW(t);     RESC(); ROT();
        STEP(pA0, pA1, pB0, pB1, t + 1, (t + 4 < NT), (t + 2 < NT), (t + 2 < NT));     ENDW(t + 1); RESC(); ROT();
    }
    STEP(pB0, pB1, pA0, pA1, NT - 1, false, false, false); RESC();
    { float sacc = pB0[0] + pB0[1]; _Pragma("unroll") for (int r = 2; r < 16; ++r) sacc += pB0[r]; _Pragma("unroll") for (int r = 0; r < 16; ++r) sacc += pB1[r]; l_reg += sacc;
      pw0 = (u32x4){PKW(pB0, 0), PKW(pB0, 2), PKW(pB0, 4), PKW(pB0, 6)}; pw1 = (u32x4){PKW(pB0, 8), PKW(pB0, 10), PKW(pB0, 12), PKW(pB0, 14)}; pw2 = (u32x4){PKW(pB1, 0), PKW(pB1, 2), PKW(pB1, 4), PKW(pB1, 6)}; pw3 = (u32x4){PKW(pB1, 8), PKW(pB1, 10), PKW(pB1, 12), PKW(pB1, 14)};
      SBAR(); pv(o, vb0 + sl_cur, PAF(0), PAF(1), PAF(2), PAF(3)); }
#undef PKW
#undef PAF
#undef VFR
#undef PIN
#undef MX3
#undef GAPA
#undef GAPB
#undef EX
#undef VRD
#undef KRD
#undef STEP
#undef ENDW
    { auto rr = __builtin_amdgcn_permlane32_swap(__float_as_uint(l_reg), __float_as_uint(l_reg), false, false); l_reg = __uint_as_float(rr[0]) + __uint_as_float(rr[1]); }
    if (hi == 0) wsf[32 + r32] = l_reg; asm volatile("s_waitcnt lgkmcnt(0)" ::: "memory");
    float rli[16];
#pragma unroll
    for (int r = 0; r < 16; ++r) rli[r] = __builtin_amdgcn_rcpf(wsf[32 + crow(r, hi)]);
    h16* Ow = Ou + (size_t)(wid * QBLK) * OP;
    { h16* stg = (h16*)(shm + LDS_OST) + wid * 2048;
#pragma unroll
      for (int r = 0; r < 16; ++r) { const int orow = crow(r, hi);
#pragma unroll
        for (int d0 = 0; d0 < 2; ++d0) stg[orow * 64 + d0 * 32 + r32] = (h16)(o[d0][r] * rli[r]); }
      asm volatile("s_waitcnt lgkmcnt(0)" ::: "memory");
#pragma unroll
      for (int i = 0; i < 4; ++i) { const int row = i * 8 + (lane >> 3), ch = lane & 7; const u32x4 v = *(const u32x4*)(stg + row * 64 + ch * 8); *(u32x4*)(Ow + (long)row * OP + ch * 8) = v; } }
    asm volatile("s_waitcnt lgkmcnt(0)\n\ts_barrier" ::: "memory");
#undef DMA_K
#undef DMA_V
#undef START
#undef RESC
#undef ROT
}
#undef SBAR
#undef WAIT_BAR
#undef AMFMA
}

__device__ __forceinline__ void ph_attn(const Params& p, char* shm, int l, int G, int c) {
    const h16* Qh = WSP(h16, OFF_QH); const h16* Kh = WSP(h16, OFF_KH); const h16* Vh = WSP(h16, OFF_VH); h16* A = WSP(h16, OFF_A);
    const int x = c & 7, j0 = c >> 3, nx = (G + 7 - x) >> 3;
    for (int j = j0; j < 128; j += nx) {
        const int set = 2 * x + (j >> 6), un = j & 63, b = set >> 1, kvh = set & 1, hq = kvh * 4 + (un >> 4), qb = un & 15;
        const size_t qrow = (size_t)MC + (size_t)b * SEQ + (size_t)qb * 256;
        attn_body::attn_unit<8>(Qh + qrow * 512 + hq * 64, Kh + (size_t)b * SB * 128 + kvh * 64, Vh + (size_t)b * SB * 128 + kvh * 64, A + qrow * AW + AY1 + hq * 64, SB / 64, shm);
    }
    if (l == 0) for (int u = c; u < 64; u += G) {
        const int b = u >> 3, hq = u & 7, kvh = hq >> 2; const size_t qrow = (size_t)b * CTX;
        attn_body::attn_unit<8>(Qh + qrow * 512 + hq * 64, Kh + (size_t)b * SB * 128 + kvh * 64, Vh + (size_t)b * SB * 128 + kvh * 64, A + qrow * AW + AY1 + hq * 64, CTX / 64, shm);
    }
}

#define XB_TMO      128
#define XB_XCNT(j)  (256  + 64 * (j))
#define XB_XSUB(j)  (1280 + 64 * (j))
#define XB_XGEN(j)  (2304 + 64 * (j))
#define XB_TOP      3328
#define XB_TOPGEN   3392
#define XCD_BAR_WORDS 3456
#define XB_SPIN_CAP (1u << 18)
__device__ __forceinline__ unsigned xb_ld(unsigned* p)              { return __hip_atomic_load(p, __ATOMIC_RELAXED, __HIP_MEMORY_SCOPE_AGENT); }
__device__ __forceinline__ unsigned xb_add(unsigned* p, unsigned v) { return __hip_atomic_fetch_add(p, v, __ATOMIC_RELAXED, __HIP_MEMORY_SCOPE_AGENT); }
__device__ __forceinline__ unsigned xb_xcc_id() { return (unsigned)__builtin_amdgcn_s_getreg((3 << 11) | 20) & 0xFu; }
#define XB_SPIN(cond, bar) do { unsigned _sp = 0; while (cond) { __builtin_amdgcn_s_sleep(1); \
    if ((++_sp & 255u) == 0u) { if (xb_ld(&(bar)[XB_TMO])) break; if (_sp > XB_SPIN_CAP) { atomicAdd(&(bar)[XB_TMO], 1u); break; } } } } while (0)
struct XcdBarrier { unsigned* bar; unsigned x; volatile LAS unsigned* st; };
__device__ __forceinline__ XcdBarrier xcd_barrier_post(unsigned* bar, volatile LAS unsigned* st) {
    XcdBarrier b; b.bar = bar; b.x = xb_xcc_id(); b.st = st;
    if (threadIdx.x == 0) (void)xb_add(&bar[XB_XCNT(b.x)], 1u);
    return b;
}
__device__ __forceinline__ void xcd_barrier_complete(unsigned* bar, unsigned x, unsigned& nloc, unsigned& nx) {
    const unsigned G = gridDim.x * gridDim.y * gridDim.z;
    unsigned sum, cnt, mine, sp = 0u;
    for (;;) {
        sum = 0u; cnt = 0u; mine = 0u;
#pragma unroll
        for (unsigned j = 0; j < 16; ++j) { const unsigned c = xb_ld(&bar[XB_XCNT(j)]); sum += c; cnt += (c > 0u) ? 1u : 0u; mine = (j == x) ? c : mine; }
        if (sum == G) break;
        __builtin_amdgcn_s_sleep(1);
        if ((++sp & 255u) == 0u) { if (xb_ld(&bar[XB_TMO])) break; if (sp > XB_SPIN_CAP) { atomicAdd(&bar[XB_TMO], 1u); break; } }
    }
    nloc = mine > 0u ? mine : 1u; nx = cnt > 0u ? cnt : 1u;
}
__device__ __forceinline__ void xcd_barrier(const XcdBarrier& b) {
    asm volatile("s_waitcnt vmcnt(0)" ::: "memory");
    __syncthreads();
    if (threadIdx.x == 0) {
        unsigned* bar = b.bar;
        __builtin_amdgcn_s_waitcnt(0);
        unsigned nloc = b.st[0], nx = b.st[1];
        if (nloc == 0u) { xcd_barrier_complete(bar, b.x, nloc, nx); b.st[0] = nloc; b.st[1] = nx; }
        const unsigned old = xb_add(&bar[XB_XSUB(b.x)], 1u);
        const unsigned gen = old / nloc;
        if (old + 1u == (gen + 1u) * nloc) {
            __builtin_amdgcn_fence(__ATOMIC_RELEASE, "agent");
            asm volatile("s_waitcnt vmcnt(0)" ::: "memory");
            const unsigned og = xb_add(&bar[XB_TOP], 1u);
            const unsigned tg = og / nx;
            if (og + 1u == (tg + 1u) * nx) xb_add(&bar[XB_TOPGEN], 1u);
            else XB_SPIN(xb_ld(&bar[XB_TOPGEN]) == tg, bar);
            __builtin_amdgcn_fence(__ATOMIC_ACQUIRE, "agent");
            xb_add(&bar[XB_XGEN(b.x)], 1u);
            asm volatile("s_waitcnt vmcnt(0)" ::: "memory");
        } else {
            XB_SPIN(xb_ld(&bar[XB_XGEN(b.x)]) == gen, bar);
            __builtin_amdgcn_fence(__ATOMIC_ACQUIRE, "agent");
            asm volatile("s_waitcnt vmcnt(0)" ::: "memory");
        }
    }
    __syncthreads();
}

constexpr int NTH = 512;
template <int NT> __device__ __forceinline__ void poolfold_unit(const Params& p, int u, float (*Ws)[132]) {
    const int l = u >> 7, g = (u >> 5) & 3, k0 = (u & 31) * 32, tid = threadIdx.x;
    const float* pw = p.pool_w + (size_t)(l * 4 + g) * 128 * 128;
    const int jj = tid & 127;
    h16* ot = (h16*)((char*)Ws + 32768);
    __syncthreads();
    for (int i = tid; i < 32 * 32; i += NT) *(float4*)&Ws[i >> 5][(i & 31) * 4] = *(const float4*)(p.w_in + (size_t)l * 1024 * WIN + (size_t)(k0 + (i >> 5)) * WIN + g * 128 + (i & 31) * 4);
    __syncthreads();
    constexpr int NKK = 32 / (NT / 128);
    float acc[NKK];
#pragma unroll
    for (int q = 0; q < NKK; ++q) acc[q] = 0.f;
#pragma unroll 1
    for (int hf = 0; hf < 2; ++hf) {
        float pcol[64];
#pragma unroll
        for (int c2 = 0; c2 < 64; ++c2) pcol[c2] = pw[(hf * 64 + c2) * 128 + jj];
#pragma unroll
        for (int q = 0; q < NKK; ++q) { const int kk = (tid >> 7) + q * (NT / 128);
#pragma unroll
            for (int c4 = 0; c4 < 16; ++c4) { const float4 w4 = *(const float4*)&Ws[kk][hf * 64 + c4 * 4]; acc[q] += w4.x * pcol[c4 * 4] + w4.y * pcol[c4 * 4 + 1] + w4.z * pcol[c4 * 4 + 2] + w4.w * pcol[c4 * 4 + 3]; } }
    }
    h16* wint = WSP(h16, OFF_W16 + l * SZ_LAYERW);
    const float sc = p.pool_scale[l * 512 + g * 128 + jj];
#pragma unroll
    for (int q = 0; q < NKK; ++q) { const int kk = (tid >> 7) + q * (NT / 128); ot[jj * 40 + kk] = (h16)(acc[q] * sc); }
    __syncthreads();
    { const int row = tid >> 2, ch = tid & 3; const u32x4 v = *(const u32x4*)(ot + row * 40 + ch * 8); *(u32x4*)(wint + (size_t)(g * 128 + row) * 1024 + k0 + ch * 8) = v; }
    __syncthreads();
}
__device__ __forceinline__ void cvt_jobs(const Params& p, int j0, int j1, int ubase, int G, int c, float (*tile)[129]) {
    int base = ubase; bool pend = false; CvtJob qp = get_job(p, j0); int tp = 0; float4 v[8];
    for (int j = j0; j < j1; ++j) {
        const CvtJob q = get_job(p, j); const int nt = job_tiles(q);
        const int first = ((c - base % G) + G) % G;
        base += nt;
        for (int t = first; t < nt; t += G) {
            float4 w[8]; cvt_load(q, t, w);
            if (pend) cvt_store(qp, tp, v, tile);
#pragma unroll
            for (int i = 0; i < 8; ++i) v[i] = w[i];
            qp = q; tp = t; pend = true;
        }
    }
    if (pend) cvt_store(qp, tp, v, tile);
}
__device__ __forceinline__ void lru_wt_prep(const Params& p, int G, int c);
__device__ __forceinline__ void ph_prologue(const Params& p, char* shm, int G, int c) {
    if (c == 0 && threadIdx.x < 32) WSP(int, OFF_CNT)[threadIdx.x] = 0;
    for (int u = c; u < 192; u += G) mod_unit<NTH>(p, u, (float*)shm, (float*)shm + 9 * 1024);
    lru_wt_prep(p, G, (c + 64) % G);
}
__device__ __forceinline__ void ph_h0(const Params& p, char* shm, int G, int c) {
    const float* mod = WSP(float, OFF_MOD); h16* A = WSP(h16, OFF_A); unsigned char* H8 = WSP(unsigned char, OFF_H8); const int tid = threadIdx.x, lane = tid & 63, wv = tid >> 6;
    const int nfull = MT / (G * 32);
#define H0_ROWS(NR, rbase) do { float4 xv[NR][4]; \
        _Pragma("unroll") for (int q = 0; q < NR; ++q) { const float* xr = xin_row(p, (rbase) + q); \
            _Pragma("unroll") for (int i = 0; i < 4; ++i) xv[q][i] = *(const float4*)(xr + i * 256 + lane * 4); } \
        _Pragma("unroll") for (int q = 0; q < NR; ++q) { const int g = row_group((rbase) + q); \
            _Pragma("unroll") for (int i = 0; i < 4; ++i) { const int d = i * 256 + lane * 4; const float4 m0 = *(const float4*)(mod + (size_t)g * 6144 + d), m1 = *(const float4*)(mod + (size_t)g * 6144 + 1024 + d); \
                const float h0_ = xv[q][i].x * (1.f + m1.x) + m0.x, h1_ = xv[q][i].y * (1.f + m1.y) + m0.y, h2_ = xv[q][i].z * (1.f + m1.z) + m0.z, h3_ = xv[q][i].w * (1.f + m1.w) + m0.w; \
                h16x4 o; o[0] = (h16)h0_; o[1] = (h16)h1_; o[2] = (h16)h2_; o[3] = (h16)h3_; \
                *(h16x4*)(A + (size_t)((rbase) + q) * AW + AH + d) = o; \
                *(int*)(H8 + (size_t)((rbase) + q) * 1024 + d) = f8pack4(h0_, h1_, h2_, h3_); } } } while (0)
    for (int trip = 0; trip < nfull; ++trip) { const int r = (trip * G + c) * 32 + wv * 4; H0_ROWS(4, r); }
    for (int r = nfull * G * 32 + c * 8 + wv; r < MT; r += G * 8) H0_ROWS(1, r);
#undef H0_ROWS
    for (int u = c; u < 256; u += G) poolfold_unit<NTH>(p, u, (float (*)[132])shm);
    cvt_jobs(p, 0, NJOBS_SMALL, 0, G, c, (float (*)[129])shm);
}
constexpr int ROPE_LDS = 138496;
__device__ __forceinline__ void rope_table(char* shm) {
    float2* tab = (float2*)(shm + ROPE_LDS);
    for (int i = threadIdx.x; i < 1024; i += NTH) { const float inv = exp2f(-(float)(i & 15) * (13.287712379549449f / 16.0f)); float sn, cs; sincosf((float)(i >> 4) * inv, &sn, &cs); tab[i] = make_float2(cs, sn); }
}
__device__ __forceinline__ void qkv_block(const Params& p, char* shm, int l, int rbase) {
    const h16* Z = WSP(h16, OFF_Z); h16* Qh = WSP(h16, OFF_QH); h16* Kh = WSP(h16, OFF_KH); h16* Vh = WSP(h16, OFF_VH);
    const int tid = threadIdx.x, lane = tid & 63, wv = tid >> 6;
    const float2* tab = (const float2*)(shm + ROPE_LDS);
    const int L = lane & 7, j0 = (L & 1) * 8;
    float qn[8], kn[8];
#pragma unroll
    for (int e = 0; e < 8; ++e) { qn[e] = p.q_norm[l * 64 + L * 8 + e] * QSCALE; kn[e] = p.k_norm[l * 64 + L * 8 + e]; }
    for (int r0 = rbase + wv * 8; r0 < rbase + wv * 8 + 8; r0 += 2) {
        h16x8 qv[2], kv[2];
#pragma unroll
        for (int q = 0; q < 2; ++q) { const int r = r0 + q; qv[q] = *(const h16x8*)(Z + (size_t)r * ZW + ZQ + lane * 8); kv[q] = *(const h16x8*)(Z + (size_t)r * ZW + ZK + (lane & 31) * 8); }
#pragma unroll
        for (int q = 0; q < 2; ++q) {
            const int r = r0 + q; int s0, len, pos; row_seq(r, s0, len, pos);
            const bool lat = r >= MC; const int b = lat ? (r - MC) >> 12 : r >> 8; const size_t krow = (size_t)b * SB + (lat ? CTX + pos : pos);
            const int tp = (L < 4) ? (pos >> 6) : (pos & 63);
            float cs[8], sn[8];
#pragma unroll
            for (int e = 0; e < 8; ++e) { const float2 t = tab[tp * 16 + j0 + e]; cs[e] = lat ? t.x : 1.f; sn[e] = lat ? t.y : 0.f; }
            { float y[8], ss = 0.f;
#pragma unroll
              for (int e = 0; e < 8; ++e) { y[e] = (float)qv[q][e]; ss += y[e] * y[e]; }
              ss += __shfl_xor(ss, 1); ss += __shfl_xor(ss, 2); ss += __shfl_xor(ss, 4);
              const float rs = rsqrtf(ss * (1.0f / 64.0f) + 1e-6f); h16x8 o;
#pragma unroll
              for (int e = 0; e < 8; ++e) { y[e] *= rs * qn[e]; }
#pragma unroll
              for (int e = 0; e < 8; ++e) { const float yp = __shfl_xor(y[e], 2); o[e] = (h16)((L & 2) ? (y[e] * cs[e] + yp * sn[e]) : (y[e] * cs[e] - yp * sn[e])); }
              *(h16x8*)(Qh + (size_t)r * 512 + lane * 8) = o; }
            { float y[8], ss = 0.f;
#pragma unroll
              for (int e = 0; e < 8; ++e) { y[e] = (float)kv[q][e]; ss += y[e] * y[e]; }
              ss += __shfl_xor(ss, 1); ss += __shfl_xor(ss, 2); ss += __shfl_xor(ss, 4);
              const float rs = rsqrtf(ss * (1.0f / 64.0f) + 1e-6f); h16x8 o;
#pragma unroll
              for (int e = 0; e < 8; ++e) { y[e] *= rs * kn[e]; }
#pragma unroll
              for (int e = 0; e < 8; ++e) { const float yp = __shfl_xor(y[e], 2); o[e] = (h16)((L & 2) ? (y[e] * cs[e] + yp * sn[e]) : (y[e] * cs[e] - yp * sn[e])); }
              if (lane < 16) *(h16x8*)(Kh + krow * 128 + lane * 8) = o;
              else if (lane < 32) *(h16x8*)(Vh + krow * 128 + (lane - 16) * 8) = kv[q]; }
        }
    }
}
template <int W> __device__ __forceinline__ void pool_slice(const h16* Z, h16* A, int s0, int len, int p0, int col) {
    constexpr int NR = 8 + W - 1;
    h16x8 v[NR];
#pragma unroll
    for (int i = 0; i < NR; ++i) { const int pos = p0 - W / 2 + i; h16x8 z8 = {0, 0, 0, 0, 0, 0, 0, 0}; if (pos >= 0 && pos < len) z8 = *(const h16x8*)(Z + (size_t)(s0 + pos) * ZW + ZP + col); v[i] = z8; }
#pragma unroll
    for (int tt = 0; tt < 8; ++tt) {
        const int lo = p0 + tt - W / 2, a = lo < 0 ? 0 : lo, e = (lo + W) > len ? len : (lo + W); const float icnt = 1.0f / (float)(e - a);
        h16x8 o;
#pragma unroll
        for (int j = 0; j < 8; ++j) { float s = 0.f;
#pragma unroll
            for (int i = 0; i < W; ++i) s += (float)v[tt + i][j];
            o[j] = (h16)(s * icnt - (float)v[tt + W / 2][j]); }
        *(h16x8*)(A + (size_t)(s0 + p0 + tt) * AW + AY0 + col) = o;
    }
}
__device__ __forceinline__ void pool_block(const Params& p, int r0) {
    const h16* Z = WSP(h16, OFF_Z); h16* A = WSP(h16, OFF_A);
    const int tid = threadIdx.x, lane = tid & 63, wv = __builtin_amdgcn_readfirstlane(tid >> 6), g = wv & 3;
    const int col = g * 128 + (lane & 15) * 8, ts = (wv >> 2) * 4 + (lane >> 4);
    int s0, len, pos; row_seq(r0, s0, len, pos);
    const int p0 = pos + ts * 8;
    if (g == 0) pool_slice<2>(Z, A, s0, len, p0, col);
    else if (g == 1) pool_slice<4>(Z, A, s0, len, p0, col);
    else if (g == 2) pool_slice<8>(Z, A, s0, len, p0, col);
    else pool_slice<16>(Z, A, s0, len, p0, col);
}
template <int NR> __device__ __forceinline__ void ph_ln(const Params& p, char* shm, int mode, int r_begin, int r_end, const float* __restrict__ gam, const float* __restrict__ bet, int lm, int sh, int sc, const h16* __restrict__ Yb, bool from_input, int G, int c, const h16* __restrict__ Yb2 = nullptr, bool h8 = false, unsigned char* h8c = nullptr) {
    h16* X = WSP(h16, OFF_X); h16* A = WSP(h16, OFF_A); const float* mod = WSP(float, OFF_MOD) + (size_t)lm * 9 * 6144;
    const int lane = threadIdx.x & 63, wv = threadIdx.x >> 6;
    int* lcnt = (int*)shm; int* lbase = lcnt + 8; int* lrank = lcnt + 16;
    float* rtT = (float*)(shm + 4096);
    if (mode == 1) { __syncthreads(); if (threadIdx.x < 8) lcnt[threadIdx.x] = 0;
        for (int i = threadIdx.x; i < 8192; i += NTH) rtT[(i & 7) * 1024 + (i >> 3)] = p.moe_router[i];
        __syncthreads(); }
    int trip = 0;
    const bool hoist = true;
    float gmr[16], ber[16], shr[16], scr[16]; int gcur = -1;
    if (hoist) {
#pragma unroll
        for (int i = 0; i < 4; ++i) { const float4 gg = *(const float4*)(gam + i * 256 + lane * 4), bb = *(const float4*)(bet + i * 256 + lane * 4);
            gmr[i * 4] = gg.x; gmr[i * 4 + 1] = gg.y; gmr[i * 4 + 2] = gg.z; gmr[i * 4 + 3] = gg.w; ber[i * 4] = bb.x; ber[i * 4 + 1] = bb.y; ber[i * 4 + 2] = bb.z; ber[i * 4 + 3] = bb.w; }
    }
    for (int r0 = r_begin + c * (8 * NR) + wv * NR; r0 < r_end; r0 += G * (8 * NR), ++trip) {
        if (hoist) { const int g0 = __builtin_amdgcn_readfirstlane(row_group(r0));
            if (g0 != gcur) { gcur = g0;
                const float* ma = mode == 2 ? WSP(float, OFF_MOD) + (size_t)(1 * 9 + g0) * 6144 + 5 * 1024 : mod + (size_t)g0 * 6144 + sh * 1024;
                const float* mb = mod + (size_t)g0 * 6144 + sc * 1024;
#pragma unroll
                for (int i = 0; i < 4; ++i) { const float4 a4 = *(const float4*)(ma + i * 256 + lane * 4); shr[i * 4] = a4.x; shr[i * 4 + 1] = a4.y; shr[i * 4 + 2] = a4.z; shr[i * 4 + 3] = a4.w;
                    if (mode != 2) { const float4 b4 = *(const float4*)(mb + i * 256 + lane * 4); scr[i * 4] = 1.f + b4.x; scr[i * 4 + 1] = 1.f + b4.y; scr[i * 4 + 2] = 1.f + b4.z; scr[i * 4 + 3] = 1.f + b4.w; } } } }
        float v[NR][16];
#pragma unroll
        for (int q = 0; q < NR; ++q) {
            if (from_input) { const float* xr = xin_row(p, r0 + q);
#pragma unroll
                for (int i = 0; i < 4; ++i) { const float4 t = *(const float4*)(xr + i * 256 + lane * 4); v[q][i * 4] = t.x; v[q][i * 4 + 1] = t.y; v[q][i * 4 + 2] = t.z; v[q][i * 4 + 3] = t.w; } }
            else { const h16* xr = X + (size_t)(r0 + q) * D;
#pragma unroll
                for (int i = 0; i < 4; ++i) { const h16x4 t = *(const h16x4*)(xr + i * 256 + lane * 4);
#pragma unroll
                    for (int j = 0; j < 4; ++j) v[q][i * 4 + j] = (float)t[j]; } } }
        if (mode != 2) {
            h16x4 ya[NR][4];
#pragma unroll
            for (int q = 0; q < NR; ++q)
#pragma unroll
                for (int i = 0; i < 4; ++i) ya[q][i] = *(const h16x4*)(Yb + (size_t)(r0 + q) * D + i * 256 + lane * 4);
#pragma unroll
            for (int q = 0; q < NR; ++q)
#pragma unroll
                for (int i = 0; i < 4; ++i)
#pragma unroll
                    for (int j = 0; j < 4; ++j) v[q][i * 4 + j] = ALPHA * v[q][i * 4 + j] + (float)ya[q][i][j];
            if (Yb2) {
#pragma unroll
                for (int q = 0; q < NR; ++q)
#pragma unroll
                    for (int i = 0; i < 4; ++i) { const h16x4 yb = *(const h16x4*)(Yb2 + (size_t)(r0 + q) * D + i * 256 + lane * 4);
#pragma unroll
                        for (int j = 0; j < 4; ++j) v[q][i * 4 + j] += (float)yb[j]; }
            }
        }
        if (mode == 2) {
#pragma unroll
            for (int q = 0; q < NR; ++q) { const int t = r0 + q - MC;
                float add[16];
#pragma unroll
                for (int i = 0; i < 16; ++i) add[i] = 0.f;
#pragma unroll
                for (int k2 = 0; k2 < 2; ++k2) {
                    const int pos = WSP(int, OFF_TOKR)[t * 2 + k2];
                    if (pos < 65536) { const h16* o = WSP(h16, OFF_OUT2) + ((size_t)k2 * ML + t) * 1024;
#pragma unroll
                        for (int i = 0; i < 4; ++i) { const h16x4 a = *(const h16x4*)(o + i * 256 + lane * 4);
#pragma unroll
                            for (int j = 0; j < 4; ++j) add[i * 4 + j] += (float)a[j]; } }
                    else {
#pragma unroll
                        for (int kq = 0; kq < 2; ++kq) { const h16* o = WSP(h16, OFF_OUTP) + ((size_t)kq * 2048 + (pos - 65536)) * 1024;
#pragma unroll
                            for (int i = 0; i < 4; ++i) { const h16x4 a = *(const h16x4*)(o + i * 256 + lane * 4);
#pragma unroll
                                for (int j = 0; j < 4; ++j) add[i * 4 + j] += (float)a[j]; } } }
                }
#pragma unroll
                for (int i = 0; i < 4; ++i) {
#pragma unroll
                    for (int j = 0; j < 4; ++j) v[q][i * 4 + j] = ALPHA * v[q][i * 4 + j] + shr[i * 4 + j] * add[i * 4 + j]; } }
        }
#pragma unroll
        for (int q = 0; q < NR; ++q) {
            const int r = r0 + q, g = row_group(r);
            float s = 0.f;
#pragma unroll
            for (int i = 0; i < 16; ++i) s += v[q][i];
#pragma unroll
            for (int o = 32; o >= 1; o >>= 1) s += __shfl_xor(s, o);
            const float mean = s * (1.0f / 1024.0f); float qq = 0.f;
#pragma unroll
            for (int i = 0; i < 16; ++i) { const float dlt = v[q][i] - mean; qq += dlt * dlt; }
#pragma unroll
            for (int o = 32; o >= 1; o >>= 1) qq += __shfl_xor(qq, o);
            const float rstd = rsqrtf(qq * (1.0f / 1024.0f) + 1e-5f);
            float lg8[8];
#pragma unroll
            for (int e = 0; e < 8; ++e) lg8[e] = 0.f;
#pragma unroll
            for (int i = 0; i < 4; ++i) {
                const int d = i * 256 + lane * 4; float gv[4], bv[4]; float y[4];
                if (hoist) {
#pragma unroll
                    for (int j = 0; j < 4; ++j) { gv[j] = gmr[i * 4 + j]; bv[j] = ber[i * 4 + j]; } }
                else { const float4 gg = *(const float4*)(gam + d), bb = *(const float4*)(bet + d); gv[0] = gg.x; gv[1] = gg.y; gv[2] = gg.z; gv[3] = gg.w; bv[0] = bb.x; bv[1] = bb.y; bv[2] = bb.z; bv[3] = bb.w; }
#pragma unroll
                for (int j = 0; j < 4; ++j) y[j] = (v[q][i * 4 + j] - mean) * rstd * gv[j] + bv[j];
                if (mode == 2) { *(float4*)(p.out + (size_t)(r - MC) * D + d) = make_float4(y[0], y[1], y[2], y[3]); continue; }
                { h16x4 xo; xo[0] = (h16)y[0]; xo[1] = (h16)y[1]; xo[2] = (h16)y[2]; xo[3] = (h16)y[3]; *(h16x4*)(X + (size_t)r * D + d) = xo; }
                float msv[4], mcv[4]; float hh[4]; h16x4 ho;
                if (hoist) {
#pragma unroll
                    for (int j = 0; j < 4; ++j) { msv[j] = shr[i * 4 + j]; mcv[j] = scr[i * 4 + j]; } }
                else { const float4 ms = *(const float4*)(mod + (size_t)g * 6144 + sh * 1024 + d), mc = *(const float4*)(mod + (size_t)g * 6144 + sc * 1024 + d);
                    msv[0] = ms.x; msv[1] = ms.y; msv[2] = ms.z; msv[3] = ms.w; mcv[0] = 1.f + mc.x; mcv[1] = 1.f + mc.y; mcv[2] = 1.f + mc.z; mcv[3] = 1.f + mc.w; }
#pragma unroll
                for (int j = 0; j < 4; ++j) { hh[j] = y[j] * mcv[j] + msv[j]; ho[j] = (h16)hh[j]; }
                if (h8) { float hc[4];
#pragma unroll
                    for (int j = 0; j < 4; ++j) hc[j] = __builtin_fminf(__builtin_fmaxf(hh[j], -448.f), 448.f);
                    int pk = __builtin_amdgcn_cvt_pk_fp8_f32(hc[0], hc[1], 0, false); pk = __builtin_amdgcn_cvt_pk_fp8_f32(hc[2], hc[3], pk, true);
                    *(int*)((unsigned char*)(A + (size_t)r * AW + AH) + d) = pk; }
                else *(h16x4*)(A + (size_t)r * AW + AH + d) = ho;
                if (h8c) *(int*)(h8c + (size_t)r * 1024 + d) = f8pack4(hh[0], hh[1], hh[2], hh[3]);
                if (mode == 1) {
#pragma unroll
                    for (int e = 0; e < 8; ++e) { const float4 w = *(const float4*)(rtT + e * 1024 + d); lg8[e] += hh[0] * w.x + hh[1] * w.y + hh[2] * w.z + hh[3] * w.w; if (e & 1) asm volatile("" ::: "memory"); }
                }
            }
            if (mode == 1) {
                float v4[4], v2[2], v1;
#pragma unroll
                for (int i = 0; i < 4; ++i) { const float a = lg8[i], b = lg8[i + 4]; const float snd = (lane & 32) ? a : b, kp = (lane & 32) ? b : a; v4[i] = kp + __shfl_xor(snd, 32); }
#pragma unroll
                for (int i = 0; i < 2; ++i) { const float a = v4[i], b = v4[i + 2]; const float snd = (lane & 16) ? a : b, kp = (lane & 16) ? b : a; v2[i] = kp + __shfl_xor(snd, 16); }
                { const float a = v2[0], b = v2[1]; const float snd = (lane & 8) ? a : b, kp = (lane & 8) ? b : a; v1 = kp + __shfl_xor(snd, 8); }
                v1 += __shfl_xor(v1, 4); v1 += __shfl_xor(v1, 2); v1 += __shfl_xor(v1, 1);
#pragma unroll
                for (int e = 0; e < 8; ++e) lg8[e] = __shfl(v1, (e >> 2) * 32 + ((e >> 1) & 1) * 16 + (e & 1) * 8) + p.moe_router_b[e];
                if (lane == 0) {
                    int i0 = 0; float v0 = lg8[0];
#pragma unroll
                    for (int e = 1; e < 8; ++e) if (lg8[e] > v0) { v0 = lg8[e]; i0 = e; }
                    int i1 = -1; float v1 = -INFINITY;
#pragma unroll
                    for (int e = 0; e < 8; ++e) if (e != i0 && lg8[e] > v1) { v1 = lg8[e]; i1 = e; }
                    const float p1 = 1.0f / (1.0f + expf(v0 - v1)), p0 = 1.0f - p1;
                    const int t = r - MC, li = trip * (8 * NR) + wv * NR + q;
                    const int k0 = atomicAdd(&lcnt[i0], 1), k1 = atomicAdd(&lcnt[i1], 1);
                    WSP(int, OFF_TOKE)[t * 2] = i0; WSP(int, OFF_TOKE)[t * 2 + 1] = i1; WSP(float, OFF_TOKP)[t * 2] = p0; WSP(float, OFF_TOKP)[t * 2 + 1] = p1;
                    lrank[li * 4] = i0; lrank[li * 4 + 1] = k0; lrank[li * 4 + 2] = i1; lrank[li * 4 + 3] = k1;
                }
            }
        }
    }
    if (mode == 1) {
        __syncthreads();
        if (threadIdx.x < 8) lbase[threadIdx.x] = atomicAdd(WSP(int, OFF_CNT) + threadIdx.x, lcnt[threadIdx.x]);
        __syncthreads();
        for (int li = threadIdx.x; li < trip * (8 * NR); li += NTH) {
            const int r = r_begin + c * (8 * NR) + (li % (8 * NR)) + (li / (8 * NR)) * G * (8 * NR); if (r >= r_end) continue;
            const int t = r - MC;
            WSP(int, OFF_TOKR)[t * 2] = lbase[lrank[li * 4]] + lrank[li * 4 + 1]; WSP(int, OFF_TOKR)[t * 2 + 1] = lbase[lrank[li * 4 + 2]] + lrank[li * 4 + 3];
        }
    }
}
__device__ __forceinline__ void ph_moe_gather(const Params& p, char* shm, int G, int c) {
    int* sp = (int*)shm; int* plan = WSP(int, OFF_PLAN); const int* cnt = WSP(int, OFF_CNT); int* rowT = WSP(int, OFF_ROWT);
    const int tid = threadIdx.x;
    __syncthreads();
    if (tid == 0) { int acc = 0; for (int e = 0; e < 8; ++e) { sp[e] = acc; const int np = (cnt[e] + 255) / 256; if (c == 0) { plan[e] = acc; for (int q = 0; q < np; ++q) plan[16 + acc / 256 + q] = e; } acc += np * 256; } sp[8] = acc; if (c == 0) plan[8] = acc / 256; }
    __syncthreads();
    if (c == 0) for (int e = 0; e < 8; ++e) { const int a = sp[e] + cnt[e], b = sp[e + 1]; for (int i = a + tid; i < b; i += NTH) rowT[i] = -1; }
    const h16* A = WSP(h16, OFF_A); h16* Xg = WSP(h16, OFF_XG);
    const int lane = tid & 63, wv = tid >> 6;
    for (int it0 = (c * 8 + wv) * 4; it0 < ML * 2; it0 += G * 32) {
        u32x4 v0[4]; int pos[4];
#pragma unroll
        for (int q = 0; q < 4; ++q) { const int it = it0 + q, t = it >> 1; pos[q] = sp[WSP(int, OFF_TOKE)[it]] + WSP(int, OFF_TOKR)[it];
            const unsigned char* src = (const unsigned char*)(A + (size_t)(MC + t) * AW + AH); v0[q] = *(const u32x4*)(src + lane * 16); }
#pragma unroll
        for (int q = 0; q < 4; ++q) { unsigned char* dst = (unsigned char*)Xg + (size_t)pos[q] * 1024; *(u32x4*)(dst + lane * 16) = v0[q];
            if (lane == 0) { WSP(int, OFF_ROWT)[pos[q]] = it0 + q; WSP(float, OFF_ROWP)[pos[q]] = WSP(float, OFF_TOKP)[it0 + q]; WSP(int, OFF_TOKR)[it0 + q] = pos[q]; } }
    }
}

typedef float f32x16 __attribute__((ext_vector_type(16)));
constexpr int XCP = 520;
constexpr int LRU_XC = 0, LRU_LG = 64 * XCP * 2, LRU_CIN = 2 * 64 * XCP * 2;
__device__ __forceinline__ void lru_wt_prep(const Params& p, int G, int c) {
    h16* WT = WSP(h16, OFF_LRUWT);
    for (int u = c; u < 64; u += G) {
        const int blk = u & 7, gate = (u >> 3) & 1, ld = u >> 4;
        const float* W = (gate ? p.lru_wx : p.lru_wa) + ((size_t)ld * 8 + blk) * 4096;
        for (int o = threadIdx.x; o < 4096; o += NTH) { const int j = o >> 6, i = o & 63; WT[(size_t)u * 4096 + o] = (h16)W[i * 64 + j]; }
    }
}
template <int PASS> __device__ __forceinline__ void lru_unit(const Params& p, char* shm, int l, int b, int k) {
    const int tid = threadIdx.x, lane = tid & 63, h = __builtin_amdgcn_readfirstlane(tid >> 6), n = lane & 31, hi = lane >> 5;
    const h16* Z = WSP(h16, OFF_Z);
    const bool isctx = k < 4; const int s0 = isctx ? b * CTX : MC + b * SEQ, len = isctx ? CTX : SEQ, t0 = isctx ? k * 64 : (k - 4) * 64, row0 = s0 + t0;
    h16* xcs = (h16*)(shm + LRU_XC); h16* lgs = (h16*)(shm + LRU_LG); float* cins = (float*)(shm + LRU_CIN);
    const int uidx = b * 68 + k; char* lau_base = uidx < 512 ? (char*)p.out + (size_t)uidx * 262144 : p.ws + OFF_LAU_TAIL + (size_t)(uidx - 512) * 262144;
    __syncthreads();
    {
        const int cg = tid & 63, ts = tid >> 6, ch0 = cg * 8;
        if (PASS == 1) {
        float cw[4][8], cb[8];
#pragma unroll
        for (int q = 0; q < 4; ++q) { const float4 a = *(const float4*)(p.conv_w + (size_t)(l * 4 + q) * 512 + ch0), b2 = *(const float4*)(p.conv_w + (size_t)(l * 4 + q) * 512 + ch0 + 4);
            cw[q][0] = a.x; cw[q][1] = a.y; cw[q][2] = a.z; cw[q][3] = a.w; cw[q][4] = b2.x; cw[q][5] = b2.y; cw[q][6] = b2.z; cw[q][7] = b2.w; }
        { const float4 a = *(const float4*)(p.conv_b + l * 512 + ch0), b2 = *(const float4*)(p.conv_b + l * 512 + ch0 + 4); cb[0] = a.x; cb[1] = a.y; cb[2] = a.z; cb[3] = a.w; cb[4] = b2.x; cb[5] = b2.y; cb[6] = b2.z; cb[7] = b2.w; }
        h16x8 v[11];
#pragma unroll
        for (int i = 0; i < 11; ++i) { const int pos = t0 + ts * 8 - 2 + i; const bool ok = pos >= 0 && pos < len;
            h16x8 z8 = {0, 0, 0, 0, 0, 0, 0, 0}; if (ok) z8 = *(const h16x8*)(Z + (size_t)(s0 + pos) * ZW + ZLX + ch0); v[i] = z8; }
#pragma unroll
        for (int tt = 0; tt < 8; ++tt) { h16x8 o;
#pragma unroll
            for (int j = 0; j < 8; ++j) { float acc = cb[j];
#pragma unroll
                for (int q = 0; q < 4; ++q) acc += cw[q][j] * (float)v[tt + q][j];
                o[j] = (h16)acc; }
            *(h16x8*)(xcs + (ts * 8 + tt) * XCP + ch0) = o; }
        }
        if (PASS == 3) {
#pragma unroll
            for (int tt = 0; tt < 8; ++tt) *(h16x8*)(lgs + (ts * 8 + tt) * XCP + ch0) = *(const h16x8*)(Z + (size_t)(row0 + ts * 8 + tt) * ZW + ZLG + ch0);
            const float* P0 = WSP(float, OFF_LRUP) + (size_t)(b * 2 + 0) * 68 * 512 + tid; const float* H0 = WSP(float, OFF_LRUH) + (size_t)(b * 2 + 0) * 68 * 512 + tid;
            float S = 0.f;
            for (int j0 = 0; j0 < k; j0 += 8) { float pp[8], hh[8];
#pragma unroll
                for (int q = 0; q < 8; ++q) { const int j = j0 + q < k ? j0 + q : 0; pp[q] = P0[(size_t)j * 512]; hh[q] = H0[(size_t)j * 512]; }
#pragma unroll
                for (int q = 0; q < 8; ++q) if (j0 + q < k) S = pp[q] * S + hh[q]; }
            cins[tid] = S;
            const float* P1 = P0 + (size_t)68 * 512; const float* H1 = H0 + (size_t)68 * 512;
            const int nb = isctx ? 3 - k : 71 - k;
            S = 0.f;
            for (int s0_ = 0; s0_ < nb; s0_ += 8) { float pp[8], hh[8];
#pragma unroll
                for (int q = 0; q < 8; ++q) { const int s = s0_ + q < nb ? s0_ + q : 0; const int j = s < 4 ? 3 - s : 71 - s; pp[q] = P1[(size_t)j * 512]; hh[q] = H1[(size_t)j * 512]; }
#pragma unroll
                for (int q = 0; q < 8; ++q) if (s0_ + q < nb) S = pp[q] * S + hh[q]; }
            cins[512 + tid] = S;
        }
    }
    __syncthreads();
    const h16* WT = WSP(h16, OFF_LRUWT) + (size_t)l * 4 * 8 * 4096;
#define LMFMA(a, b, c) __builtin_amdgcn_mfma_f32_32x32x16_f16(a, b, c, 0, 0, 0)
#pragma unroll 1
    for (int ct = 0; ct < 2; ++ct) {
        const int cbase = h * 64 + ct * 32, ch = cbase + n;
        f32x16 xD[2], gD[2], hs[2];
#pragma unroll
        for (int rt = 0; rt < 2; ++rt) { xD[rt] = f32x16{}; gD[rt] = f32x16{}; hs[rt] = f32x16{}; }
        if (PASS == 1) {
#pragma unroll
        for (int s = 0; s < 2; ++s) { h16x8 id;
#pragma unroll
            for (int j = 0; j < 8; ++j) id[j] = (n == s * 16 + hi * 8 + j) ? (h16)1.0f : (h16)0.0f;
#pragma unroll
            for (int rt = 0; rt < 2; ++rt) { const h16x8 a = *(const h16x8*)(xcs + (rt * 32 + n) * XCP + cbase + s * 16 + hi * 8); xD[rt] = LMFMA(a, id, xD[rt]); } }
        }
#pragma unroll
        for (int dir = 0; dir < 2; ++dir) {
            f32x16 R[2], I[2];
            unsigned w32[32];
            u32x4* lau = (u32x4*)(lau_base + ((size_t)(h * 4 + ct * 2 + dir)) * 8192 + lane * 16);
            if (PASS == 1) {
#pragma unroll
                for (int rt = 0; rt < 2; ++rt) { R[rt] = f32x16{}; I[rt] = f32x16{}; }
                const h16* wa = WT + ((size_t)(dir * 2 + 0) * 8 + h) * 4096 + (ct * 32 + n) * 64 + hi * 8;
                const h16* wx = WT + ((size_t)(dir * 2 + 1) * 8 + h) * 4096 + (ct * 32 + n) * 64 + hi * 8;
#pragma unroll
                for (int ks = 0; ks < 4; ++ks) { const h16x8 ba8 = *(const h16x8*)(wa + ks * 16), bx8 = *(const h16x8*)(wx + ks * 16);
#pragma unroll
                    for (int rt = 0; rt < 2; ++rt) { const h16x8 a = *(const h16x8*)(xcs + (rt * 32 + n) * XCP + h * 64 + ks * 16 + hi * 8); R[rt] = LMFMA(a, ba8, R[rt]); I[rt] = LMFMA(a, bx8, I[rt]); } }
                const int pi = (l * 2 + dir) * 512 + ch;
                const float ba = p.lru_ba[pi], bx = p.lru_bx[pi], spl = log1pf(__expf(-p.lru_lambda[pi])) * (-8.0f * 1.4426950408889634f);
#pragma unroll
                for (int rt = 0; rt < 2; ++rt)
#pragma unroll
                    for (int r = 0; r < 16; ++r) { const float rg = sigmoidf_(R[rt][r] + ba), ig = sigmoidf_(I[rt][r] + bx);
                        const float la2 = rg * spl, a = __builtin_amdgcn_exp2f(la2), uu = __builtin_amdgcn_sqrtf(fmaxf(1.0f - a * a, 0.f)) * ig * xD[rt][r];
                        w32[rt * 16 + r] = pg8::cvt_pk_f16(la2, uu); }
#pragma unroll
                for (int j = 0; j < 8; ++j) { u32x4 t; t.x = w32[4 * j]; t.y = w32[4 * j + 1]; t.z = w32[4 * j + 2]; t.w = w32[4 * j + 3]; lau[j * 64] = t; }
            } else {
#pragma unroll
                for (int j = 0; j < 8; ++j) { const u32x4 t = lau[j * 64]; w32[4 * j] = t.x; w32[4 * j + 1] = t.y; w32[4 * j + 2] = t.z; w32[4 * j + 3] = t.w; }
            }
#pragma unroll
            for (int rt = 0; rt < 2; ++rt)
#pragma unroll
                for (int r = 0; r < 16; ++r) { const h16x2 pr = __builtin_bit_cast(h16x2, w32[rt * 16 + r]); R[rt][r] = __builtin_amdgcn_exp2f((float)pr[0]); I[rt][r] = (float)pr[1]; }
            float Pg[8], Hg[8], Po[8], Ho[8];
#pragma unroll
            for (int q = 0; q < 8; ++q) { const int rt = q >> 2, r0 = (q & 3) * 4; float P = 1.f, H = 0.f;
#pragma unroll
                for (int i = 0; i < 4; ++i) { const int r = r0 + (dir ? 3 - i : i); P *= R[rt][r]; H = R[rt][r] * H + I[rt][r]; }
                Pg[q] = P; Hg[q] = H; }
#pragma unroll
            for (int q = 0; q < 8; ++q) {
                const auto rp = __builtin_amdgcn_permlane32_swap(__float_as_uint(Pg[q]), __float_as_uint(Pg[q]), false, false); Po[q] = __uint_as_float(hi ? rp[0] : rp[1]);
                const auto rh = __builtin_amdgcn_permlane32_swap(__float_as_uint(Hg[q]), __float_as_uint(Hg[q]), false, false); Ho[q] = __uint_as_float(hi ? rh[0] : rh[1]); }
            float S = (PASS == 3) ? cins[dir * 512 + ch] : 0.f, Pt = 1.f; float cg[8];
#pragma unroll
            for (int s2 = 0; s2 < 16; ++s2) { const int Gi = dir ? 15 - s2 : s2, q = Gi >> 1, own = Gi & 1;
                const float Pq = (hi == own) ? Pg[q] : Po[q], Hq = (hi == own) ? Hg[q] : Ho[q];
                if (hi == own) cg[q] = S;
                S = Pq * S + Hq; Pt *= Pq; }
            if (PASS == 1) { if (hi == 0) { WSP(float, OFF_LRUP)[((size_t)(b * 2 + dir) * 68 + k) * 512 + ch] = Pt; WSP(float, OFF_LRUH)[((size_t)(b * 2 + dir) * 68 + k) * 512 + ch] = S; } }
            else {
#pragma unroll
                for (int q = 0; q < 8; ++q) { const int rt = q >> 2, r0 = (q & 3) * 4; float hh = cg[q];
#pragma unroll
                    for (int i = 0; i < 4; ++i) { const int r = r0 + (dir ? 3 - i : i); hh = R[rt][r] * hh + I[rt][r]; hs[rt][r] += hh; } }
            }
        }
        if (PASS == 3) {
#pragma unroll
            for (int s = 0; s < 2; ++s) { h16x8 id;
#pragma unroll
                for (int j = 0; j < 8; ++j) id[j] = (n == s * 16 + hi * 8 + j) ? (h16)1.0f : (h16)0.0f;
#pragma unroll
                for (int rt = 0; rt < 2; ++rt) { const h16x8 a2 = *(const h16x8*)(lgs + (rt * 32 + n) * XCP + cbase + s * 16 + hi * 8); gD[rt] = LMFMA(a2, id, gD[rt]); } }
#pragma unroll
            for (int rt = 0; rt < 2; ++rt)
#pragma unroll
                for (int r = 0; r < 16; ++r) { const float x = gD[rt][r]; const float u2 = 1.5957691216057308f * (x + 0.044715f * x * x * x);
                    lgs[(rt * 32 + (r & 3) + 8 * (r >> 2) + 4 * hi) * XCP + ch] = (h16)(hs[rt][r] * x * sigmoidf_(u2)); }
        }
    }
#undef LMFMA
    if (PASS == 3) {
        __syncthreads();
        h16* A = WSP(h16, OFF_A); const int cg = tid & 63, ts = tid >> 6, ch0 = cg * 8;
#pragma unroll
        for (int tt = 0; tt < 8; ++tt) *(h16x8*)(A + (size_t)(row0 + ts * 8 + tt) * AW + AY2 + ch0) = *(const h16x8*)(lgs + (ts * 8 + tt) * XCP + ch0);
    }
}
template <int PASS> __device__ __forceinline__ void ph_lru(const Params& p, char* shm, int l, int G, int c) {
    int* head = WSP(int, OFF_CNT) + 16 + l * 2 + (PASS == 3 ? 1 : 0); volatile int* slot = (volatile int*)(shm + 138240);
    for (;;) {
        __syncthreads();
        if (threadIdx.x == 0) *slot = atomicAdd(head, 1);
        __syncthreads();
        const int u = *slot; if (u >= NB * 68) break;
        lru_unit<PASS>(p, shm, l, u / 68, u % 68);
    }
}

__device__ __forceinline__ void ph_thin(const Params& p, char* shm, int l, int rb, int G, int c) {
    int* head = WSP(int, OFF_CNT) + 16 + l * 2; volatile int* slot = (volatile int*)(shm + 138240);
    const int NL = NB * 68, NQ = MT / 64, NP = (MT - rb) / 64;
    __syncthreads();
    rope_table(shm);
    for (;;) {
        __syncthreads();
        if (threadIdx.x == 0) *slot = atomicAdd(head, 1);
        __syncthreads();
        const int u = *slot; if (u >= NL + NQ + NP) break;
        if (u < NL) lru_unit<1>(p, shm, l, u / 68, u % 68);
        else if (u < NL + NQ) qkv_block(p, shm, l, (u - NL) * 64);
        else pool_block(p, rb + (u - NL - NQ) * 64);
    }
}

constexpr int XB_LDS_OFF = LDS_BYTES - 16;
__global__ void __launch_bounds__(512, 2) k_mega(Params p, int lo, int hi) {
    extern __shared__ __attribute__((aligned(16))) unsigned char shm[];
    LAS unsigned char* lds = (LAS unsigned char*)shm;
    const int G = gridDim.x, c = blockIdx.x;
    if (threadIdx.x == 0) { *(uint4*)(shm + XB_LDS_OFF) = make_uint4(0u, 0u, 0u, 0u); *(uint4*)(shm + 147424) = make_uint4(0u, 0u, 0u, 0u); }
    __syncthreads();
    XcdBarrier bar = xcd_barrier_post(WSP(unsigned, OFF_BAR), (volatile LAS unsigned*)(lds + XB_LDS_OFF));
    int ph = 0;
#ifndef REP_MASK
#define REP_MASK 0
#endif
#define REP(bit, call) do { call; if (REP_MASK & (bit)) { __syncthreads(); call; } } while (0)
#ifndef PROBE_MASK
#define PROBE_MASK 0u
#endif
    unsigned long long t_acc = 0ull, t_0 = 0ull;
#define PHASE(body) do { if (ph >= lo && ph < hi) { const bool pr_ = ((PROBE_MASK >> ph) & 1u) != 0u; if (pr_) t_0 = __builtin_amdgcn_s_memrealtime(); \
        body; if (ph + 1 < hi) { xcd_barrier(bar); if (REP_MASK & 8) xcd_barrier(bar); } if (pr_) t_acc += __builtin_amdgcn_s_memrealtime() - t_0; } ++ph; } while (0)
    PHASE(REP(4, ph_prologue(p, (char*)shm, G, c)));
    PHASE(REP(4, ph_h0(p, (char*)shm, G, c)));
    {
        const float* ln1g = p.ln1_g; const float* ln1b = p.ln1_b; const float* ln2g = p.ln2_g; const float* ln2b = p.ln2_b;
        PHASE(REP(1, ph_gemm_in(p, lds, 0, G, c)));
        PHASE(ph_thin(p, (char*)shm, 0, 0, G, c));
        PHASE(REP(512, ph_attn(p, (char*)shm, 0, G, c)); REP(256, ph_lru<3>(p, (char*)shm, 0, G, c)));
        PHASE(ph_gates(p, lds, 0, 0, 136, G, c));
        PHASE(ph_merge(p, lds, 0, 8, 128, G, c));
        PHASE(if (c < 64) ph_merge(p, lds, 0, 0, 8, 64, c); else ph_wout(p, lds, 0, 8, 128, G - 64, c - 64));
        PHASE(if (c < 16) ph_wout(p, lds, 0, 0, 8, 16, c); else ph_ln<4>(p, (char*)shm, 0, MC, MT, ln1g, ln1b, 0, 3, 4, YW_base(p, 0), true, G - 16, c - 16, nullptr, true));
        PHASE(ph_ln<1>(p, (char*)shm, 0, 0, MC, ln1g, ln1b, 0, 3, 4, YW_base(p, 0), true, G, c, nullptr, true); ph_ffn_gu(p, lds, 8, 128, G, c));
        PHASE(ph_ffn_gu(p, lds, 0, 8, G, c));
    PHASE(ph_ffn_down(p, lds, 8, 128, G, c));
        PHASE(if (c < 32) ph_ffn_down_k2(p, lds, 0, 8, 32, c); else ph_ln<4>(p, (char*)shm, 0, MC, MT, ln2g, ln2b, 1, 0, 1, (const h16*)p.out, false, G - 32, c - 32, nullptr, false, WSP(unsigned char, OFF_H8)));
        PHASE(ph_ln<1>(p, (char*)shm, 0, 0, MC, ln2g, ln2b, 1, 0, 1, (const h16*)p.out, false, G, c, WSP(h16, OFF_Y2CTX), false, WSP(unsigned char, OFF_H8)));
    }
    {
        const float* ln1g = p.ln1_g + D; const float* ln1b = p.ln1_b + D; const float* ln2g = p.ln2_g + D; const float* ln2b = p.ln2_b + D;
        PHASE(REP(1, ph_gemm_in(p, lds, 1, G, c)));
        PHASE(ph_thin(p, (char*)shm, 1, MC, G, c));
        PHASE(REP(512, ph_attn(p, (char*)shm, 1, G, c)); REP(256, ph_lru<3>(p, (char*)shm, 1, G, c)));
        PHASE(ph_gates(p, lds, 1, 8, 128, G, c));
        PHASE(REP(1, ph_merge(p, lds, 1, 8, 128, G, c)));
        PHASE(ph_wout(p, lds, 1, 8, 128, G, c));
        PHASE(ph_ln<2>(p, (char*)shm, 1, MC, MT, ln1g, ln1b, 1, 3, 4, YW_base(p, 1), false, G, c, nullptr, true); cvt_jobs(p, NJOBS_SMALL, NJOBS_ALL, 0, G, c, (float (*)[129])shm));
        PHASE(ph_moe_gather(p, (char*)shm, G, c));
        for (int chn = 0; chn < 3; ++chn) {
            PHASE(REP(1, ph_moe_gu(p, lds, chn * 128, G, c)));
            PHASE(REP(1, ph_moe_down(p, lds, chn * 128, G, c)));
        }
        PHASE(ph_ln<2>(p, (char*)shm, 2, MC, MT, ln2g, ln2b, 1, 0, 1, (const h16*)0, false, G, c));
    }
    if (PROBE_EPI != 0) { t_acc = ((LAS unsigned long long*)(lds + 147424))[0]; }
    if ((PROBE_MASK != 0u || PROBE_EPI != 0) && blockIdx.x == 0 && threadIdx.x == 0) { const unsigned long long t_e = __builtin_amdgcn_s_memrealtime(); while (__builtin_amdgcn_s_memrealtime() - t_e < 3ull * t_acc) __builtin_amdgcn_s_sleep(8); }
#undef PHASE
}
constexpr int NPHASES = 2 + 12 + (6 + 2 + 6 + 1);

#ifndef MEGA_LAUNCHES
#define MEGA_LAUNCHES 1
#endif
extern "C" void kernel_launch(void* const* d_in, const int* in_sizes, int n_in, void* d_out, int out_size, void* d_ws, size_t ws_size, hipStream_t stream) {
    (void)in_sizes; (void)n_in; (void)out_size;
    if (ws_size < WS_NEED) return;
    Params p;
    const float** pp = (const float**)&p;
    for (int i = 0; i < 33; ++i) pp[i] = (const float*)d_in[i];
    p.out = (float*)d_out; p.ws = (char*)d_ws;
    static int grid = 0;
    if (!grid) {
        int dev = 0, cus = 0, per_cu = 0;
        hipGetDevice(&dev);
        hipDeviceGetAttribute(&cus, hipDeviceAttributeMultiprocessorCount, dev);
        hipFuncSetAttribute((const void*)k_mega, hipFuncAttributeMaxDynamicSharedMemorySize, LDS_BYTES);
        hipOccupancyMaxActiveBlocksPerMultiprocessor(&per_cu, (const void*)k_mega, 512, LDS_BYTES);
        grid = (per_cu >= 1 && cus > 0) ? cus : -1;
    }
    if (grid <= 0) return;
    hipMemsetAsync(p.ws + OFF_BAR, 0, XCD_BAR_WORDS * sizeof(unsigned), stream);
#if MEGA_LAUNCHES == 1
    k_mega<<<grid, 512, LDS_BYTES, stream>>>(p, 0, NPHASES);
#else
    for (int ph = 0; ph < NPHASES; ++ph) k_mega<<<grid, 512, LDS_BYTES, stream>>>(p, ph, ph + 1);
#endif
}
```
